# Optimizing an MI355X kernel written in HIP

```python
import jax, jax.numpy as jnp
from jax import lax
import numpy as np

D_MODEL = 1024
BATCH = 4
SEQ = 8192
DEPTH = 1

HEAD_DIM = 64
SB_HEADS = 8
DIL_GROUPS = ((128, 1), (512, 4), (2048, 16))
DIL_HEADS_PER_GROUP = 4
N_DIL_GROUPS = len(DIL_GROUPS)
DIL_HEADS = DIL_HEADS_PER_GROUP * N_DIL_GROUPS
SB_WIDTH = SB_HEADS * HEAD_DIM
DIL_WIDTH = DIL_HEADS * HEAD_DIM
DIL_OUT_WIDTH = DIL_HEADS_PER_GROUP * HEAD_DIM
IN_COLS = 3 * SB_WIDTH + 3 * DIL_WIDTH + 2 * D_MODEL
Q_BLOCK = 128
ROPE_THETA = 10000.0
PEER_HEADS = 8
PEER_NKEYS = 128
PEER_EXPERTS = PEER_NKEYS * PEER_NKEYS
PEER_QDIM = 256
PEER_HALF = PEER_QDIM // 2
PEER_TOPK = 16
PEER_TOKEN_CHUNK = 128
N_MOD = 6
EPS = 1e-6

kernel_name = "hybrid_stickbreak_dilated_peer_adaln"


def rms_norm(x, g):
    xf = x.astype(jnp.float32)
    y = xf * lax.rsqrt(jnp.mean(xf * xf, axis=-1, keepdims=True) + EPS)
    return (y * g.astype(jnp.float32)).astype(x.dtype)


def modulate(h, shift, scale):
    return h * (1.0 + scale[:, None, :]) + shift[:, None, :]


def rope(x, pos):
    half = HEAD_DIM // 2
    inv = ROPE_THETA ** (-jnp.arange(half, dtype=jnp.float32) / half)
    ang = pos.astype(jnp.float32)[:, None] * inv[None, :]
    cos = jnp.cos(ang)[None, :, None, :]
    sin = jnp.sin(ang)[None, :, None, :]
    xf = x.astype(jnp.float32)
    x1, x2 = xf[..., :half], xf[..., half:]
    return jnp.concatenate([x1 * cos - x2 * sin, x1 * sin + x2 * cos], axis=-1).astype(x.dtype)


def stick_breaking_attention(q, k, v):
    S = q.shape[1]
    scale = HEAD_DIM ** -0.5
    outs = []
    for blk in range(S // Q_BLOCK):
        t0 = blk * Q_BLOCK
        kl = t0 + Q_BLOCK
        qb, kb, vb = q[:, t0:kl], k[:, :kl], v[:, :kl]
        z = jnp.einsum('bqhd,bkhd->bhqk', qb, kb).astype(jnp.float32) * scale
        t_idx = t0 + jnp.arange(Q_BLOCK)
        s_idx = jnp.arange(kl)
        mask = s_idx[None, :] < t_idx[:, None]
        log_1m_beta = jnp.where(mask, jax.nn.log_sigmoid(-z), 0.0)
        after = lax.cumsum(log_1m_beta, axis=3, reverse=True) - log_1m_beta
        a = jnp.where(mask, jnp.exp(jax.nn.log_sigmoid(z) + after), 0.0)
        outs.append(jnp.einsum('bhqk,bkhd->bqhd', a.astype(v.dtype), vb))
    return jnp.concatenate(outs, axis=1)


def dilated_attention(q, k, v):
    B, S = q.shape[:2]
    scale = HEAD_DIM ** -0.5
    n_blocks = S // Q_BLOCK

    def block(blk):
        t = blk * Q_BLOCK + jnp.arange(Q_BLOCK)
        qb = lax.dynamic_slice_in_dim(q, blk * Q_BLOCK, Q_BLOCK, axis=1)
        outs, lses = [], []
        for g, (w, r) in enumerate(DIL_GROUPS):
            n = w // r + 1
            idx = t[:, None] - r * jnp.arange(n)[None, :]
            valid = idx >= 0
            idx_c = jnp.maximum(idx, 0)
            kg = jnp.take(k[:, :, g], idx_c, axis=1)
            vg = jnp.take(v[:, :, g], idx_c, axis=1)
            z = jnp.einsum('bqhd,bqnhd->bhqn', qb[:, :, g], kg).astype(jnp.float32) * scale
            z = jnp.where(valid[None, None], z, -jnp.inf)
            lse = jax.nn.logsumexp(z, axis=-1)
            p = jnp.exp(z - lse[..., None])
            outs.append(jnp.einsum('bhqn,bqnhd->bqhd', p.astype(vg.dtype), vg).astype(jnp.float32))
            lses.append(lse)
        wts = jax.nn.softmax(jnp.stack(lses, axis=0), axis=0)
        wts = jnp.transpose(wts, (0, 1, 3, 2))[..., None]
        return jnp.sum(wts * jnp.stack(outs, axis=0), axis=0).astype(q.dtype)

    out = lax.map(block, jnp.arange(n_blocks))
    return jnp.transpose(out, (1, 0, 2, 3, 4)).reshape(B, S, DIL_HEADS_PER_GROUP, HEAD_DIM)


def peer_ffn(h, w_pq, peer_keys, peer_u, peer_v):
    B, S, D = h.shape
    T = B * S
    ht = h.reshape(T, D)
    q = (ht @ w_pq).reshape(T, PEER_HEADS, 2, PEER_HALF)
    sub = jnp.einsum('thpc,hpnc->thpn', q, peer_keys).astype(jnp.float32)
    s_top, i_top = lax.top_k(sub, PEER_TOPK)
    cand_s = (s_top[:, :, 0, :, None] + s_top[:, :, 1, None, :]).reshape(T, PEER_HEADS, PEER_TOPK * PEER_TOPK)
    cand_i = (i_top[:, :, 0, :, None] * PEER_NKEYS + i_top[:, :, 1, None, :]).reshape(T, PEER_HEADS, PEER_TOPK * PEER_TOPK)
    best_s, pos = lax.top_k(cand_s, PEER_TOPK)
    expert = jnp.take_along_axis(cand_i, pos, axis=-1)
    gate = jax.nn.softmax(best_s, axis=-1)
    hk = PEER_HEADS * PEER_TOPK
    n_chunks = T // PEER_TOKEN_CHUNK

    def chunk(args):
        xc, ec, gc = args
        u = jnp.take(peer_u, ec, axis=0)
        act = jax.nn.gelu(jnp.einsum('cd,ckd->ck', xc, u))
        vv = jnp.take(peer_v, ec, axis=0)
        return jnp.einsum('ck,ckd->cd', gc.astype(xc.dtype) * act, vv)

    out = lax.map(chunk, (ht.reshape(n_chunks, PEER_TOKEN_CHUNK, D),
                          expert.reshape(n_chunks, PEER_TOKEN_CHUNK, hk),
                          gate.reshape(n_chunks, PEER_TOKEN_CHUNK, hk)))
    return out.reshape(B, S, D)


def setup_inputs(seed: int = 0) -> dict:
    key = jax.random.key(seed)
    ks = jax.random.split(key, 16)
    D = D_MODEL
    f = jnp.float32
    nrm = lambda k, shape, s: jax.random.normal(k, shape, f) * s
    return {
        "x": nrm(ks[0], (BATCH, SEQ, D), 1.0),
        "c": nrm(ks[1], (BATCH, D), 1.0),
        "w_ada": nrm(ks[2], (DEPTH, D, N_MOD * D), 0.5 * D ** -0.5),
        "b_ada": nrm(ks[3], (DEPTH, N_MOD * D), 0.01),
        "g_mix": 1.0 + nrm(ks[4], (DEPTH, D), 0.02),
        "w_in": nrm(ks[5], (DEPTH, D, IN_COLS), D ** -0.5),
        "w_sb_o": nrm(ks[6], (DEPTH, SB_WIDTH, D), SB_WIDTH ** -0.5),
        "w_dil_o": nrm(ks[7], (DEPTH, DIL_OUT_WIDTH, D), DIL_OUT_WIDTH ** -0.5),
        "w_out": nrm(ks[8], (DEPTH, D, D), D ** -0.5),
        "g_ffn": 1.0 + nrm(ks[9], (DEPTH, D), 0.02),
        "w_pq": nrm(ks[10], (DEPTH, D, PEER_HEADS * PEER_QDIM), D ** -0.5),
        "peer_keys": nrm(ks[11], (DEPTH, PEER_HEADS, 2, PEER_NKEYS, PEER_HALF), PEER_HALF ** -0.5),
        "peer_u": nrm(ks[12], (DEPTH, PEER_EXPERTS, D), D ** -0.5),
        "peer_v": nrm(ks[13], (DEPTH, PEER_EXPERTS, D), PEER_HEADS ** -0.5),
        "g_final": 1.0 + nrm(ks[14], (D,), 0.02),
    }


def reference(x, c, w_ada, b_ada, g_mix, w_in, w_sb_o, w_dil_o, w_out, g_ffn, w_pq,
              peer_keys, peer_u, peer_v, g_final):
    B, S, D = x.shape
    pos = jnp.arange(S)
    splits = np.cumsum([SB_WIDTH] * 3 + [DIL_WIDTH] * 3 + [D_MODEL]).tolist()
    for layer in range(DEPTH):
        mod = jax.nn.silu(c) @ w_ada[layer] + b_ada[layer]
        sh1, sc1, gt1, sh2, sc2, gt2 = jnp.split(mod, N_MOD, axis=-1)

        h = modulate(rms_norm(x, g_mix[layer]), sh1, sc1)
        proj = h @ w_in[layer]
        q_sb, k_sb, v_sb, q_d, k_d, v_d, gate_sb, gate_d = jnp.split(proj, splits, axis=-1)

        hs = (B, S, SB_HEADS, HEAD_DIM)
        o_sb = stick_breaking_attention(q_sb.reshape(hs), k_sb.reshape(hs), v_sb.reshape(hs))

        hd = (B, S, DIL_HEADS, HEAD_DIM)
        gd = (B, S, N_DIL_GROUPS, DIL_HEADS_PER_GROUP, HEAD_DIM)
        q_dr = rope(q_d.reshape(hd), pos).reshape(gd)
        k_dr = rope(k_d.reshape(hd), pos).reshape(gd)
        o_d = dilated_attention(q_dr, k_dr, v_d.reshape(gd))

        br_sb = o_sb.reshape(B, S, SB_WIDTH) @ w_sb_o[layer]
        br_d = o_d.reshape(B, S, DIL_OUT_WIDTH) @ w_dil_o[layer]
        merged = jax.nn.sigmoid(gate_sb) * br_sb + jax.nn.sigmoid(gate_d) * br_d
        x = x + gt1[:, None, :] * (merged @ w_out[layer])

        h2 = modulate(rms_norm(x, g_ffn[layer]), sh2, sc2)
        x = x + gt2[:, None, :] * peer_ffn(h2, w_pq[layer], peer_keys[layer], peer_u[layer], peer_v[layer])
    return rms_norm(x, g_final)
```

```cpp
#include <hip/hip_runtime.h>
#include <hip/hip_cooperative_groups.h>
#include <cstdio>
#include <cstdint>
namespace pg8 {
#define PG8_LAS __attribute__((address_space(3)))
typedef unsigned short bf16_t;
typedef short bf16x8 __attribute__((ext_vector_type(8)));
typedef float f32x4 __attribute__((ext_vector_type(4)));
typedef unsigned u32x4 __attribute__((ext_vector_type(4)));
constexpr int BM = 256, BK = 64, HALF = 128, HTB = HALF * BK * 2  , STAGE_BYTES = 8 * HTB, NXCD = 8, WGM = 8;

__host__ __device__ __forceinline__ int lds_byte(int r, int c) { const int st = (r >> 4) * 2 + (c >> 5), rr = r & 15, cc = c & 31, ob = rr * 64 + cc * 2; return st * 1024 + (ob ^ (((ob >> 9) & 1) << 5)); }
__host__ __device__ __forceinline__ void stage_rc(int b, int& R, int& C) { const int st = b / 1024, sb = b % 1024, swz = sb ^ (((sb >> 9) & 1) << 5); R = (st >> 1) * 16 + swz / 64; C = (st & 1) * 32 + (swz % 64) / 2; }
__host__ __device__ __forceinline__ int perm32(int rho) { const int n = rho >> 4, i = rho & 15; return 8 * (i >> 2) + 4 * n + (i & 3); }

struct Unit { int pm, pn; };
struct Gemm { const bf16_t* A; const bf16_t* Bt; int M, N, K; };

struct StaticOrder {
    int nM, nN, nwg, G, c;
    __host__ __device__ void init(int M, int N, int G_, int c_) { nM = M / BM; nN = N / BM; nwg = nM * nN; G = G_; c = c_; }
    __host__ __device__ bool next(int i, Unit& u) const {
        const long L = (long)i * G + c; if (L >= nwg) return false;
        int wgid = (int)L; { const int q = nwg / NXCD, r = nwg % NXCD, xcd = wgid % NXCD, off = wgid / NXCD; wgid = (xcd < r ? xcd * (q + 1) : r * (q + 1) + (xcd - r) * q) + off; }
        const int nig = WGM * nN, gid = wgid / nig, fm = gid * WGM, gsz = (nM - fm) < WGM ? (nM - fm) : WGM;
        u.pm = fm + ((wgid % nig) % gsz); u.pn = (wgid % nig) / gsz; return true;
    }
    __device__ __forceinline__ void a_ready(const Unit&) const {}
    __device__ __forceinline__ void done(const Unit&) const {}
};

__device__ __forceinline__ unsigned cvt_pk_bf16(float lo, float hi) { unsigned r; asm volatile("v_cvt_pk_bf16_f32 %0, %1, %2" : "=v"(r) : "v"(lo), "v"(hi)); return r; }
template <class Epi, class Sched, bool ALIGN_EPI = false, bool SP2 = false>
__device__ __forceinline__ void gemm_phase(PG8_LAS unsigned char* lds, const Gemm g, const Sched& S, const Epi& E) {
    int tid_ = threadIdx.x; asm volatile("" : "+v"(tid_));
    const int tid = tid_, wid = __builtin_amdgcn_readfirstlane(tid >> 6), lane = tid & 63, wr = wid >> 2, wc = wid & 3, fr = lane & 15, fq = lane >> 4;
    const int K = g.K, nt = K / BK;
    unsigned voffA[2], voffB[2];
#pragma unroll
    for (int i = 0; i < 2; ++i) { int R, C; stage_rc(tid * 16 + i * 8192, R, C); const int Rb = Epi::PERM ? ((R & ~31) + perm32(R & 31)) : R;
        voffA[i] = (unsigned)(R * K + C) * 2u; voffB[i] = (unsigned)(Rb * K + C) * 2u; }
    const size_t kstep = (size_t)(BK * 2);
    const size_t hstep = (size_t)HALF * K * 2;
    const size_t tstep = 2 * hstep;
    const unsigned ldsw = (unsigned)wid * 1024u;
    const int aoff = lds_byte(wr * 64 + fr, fq * 8), boff = lds_byte(wc * 32 + fr, fq * 8);
#define PG8_SA(b, h) (((b) * 2 + (h)) * HTB)
#define PG8_SB(b, h) ((4 + (b) * 2 + (h)) * HTB)
#define PG8_STAGE(bufoff, gbase, voff) do { _Pragma("unroll") for (int _i = 0; _i < 2; ++_i) \
        __builtin_amdgcn_global_load_lds((const unsigned*)((const char*)(gbase) + (voff)[_i]), (PG8_LAS unsigned*)(lds + (bufoff) + ldsw + _i * 8192), 16, 0, 0); } while (0)
#define PG8_LDA(dst, b, h) do { _Pragma("unroll") for (int m = 0; m < 4; ++m) _Pragma("unroll") for (int k = 0; k < 2; ++k) dst[m][k] = *(const PG8_LAS bf16x8*)(lds + PG8_SA(b, h) + aoff + m * 2048 + k * 1024); } while (0)
#define PG8_LDB(dst, b, h) do { _Pragma("unroll") for (int n = 0; n < 2; ++n) _Pragma("unroll") for (int k = 0; k < 2; ++k) dst[n][k] = *(const PG8_LAS bf16x8*)(lds + PG8_SB(b, h) + boff + n * 2048 + k * 1024); } while (0)
#define PG8_MMA(ai, bj, At, Bt) do { __builtin_amdgcn_s_setprio(1); _Pragma("unroll") for (int m = 0; m < 4; ++m) _Pragma("unroll") for (int n = 0; n < 2; ++n) _Pragma("unroll") for (int k = 0; k < 2; ++k) \
        acc[ai][bj][m][n] = __builtin_amdgcn_mfma_f32_16x16x32_bf16(Bt[n][k], At[m][k], acc[ai][bj][m][n], 0, 0, 0); __builtin_amdgcn_s_setprio(0); } while (0)
#define PG8_WAIT_V(n) asm volatile("s_waitcnt vmcnt(" #n ")" ::: "memory")
#define PG8_WAIT_L(n) asm volatile("s_waitcnt lgkmcnt(" #n ")" ::: "memory")
#define PG8_BAR __builtin_amdgcn_s_barrier()
#define PG8_SCHED __builtin_amdgcn_sched_barrier(0)
    Unit cur, nxt; int ui = 0;
    if (!S.next(0, cur)) return;
    f32x4 acc[2][2][4][2];
#pragma unroll
    for (int a = 0; a < 2; ++a)
#pragma unroll
        for (int b = 0; b < 2; ++b)
#pragma unroll
            for (int m = 0; m < 4; ++m)
#pragma unroll
                for (int n = 0; n < 2; ++n) acc[a][b][m][n] = (f32x4){0.f, 0.f, 0.f, 0.f};
    bf16x8 At[4][2], B0[2][2], B1[2][2];
    const char* cA = (const char*)g.A + (size_t)cur.pm * tstep; const char* cB = (const char*)g.Bt + (size_t)cur.pn * tstep;
    S.a_ready(cur);
    if constexpr (SP2) {
        PG8_STAGE(PG8_SB(0, 0), cB, voffB); PG8_STAGE(PG8_SB(0, 1), cB + hstep, voffB); PG8_STAGE(PG8_SA(0, 0), cA, voffA); PG8_STAGE(PG8_SA(0, 1), cA + hstep, voffA);
        if (wr == 1) PG8_BAR;
        PG8_WAIT_V(2); PG8_BAR;
        PG8_STAGE(PG8_SB(1, 0), cB + kstep, voffB); PG8_STAGE(PG8_SA(1, 0), cA + kstep, voffA); PG8_STAGE(PG8_SB(1, 1), cB + hstep + kstep, voffB);
        PG8_WAIT_V(6); PG8_BAR;
    } else {
        PG8_STAGE(PG8_SB(0, 0), cB, voffB); PG8_STAGE(PG8_SA(0, 0), cA, voffA); PG8_STAGE(PG8_SB(0, 1), cB + hstep, voffB); PG8_STAGE(PG8_SA(0, 1), cA + hstep, voffA);
        if (wr == 1) PG8_BAR;
        PG8_WAIT_V(4); PG8_BAR;
        PG8_STAGE(PG8_SB(1, 0), cB + kstep, voffB); PG8_STAGE(PG8_SA(1, 0), cA + kstep, voffA); PG8_STAGE(PG8_SB(1, 1), cB + hstep + kstep, voffB);
        PG8_WAIT_V(6); PG8_BAR;
    }
    for (;;) {
        const bool has_next = S.next(ui + 1, nxt);
        const char* nA = has_next ? (const char*)g.A + (size_t)nxt.pm * tstep : cA; const char* nB = has_next ? (const char*)g.Bt + (size_t)nxt.pn * tstep : cB;
        for (int t = 0; t < nt; t += 2) {
            const bool last = (t == nt - 2);
            const char* a1 = cA + (size_t)(t + 1) * kstep;
            const char* a2 = last ? nA : cA + (size_t)(t + 2) * kstep; const char* b2 = last ? nB : cB + (size_t)(t + 2) * kstep;
            const char* a3 = a2 + kstep; const char* b3 = b2 + kstep;
            if (last && has_next) S.a_ready(nxt);
            if constexpr (SP2) {
            PG8_LDB(B0, 0, 0); PG8_LDB(B1, 0, 1); PG8_SCHED; PG8_LDA(At, 0, 0); PG8_STAGE(PG8_SA(1, 1), a1 + hstep, voffA);
            PG8_WAIT_V(8); PG8_WAIT_L(0); PG8_BAR; PG8_MMA(0, 0, At, B0); PG8_MMA(0, 1, At, B1); PG8_BAR; PG8_SCHED;
            PG8_LDA(At, 0, 1); PG8_STAGE(PG8_SB(0, 0), b2, voffB); PG8_STAGE(PG8_SB(0, 1), b2 + hstep, voffB); PG8_STAGE(PG8_SA(0, 0), a2, voffA);
            PG8_WAIT_V(8); PG8_WAIT_L(0); PG8_BAR; PG8_MMA(1, 0, At, B0); PG8_MMA(1, 1, At, B1); PG8_BAR; PG8_SCHED;
            PG8_LDB(B0, 1, 0); PG8_LDB(B1, 1, 1); PG8_SCHED; PG8_LDA(At, 1, 0); PG8_STAGE(PG8_SA(0, 1), a2 + hstep, voffA);
            PG8_WAIT_V(8); PG8_WAIT_L(0); PG8_BAR; PG8_MMA(0, 0, At, B0); PG8_MMA(0, 1, At, B1); PG8_BAR; PG8_SCHED;
            PG8_LDA(At, 1, 1); PG8_STAGE(PG8_SB(1, 0), b3, voffB); PG8_STAGE(PG8_SB(1, 1), b3 + hstep, voffB); PG8_STAGE(PG8_SA(1, 0), a3, voffA);
            PG8_WAIT_V(8); PG8_WAIT_L(0); PG8_BAR; PG8_MMA(1, 0, At, B0); PG8_MMA(1, 1, At, B1); PG8_BAR; PG8_SCHED;
            } else {
            PG8_LDB(B0, 0, 0); PG8_SCHED; PG8_LDA(At, 0, 0); PG8_STAGE(PG8_SA(1, 1), a1 + hstep, voffA);
            PG8_WAIT_L(8); PG8_BAR; PG8_WAIT_L(0); PG8_MMA(0, 0, At, B0); PG8_BAR; PG8_SCHED;
            PG8_LDB(B1, 0, 1); PG8_STAGE(PG8_SB(0, 0), b2, voffB);
            PG8_BAR; PG8_WAIT_L(0); PG8_MMA(0, 1, At, B1); PG8_BAR;
            PG8_LDA(At, 0, 1); PG8_STAGE(PG8_SA(0, 0), a2, voffA);
            PG8_BAR; PG8_WAIT_L(0); PG8_MMA(1, 0, At, B0); PG8_BAR; PG8_SCHED;
            PG8_STAGE(PG8_SB(0, 1), b2 + hstep, voffB);
            PG8_WAIT_V(6); PG8_BAR; PG8_MMA(1, 1, At, B1); PG8_BAR;
            PG8_LDB(B0, 1, 0); PG8_SCHED; PG8_LDA(At, 1, 0); PG8_STAGE(PG8_SA(0, 1), a2 + hstep, voffA);
            PG8_WAIT_L(8); PG8_BAR; PG8_WAIT_L(0); PG8_MMA(0, 0, At, B0); PG8_BAR; PG8_SCHED;
            PG8_LDB(B1, 1, 1); PG8_STAGE(PG8_SB(1, 0), b3, voffB);
            PG8_BAR; PG8_WAIT_L(0); PG8_MMA(0, 1, At, B1); PG8_BAR;
            PG8_LDA(At, 1, 1); PG8_STAGE(PG8_SA(1, 0), a3, voffA);
            PG8_BAR; PG8_WAIT_L(0); PG8_MMA(1, 0, At, B0); PG8_BAR; PG8_SCHED;
            PG8_STAGE(PG8_SB(1, 1), b3 + hstep, voffB);
            PG8_WAIT_V(6); PG8_BAR; PG8_MMA(1, 1, At, B1); PG8_BAR;
            }
        }
        if constexpr (ALIGN_EPI) { if (wr == 0) PG8_BAR; }
        if constexpr (!Epi::AFTER_DRAIN) { E(acc, cur, wr, wc, fr, fq); S.done(cur); }
        if (!has_next) break;
#pragma unroll
        for (int a = 0; a < 2; ++a)
#pragma unroll
            for (int b = 0; b < 2; ++b)
#pragma unroll
                for (int m = 0; m < 4; ++m)
#pragma unroll
                    for (int n = 0; n < 2; ++n) acc[a][b][m][n] = (f32x4){0.f, 0.f, 0.f, 0.f};
        cur = nxt; cA = nA; cB = nB; ++ui;
        if constexpr (ALIGN_EPI) { if (wr == 1) PG8_BAR; }
    }
    PG8_WAIT_V(0);
    if constexpr (!ALIGN_EPI) { if (wr == 0) PG8_BAR; }
    PG8_BAR;
    if constexpr (Epi::AFTER_DRAIN) { E.fused(acc, cur, wr, wc, fr, fq, lds, wid, lane); S.done(cur); }
#undef PG8_SA
#undef PG8_SB
#undef PG8_STAGE
#undef PG8_LDA
#undef PG8_LDB
#undef PG8_MMA
#undef PG8_WAIT_V
#undef PG8_WAIT_L
#undef PG8_BAR
#undef PG8_SCHED
}
}

#define GAS __attribute__((address_space(1)))
#define LAS __attribute__((address_space(3)))
typedef unsigned short bf16;
typedef unsigned v4u __attribute__((ext_vector_type(4)));
typedef unsigned v2u __attribute__((ext_vector_type(2)));
typedef float f32x4 __attribute__((ext_vector_type(4)));
typedef float f32x16 __attribute__((ext_vector_type(16)));
typedef short bf16x8 __attribute__((ext_vector_type(8)));
typedef short s16x4 __attribute__((ext_vector_type(4)));

constexpr int NWAVES = 8;
constexpr int NB = 4, SEQ = 8192, DM = 1024, TOK = NB * SEQ;
constexpr int NIN = 5888;
constexpr int SBH = 8, DILH = 12;
constexpr int NMOD = 6 * DM;
constexpr int KSPLIT = 16;
constexpr float EPS = 1e-6f;
constexpr float LOG2E = 1.4426950408889634f;
constexpr float C2 = 0.125f * LOG2E;
constexpr int PEER_E = 16384;

constexpr size_t MiB = 1u << 20;
constexpr size_t WS_CTL = 0, CTL_ZERO_BYTES = 1 * MiB;
constexpr size_t WS_MODP = 1 * MiB;
constexpr size_t WS_MOD = 2 * MiB + 512 * 1024;
constexpr size_t WS_BIASPQ = 2 * MiB + 768 * 1024;
constexpr size_t WS_ROPEC = 3 * MiB, WS_ROPES = 4 * MiB;
constexpr size_t WS_SSQ = 5 * MiB;
constexpr size_t WS_KEYS = 7 * MiB;
constexpr size_t WS_WIN = 8 * MiB;
constexpr size_t WS_WSBO = 20 * MiB;
constexpr size_t WS_WDILO = 21 * MiB;
constexpr size_t WS_WOUT = 22 * MiB;
constexpr size_t WS_WPQ = 24 * MiB;
constexpr size_t WS_UB = 32 * MiB, WS_VB = 64 * MiB;
constexpr size_t WS_ACT = 96 * MiB;
constexpr size_t A_QSB = WS_ACT, A_KSB = WS_ACT + 32 * MiB, A_VSB = WS_ACT + 64 * MiB;
constexpr size_t A_QD = WS_ACT + 96 * MiB, A_KD = WS_ACT + 144 * MiB, A_VD = WS_ACT + 192 * MiB;
constexpr size_t A_GSB = WS_ACT + 240 * MiB, A_GD = WS_ACT + 304 * MiB;
constexpr size_t A_MERGED = WS_ACT;
constexpr size_t A_X1M = WS_ACT + 64 * MiB;
constexpr size_t A_QPEER = WS_ACT + 128 * MiB;
constexpr size_t A_IDX = WS_ACT + 256 * MiB;
constexpr size_t A_GATE = WS_ACT + 272 * MiB;
constexpr size_t WS_END = WS_ACT + 368 * MiB;
constexpr size_t O_H = 0, O_OSB = 64 * MiB, O_OD = 96 * MiB;

constexpr int CW_BAR = 4096;

constexpr int RING_BYTES = 131072;
constexpr int MISC_OFF = RING_BYTES + 320;
constexpr int LDS_BYTES = 147456;

#define RLX_AGENT __ATOMIC_RELAXED, __HIP_MEMORY_SCOPE_AGENT
__device__ __forceinline__ unsigned f2bf(float f) { unsigned u = __builtin_bit_cast(unsigned, f); return (u + 0x7fffu + ((u >> 16) & 1u)) >> 16; }
typedef float f32x2_t __attribute__((ext_vector_type(2))); typedef __bf16 bf16x2_t __attribute__((ext_vector_type(2)));
__device__ __forceinline__ unsigned pk2(float lo, float hi) { f32x2_t v = {lo, hi}; bf16x2_t b = __builtin_convertvector(v, bf16x2_t); return __builtin_bit_cast(unsigned, b); }
__device__ __forceinline__ float bflo(unsigned w) { return __uint_as_float(w << 16); }
__device__ __forceinline__ float bfhi(unsigned w) { return __uint_as_float(w & 0xffff0000u); }
__device__ __forceinline__ float wave_sum(float v) {
#pragma unroll
    for (int o = 1; o < 64; o <<= 1) v += __shfl_xor(v, o);
    return v;
}
__device__ __forceinline__ float fast_exp2(float x) { return __builtin_amdgcn_exp2f(x); }
__device__ __forceinline__ float fast_log2(float x) { return __builtin_amdgcn_logf(x); }
__device__ __forceinline__ float fast_rcp(float x) { return __builtin_amdgcn_rcpf(x); }
__device__ __forceinline__ float sigmoidf_(float x) { return fast_rcp(1.f + fast_exp2(-x * LOG2E)); }
#define XB_TMO      128
#define XB_XCNT(j)  (256  + 64 * (j))
#define XB_XSUB(j)  (1280 + 64 * (j))
#define XB_XGEN(j)  (2304 + 64 * (j))
#define XB_TOP      3328
#define XB_TOPGEN   3392
#define XCD_BAR_WORDS 3456
#define XB_SPIN_CAP (1u << 18)

__device__ __forceinline__ unsigned xb_ld(unsigned* p)              { return __hip_atomic_load(p, __ATOMIC_RELAXED, __HIP_MEMORY_SCOPE_AGENT); }
__device__ __forceinline__ unsigned xb_add(unsigned* p, unsigned v) { return __hip_atomic_fetch_add(p, v, __ATOMIC_RELAXED, __HIP_MEMORY_SCOPE_AGENT); }
__device__ __forceinline__ unsigned xb_xcc_id() { return (unsigned)__builtin_amdgcn_s_getreg((3 << 11) | 20) & 0xFu; }
#define XB_SPIN(cond, bar) do { unsigned _sp = 0; while (cond) { __builtin_amdgcn_s_sleep(1); \
    if ((++_sp & 255u) == 0u) { if (xb_ld(&(bar)[XB_TMO])) break; if (_sp > XB_SPIN_CAP) { atomicAdd(&(bar)[XB_TMO], 1u); break; } } } } while (0)

struct XcdBarrier {
    unsigned* bar; unsigned x;
    volatile LAS unsigned* st;
};

__device__ __forceinline__ XcdBarrier xcd_barrier_post(unsigned* bar, volatile LAS unsigned* st) {
    XcdBarrier b; b.bar = bar; b.x = xb_xcc_id(); b.st = st;
    if (threadIdx.x == 0) (void)xb_add(&bar[XB_XCNT(b.x)], 1u);
    return b;
}
__device__ __forceinline__ void xcd_barrier_complete(unsigned* bar, unsigned x, unsigned& nloc, unsigned& nx) {
    const unsigned G = gridDim.x * gridDim.y * gridDim.z;
    unsigned sum, cnt, mine, sp = 0u;
    for (;;) {
        sum = 0u; cnt = 0u; mine = 0u;
#pragma unroll
        for (unsigned j = 0; j < 16; ++j) { const unsigned c = xb_ld(&bar[XB_XCNT(j)]); sum += c; cnt += (c > 0u) ? 1u : 0u; mine = (j == x) ? c : mine; }
        if (sum == G) break;
        __builtin_amdgcn_s_sleep(1);
        if ((++sp & 255u) == 0u) { if (xb_ld(&bar[XB_TMO])) break; if (sp > XB_SPIN_CAP) { atomicAdd(&bar[XB_TMO], 1u); break; } }
    }
    nloc = mine > 0u ? mine : 1u; nx = cnt > 0u ? cnt : 1u;
}

__device__ __forceinline__ void xcd_barrier(const XcdBarrier& b) {
    asm volatile("s_waitcnt vmcnt(0)" ::: "memory");
    __syncthreads();
    if (threadIdx.x == 0) {
        unsigned* bar = b.bar;
        __builtin_amdgcn_s_waitcnt(0);
        unsigned nloc = b.st[0], nx = b.st[1];
        if (nloc == 0u) { xcd_barrier_complete(bar, b.x, nloc, nx); b.st[0] = nloc; b.st[1] = nx; }
        const unsigned old = xb_add(&bar[XB_XSUB(b.x)], 1u);
        const unsigned gen = old / nloc;
        if (old + 1u == (gen + 1u) * nloc) {
            __builtin_amdgcn_fence(__ATOMIC_RELEASE, "agent");
            asm volatile("s_waitcnt vmcnt(0)" ::: "memory");
            const unsigned og = xb_add(&bar[XB_TOP], 1u);
            const unsigned tg = og / nx;
            if (og + 1u == (tg + 1u) * nx) xb_add(&bar[XB_TOPGEN], 1u);
            else XB_SPIN(xb_ld(&bar[XB_TOPGEN]) == tg, bar);
            __builtin_amdgcn_fence(__ATOMIC_ACQUIRE, "agent");
            xb_add(&bar[XB_XGEN(b.x)], 1u);
            asm volatile("s_waitcnt vmcnt(0)" ::: "memory");
        } else {
            XB_SPIN(xb_ld(&bar[XB_XGEN(b.x)]) == gen, bar);
            __builtin_amdgcn_fence(__ATOMIC_ACQUIRE, "agent");
            asm volatile("s_waitcnt vmcnt(0)" ::: "memory");
        }
    }
    __syncthreads();
}

struct Args {
    const float* x; const float* c; const float* w_ada; const float* b_ada; const float* g_mix; const float* w_in; const float* w_sb_o; const float* w_dil_o;
    const float* w_out; const float* g_ffn; const float* w_pq; const float* peer_keys; const float* peer_u; const float* peer_v; const float* g_final;
    float* out; unsigned char* ws; int ph_lo, ph_hi;
};
struct Frame {
    LAS unsigned char* lds;
    int tid, lane, wave, vcu, G, gw, NGW;
};

__device__ __forceinline__ int win_row(int ncol) {
    const int tile = ncol >> 8;
    if (tile >= 6 && tile < 12) { const int d = ncol & 63; const int j = (d & 31) >> 2, i = (d & 3) + ((d >> 5) << 2); return (ncol & ~63) + 8 * j + i; }
    return ncol;
}
template <bool MAPWIN>
__device__ __forceinline__ void p0_transpose_item(const float* W, int K, int N, bf16* WT, LAS float* scr, int item, int lane) {
    const int nblk = N / 32, kb = item / nblk, nb = item % nblk, k0 = 64 * kb, n0 = 32 * nb;
#pragma unroll 8
    for (int i = 0; i < 32; ++i) { const int kk = 2 * i + (lane >> 5); scr[kk * 33 + (lane & 31)] = W[(size_t)(k0 + kk) * N + n0 + (lane & 31)]; }
    asm volatile("s_waitcnt lgkmcnt(0)" ::: "memory");
    const int c = lane & 7;
#pragma unroll
    for (int j = 0; j < 4; ++j) { const int n = (lane >> 3) + 8 * j; const LAS float* s = scr + (8 * c) * 33 + n;
        v4u o; o.x = pk2(s[0 * 33], s[1 * 33]); o.y = pk2(s[2 * 33], s[3 * 33]); o.z = pk2(s[4 * 33], s[5 * 33]); o.w = pk2(s[6 * 33], s[7 * 33]);
        const int rowo = MAPWIN ? win_row(n0 + n) : (n0 + n);
        *(GAS v4u*)(WT + (size_t)rowo * K + k0 + 8 * c) = o; }
    asm volatile("s_waitcnt lgkmcnt(0)" ::: "memory");
}
__device__ __forceinline__ void cvt_row_1024(const float* src, bf16* dst, int lane) {
    const GAS f32x4* s = (const GAS f32x4*)src + lane; GAS v2u* d = (GAS v2u*)dst + lane;
    f32x4 v[4];
#pragma unroll
    for (int j = 0; j < 4; ++j) v[j] = s[64 * j];
#pragma unroll
    for (int j = 0; j < 4; ++j) { v2u o; o.x = pk2(v[j].x, v[j].y); o.y = pk2(v[j].z, v[j].w); d[64 * j] = o; }
}
__device__ __forceinline__ void sincos_d(double a, float& sn, float& cs) {
    const double TWO_PI = 6.283185307179586476925286766559;
    const double k = __builtin_rint(a / TWO_PI); const double r = a - k * TWO_PI; const double r2 = r * r;
    double ts = 1.0, tc = 1.0, ss = 1.0, cc = 1.0;
#pragma unroll
    for (int n = 1; n <= 14; ++n) { tc = -tc * r2 / (double)((2 * n - 1) * (2 * n)); ts = -ts * r2 / (double)((2 * n) * (2 * n + 1)); cc += tc; ss += ts; }
    sn = (float)(r * ss); cs = (float)cc;
}

__device__ __forceinline__ void p0_prologue(const Args& A, Frame& F) {
    unsigned char* ws = A.ws;
    LAS float* scr = (LAS float*)(F.lds + F.wave * 16384);
    const int lane = F.lane;
    constexpr int I_MOD = KSPLIT * 24;
    constexpr int I_WIN = (DM / 64) * (NIN / 32);
    constexpr int I_SBO = (512 / 64) * (DM / 32), I_DILO = (256 / 64) * (DM / 32), I_OUT = (DM / 64) * (DM / 32), I_PQ = (DM / 64) * (2048 / 32);
    constexpr int I_KEYS = 256, I_TAB = 2 * PEER_E, I_ROPE = SEQ * 32 / 64;
    constexpr int NITEMS = I_MOD + I_WIN + I_SBO + I_DILO + I_OUT + I_PQ + I_KEYS + I_TAB + I_ROPE;
    for (int it = F.gw; it < NITEMS; it += F.NGW) {
        int r = it;
        if (r < I_MOD) {
            const int ks = r / 24, cc = r % 24, col = 256 * cc + 4 * lane, k0 = 64 * ks;
            float sv[4];
#pragma unroll
            for (int b = 0; b < 4; ++b) { const float cv = A.c[b * DM + k0 + lane]; sv[b] = cv * sigmoidf_(cv); }
            f32x4 acc[4];
#pragma unroll
            for (int b = 0; b < 4; ++b) acc[b] = (f32x4){0.f, 0.f, 0.f, 0.f};
            const GAS f32x4* wp = (const GAS f32x4*)(A.w_ada + (size_t)k0 * NMOD + col);
#pragma unroll 8
            for (int kk = 0; kk < 64; ++kk) { const f32x4 w4 = wp[(size_t)kk * (NMOD / 4)];
#pragma unroll
                for (int b = 0; b < 4; ++b) { const float s = __uint_as_float(__builtin_amdgcn_readlane(__float_as_uint(sv[b]), kk)); acc[b] += w4 * s; } }
            float* mp = (float*)(ws + WS_MODP);
#pragma unroll
            for (int b = 0; b < 4; ++b) *(GAS f32x4*)(mp + ((size_t)(ks * 4 + b)) * NMOD + col) = acc[b];
            continue;
        }
        r -= I_MOD;
        if (r < I_WIN) { p0_transpose_item<true>(A.w_in, DM, NIN, (bf16*)(ws + WS_WIN), scr, r, lane); continue; } r -= I_WIN;
        if (r < I_SBO) { p0_transpose_item<false>(A.w_sb_o, 512, DM, (bf16*)(ws + WS_WSBO), scr, r, lane); continue; } r -= I_SBO;
        if (r < I_DILO) { p0_transpose_item<false>(A.w_dil_o, 256, DM, (bf16*)(ws + WS_WDILO), scr, r, lane); continue; } r -= I_DILO;
        if (r < I_OUT) { p0_transpose_item<false>(A.w_out, DM, DM, (bf16*)(ws + WS_WOUT), scr, r, lane); continue; } r -= I_OUT;
        if (r < I_PQ) { p0_transpose_item<false>(A.w_pq, DM, 2048, (bf16*)(ws + WS_WPQ), scr, r, lane); continue; } r -= I_PQ;
        if (r < I_KEYS) { cvt_row_1024(A.peer_keys + (size_t)r * 1024, (bf16*)(ws + WS_KEYS) + (size_t)r * 1024, lane); continue; } r -= I_KEYS;
        if (r < I_TAB) { if (r < PEER_E) cvt_row_1024(A.peer_u + (size_t)r * 1024, (bf16*)(ws + WS_UB) + (size_t)r * 1024, lane);
                         else cvt_row_1024(A.peer_v + (size_t)(r - PEER_E) * 1024, (bf16*)(ws + WS_VB) + (size_t)(r - PEER_E) * 1024, lane); continue; } r -= I_TAB;
        {
            const int idx = r * 64 + lane, s = idx >> 5, j = idx & 31;
            const float inv = (float)exp2(-(double)j * (13.287712379549449 / 32.0));
            const float ang = (float)s * inv;
            float sn, cs; sincos_d((double)ang, sn, cs);
            ((float*)(ws + WS_ROPEC))[idx] = cs; ((float*)(ws + WS_ROPES))[idx] = sn;
        }
    }
}

__device__ __forceinline__ void p1_hrows(const Args& A, Frame& F) {
    unsigned char* ws = A.ws;
    LAS float* mult = (LAS float*)F.lds; LAS float* addv = mult + DM;
    const float* mp = (const float*)(ws + WS_MODP);
    float* mod = (float*)(ws + WS_MOD);
    bf16* H = (bf16*)((unsigned char*)A.out + O_H);
    for (int ch = F.vcu; ch < TOK / 128; ch += F.G) {
        const int b = (ch * 128) / SEQ;
        __syncthreads();
        for (int k = F.tid; k < DM; k += NWAVES * 64) {
            float sh = A.b_ada[k], sc = A.b_ada[DM + k];
#pragma unroll
            for (int ks = 0; ks < KSPLIT; ++ks) { sh += mp[(size_t)(ks * 4 + b) * NMOD + k]; sc += mp[(size_t)(ks * 4 + b) * NMOD + DM + k]; }
            mult[k] = A.g_mix[k] * (1.f + sc); addv[k] = sh;
        }
        if ((ch * 128) % SEQ == 0) {
            for (int j = F.tid; j < NMOD; j += NWAVES * 64) { float v = A.b_ada[j];
#pragma unroll
                for (int ks = 0; ks < KSPLIT; ++ks) v += mp[(size_t)(ks * 4 + b) * NMOD + j];
                mod[b * NMOD + j] = v; }
        }
        __syncthreads();
        for (int i = 0; i < 16; ++i) {
            const int row = ch * 128 + F.wave * 16 + i;
            const GAS f32x4* xr = (const GAS f32x4*)(A.x + (size_t)row * DM) + F.lane;
            f32x4 v[4]; float s = 0.f;
#pragma unroll
            for (int j = 0; j < 4; ++j) { v[j] = xr[64 * j]; s += (v[j].x * v[j].x + v[j].y * v[j].y) + (v[j].z * v[j].z + v[j].w * v[j].w); }
            const float rr = 1.0f / sqrtf(wave_sum(s) * (1.f / DM) + EPS);
            GAS v2u* o8 = (GAS v2u*)(H + (size_t)row * DM) + F.lane;
#pragma unroll
            for (int j = 0; j < 4; ++j) { const f32x4 mu = *(const LAS f32x4*)(mult + 256 * j + 4 * F.lane), ad = *(const LAS f32x4*)(addv + 256 * j + 4 * F.lane);
                const f32x4 hh = v[j] * rr * mu + ad; v2u o; o.x = pk2(hh.x, hh.y); o.y = pk2(hh.z, hh.w); o8[64 * j] = o; }
        }
    }
}

typedef pg8::f32x4 pf4;
struct EpiG1 {
    static constexpr bool PERM = true, AFTER_DRAIN = false;
    bf16 *Qsb, *Ksb, *Vsb, *Qd, *Kd, *Vd, *Gsb, *Gd; const float* ropeC; const float* ropeS;
    __device__ __forceinline__ void operator()(const pf4 (&acc)[2][2][4][2], const pg8::Unit& u, int wr, int wc, int fr, int fq) const {
        const int pn = u.pn;
        const int row0 = u.pm * 256 + wr * 64 + fr;
        const int b = (u.pm * 256) >> 13;
        if (pn < 6 || (pn >= 12 && pn < 15)) {
            bf16* base; int H, head0; float sc = 1.f;
            if (pn < 2) { base = Qsb; H = SBH; head0 = 4 * pn; sc = C2; }
            else if (pn < 4) { base = Ksb; H = SBH; head0 = 4 * (pn - 2); }
            else if (pn < 6) { base = Vsb; H = SBH; head0 = 4 * (pn - 4); }
            else { base = Vd; H = DILH; head0 = 4 * (pn - 12); }
            const int d0 = 32 * (wc & 1) + 8 * fq;
#pragma unroll
            for (int ai = 0; ai < 2; ++ai)
#pragma unroll
                for (int m = 0; m < 4; ++m) { const int s = (row0 + ai * 128 + m * 16) & (SEQ - 1);
#pragma unroll
                    for (int bj = 0; bj < 2; ++bj) { const int head = head0 + 2 * bj + (wc >> 1);
                        const pf4 v0 = acc[ai][bj][m][0] * sc, v1 = acc[ai][bj][m][1] * sc;
                        v4u w; w.x = pk2(v0[0], v0[1]); w.y = pk2(v0[2], v0[3]); w.z = pk2(v1[0], v1[1]); w.w = pk2(v1[2], v1[3]);
                        *(GAS v4u*)(base + ((size_t)(b * H + head) * SEQ + s) * 64 + d0) = w; } }
        } else if (pn < 12) {
            bf16* base; int head0; float sc = 1.f;
            if (pn < 9) { base = Qd; head0 = 4 * (pn - 6); sc = C2; } else { base = Kd; head0 = 4 * (pn - 9); }
            const int j4 = 4 * (4 * (wc & 1) + fq);
#pragma unroll
            for (int ai = 0; ai < 2; ++ai)
#pragma unroll
                for (int m = 0; m < 4; ++m) { const int s = (row0 + ai * 128 + m * 16) & (SEQ - 1);
                    const pf4 cs = *(const GAS pf4*)(ropeC + s * 32 + j4) * sc, sn = *(const GAS pf4*)(ropeS + s * 32 + j4) * sc;
#pragma unroll
                    for (int bj = 0; bj < 2; ++bj) { const int head = head0 + 2 * bj + (wc >> 1);
                        const pf4 x1 = acc[ai][bj][m][0], x2 = acc[ai][bj][m][1];
                        const pf4 o1 = x1 * cs - x2 * sn, o2 = x1 * sn + x2 * cs;
                        bf16* p = base + ((size_t)(b * DILH + head) * SEQ + s) * 64 + j4;
                        v2u w1, w2; w1.x = pk2(o1[0], o1[1]); w1.y = pk2(o1[2], o1[3]); w2.x = pk2(o2[0], o2[1]); w2.y = pk2(o2[2], o2[3]);
                        *(GAS v2u*)p = w1; *(GAS v2u*)(p + 32) = w2; } }
        } else {
            bf16* base = pn < 19 ? Gsb : Gd; const int ct = (pn < 19 ? pn - 15 : pn - 19) * 256 + wc * 32 + 8 * fq;
#pragma unroll
            for (int ai = 0; ai < 2; ++ai)
#pragma unroll
                for (int m = 0; m < 4; ++m) { const size_t row = (size_t)(row0 + ai * 128 + m * 16);
#pragma unroll
                    for (int bj = 0; bj < 2; ++bj) { const pf4 v0 = acc[ai][bj][m][0], v1 = acc[ai][bj][m][1];
                        v4u w; w.x = pk2(sigmoidf_(v0[0]), sigmoidf_(v0[1])); w.y = pk2(sigmoidf_(v0[2]), sigmoidf_(v0[3]));
                        w.z = pk2(sigmoidf_(v1[0]), sigmoidf_(v1[1])); w.w = pk2(sigmoidf_(v1[2]), sigmoidf_(v1[3]));
                        *(GAS v4u*)(base + row * DM + ct + bj * 128) = w; } }
        }
    }
};
template <bool SECOND> struct EpiMerge {
    static constexpr bool PERM = true, AFTER_DRAIN = false;
    const bf16* G; bf16* Mg;
    __device__ __forceinline__ void operator()(const pf4 (&acc)[2][2][4][2], const pg8::Unit& u, int wr, int wc, int fr, int fq) const {
        const int row0 = u.pm * 256 + wr * 64 + fr, col0 = u.pn * 256 + wc * 32 + 8 * fq;
#pragma unroll
        for (int ai = 0; ai < 2; ++ai)
#pragma unroll
            for (int m = 0; m < 4; ++m) { const size_t off = (size_t)(row0 + ai * 128 + m * 16) * DM + col0;
#pragma unroll
                for (int bj = 0; bj < 2; ++bj) { const v4u g = *(const GAS v4u*)(G + off + bj * 128);
                    pf4 v0 = acc[ai][bj][m][0], v1 = acc[ai][bj][m][1];
                    v0[0] *= bflo(g.x); v0[1] *= bfhi(g.x); v0[2] *= bflo(g.y); v0[3] *= bfhi(g.y); v1[0] *= bflo(g.z); v1[1] *= bfhi(g.z); v1[2] *= bflo(g.w); v1[3] *= bfhi(g.w);
                    if (SECOND) { const v4u t = *(const GAS v4u*)(Mg + off + bj * 128);
                        v0[0] += bflo(t.x); v0[1] += bfhi(t.x); v0[2] += bflo(t.y); v0[3] += bfhi(t.y); v1[0] += bflo(t.z); v1[1] += bfhi(t.z); v1[2] += bflo(t.w); v1[3] += bfhi(t.w); }
                    v4u w; w.x = pk2(v0[0], v0[1]); w.y = pk2(v0[2], v0[3]); w.z = pk2(v1[0], v1[1]); w.w = pk2(v1[2], v1[3]);
                    *(GAS v4u*)(Mg + off + bj * 128) = w; }
                asm volatile("" ::: "memory"); }
    }
};
struct EpiOut {
    static constexpr bool PERM = true, AFTER_DRAIN = false;
    const float* x; float* x1; bf16* x1m; float* ssq; const float* mod; const float* g_ffn;
    __device__ __forceinline__ void operator()(const pf4 (&acc)[2][2][4][2], const pg8::Unit& u, int wr, int wc, int fr, int fq) const {
        const int row0 = u.pm * 256 + wr * 64 + fr, col0 = u.pn * 256 + wc * 32 + 8 * fq;
        const int b = (u.pm * 256) >> 13; const float* mb = mod + (size_t)b * NMOD;
        pf4 gt[2][2], mm[2][2];
#pragma unroll
        for (int bj = 0; bj < 2; ++bj)
#pragma unroll
            for (int n = 0; n < 2; ++n) { const int c = col0 + bj * 128 + 4 * n; gt[bj][n] = *(const GAS pf4*)(mb + 2 * DM + c);
                mm[bj][n] = *(const GAS pf4*)(g_ffn + c) * (*(const GAS pf4*)(mb + 4 * DM + c) + 1.0f); }
#pragma unroll
        for (int ai = 0; ai < 2; ++ai)
#pragma unroll
            for (int m = 0; m < 4; ++m) { const int row = row0 + ai * 128 + m * 16; const size_t off = (size_t)row * DM + col0; float s = 0.f;
#pragma unroll
                for (int bj = 0; bj < 2; ++bj) {
                    const pf4 a0 = *(const GAS pf4*)(x + off + bj * 128), a1 = *(const GAS pf4*)(x + off + bj * 128 + 4);
                    const pf4 y0 = a0 + gt[bj][0] * acc[ai][bj][m][0], y1 = a1 + gt[bj][1] * acc[ai][bj][m][1];
                    *(GAS pf4*)(x1 + off + bj * 128) = y0; *(GAS pf4*)(x1 + off + bj * 128 + 4) = y1;
                    s += (y0[0] * y0[0] + y0[1] * y0[1]) + (y0[2] * y0[2] + y0[3] * y0[3]) + (y1[0] * y1[0] + y1[1] * y1[1]) + (y1[2] * y1[2] + y1[3] * y1[3]);
                    const pf4 z0 = y0 * mm[bj][0], z1 = y1 * mm[bj][1];
                    v4u w; w.x = pk2(z0[0], z0[1]); w.y = pk2(z0[2], z0[3]); w.z = pk2(z1[0], z1[1]); w.w = pk2(z1[2], z1[3]);
                    *(GAS v4u*)(x1m + off + bj * 128) = w; }
                s += __shfl_xor(s, 16); s += __shfl_xor(s, 32);
                if (fq == 0) ssq[(size_t)row * 16 + 4 * u.pn + wc] = s; }
    }
};
struct EpiPq {
    static constexpr bool PERM = true, AFTER_DRAIN = false;
    const float* ssq; const float* bias; bf16* Q;
    __device__ __forceinline__ void operator()(const pf4 (&acc)[2][2][4][2], const pg8::Unit& u, int wr, int wc, int fr, int fq) const {
        const int row0 = u.pm * 256 + wr * 64 + fr, col0 = u.pn * 256 + wc * 32 + 8 * fq;
        const int b = (u.pm * 256) >> 13; const float* bb = bias + (size_t)b * 2048;
        pf4 bv[2][2];
#pragma unroll
        for (int bj = 0; bj < 2; ++bj)
#pragma unroll
            for (int n = 0; n < 2; ++n) bv[bj][n] = *(const GAS pf4*)(bb + col0 + bj * 128 + 4 * n);
#pragma unroll
        for (int ai = 0; ai < 2; ++ai)
#pragma unroll
            for (int m = 0; m < 4; ++m) { const int row = row0 + ai * 128 + m * 16;
                const GAS pf4* sp = (const GAS pf4*)(ssq + (size_t)row * 16);
                const pf4 s4 = (sp[0] + sp[1]) + (sp[2] + sp[3]);
                const float r2 = 1.0f / sqrtf(((s4[0] + s4[1]) + (s4[2] + s4[3])) * (1.f / DM) + EPS);
#pragma unroll
                for (int bj = 0; bj < 2; ++bj) { const pf4 v0 = acc[ai][bj][m][0] * r2 + bv[bj][0], v1 = acc[ai][bj][m][1] * r2 + bv[bj][1];
                    v4u w; w.x = pk2(v0[0], v0[1]); w.y = pk2(v0[2], v0[3]); w.z = pk2(v1[0], v1[1]); w.w = pk2(v1[2], v1[3]);
                    *(GAS v4u*)(Q + (size_t)row * 2048 + col0 + bj * 128) = w; } }
    }
};

constexpr int VSTR = 144;
constexpr int ATT_WAVE_LDS = 32 * VSTR;
__device__ __forceinline__ int kappa(int r) { return (((r >> 2) & 1) << 4) + ((r >> 3) << 2) + (r & 3); }
struct KVTile { bf16x8 k[4]; v4u v[4]; };
typedef short v4i16_t __attribute__((ext_vector_type(4)));
__device__ __forceinline__ s16x4 vtr(const LAS unsigned char* p) { return __builtin_bit_cast(s16x4, __builtin_amdgcn_ds_read_tr16_b64_v4i16((LAS v4i16_t*)p)); }

__device__ __forceinline__ void kv_load(KVTile& t, const bf16* Kh, const bf16* Vh, int base_tok, int sshift, int lane) {
    const int r = lane & 31, h = lane >> 5;
    const bf16* kp = Kh + (size_t)(base_tok + (kappa(r) << sshift)) * 64 + 8 * h;
#pragma unroll
    for (int st = 0; st < 4; ++st) t.k[st] = *(const GAS bf16x8*)(kp + 16 * st);
#pragma unroll
    for (int i = 0; i < 4; ++i) t.v[i] = *(const GAS v4u*)(Vh + (size_t)(base_tok + (((lane >> 3) + 8 * i) << sshift)) * 64 + 8 * (lane & 7));
}
__device__ __forceinline__ void v_to_lds(const KVTile& t, LAS unsigned char* vl, int lane) {
#pragma unroll
    for (int i = 0; i < 4; ++i) *(LAS v4u*)(vl + ((lane >> 3) + 8 * i) * VSTR + 16 * (lane & 7)) = t.v[i];
}
__device__ __forceinline__ f32x16 qk_tile(const KVTile& t, const bf16x8 (&qf)[4]) {
    f32x16 s = {};
#pragma unroll
    for (int st = 0; st < 4; ++st) s = __builtin_amdgcn_mfma_f32_32x32x16_bf16(t.k[st], qf[st], s, 0, 0, 0);
    return s;
}
__device__ __forceinline__ void pv_tile(f32x16& o0, f32x16& o1, const float (&p)[16], const LAS unsigned char* vl, int lane) {
    const int g = lane >> 4, li = lane & 15, q = li >> 2, pp = li & 3, h = g >> 1;
    const LAS unsigned char* tb = vl + (16 * h + q) * VSTR + (16 * (g & 1) + 4 * pp) * 2;
    bf16x8 pf[2];
#pragma unroll
    for (int st = 0; st < 2; ++st) { v4u w; w.x = pk2(p[8 * st + 0], p[8 * st + 1]); w.y = pk2(p[8 * st + 2], p[8 * st + 3]); w.z = pk2(p[8 * st + 4], p[8 * st + 5]); w.w = pk2(p[8 * st + 6], p[8 * st + 7]); pf[st] = __builtin_bit_cast(bf16x8, w); }
#pragma unroll
    for (int db = 0; db < 2; ++db)
#pragma unroll
        for (int st = 0; st < 2; ++st) {
            const s16x4 lo = vtr(tb + (8 * st) * VSTR + 64 * db), hi = vtr(tb + (8 * st + 4) * VSTR + 64 * db);
            const bf16x8 vf = (bf16x8){lo[0], lo[1], lo[2], lo[3], hi[0], hi[1], hi[2], hi[3]};
            if (db == 0) o0 = __builtin_amdgcn_mfma_f32_32x32x16_bf16(vf, pf[st], o0, 0, 0, 0);
            else         o1 = __builtin_amdgcn_mfma_f32_32x32x16_bf16(vf, pf[st], o1, 0, 0, 0);
        }
}
__device__ __forceinline__ void o_store(bf16* orow, const f32x16& o0, const f32x16& o1, float sc, int hC) {
#pragma unroll
    for (int a = 0; a < 4; ++a) {
        v2u w0, w1; w0.x = pk2(o0[4 * a] * sc, o0[4 * a + 1] * sc); w0.y = pk2(o0[4 * a + 2] * sc, o0[4 * a + 3] * sc);
        w1.x = pk2(o1[4 * a] * sc, o1[4 * a + 1] * sc); w1.y = pk2(o1[4 * a + 2] * sc, o1[4 * a + 3] * sc);
        *(GAS v2u*)(orow + 8 * a + 4 * hC) = w0; *(GAS v2u*)(orow + 32 + 8 * a + 4 * hC) = w1; }
}

__device__ __forceinline__ void sb_task(const bf16* Qsb, const bf16* Ksb, const bf16* Vsb, bf16* Osb, int task, LAS unsigned char* vl, int lane) {
    const int qt = task & 255, bh = task >> 8, b = bh >> 3, h = bh & 7, t0 = qt * 32;
    const int q = lane & 31, hC = lane >> 5;
    const bf16* Kh = Ksb + (size_t)bh * SEQ * 64; const bf16* Vh = Vsb + (size_t)bh * SEQ * 64;
    bf16x8 qf[4];
    { const bf16* qp = Qsb + ((size_t)bh * SEQ + t0 + q) * 64 + 8 * hC;
#pragma unroll
      for (int st = 0; st < 4; ++st) qf[st] = *(const GAS bf16x8*)(qp + 16 * st); }
    f32x16 o0 = {}, o1 = {}; float carry = 0.f;
    KVTile nxt; kv_load(nxt, Kh, Vh, t0, 0, lane);
    for (int k0 = t0;; k0 -= 32) {
        KVTile cur = nxt;
        const bool more = k0 >= 32;
        if (more) kv_load(nxt, Kh, Vh, k0 - 32, 0, lane);
        v_to_lds(cur, vl, lane);
        const f32x16 s = qk_tile(cur, qf);
        const bool diag = (k0 == t0);
        float L[16], z[16];
#pragma unroll
        for (int r = 0; r < 16; ++r) { z[r] = __builtin_amdgcn_fmed3f(s[r], -120.f, 120.f); const float e = fast_exp2(z[r]); L[r] = -fast_log2(1.f + e);
            if (diag && !(16 * hC + r < q)) L[r] = 0.f; }
        float c[16]; c[15] = L[15];
#pragma unroll
        for (int r = 14; r >= 0; --r) c[r] = c[r + 1] + L[r];
        const float tot = c[0], oth = __shfl_xor(tot, 32);
        const float base = carry + (hC ? 0.f : oth);
        float p[16];
#pragma unroll
        for (int r = 0; r < 16; ++r) { p[r] = fast_exp2(z[r] + (base + c[r])); if (diag && !(16 * hC + r < q)) p[r] = 0.f; }
        carry += tot + oth;
        pv_tile(o0, o1, p, vl, lane);
        if (!more) break;
        if (__all(carry < -160.f)) break;
    }
    o_store(Osb + ((size_t)(b * SEQ + t0 + q)) * 512 + h * 64, o0, o1, 1.f, hC);
}

__device__ __forceinline__ void dil_task(const bf16* Qd, const bf16* Kd, const bf16* Vd, bf16* Od, int task, LAS unsigned char* vl, int lane) {
    const int it = task & 15, rho = (task >> 4) & 15, hg = (task >> 8) & 3, b = task >> 10;
    const int q = lane & 31, hC = lane >> 5, i0 = 32 * it;
    const int tq = 16 * (i0 + q) + rho;
    f32x16 o0 = {}, o1 = {}; float mrun = -1e30f, lsum = 0.f;
#pragma unroll
    for (int g = 0; g < 3; ++g) {
        bf16x8 qf[4];
        { const bf16* qp = Qd + ((size_t)(b * DILH + g * 4 + hg) * SEQ + tq) * 64 + 8 * hC;
#pragma unroll
          for (int st = 0; st < 4; ++st) qf[st] = *(const GAS bf16x8*)(qp + 16 * st); }
        const int rs = 2 * g, cg = 16 >> rs, rho_g = rho & ((1 << rs) - 1), og = rho >> rs;
        const bf16* Kh = Kd + (size_t)(b * DILH + g * 4 + hg) * SEQ * 64; const bf16* Vh = Vd + (size_t)(b * DILH + g * 4 + hg) * SEQ * 64;
        const int uq = cg * (i0 + q) + og;
        const int u_hi = cg * (i0 + 31) + og; int u_lo = cg * i0 + og - 128; u_lo = u_lo < 0 ? 0 : u_lo;
        const int ub_last = u_lo & ~31;
        int ub = u_hi & ~31;
        KVTile nxt; kv_load(nxt, Kh, Vh, (ub << rs) + rho_g, rs, lane);
        for (;; ub -= 32) {
            KVTile cur = nxt;
            const bool more = ub > ub_last;
            if (more) kv_load(nxt, Kh, Vh, ((ub - 32) << rs) + rho_g, rs, lane);
            v_to_lds(cur, vl, lane);
            const f32x16 s = qk_tile(cur, qf);
            float z[16]; float tmax = -1e30f;
            const int d0 = uq - (ub + 16 * hC);
#pragma unroll
            for (int r = 0; r < 16; ++r) { const bool valid = (unsigned)(d0 - r) <= 128u; z[r] = valid ? s[r] : -1e30f; tmax = fmaxf(tmax, z[r]); }
            tmax = fmaxf(tmax, __shfl_xor(tmax, 32));
            const float mnew = fmaxf(mrun, tmax); const float alpha = fast_exp2(mrun - mnew); mrun = mnew;
            float p[16]; float ps = 0.f;
#pragma unroll
            for (int r = 0; r < 16; ++r) { p[r] = (z[r] > -1e29f) ? fast_exp2(z[r] - mnew) : 0.f; ps += p[r]; }
            lsum = lsum * alpha + ps;
            if (!__all(alpha == 1.0f)) {
#pragma unroll
                for (int r = 0; r < 16; ++r) { o0[r] *= alpha; o1[r] *= alpha; }
            }
            pv_tile(o0, o1, p, vl, lane);
            if (!more) break;
        }
    }
    const float l = lsum + __shfl_xor(lsum, 32);
    o_store(Od + (size_t)(b * SEQ + tq) * 256 + hg * 64, o0, o1, 1.0f / l, hC);
}

__device__ __forceinline__ void p3_attention(const Args& A, Frame& F) {
    unsigned char* ws = A.ws;
    LAS unsigned char* vl = F.lds + F.wave * ATT_WAVE_LDS;
    const bf16 *Qsb = (const bf16*)(ws + A_QSB), *Ksb = (const bf16*)(ws + A_KSB), *Vsb = (const bf16*)(ws + A_VSB);
    const bf16 *Qd = (const bf16*)(ws + A_QD), *Kd = (const bf16*)(ws + A_KD), *Vd = (const bf16*)(ws + A_VD);
    bf16* Osb = (bf16*)((unsigned char*)A.out + O_OSB); bf16* Od = (bf16*)((unsigned char*)A.out + O_OD);
    constexpr int N_DIL = NB * 4 * 16 * 16, N_SB = NB * SBH * (SEQ / 32);
    for (int t = F.gw; t < N_DIL + N_SB; t += F.NGW) {
        if (t < N_DIL) dil_task(Qd, Kd, Vd, Od, t, vl, F.lane);
        else sb_task(Qsb, Ksb, Vsb, Osb, t - N_DIL, vl, F.lane);
    }
}

__device__ __forceinline__ unsigned sortable(float f) { const unsigned u = __float_as_uint(f); return u ^ ((unsigned)((int)u >> 31) | 0x80000000u); }
__device__ __forceinline__ float unsortable(unsigned s) { const unsigned u = (s & 0x80000000u) ? (s ^ 0x80000000u) : ~s; return __uint_as_float(u); }
__device__ __forceinline__ unsigned umax_(unsigned a, unsigned b) { return a > b ? a : b; }

__device__ __forceinline__ void top16_of_128(unsigned (&key)[64], LAS unsigned* top  , int lane) {
#pragma unroll
    for (int it = 0; it < 16; ++it) {
        unsigned m0 = key[0], m1 = key[1], m2 = key[2], m3 = key[3];
#pragma unroll
        for (int i = 4; i < 64; i += 4) { m0 = umax_(m0, key[i]); m1 = umax_(m1, key[i + 1]); m2 = umax_(m2, key[i + 2]); m3 = umax_(m3, key[i + 3]); }
        m0 = umax_(umax_(m0, m1), umax_(m2, m3));
        const unsigned best = umax_(m0, (unsigned)__shfl_xor((int)m0, 32));
        top[it * 64 + lane] = best;
#pragma unroll
        for (int i = 0; i < 64; ++i) key[i] = (key[i] == best) ? 0u : key[i];
    }
}
__device__ __forceinline__ unsigned pk_lookup(unsigned p0, unsigned p1, unsigned p2, unsigned p3, unsigned a) {
    const unsigned hi = a >> 2; unsigned d = p0; d = hi == 1 ? p1 : d; d = hi == 2 ? p2 : d; d = hi == 3 ? p3 : d;
    return (d >> (8 * (a & 3))) & 0xffu;
}
__device__ __forceinline__ unsigned pack4idx(unsigned t0, unsigned t1, unsigned t2, unsigned t3) { return (127u - (t0 & 127u)) | ((127u - (t1 & 127u)) << 8) | ((127u - (t2 & 127u)) << 16) | ((127u - (t3 & 127u)) << 24); }

__device__ __forceinline__ void topk_task(const bf16* Qp, const bf16* Kb, int* IDX, float* GATE, int task, int lane, LAS unsigned* tl  ) {
    const int ph = task & 7, t0 = (task >> 3) * 32;
    const int q = lane & 31, hC = lane >> 5;
#pragma unroll 1
    for (int half = 0; half < 2; ++half) {
        bf16x8 qf[8];
        { const bf16* qp = Qp + (size_t)(t0 + q) * 2048 + ph * 256 + half * 128 + 8 * hC;
#pragma unroll
          for (int st = 0; st < 8; ++st) qf[st] = *(const GAS bf16x8*)(qp + 16 * st); }
        f32x16 C[4] = {};
        const bf16* kpm[4];
#pragma unroll
        for (int mt = 0; mt < 4; ++mt) { kpm[mt] = Kb + ((size_t)(ph * 2 + half) * 128 + 32 * mt + q) * 128 + 8 * hC; asm volatile("" : "+v"(kpm[mt])); }
#pragma unroll
        for (int st = 0; st < 8; ++st) {
#pragma unroll
            for (int mt = 0; mt < 4; ++mt) { const bf16x8 kf = *(const GAS bf16x8*)(kpm[mt] + 16 * st); C[mt] = __builtin_amdgcn_mfma_f32_32x32x16_bf16(kf, qf[st], C[mt], 0, 0, 0); }
            if (st & 1) asm volatile("" ::: "memory"); }
        unsigned key[64];
#pragma unroll
        for (int mt = 0; mt < 4; ++mt)
#pragma unroll
            for (int r = 0; r < 16; ++r) { const int kidx = 32 * mt + (r & 3) + 8 * (r >> 2) + 4 * hC; key[16 * mt + r] = (sortable(C[mt][r]) & ~127u) | (unsigned)(127 - kidx); }
        top16_of_128(key, tl + half * 1024, lane);
    }
    unsigned tops[2][16];
#pragma unroll
    for (int a = 0; a < 16; ++a) { tops[0][a] = tl[a * 64 + lane]; tops[1][a] = tl[1024 + a * 64 + lane]; }
    float s0[16], s1[16];
#pragma unroll
    for (int a = 0; a < 16; ++a) { s0[a] = unsortable(tops[0][a] & ~127u); s1[a] = unsortable(tops[1][a] & ~127u); }
    const unsigned pa0 = pack4idx(tops[0][0], tops[0][1], tops[0][2], tops[0][3]), pa1 = pack4idx(tops[0][4], tops[0][5], tops[0][6], tops[0][7]),
                   pa2 = pack4idx(tops[0][8], tops[0][9], tops[0][10], tops[0][11]), pa3 = pack4idx(tops[0][12], tops[0][13], tops[0][14], tops[0][15]);
    const unsigned pb0 = pack4idx(tops[1][0], tops[1][1], tops[1][2], tops[1][3]), pb1 = pack4idx(tops[1][4], tops[1][5], tops[1][6], tops[1][7]),
                   pb2 = pack4idx(tops[1][8], tops[1][9], tops[1][10], tops[1][11]), pb3 = pack4idx(tops[1][12], tops[1][13], tops[1][14], tops[1][15]);
    unsigned cand[25];
    {
        int n = 0;
#pragma unroll
        for (int a = 0; a < 16; ++a)
#pragma unroll
            for (int bq = 0; bq < 16; ++bq) if ((a + 1) * (bq + 1) <= 16) {
                const unsigned ck = (sortable(s0[a] + s1[bq]) & ~255u) | (unsigned)(a * 16 + bq);
                if (n < 25) cand[n] = ck; else cand[n - 25] = hC ? ck : cand[n - 25];
                ++n; }
    }
    unsigned win[16];
#pragma unroll
    for (int it = 0; it < 16; ++it) {
        unsigned m = cand[0];
#pragma unroll
        for (int i = 1; i < 25; ++i) m = umax_(m, cand[i]);
        const unsigned best = umax_(m, (unsigned)__shfl_xor((int)m, 32));
        win[it] = best;
#pragma unroll
        for (int i = 0; i < 25; ++i) cand[i] = (cand[i] == best) ? 0u : cand[i];
    }
    float gv[16]; int eid[16]; float gs = 0.f;
    const float vmax = unsortable(win[0] & ~255u);
#pragma unroll
    for (int k = 0; k < 16; ++k) { const unsigned a = (win[k] >> 4) & 15u, bq = win[k] & 15u;
        eid[k] = (int)(pk_lookup(pa0, pa1, pa2, pa3, a) * 128u + pk_lookup(pb0, pb1, pb2, pb3, bq));
        gv[k] = fast_exp2((unsortable(win[k] & ~255u) - vmax) * LOG2E); gs += gv[k]; }
    const float ginv = 1.0f / gs;
    const size_t o = (size_t)(t0 + q) * 128 + ph * 16;
    if (hC == 0) {
#pragma unroll
        for (int k = 0; k < 16; k += 4) *(GAS v4u*)(IDX + o + k) = (v4u){(unsigned)eid[k], (unsigned)eid[k + 1], (unsigned)eid[k + 2], (unsigned)eid[k + 3]};
    } else {
#pragma unroll
        for (int k = 0; k < 16; k += 4) *(GAS f32x4*)(GATE + o + k) = (f32x4){gv[k] * ginv, gv[k + 1] * ginv, gv[k + 2] * ginv, gv[k + 3] * ginv};
    }
}

__device__ __forceinline__ float gelu_tanh(float x) {
    const float y2 = 2.0f * 0.7978845608028654f * (x + 0.044715f * x * x * x);
    return x * fast_rcp(1.f + fast_exp2(-y2 * LOG2E));
}
__device__ __forceinline__ void unpack8(const v4u w, float (&f)[8]) { f[0] = bflo(w.x); f[1] = bfhi(w.x); f[2] = bflo(w.y); f[3] = bfhi(w.y); f[4] = bflo(w.z); f[5] = bfhi(w.z); f[6] = bflo(w.w); f[7] = bfhi(w.w); }
__device__ __forceinline__ void peer_token(const Args& A, int t, int lane) {
    unsigned char* ws = A.ws;
    const bf16* X1M = (const bf16*)(ws + A_X1M); const bf16* UB = (const bf16*)(ws + WS_UB); const bf16* VB = (const bf16*)(ws + WS_VB);
    const int* IDX = (const int*)(ws + A_IDX); const float* GATE = (const float*)(ws + A_GATE);
    const float* mod = (const float*)(ws + WS_MOD) + (size_t)(t >> 13) * NMOD;
    const float* ssq = (const float*)(ws + WS_SSQ) + (size_t)t * 16;
    float r2; { const GAS f32x4* sp = (const GAS f32x4*)ssq; const f32x4 s4 = (sp[0] + sp[1]) + (sp[2] + sp[3]); r2 = 1.0f / sqrtf(((s4[0] + s4[1]) + (s4[2] + s4[3])) * (1.f / DM) + EPS); }
    float h2[16];
    { const v4u a = *(const GAS v4u*)(X1M + (size_t)t * DM + 8 * lane), b2 = *(const GAS v4u*)(X1M + (size_t)t * DM + 512 + 8 * lane);
      float fa[8], fb[8]; unpack8(a, fa); unpack8(b2, fb);
      const GAS f32x4* s0 = (const GAS f32x4*)(mod + 3 * DM + 8 * lane); const GAS f32x4* s1 = (const GAS f32x4*)(mod + 3 * DM + 512 + 8 * lane);
      const f32x4 sa0 = s0[0], sa1 = s0[1], sb0 = s1[0], sb1 = s1[1];
#pragma unroll
      for (int i = 0; i < 4; ++i) { h2[i] = fa[i] * r2 + sa0[i]; h2[4 + i] = fa[4 + i] * r2 + sa1[i]; h2[8 + i] = fb[i] * r2 + sb0[i]; h2[12 + i] = fb[4 + i] * r2 + sb1[i]; } }
    const int id0 = IDX[(size_t)t * 128 + lane], id1 = IDX[(size_t)t * 128 + 64 + lane];
    const float g0 = GATE[(size_t)t * 128 + lane], g1 = GATE[(size_t)t * 128 + 64 + lane];
    float acc[16];
#pragma unroll
    for (int i = 0; i < 16; ++i) acc[i] = 0.f;
    for (int e0 = 0; e0 < 128; e0 += 4) {
        v4u ua[4], ub[4], va[4], vb[4]; float gg[4];
#pragma unroll
        for (int j = 0; j < 4; ++j) { const int e = e0 + j;
            const int id = __builtin_amdgcn_readlane(e < 64 ? id0 : id1, e & 63);
            gg[j] = __uint_as_float(__builtin_amdgcn_readlane(__float_as_uint(e < 64 ? g0 : g1), e & 63));
            const bf16* up = UB + (size_t)id * DM + 8 * lane; const bf16* vp = VB + (size_t)id * DM + 8 * lane;
            ua[j] = *(const GAS v4u*)up; ub[j] = *(const GAS v4u*)(up + 512); va[j] = *(const GAS v4u*)vp; vb[j] = *(const GAS v4u*)(vp + 512); }
#pragma unroll
        for (int j = 0; j < 4; ++j) {
            float fa[8], fb[8]; unpack8(ua[j], fa); unpack8(ub[j], fb);
            float d = 0.f;
#pragma unroll
            for (int i = 0; i < 8; ++i) { d += fa[i] * h2[i]; d += fb[i] * h2[8 + i]; }
            d = wave_sum(d);
            const float a = gelu_tanh(d) * gg[j];
            unpack8(va[j], fa); unpack8(vb[j], fb);
#pragma unroll
            for (int i = 0; i < 8; ++i) { acc[i] += a * fa[i]; acc[8 + i] += a * fb[i]; }
        }
    }
    float* orow = A.out + (size_t)t * DM;
    float x2[16]; float s = 0.f;
#pragma unroll
    for (int hh = 0; hh < 2; ++hh)
#pragma unroll
        for (int v = 0; v < 2; ++v) { const int c = 512 * hh + 8 * lane + 4 * v; const f32x4 x1 = *(const GAS f32x4*)(orow + c), gt = *(const GAS f32x4*)(mod + 5 * DM + c);
#pragma unroll
            for (int i = 0; i < 4; ++i) { const float y = x1[i] + gt[i] * acc[8 * hh + 4 * v + i]; x2[8 * hh + 4 * v + i] = y; s += y * y; } }
    const float rr = 1.0f / sqrtf(wave_sum(s) * (1.f / DM) + EPS);
#pragma unroll
    for (int hh = 0; hh < 2; ++hh)
#pragma unroll
        for (int v = 0; v < 2; ++v) { const int c = 512 * hh + 8 * lane + 4 * v; const f32x4 gf = *(const GAS f32x4*)(A.g_final + c);
            f32x4 o;
#pragma unroll
            for (int i = 0; i < 4; ++i) o[i] = x2[8 * hh + 4 * v + i] * rr * gf[i];
            *(GAS f32x4*)(orow + c) = o; }
}

#ifndef MK_ONE_LAUNCH
#define MK_ONE_LAUNCH 1
#endif
constexpr int N_PHASES = 9;

__device__ __forceinline__ void biaspq_task(unsigned char* ws, int n, int lane) {
    const bf16* w = (const bf16*)(ws + WS_WPQ) + (size_t)n * DM + 16 * lane;
    float fa[8], fb[8]; unpack8(*(const GAS v4u*)w, fa); unpack8(*(const GAS v4u*)(w + 8), fb);
    float* bias = (float*)(ws + WS_BIASPQ);
#pragma unroll
    for (int b = 0; b < 4; ++b) { const GAS f32x4* sp = (const GAS f32x4*)((const float*)(ws + WS_MOD) + (size_t)b * NMOD + 3 * DM + 16 * lane);
        const f32x4 s0 = sp[0], s1 = sp[1], s2 = sp[2], s3 = sp[3]; float d = 0.f;
#pragma unroll
        for (int i = 0; i < 4; ++i) { d += fa[i] * s0[i]; d += fa[4 + i] * s1[i]; d += fb[i] * s2[i]; d += fb[4 + i] * s3[i]; }
        d = wave_sum(d); if (lane == 0) bias[b * 2048 + n] = d; }
}

__global__ void __launch_bounds__(NWAVES * 64, 2) mk_fwd(Args A) {
    extern __shared__ __attribute__((aligned(16))) unsigned char lds[];
    Frame F;
    F.lds = (LAS unsigned char*)lds;
    F.G = gridDim.x; { const int bx = blockIdx.x; F.vcu = (F.G % 8 == 0) ? (bx % 8) * (F.G / 8) + bx / 8 : bx; }
    F.NGW = F.G * NWAVES;
#define PHASE_BEGIN() do { int t_ = threadIdx.x; asm volatile("" : "+v"(t_)); F.tid = t_; F.lane = t_ & 63; F.wave = __builtin_amdgcn_readfirstlane(t_ >> 6); F.gw = F.vcu * NWAVES + F.wave; } while (0)
    PHASE_BEGIN();
    unsigned char* ws = A.ws;
    const int lo = A.ph_lo, hi = A.ph_hi;
#if MK_ONE_LAUNCH
    volatile LAS unsigned* MISC = (volatile LAS unsigned*)(F.lds + MISC_OFF);
    for (int u = F.tid; u < (LDS_BYTES - RING_BYTES) / 4; u += NWAVES * 64) ((LAS unsigned*)(F.lds + RING_BYTES))[u] = 0u;
    __syncthreads();
    XcdBarrier bar = xcd_barrier_post((unsigned*)(ws + WS_CTL) + CW_BAR, MISC + 8);
#define GRID_BAR() xcd_barrier(bar)
#else
#define GRID_BAR() do {} while (0)
#endif
#ifdef ONLY_PHASE
#define IN(k) ((k) == ONLY_PHASE && lo <= (k) && (k) < hi)
#else
#define IN(k) (lo <= (k) && (k) < hi)
#endif
#define BOTH(k) (IN(k) && IN((k) + 1))

    if (IN(0)) { PHASE_BEGIN(); p0_prologue(A, F); if (BOTH(0)) GRID_BAR(); }
    if (IN(1)) { PHASE_BEGIN(); p1_hrows(A, F); if (BOTH(1)) GRID_BAR(); }
    if (IN(2)) { PHASE_BEGIN();
        pg8::Gemm g{(const bf16*)((unsigned char*)A.out + O_H), (const bf16*)(ws + WS_WIN), TOK, NIN, DM}; pg8::StaticOrder S; S.init(TOK, NIN, F.G, (int)blockIdx.x);
        EpiG1 E{(bf16*)(ws + A_QSB), (bf16*)(ws + A_KSB), (bf16*)(ws + A_VSB), (bf16*)(ws + A_QD), (bf16*)(ws + A_KD), (bf16*)(ws + A_VD), (bf16*)(ws + A_GSB), (bf16*)(ws + A_GD),
                (const float*)(ws + WS_ROPEC), (const float*)(ws + WS_ROPES)};
        pg8::gemm_phase<EpiG1, pg8::StaticOrder, true, true>(F.lds, g, S, E);
        if (BOTH(2)) GRID_BAR();
    }
    if (IN(3)) { PHASE_BEGIN(); p3_attention(A, F); if (BOTH(3)) GRID_BAR(); }
    if (IN(4)) { PHASE_BEGIN();
        for (int n = F.gw; n < 2048; n += F.NGW) biaspq_task(ws, n, F.lane);
        __syncthreads();
        {   pg8::Gemm g{(const bf16*)((unsigned char*)A.out + O_OD), (const bf16*)(ws + WS_WDILO), TOK, DM, 256}; pg8::StaticOrder S; S.init(TOK, DM, F.G, (int)blockIdx.x);
            EpiMerge<false> E{(const bf16*)(ws + A_GD), (bf16*)(ws + A_MERGED)};
            pg8::gemm_phase<EpiMerge<false>, pg8::StaticOrder, true, true>(F.lds, g, S, E); }
        asm volatile("s_waitcnt vmcnt(0)" ::: "memory"); __syncthreads();
        {   pg8::Gemm g{(const bf16*)((unsigned char*)A.out + O_OSB), (const bf16*)(ws + WS_WSBO), TOK, DM, 512}; pg8::StaticOrder S; S.init(TOK, DM, F.G, (int)blockIdx.x);
            EpiMerge<true> E{(const bf16*)(ws + A_GSB), (bf16*)(ws + A_MERGED)};
            pg8::gemm_phase<EpiMerge<true>, pg8::StaticOrder, true, true>(F.lds, g, S, E); }
        if (BOTH(4)) GRID_BAR();
    }
    if (IN(5)) { PHASE_BEGIN();
        pg8::Gemm g{(const bf16*)(ws + A_MERGED), (const bf16*)(ws + WS_WOUT), TOK, DM, DM}; pg8::StaticOrder S; S.init(TOK, DM, F.G, (int)blockIdx.x);
        EpiOut E{A.x, A.out, (bf16*)(ws + A_X1M), (float*)(ws + WS_SSQ), (const float*)(ws + WS_MOD), A.g_ffn};
        pg8::gemm_phase<EpiOut, pg8::StaticOrder, true, true>(F.lds, g, S, E);
        if (BOTH(5)) GRID_BAR();
    }
    if (IN(6)) { PHASE_BEGIN();
        pg8::Gemm g{(const bf16*)(ws + A_X1M), (const bf16*)(ws + WS_WPQ), TOK, 2048, DM}; pg8::StaticOrder S; S.init(TOK, 2048, F.G, (int)blockIdx.x);
        EpiPq E{(const float*)(ws + WS_SSQ), (const float*)(ws + WS_BIASPQ), (bf16*)(ws + A_QPEER)};
        pg8::gemm_phase<EpiPq, pg8::StaticOrder, true, true>(F.lds, g, S, E);
        if (BOTH(6)) GRID_BAR();
    }
    if (IN(7)) { PHASE_BEGIN();
        for (int t = F.gw; t < (TOK / 32) * 8; t += F.NGW) topk_task((const bf16*)(ws + A_QPEER), (const bf16*)(ws + WS_KEYS), (int*)(ws + A_IDX), (float*)(ws + A_GATE), t, F.lane, (LAS unsigned*)(F.lds + F.wave * 8192));
        if (BOTH(7)) GRID_BAR();
    }
    if (IN(8)) { PHASE_BEGIN();
        for (int t = F.gw; t < TOK; t += F.NGW) peer_token(A, t, F.lane);
    }
#undef IN
#undef BOTH
}

extern "C" void kernel_launch(void* const* d_in, const int* in_sizes, int n_in, void* d_out, int out_size, void* d_ws, size_t ws_size, hipStream_t stream) {
    static int grid = 0;
    if (grid == 0) {
        if (n_in != 15 || in_sizes[0] != TOK * DM || out_size != TOK * DM || ws_size < WS_END) { fprintf(stderr, "kernel_launch: unexpected shapes (n_in %d, in0 %d, out %d, ws %zu < %zu)\n", n_in, n_in > 0 ? in_sizes[0] : -1, out_size, ws_size, (size_t)WS_END); grid = -1; return; }
        int dev = 0, cus = 0, per_cu = 0;
        if (hipGetDevice(&dev) != hipSuccess || hipDeviceGetAttribute(&cus, hipDeviceAttributeMultiprocessorCount, dev) != hipSuccess) { grid = -1; return; }
        if (hipFuncSetAttribute((const void*)mk_fwd, hipFuncAttributeMaxDynamicSharedMemorySize, LDS_BYTES) != hipSuccess) { fprintf(stderr, "kernel_launch: hipFuncSetAttribute failed\n"); grid = -1; return; }
        if (hipOccupancyMaxActiveBlocksPerMultiprocessor(&per_cu, (const void*)mk_fwd, NWAVES * 64, LDS_BYTES) != hipSuccess || per_cu < 1) { fprintf(stderr, "kernel_launch: occupancy query says %d\n", per_cu); per_cu = 1; }
        (void)hipGetLastError();
        grid = cus;
    }
    if (grid < 0) return;
    (void)hipMemsetAsync((char*)d_ws + WS_CTL, 0, CTL_ZERO_BYTES, stream);
    Args a{};
    a.x = (const float*)d_in[0]; a.c = (const float*)d_in[1]; a.w_ada = (const float*)d_in[2]; a.b_ada = (const float*)d_in[3]; a.g_mix = (const float*)d_in[4];
    a.w_in = (const float*)d_in[5]; a.w_sb_o = (const float*)d_in[6]; a.w_dil_o = (const float*)d_in[7]; a.w_out = (const float*)d_in[8]; a.g_ffn = (const float*)d_in[9];
    a.w_pq = (const float*)d_in[10]; a.peer_keys = (const float*)d_in[11]; a.peer_u = (const float*)d_in[12]; a.peer_v = (const float*)d_in[13]; a.g_final = (const float*)d_in[14];
    a.out = (float*)d_out; a.ws = (unsigned char*)d_ws;
#if MK_ONE_LAUNCH
    a.ph_lo = 0; a.ph_hi = N_PHASES;
    void* args[] = {&a};
    hipError_t e = hipLaunchCooperativeKernel((const void*)mk_fwd, dim3(grid), dim3(NWAVES * 64), args, LDS_BYTES, stream);
    if (e != hipSuccess) fprintf(stderr, "kernel_launch: cooperative launch failed: %s (grid %d)\n", hipGetErrorString(e), grid);
#else
    for (int p = 0; p < N_PHASES; ++p) { a.ph_lo = p; a.ph_hi = p + 1; hipLaunchKernelGGL(mk_fwd, dim3(grid), dim3(NWAVES * 64), LDS_BYTES, stream, a); }
#endif
}
```

```cpp
#include <hip/hip_runtime.h>
#include <hip/hip_cooperative_groups.h>
#include <cstdio>
#include <cstdint>
namespace pg8 {
#define PG8_LAS __attribute__((address_space(3)))
typedef unsigned short bf16_t;
typedef short bf16x8 __attribute__((ext_vector_type(8)));
typedef float f32x4 __attribute__((ext_vector_type(4)));
typedef unsigned u32x4 __attribute__((ext_vector_type(4)));
constexpr int BM = 256, BK = 64, HALF = 128, HTB = HALF * BK * 2  , STAGE_BYTES = 8 * HTB, NXCD = 8, WGM = 8;

__host__ __device__ __forceinline__ int lds_byte(int r, int c) { const int st = (r >> 4) * 2 + (c >> 5), rr = r & 15, cc = c & 31, ob = rr * 64 + cc * 2; return st * 1024 + (ob ^ (((ob >> 9) & 1) << 5)); }
__host__ __device__ __forceinline__ void stage_rc(int b, int& R, int& C) { const int st = b / 1024, sb = b % 1024, swz = sb ^ (((sb >> 9) & 1) << 5); R = (st >> 1) * 16 + swz / 64; C = (st & 1) * 32 + (swz % 64) / 2; }
__host__ __device__ __forceinline__ int perm32(int rho) { const int n = rho >> 4, i = rho & 15; return 8 * (i >> 2) + 4 * n + (i & 3); }

struct Unit { int pm, pn; };
struct Gemm { const bf16_t* A; const bf16_t* Bt; int M, N, K; };

struct StaticOrder {
    int nM, nN, nwg, G, c;
    __host__ __device__ void init(int M, int N, int G_, int c_) { nM = M / BM; nN = N / BM; nwg = nM * nN; G = G_; c = c_; }
    __host__ __device__ bool next(int i, Unit& u) const {
        const long L = (long)i * G + c; if (L >= nwg) return false;
        int wgid = (int)L; { const int q = nwg / NXCD, r = nwg % NXCD, xcd = wgid % NXCD, off = wgid / NXCD; wgid = (xcd < r ? xcd * (q + 1) : r * (q + 1) + (xcd - r) * q) + off; }
        const int nig = WGM * nN, gid = wgid / nig, fm = gid * WGM, gsz = (nM - fm) < WGM ? (nM - fm) : WGM;
        u.pm = fm + ((wgid % nig) % gsz); u.pn = (wgid % nig) / gsz; return true;
    }
    __device__ __forceinline__ void a_ready(const Unit&) const {}
    __device__ __forceinline__ void done(const Unit&) const {}
};

__device__ __forceinline__ unsigned cvt_pk_bf16(float lo, float hi) { unsigned r; asm volatile("v_cvt_pk_bf16_f32 %0, %1, %2" : "=v"(r) : "v"(lo), "v"(hi)); return r; }
template <class Epi, class Sched, bool ALIGN_EPI = false, bool SP2 = false>
__device__ __forceinline__ void gemm_phase(PG8_LAS unsigned char* lds, const Gemm g, const Sched& S, const Epi& E) {
    int tid_ = threadIdx.x; asm volatile("" : "+v"(tid_));
    const int tid = tid_, wid = __builtin_amdgcn_readfirstlane(tid >> 6), lane = tid & 63, wr = wid >> 2, wc = wid & 3, fr = lane & 15, fq = lane >> 4;
    const int K = g.K, nt = K / BK;
    unsigned voffA[2], voffB[2];
#pragma unroll
    for (int i = 0; i < 2; ++i) { int R, C; stage_rc(tid * 16 + i * 8192, R, C); const int Rb = Epi::PERM ? ((R & ~31) + perm32(R & 31)) : R;
        voffA[i] = (unsigned)(R * K + C) * 2u; voffB[i] = (unsigned)(Rb * K + C) * 2u; }
    const size_t kstep = (size_t)(BK * 2);
    const size_t hstep = (size_t)HALF * K * 2;
    const size_t tstep = 2 * hstep;
    const unsigned ldsw = (unsigned)wid * 1024u;
    const int aoff = lds_byte(wr * 64 + fr, fq * 8), boff = lds_byte(wc * 32 + fr, fq * 8);
#define PG8_SA(b, h) (((b) * 2 + (h)) * HTB)
#define PG8_SB(b, h) ((4 + (b) * 2 + (h)) * HTB)
#define PG8_STAGE(bufoff, gbase, voff) do { _Pragma("unroll") for (int _i = 0; _i < 2; ++_i) \
        __builtin_amdgcn_global_load_lds((const unsigned*)((const char*)(gbase) + (voff)[_i]), (PG8_LAS unsigned*)(lds + (bufoff) + ldsw + _i * 8192), 16, 0, 0); } while (0)
#define PG8_LDA(dst, b, h) do { _Pragma("unroll") for (int m = 0; m < 4; ++m) _Pragma("unroll") for (int k = 0; k < 2; ++k) dst[m][k] = *(const PG8_LAS bf16x8*)(lds + PG8_SA(b, h) + aoff + m * 2048 + k * 1024); } while (0)
#define PG8_LDB(dst, b, h) do { _Pragma("unroll") for (int n = 0; n < 2; ++n) _Pragma("unroll") for (int k = 0; k < 2; ++k) dst[n][k] = *(const PG8_LAS bf16x8*)(lds + PG8_SB(b, h) + boff + n * 2048 + k * 1024); } while (0)
#define PG8_MMA(ai, bj, At, Bt) do { __builtin_amdgcn_s_setprio(1); _Pragma("unroll") for (int m = 0; m < 4; ++m) _Pragma("unroll") for (int n = 0; n < 2; ++n) _Pragma("unroll") for (int k = 0; k < 2; ++k) \
        acc[ai][bj][m][n] = __builtin_amdgcn_mfma_f32_16x16x32_bf16(Bt[n][k], At[m][k], acc[ai][bj][m][n], 0, 0, 0); __builtin_amdgcn_s_setprio(0); } while (0)
#define PG8_WAIT_V(n) asm volatile("s_waitcnt vmcnt(" #n ")" ::: "memory")
#define PG8_WAIT_L(n) asm volatile("s_waitcnt lgkmcnt(" #n ")" ::: "memory")
#define PG8_BAR __builtin_amdgcn_s_barrier()
#define PG8_SCHED __builtin_amdgcn_sched_barrier(0)
    Unit cur, nxt; int ui = 0;
    if (!S.next(0, cur)) return;
    f32x4 acc[2][2][4][2];
#pragma unroll
    for (int a = 0; a < 2; ++a)
#pragma unroll
        for (int b = 0; b < 2; ++b)
#pragma unroll
            for (int m = 0; m < 4; ++m)
#pragma unroll
                for (int n = 0; n < 2; ++n) acc[a][b][m][n] = (f32x4){0.f, 0.f, 0.f, 0.f};
    bf16x8 At[4][2], B0[2][2], B1[2][2];
    const char* cA = (const char*)g.A + (size_t)cur.pm * tstep; const char* cB = (const char*)g.Bt + (size_t)cur.pn * tstep;
    S.a_ready(cur);
    if constexpr (SP2) {
        PG8_STAGE(PG8_SB(0, 0), cB, voffB); PG8_STAGE(PG8_SB(0, 1), cB + hstep, voffB); PG8_STAGE(PG8_SA(0, 0), cA, voffA); PG8_STAGE(PG8_SA(0, 1), cA + hstep, voffA);
        if (wr == 1) PG8_BAR;
        PG8_WAIT_V(2); PG8_BAR;
        PG8_STAGE(PG8_SB(1, 0), cB + kstep, voffB); PG8_STAGE(PG8_SA(1, 0), cA + kstep, voffA); PG8_STAGE(PG8_SB(1, 1), cB + hstep + kstep, voffB);
        PG8_WAIT_V(6); PG8_BAR;
    } else {
        PG8_STAGE(PG8_SB(0, 0), cB, voffB); PG8_STAGE(PG8_SA(0, 0), cA, voffA); PG8_STAGE(PG8_SB(0, 1), cB + hstep, voffB); PG8_STAGE(PG8_SA(0, 1), cA + hstep, voffA);
        if (wr == 1) PG8_BAR;
        PG8_WAIT_V(4); PG8_BAR;
        PG8_STAGE(PG8_SB(1, 0), cB + kstep, voffB); PG8_STAGE(PG8_SA(1, 0), cA + kstep, voffA); PG8_STAGE(PG8_SB(1, 1), cB + hstep + kstep, voffB);
        PG8_WAIT_V(6); PG8_BAR;
    }
    for (;;) {
        const bool has_next = S.next(ui + 1, nxt);
        const char* nA = has_next ? (const char*)g.A + (size_t)nxt.pm * tstep : cA; const char* nB = has_next ? (const char*)g.Bt + (size_t)nxt.pn * tstep : cB;
        for (int t = 0; t < nt; t += 2) {
            const bool last = (t == nt - 2);
            const char* a1 = cA + (size_t)(t + 1) * kstep;
            const char* a2 = last ? nA : cA + (size_t)(t + 2) * kstep; const char* b2 = last ? nB : cB + (size_t)(t + 2) * kstep;
            const char* a3 = a2 + kstep; const char* b3 = b2 + kstep;
            if (last && has_next) S.a_ready(nxt);
            if constexpr (SP2) {
            PG8_LDB(B0, 0, 0); PG8_LDB(B1, 0, 1); PG8_SCHED; PG8_LDA(At, 0, 0); PG8_STAGE(PG8_SA(1, 1), a1 + hstep, voffA);
            PG8_WAIT_V(8); PG8_WAIT_L(0); PG8_BAR; PG8_MMA(0, 0, At, B0); PG8_MMA(0, 1, At, B1); PG8_BAR; PG8_SCHED;
            PG8_LDA(At, 0, 1); PG8_STAGE(PG8_SB(0, 0), b2, voffB); PG8_STAGE(PG8_SB(0, 1), b2 + hstep, voffB); PG8_STAGE(PG8_SA(0, 0), a2, voffA);
            PG8_WAIT_V(8); PG8_WAIT_L(0); PG8_BAR; PG8_MMA(1, 0, At, B0); PG8_MMA(1, 1, At, B1); PG8_BAR; PG8_SCHED;
            PG8_LDB(B0, 1, 0); PG8_LDB(B1, 1, 1); PG8_SCHED; PG8_LDA(At, 1, 0); PG8_STAGE(PG8_SA(0, 1), a2 + hstep, voffA);
            PG8_WAIT_V(8); PG8_WAIT_L(0); PG8_BAR; PG8_MMA(0, 0, At, B0); PG8_MMA(0, 1, At, B1); PG8_BAR; PG8_SCHED;
            PG8_LDA(At, 1, 1); PG8_STAGE(PG8_SB(1, 0), b3, voffB); PG8_STAGE(PG8_SB(1, 1), b3 + hstep, voffB); PG8_STAGE(PG8_SA(1, 0), a3, voffA);
            PG8_WAIT_V(8); PG8_WAIT_L(0); PG8_BAR; PG8_MMA(1, 0, At, B0); PG8_MMA(1, 1, At, B1); PG8_BAR; PG8_SCHED;
            } else {
            PG8_LDB(B0, 0, 0); PG8_SCHED; PG8_LDA(At, 0, 0); PG8_STAGE(PG8_SA(1, 1), a1 + hstep, voffA);
            PG8_WAIT_L(8); PG8_BAR; PG8_WAIT_L(0); PG8_MMA(0, 0, At, B0); PG8_BAR; PG8_SCHED;
            PG8_LDB(B1, 0, 1); PG8_STAGE(PG8_SB(0, 0), b2, voffB);
            PG8_BAR; PG8_WAIT_L(0); PG8_MMA(0, 1, At, B1); PG8_BAR;
            PG8_LDA(At, 0, 1); PG8_STAGE(PG8_SA(0, 0), a2, voffA);
            PG8_BAR; PG8_WAIT_L(0); PG8_MMA(1, 0, At, B0); PG8_BAR; PG8_SCHED;
            PG8_STAGE(PG8_SB(0, 1), b2 + hstep, voffB);
            PG8_WAIT_V(6); PG8_BAR; PG8_MMA(1, 1, At, B1); PG8_BAR;
            PG8_LDB(B0, 1, 0); PG8_SCHED; PG8_LDA(At, 1, 0); PG8_STAGE(PG8_SA(0, 1), a2 + hstep, voffA);
            PG8_WAIT_L(8); PG8_BAR; PG8_WAIT_L(0); PG8_MMA(0, 0, At, B0); PG8_BAR; PG8_SCHED;
            PG8_LDB(B1, 1, 1); PG8_STAGE(PG8_SB(1, 0), b3, voffB);
            PG8_BAR; PG8_WAIT_L(0); PG8_MMA(0, 1, At, B1); PG8_BAR;
            PG8_LDA(At, 1, 1); PG8_STAGE(PG8_SA(1, 0), a3, voffA);
            PG8_BAR; PG8_WAIT_L(0); PG8_MMA(1, 0, At, B0); PG8_BAR; PG8_SCHED;
            PG8_STAGE(PG8_SB(1, 1), b3 + hstep, voffB);
            PG8_WAIT_V(6); PG8_BAR; PG8_MMA(1, 1, At, B1); PG8_BAR;
            }
        }
        if constexpr (ALIGN_EPI) { if (wr == 0) PG8_BAR; }
        if constexpr (!Epi::AFTER_DRAIN) { E(acc, cur, wr, wc, fr, fq); S.done(cur); }
        if (!has_next) break;
#pragma unroll
        for (int a = 0; a < 2; ++a)
#pragma unroll
            for (int b = 0; b < 2; ++b)
#pragma unroll
                for (int m = 0; m < 4; ++m)
#pragma unroll
                    for (int n = 0; n < 2; ++n) acc[a][b][m][n] = (f32x4){0.f, 0.f, 0.f, 0.f};
        cur = nxt; cA = nA; cB = nB; ++ui;
        if constexpr (ALIGN_EPI) { if (wr == 1) PG8_BAR; }
    }
    PG8_WAIT_V(0);
    if constexpr (!ALIGN_EPI) { if (wr == 0) PG8_BAR; }
    PG8_BAR;
    if constexpr (Epi::AFTER_DRAIN) { E.fused(acc, cur, wr, wc, fr, fq, lds, wid, lane); S.done(cur); }
#undef PG8_SA
#undef PG8_SB
#undef PG8_STAGE
#undef PG8_LDA
#undef PG8_LDB
#undef PG8_MMA
#undef PG8_WAIT_V
#undef PG8_WAIT_L
#undef PG8_BAR
#undef PG8_SCHED
}
}

#define GAS __attribute__((address_space(1)))
#define LAS __attribute__((address_space(3)))
typedef unsigned short bf16;
typedef unsigned v4u __attribute__((ext_vector_type(4)));
typedef unsigned v2u __attribute__((ext_vector_type(2)));
typedef float f32x4 __attribute__((ext_vector_type(4)));
typedef float f32x16 __attribute__((ext_vector_type(16)));
typedef short bf16x8 __attribute__((ext_vector_type(8)));
typedef short s16x4 __attribute__((ext_vector_type(4)));

constexpr int NWAVES = 8;
constexpr int NB = 4, SEQ = 8192, DM = 1024, TOK = NB * SEQ;
constexpr int NIN = 5888;
constexpr int SBH = 8, DILH = 12;
constexpr int NMOD = 6 * DM;
constexpr int KSPLIT = 16;
constexpr float EPS = 1e-6f;
constexpr float LOG2E = 1.4426950408889634f;
constexpr float C2 = 0.125f * LOG2E;
constexpr int PEER_E = 16384;

constexpr size_t MiB = 1u << 20;
constexpr size_t WS_CTL = 0, CTL_ZERO_BYTES = 1 * MiB;
constexpr size_t WS_MODP = 1 * MiB;
constexpr size_t WS_MOD = 2 * MiB + 512 * 1024;
constexpr size_t WS_BIASPQ = 2 * MiB + 768 * 1024;
constexpr size_t WS_ROPEC = 3 * MiB, WS_ROPES = 4 * MiB;
constexpr size_t WS_SSQ = 5 * MiB;
constexpr size_t WS_KEYS = 7 * MiB;
constexpr size_t WS_WIN = 8 * MiB;
constexpr size_t WS_WSBO = 20 * MiB;
constexpr size_t WS_WDILO = 21 * MiB;
constexpr size_t WS_WOUT = 22 * MiB;
constexpr size_t WS_WPQ = 24 * MiB;
constexpr size_t WS_UB = 32 * MiB, WS_VB = 64 * MiB;
constexpr size_t WS_ACT = 96 * MiB;
constexpr size_t A_QSB = WS_ACT, A_KSB = WS_ACT + 32 * MiB, A_VSB = WS_ACT + 64 * MiB;
constexpr size_t A_QD = WS_ACT + 96 * MiB, A_KD = WS_ACT + 144 * MiB, A_VD = WS_ACT + 192 * MiB;
constexpr size_t A_GSB = WS_ACT + 240 * MiB, A_GD = WS_ACT + 304 * MiB;
constexpr size_t A_MERGED = WS_ACT;
constexpr size_t A_X1M = WS_ACT + 64 * MiB;
constexpr size_t A_QPEER = WS_ACT + 128 * MiB;
constexpr size_t A_IDX = WS_ACT + 256 * MiB;
constexpr size_t A_GATE = WS_ACT + 272 * MiB;
constexpr size_t A_ACTG = WS_ACT + 288 * MiB;
constexpr size_t A_POUT = WS_ACT;
constexpr size_t WS_END = WS_ACT + 368 * MiB;
constexpr size_t O_H = 0, O_OSB = 64 * MiB, O_OD = 96 * MiB;

constexpr int CW_BAR = 4096;

constexpr int RING_BYTES = 131072;
constexpr int MISC_OFF = RING_BYTES + 320;
constexpr int LDS_BYTES = 147456;

#define RLX_AGENT __ATOMIC_RELAXED, __HIP_MEMORY_SCOPE_AGENT
__device__ __forceinline__ unsigned f2bf(float f) { unsigned u = __builtin_bit_cast(unsigned, f); return (u + 0x7fffu + ((u >> 16) & 1u)) >> 16; }
typedef float f32x2_t __attribute__((ext_vector_type(2))); typedef __bf16 bf16x2_t __attribute__((ext_vector_type(2)));
__device__ __forceinline__ unsigned pk2(float lo, float hi) { f32x2_t v = {lo, hi}; bf16x2_t b = __builtin_convertvector(v, bf16x2_t); return __builtin_bit_cast(unsigned, b); }
__device__ __forceinline__ float bflo(unsigned w) { return __uint_as_float(w << 16); }
__device__ __forceinline__ float bfhi(unsigned w) { return __uint_as_float(w & 0xffff0000u); }
__device__ __forceinline__ float wave_sum(float v) {
#pragma unroll
    for (int o = 1; o < 64; o <<= 1) v += __shfl_xor(v, o);
    return v;
}
__device__ __forceinline__ float fast_exp2(float x) { return __builtin_amdgcn_exp2f(x); }
__device__ __forceinline__ float fast_log2(float x) { return __builtin_amdgcn_logf(x); }
__device__ __forceinline__ float fast_rcp(float x) { return __builtin_amdgcn_rcpf(x); }
__device__ __forceinline__ float sigmoidf_(float x) { return fast_rcp(1.f + fast_exp2(-x * LOG2E)); }
#define XB_TMO      128
#define XB_XCNT(j)  (256  + 64 * (j))
#define XB_XSUB(j)  (1280 + 64 * (j))
#define XB_XGEN(j)  (2304 + 64 * (j))
#define XB_TOP      3328
#define XB_TOPGEN   3392
#define XCD_BAR_WORDS 3456
#define XB_SPIN_CAP (1u << 18)

__device__ __forceinline__ unsigned xb_ld(unsigned* p)              { return __hip_atomic_load(p, __ATOMIC_RELAXED, __HIP_MEMORY_SCOPE_AGENT); }
__device__ __forceinline__ unsigned xb_add(unsigned* p, unsigned v) { return __hip_atomic_fetch_add(p, v, __ATOMIC_RELAXED, __HIP_MEMORY_SCOPE_AGENT); }
__device__ __forceinline__ unsigned xb_xcc_id() { return (unsigned)__builtin_amdgcn_s_getreg((3 << 11) | 20) & 0xFu; }
#define XB_SPIN(cond, bar) do { unsigned _sp = 0; while (cond) { __builtin_amdgcn_s_sleep(1); \
    if ((++_sp & 255u) == 0u) { if (xb_ld(&(bar)[XB_TMO])) break; if (_sp > XB_SPIN_CAP) { atomicAdd(&(bar)[XB_TMO], 1u); break; } } } } while (0)

struct XcdBarrier {
    unsigned* bar; unsigned x;
    volatile LAS unsigned* st;
};

__device__ __forceinline__ XcdBarrier xcd_barrier_post(unsigned* bar, volatile LAS unsigned* st) {
    XcdBarrier b; b.bar = bar; b.x = xb_xcc_id(); b.st = st;
    if (threadIdx.x == 0) (void)xb_add(&bar[XB_XCNT(b.x)], 1u);
    return b;
}
__device__ __forceinline__ void xcd_barrier_complete(unsigned* bar, unsigned x, unsigned& nloc, unsigned& nx) {
    const unsigned G = gridDim.x * gridDim.y * gridDim.z;
    unsigned sum, cnt, mine, sp = 0u;
    for (;;) {
        sum = 0u; cnt = 0u; mine = 0u;
#pragma unroll
        for (unsigned j = 0; j < 16; ++j) { const unsigned c = xb_ld(&bar[XB_XCNT(j)]); sum += c; cnt += (c > 0u) ? 1u : 0u; mine = (j == x) ? c : mine; }
        if (sum == G) break;
        __builtin_amdgcn_s_sleep(1);
        if ((++sp & 255u) == 0u) { if (xb_ld(&bar[XB_TMO])) break; if (sp > XB_SPIN_CAP) { atomicAdd(&bar[XB_TMO], 1u); break; } }
    }
    nloc = mine > 0u ? mine : 1u; nx = cnt > 0u ? cnt : 1u;
}

__device__ __forceinline__ void xcd_barrier(const XcdBarrier& b) {
    asm volatile("s_waitcnt vmcnt(0)" ::: "memory");
    __syncthreads();
    if (threadIdx.x == 0) {
        unsigned* bar = b.bar;
        __builtin_amdgcn_s_waitcnt(0);
        unsigned nloc = b.st[0], nx = b.st[1];
        if (nloc == 0u) { xcd_barrier_complete(bar, b.x, nloc, nx); b.st[0] = nloc; b.st[1] = nx; }
        const unsigned old = xb_add(&bar[XB_XSUB(b.x)], 1u);
        const unsigned gen = old / nloc;
        if (old + 1u == (gen + 1u) * nloc) {
            __builtin_amdgcn_fence(__ATOMIC_RELEASE, "agent");
            asm volatile("s_waitcnt vmcnt(0)" ::: "memory");
            const unsigned og = xb_add(&bar[XB_TOP], 1u);
            const unsigned tg = og / nx;
            if (og + 1u == (tg + 1u) * nx) xb_add(&bar[XB_TOPGEN], 1u);
            else XB_SPIN(xb_ld(&bar[XB_TOPGEN]) == tg, bar);
            __builtin_amdgcn_fence(__ATOMIC_ACQUIRE, "agent");
            xb_add(&bar[XB_XGEN(b.x)], 1u);
            asm volatile("s_waitcnt vmcnt(0)" ::: "memory");
        } else {
            XB_SPIN(xb_ld(&bar[XB_XGEN(b.x)]) == gen, bar);
            __builtin_amdgcn_fence(__ATOMIC_ACQUIRE, "agent");
            asm volatile("s_waitcnt vmcnt(0)" ::: "memory");
        }
    }
    __syncthreads();
}

struct Args {
    const float* x; const float* c; const float* w_ada; const float* b_ada; const float* g_mix; const float* w_in; const float* w_sb_o; const float* w_dil_o;
    const float* w_out; const float* g_ffn; const float* w_pq; const float* peer_keys; const float* peer_u; const float* peer_v; const float* g_final;
    float* out; unsigned char* ws; int ph_lo, ph_hi;
};
struct Frame {
    LAS unsigned char* lds;
    int tid, lane, wave, vcu, G, gw, NGW;
};

__device__ __forceinline__ int win_row(int ncol) {
    const int tile = ncol >> 8;
    if (tile >= 6 && tile < 12) { const int d = ncol & 63; const int j = (d & 31) >> 2, i = (d & 3) + ((d >> 5) << 2); return (ncol & ~63) + 8 * j + i; }
    return ncol;
}
template <bool MAPWIN>
__device__ __forceinline__ void p0_transpose_item(const float* W, int K, int N, bf16* WT, LAS float* scr, int item, int lane) {
    const int nblk = N / 32, kb = item / nblk, nb = item % nblk, k0 = 64 * kb, n0 = 32 * nb;
#pragma unroll 8
    for (int i = 0; i < 32; ++i) { const int kk = 2 * i + (lane >> 5); scr[kk * 33 + (lane & 31)] = W[(size_t)(k0 + kk) * N + n0 + (lane & 31)]; }
    asm volatile("s_waitcnt lgkmcnt(0)" ::: "memory");
    const int c = lane & 7;
#pragma unroll
    for (int j = 0; j < 4; ++j) { const int n = (lane >> 3) + 8 * j; const LAS float* s = scr + (8 * c) * 33 + n;
        v4u o; o.x = pk2(s[0 * 33], s[1 * 33]); o.y = pk2(s[2 * 33], s[3 * 33]); o.z = pk2(s[4 * 33], s[5 * 33]); o.w = pk2(s[6 * 33], s[7 * 33]);
        const int rowo = MAPWIN ? win_row(n0 + n) : (n0 + n);
        *(GAS v4u*)(WT + (size_t)rowo * K + k0 + 8 * c) = o; }
    asm volatile("s_waitcnt lgkmcnt(0)" ::: "memory");
}
__device__ __forceinline__ void cvt_row_1024(const float* src, bf16* dst, int lane) {
    const GAS f32x4* s = (const GAS f32x4*)src + lane; GAS v2u* d = (GAS v2u*)dst + lane;
    f32x4 v[4];
#pragma unroll
    for (int j = 0; j < 4; ++j) v[j] = s[64 * j];
#pragma unroll
    for (int j = 0; j < 4; ++j) { v2u o; o.x = pk2(v[j].x, v[j].y); o.y = pk2(v[j].z, v[j].w); d[64 * j] = o; }
}
template <bool SLICED>
__device__ __forceinline__ void cvt_row_fp8(const float* src, unsigned char* dst, float* inv, int e, int lane) {
    const GAS f32x4* s = (const GAS f32x4*)src + lane;
    f32x4 v[4]; float m = 0.f;
#pragma unroll
    for (int j = 0; j < 4; ++j) { v[j] = s[64 * j]; m = fmaxf(m, fmaxf(fmaxf(fabsf(v[j].x), fabsf(v[j].y)), fmaxf(fabsf(v[j].z), fabsf(v[j].w)))); }
#pragma unroll
    for (int o = 1; o < 64; o <<= 1) m = fmaxf(m, __shfl_xor(m, o));
    m = fmaxf(m, 1e-30f);
    const int ex = (int)((__float_as_uint(m) >> 23) & 0xff) - 127;
    const float scale = __uint_as_float((unsigned)(127 + 7 - ex) << 23);
    const float iscale = __uint_as_float((unsigned)(127 - 7 + ex) << 23);
    unsigned w[4];
#pragma unroll
    for (int j = 0; j < 4; ++j) { int t = __builtin_amdgcn_cvt_pk_fp8_f32(v[j].x * scale, v[j].y * scale, 0, false); t = __builtin_amdgcn_cvt_pk_fp8_f32(v[j].z * scale, v[j].w * scale, t, true); w[j] = (unsigned)t; }
    if (!SLICED) { *(GAS v4u*)(dst + (size_t)e * 1024 + 16 * lane) = (v4u){w[0], w[1], w[2], w[3]}; }
    else {
#pragma unroll
        for (int j = 0; j < 4; ++j) *(GAS unsigned*)(dst + (size_t)(2 * j + (lane >> 5)) * (2 * MiB) + (size_t)e * 128 + 4 * (lane & 31)) = w[j]; }
    if (lane == 0) inv[e] = iscale;
}
__device__ __forceinline__ void sincos_d(double a, float& sn, float& cs) {
    const double TWO_PI = 6.283185307179586476925286766559;
    const double k = __builtin_rint(a / TWO_PI); const double r = a - k * TWO_PI; const double r2 = r * r;
    double ts = 1.0, tc = 1.0, ss = 1.0, cc = 1.0;
#pragma unroll
    for (int n = 1; n <= 14; ++n) { tc = -tc * r2 / (double)((2 * n - 1) * (2 * n)); ts = -ts * r2 / (double)((2 * n) * (2 * n + 1)); cc += tc; ss += ts; }
    sn = (float)(r * ss); cs = (float)cc;
}

__device__ __forceinline__ void p0_prologue(const Args& A, Frame& F) {
    unsigned char* ws = A.ws;
    LAS float* scr = (LAS float*)(F.lds + F.wave * 16384);
    const int lane = F.lane;
    constexpr int I_MOD = KSPLIT * 24;
    constexpr int I_WIN = (DM / 64) * (NIN / 32);
    constexpr int I_SBO = (512 / 64) * (DM / 32), I_DILO = (256 / 64) * (DM / 32), I_OUT = (DM / 64) * (DM / 32), I_PQ = (DM / 64) * (2048 / 32);
    constexpr int I_KEYS = 256, I_TAB = 2 * PEER_E, I_ROPE = SEQ * 32 / 64;
    constexpr int NITEMS = I_MOD + I_WIN + I_SBO + I_DILO + I_OUT + I_PQ + I_KEYS + I_TAB + I_ROPE;
    for (int it = F.gw; it < NITEMS; it += F.NGW) {
        int r = it;
        if (r < I_MOD) {
            const int ks = r / 24, cc = r % 24, col = 256 * cc + 4 * lane, k0 = 64 * ks;
            float sv[4];
#pragma unroll
            for (int b = 0; b < 4; ++b) { const float cv = A.c[b * DM + k0 + lane]; sv[b] = cv * sigmoidf_(cv); }
            f32x4 acc[4];
#pragma unroll
            for (int b = 0; b < 4; ++b) acc[b] = (f32x4){0.f, 0.f, 0.f, 0.f};
            const GAS f32x4* wp = (const GAS f32x4*)(A.w_ada + (size_t)k0 * NMOD + col);
#pragma unroll 8
            for (int kk = 0; kk < 64; ++kk) { const f32x4 w4 = wp[(size_t)kk * (NMOD / 4)];
#pragma unroll
                for (int b = 0; b < 4; ++b) { const float s = __uint_as_float(__builtin_amdgcn_readlane(__float_as_uint(sv[b]), kk)); acc[b] += w4 * s; } }
            float* mp = (float*)(ws + WS_MODP);
#pragma unroll
            for (int b = 0; b < 4; ++b) *(GAS f32x4*)(mp + ((size_t)(ks * 4 + b)) * NMOD + col) = acc[b];
            continue;
        }
        r -= I_MOD;
        if (r < I_WIN) { p0_transpose_item<true>(A.w_in, DM, NIN, (bf16*)(ws + WS_WIN), scr, r, lane); continue; } r -= I_WIN;
        if (r < I_SBO) { p0_transpose_item<false>(A.w_sb_o, 512, DM, (bf16*)(ws + WS_WSBO), scr, r, lane); continue; } r -= I_SBO;
        if (r < I_DILO) { p0_transpose_item<false>(A.w_dil_o, 256, DM, (bf16*)(ws + WS_WDILO), scr, r, lane); continue; } r -= I_DILO;
        if (r < I_OUT) { p0_transpose_item<false>(A.w_out, DM, DM, (bf16*)(ws + WS_WOUT), scr, r, lane); continue; } r -= I_OUT;
        if (r < I_PQ) { p0_transpose_item<false>(A.w_pq, DM, 2048, (bf16*)(ws + WS_WPQ), scr, r, lane); continue; } r -= I_PQ;
        if (r < I_KEYS) { cvt_row_1024(A.peer_keys + (size_t)r * 1024, (bf16*)(ws + WS_KEYS) + (size_t)r * 1024, lane); continue; } r -= I_KEYS;
        if (r < I_TAB) { if (r < PEER_E) cvt_row_fp8<false>(A.peer_u + (size_t)r * 1024, ws + WS_UB, (float*)(ws + WS_UB + 16 * MiB), r, lane);
                         else cvt_row_fp8<true>(A.peer_v + (size_t)(r - PEER_E) * 1024, ws + WS_VB, (float*)(ws + WS_VB + 16 * MiB), r - PEER_E, lane); continue; } r -= I_TAB;
        {
            const int idx = r * 64 + lane, s = idx >> 5, j = idx & 31;
            const float inv = (float)exp2(-(double)j * (13.287712379549449 / 32.0));
            const float ang = (float)s * inv;
            float sn, cs; sincos_d((double)ang, sn, cs);
            ((float*)(ws + WS_ROPEC))[idx] = cs; ((float*)(ws + WS_ROPES))[idx] = sn;
        }
    }
}

__device__ __forceinline__ void p1_hrows(const Args& A, Frame& F) {
    unsigned char* ws = A.ws;
    LAS float* mult = (LAS float*)F.lds; LAS float* addv = mult + DM;
    const float* mp = (const float*)(ws + WS_MODP);
    float* mod = (float*)(ws + WS_MOD);
    bf16* H = (bf16*)((unsigned char*)A.out + O_H);
    for (int ch = F.vcu; ch < TOK / 128; ch += F.G) {
        const int b = (ch * 128) / SEQ;
        __syncthreads();
        for (int k = F.tid; k < DM; k += NWAVES * 64) {
            float sh = A.b_ada[k], sc = A.b_ada[DM + k];
#pragma unroll
            for (int ks = 0; ks < KSPLIT; ++ks) { sh += mp[(size_t)(ks * 4 + b) * NMOD + k]; sc += mp[(size_t)(ks * 4 + b) * NMOD + DM + k]; }
            mult[k] = A.g_mix[k] * (1.f + sc); addv[k] = sh;
        }
        if ((ch * 128) % SEQ == 0) {
            for (int j = F.tid; j < NMOD; j += NWAVES * 64) { float v = A.b_ada[j];
#pragma unroll
                for (int ks = 0; ks < KSPLIT; ++ks) v += mp[(size_t)(ks * 4 + b) * NMOD + j];
                mod[b * NMOD + j] = v; }
        }
        __syncthreads();
        for (int i = 0; i < 16; ++i) {
            const int row = ch * 128 + F.wave * 16 + i;
            const GAS f32x4* xr = (const GAS f32x4*)(A.x + (size_t)row * DM) + F.lane;
            f32x4 v[4]; float s = 0.f;
#pragma unroll
            for (int j = 0; j < 4; ++j) { v[j] = xr[64 * j]; s += (v[j].x * v[j].x + v[j].y * v[j].y) + (v[j].z * v[j].z + v[j].w * v[j].w); }
            const float rr = 1.0f / sqrtf(wave_sum(s) * (1.f / DM) + EPS);
            GAS v2u* o8 = (GAS v2u*)(H + (size_t)row * DM) + F.lane;
#pragma unroll
            for (int j = 0; j < 4; ++j) { const f32x4 mu = *(const LAS f32x4*)(mult + 256 * j + 4 * F.lane), ad = *(const LAS f32x4*)(addv + 256 * j + 4 * F.lane);
                const f32x4 hh = v[j] * rr * mu + ad; v2u o; o.x = pk2(hh.x, hh.y); o.y = pk2(hh.z, hh.w); o8[64 * j] = o; }
        }
    }
}

typedef pg8::f32x4 pf4;
struct EpiG1 {
    static constexpr bool PERM = true, AFTER_DRAIN = false;
    bf16 *Qsb, *Ksb, *Vsb, *Qd, *Kd, *Vd, *Gsb, *Gd; const float* ropeC; const float* ropeS;
    __device__ __forceinline__ void operator()(const pf4 (&acc)[2][2][4][2], const pg8::Unit& u, int wr, int wc, int fr, int fq) const {
        const int pn = u.pn;
        const int row0 = u.pm * 256 + wr * 64 + fr;
        const int b = (u.pm * 256) >> 13;
        if (pn < 6 || (pn >= 12 && pn < 15)) {
            bf16* base; int H, head0; float sc = 1.f;
            if (pn < 2) { base = Qsb; H = SBH; head0 = 4 * pn; sc = C2; }
            else if (pn < 4) { base = Ksb; H = SBH; head0 = 4 * (pn - 2); }
            else if (pn < 6) { base = Vsb; H = SBH; head0 = 4 * (pn - 4); }
            else { base = Vd; H = DILH; head0 = 4 * (pn - 12); }
            const int d0 = 32 * (wc & 1) + 8 * fq;
#pragma unroll
            for (int ai = 0; ai < 2; ++ai)
#pragma unroll
                for (int m = 0; m < 4; ++m) { const int s = (row0 + ai * 128 + m * 16) & (SEQ - 1);
#pragma unroll
                    for (int bj = 0; bj < 2; ++bj) { const int head = head0 + 2 * bj + (wc >> 1);
                        const pf4 v0 = acc[ai][bj][m][0] * sc, v1 = acc[ai][bj][m][1] * sc;
                        v4u w; w.x = pk2(v0[0], v0[1]); w.y = pk2(v0[2], v0[3]); w.z = pk2(v1[0], v1[1]); w.w = pk2(v1[2], v1[3]);
                        *(GAS v4u*)(base + ((size_t)(b * H + head) * SEQ + s) * 64 + d0) = w; } }
        } else if (pn < 12) {
            bf16* base; int head0; float sc = 1.f;
            if (pn < 9) { base = Qd; head0 = 4 * (pn - 6); sc = C2; } else { base = Kd; head0 = 4 * (pn - 9); }
            const int j4 = 4 * (4 * (wc & 1) + fq);
#pragma unroll
            for (int ai = 0; ai < 2; ++ai)
#pragma unroll
                for (int m = 0; m < 4; ++m) { const int s = (row0 + ai * 128 + m * 16) & (SEQ - 1);
                    const pf4 cs = *(const GAS pf4*)(ropeC + s * 32 + j4) * sc, sn = *(const GAS pf4*)(ropeS + s * 32 + j4) * sc;
#pragma unroll
                    for (int bj = 0; bj < 2; ++bj) { const int head = head0 + 2 * bj + (wc >> 1);
                        const pf4 x1 = acc[ai][bj][m][0], x2 = acc[ai][bj][m][1];
                        const pf4 o1 = x1 * cs - x2 * sn, o2 = x1 * sn + x2 * cs;
                        bf16* p = base + ((size_t)(b * DILH + head) * SEQ + s) * 64 + j4;
                        v2u w1, w2; w1.x = pk2(o1[0], o1[1]); w1.y = pk2(o1[2], o1[3]); w2.x = pk2(o2[0], o2[1]); w2.y = pk2(o2[2], o2[3]);
                        *(GAS v2u*)p = w1; *(GAS v2u*)(p + 32) = w2; } }
        } else {
            bf16* base = pn < 19 ? Gsb : Gd; const int ct = (pn < 19 ? pn - 15 : pn - 19) * 256 + wc * 32 + 8 * fq;
#pragma unroll
            for (int ai = 0; ai < 2; ++ai)
#pragma unroll
                for (int m = 0; m < 4; ++m) { const size_t row = (size_t)(row0 + ai * 128 + m * 16);
#pragma unroll
                    for (int bj = 0; bj < 2; ++bj) { const pf4 v0 = acc[ai][bj][m][0], v1 = acc[ai][bj][m][1];
                        v4u w; w.x = pk2(sigmoidf_(v0[0]), sigmoidf_(v0[1])); w.y = pk2(sigmoidf_(v0[2]), sigmoidf_(v0[3]));
                        w.z = pk2(sigmoidf_(v1[0]), sigmoidf_(v1[1])); w.w = pk2(sigmoidf_(v1[2]), sigmoidf_(v1[3]));
                        *(GAS v4u*)(base + row * DM + ct + bj * 128) = w; } }
        }
    }
};
template <bool SECOND> struct EpiMerge {
    static constexpr bool PERM = true, AFTER_DRAIN = false;
    const bf16* G; bf16* Mg;
    __device__ __forceinline__ void operator()(const pf4 (&acc)[2][2][4][2], const pg8::Unit& u, int wr, int wc, int fr, int fq) const {
        const int row0 = u.pm * 256 + wr * 64 + fr, col0 = u.pn * 256 + wc * 32 + 8 * fq;
#pragma unroll
        for (int ai = 0; ai < 2; ++ai)
#pragma unroll
            for (int m = 0; m < 4; ++m) { const size_t off = (size_t)(row0 + ai * 128 + m * 16) * DM + col0;
#pragma unroll
                for (int bj = 0; bj < 2; ++bj) { const v4u g = *(const GAS v4u*)(G + off + bj * 128);
                    pf4 v0 = acc[ai][bj][m][0], v1 = acc[ai][bj][m][1];
                    v0[0] *= bflo(g.x); v0[1] *= bfhi(g.x); v0[2] *= bflo(g.y); v0[3] *= bfhi(g.y); v1[0] *= bflo(g.z); v1[1] *= bfhi(g.z); v1[2] *= bflo(g.w); v1[3] *= bfhi(g.w);
                    if (SECOND) { const v4u t = *(const GAS v4u*)(Mg + off + bj * 128);
                        v0[0] += bflo(t.x); v0[1] += bfhi(t.x); v0[2] += bflo(t.y); v0[3] += bfhi(t.y); v1[0] += bflo(t.z); v1[1] += bfhi(t.z); v1[2] += bflo(t.w); v1[3] += bfhi(t.w); }
                    v4u w; w.x = pk2(v0[0], v0[1]); w.y = pk2(v0[2], v0[3]); w.z = pk2(v1[0], v1[1]); w.w = pk2(v1[2], v1[3]);
                    *(GAS v4u*)(Mg + off + bj * 128) = w; }
                asm volatile("" ::: "memory"); }
    }
};
struct EpiOut {
    static constexpr bool PERM = true, AFTER_DRAIN = false;
    const float* x; float* x1; bf16* x1m; float* ssq; const float* mod; const float* g_ffn;
    __device__ __forceinline__ void operator()(const pf4 (&acc)[2][2][4][2], const pg8::Unit& u, int wr, int wc, int fr, int fq) const {
        const int row0 = u.pm * 256 + wr * 64 + fr, col0 = u.pn * 256 + wc * 32 + 8 * fq;
        const int b = (u.pm * 256) >> 13; const float* mb = mod + (size_t)b * NMOD;
        pf4 gt[2][2], mm[2][2];
#pragma unroll
        for (int bj = 0; bj < 2; ++bj)
#pragma unroll
            for (int n = 0; n < 2; ++n) { const int c = col0 + bj * 128 + 4 * n; gt[bj][n] = *(const GAS pf4*)(mb + 2 * DM + c);
                mm[bj][n] = *(const GAS pf4*)(g_ffn + c) * (*(const GAS pf4*)(mb + 4 * DM + c) + 1.0f); }
#pragma unroll
        for (int ai = 0; ai < 2; ++ai)
#pragma unroll
            for (int m = 0; m < 4; ++m) { const int row = row0 + ai * 128 + m * 16; const size_t off = (size_t)row * DM + col0; float s = 0.f;
#pragma unroll
                for (int bj = 0; bj < 2; ++bj) {
                    const pf4 a0 = *(const GAS pf4*)(x + off + bj * 128), a1 = *(const GAS pf4*)(x + off + bj * 128 + 4);
                    const pf4 y0 = a0 + gt[bj][0] * acc[ai][bj][m][0], y1 = a1 + gt[bj][1] * acc[ai][bj][m][1];
                    *(GAS pf4*)(x1 + off + bj * 128) = y0; *(GAS pf4*)(x1 + off + bj * 128 + 4) = y1;
                    s += (y0[0] * y0[0] + y0[1] * y0[1]) + (y0[2] * y0[2] + y0[3] * y0[3]) + (y1[0] * y1[0] + y1[1] * y1[1]) + (y1[2] * y1[2] + y1[3] * y1[3]);
                    const pf4 z0 = y0 * mm[bj][0], z1 = y1 * mm[bj][1];
                    v4u w; w.x = pk2(z0[0], z0[1]); w.y = pk2(z0[2], z0[3]); w.z = pk2(z1[0], z1[1]); w.w = pk2(z1[2], z1[3]);
                    *(GAS v4u*)(x1m + off + bj * 128) = w; }
                s += __shfl_xor(s, 16); s += __shfl_xor(s, 32);
                if (fq == 0) ssq[(size_t)row * 16 + 4 * u.pn + wc] = s; }
    }
};
struct EpiPq {
    static constexpr bool PERM = true, AFTER_DRAIN = false;
    const float* ssq; const float* bias; bf16* Q;
    __device__ __forceinline__ void operator()(const pf4 (&acc)[2][2][4][2], const pg8::Unit& u, int wr, int wc, int fr, int fq) const {
        const int row0 = u.pm * 256 + wr * 64 + fr, col0 = u.pn * 256 + wc * 32 + 8 * fq;
        const int b = (u.pm * 256) >> 13; const float* bb = bias + (size_t)b * 2048;
        pf4 bv[2][2];
#pragma unroll
        for (int bj = 0; bj < 2; ++bj)
#pragma unroll
            for (int n = 0; n < 2; ++n) bv[bj][n] = *(const GAS pf4*)(bb + col0 + bj * 128 + 4 * n);
#pragma unroll
        for (int ai = 0; ai < 2; ++ai)
#pragma unroll
            for (int m = 0; m < 4; ++m) { const int row = row0 + ai * 128 + m * 16;
                const GAS pf4* sp = (const GAS pf4*)(ssq + (size_t)row * 16);
                const pf4 s4 = (sp[0] + sp[1]) + (sp[2] + sp[3]);
                const float r2 = 1.0f / sqrtf(((s4[0] + s4[1]) + (s4[2] + s4[3])) * (1.f / DM) + EPS);
#pragma unroll
                for (int bj = 0; bj < 2; ++bj) { const pf4 v0 = acc[ai][bj][m][0] * r2 + bv[bj][0], v1 = acc[ai][bj][m][1] * r2 + bv[bj][1];
                    v4u w; w.x = pk2(v0[0], v0[1]); w.y = pk2(v0[2], v0[3]); w.z = pk2(v1[0], v1[1]); w.w = pk2(v1[2], v1[3]);
                    *(GAS v4u*)(Q + (size_t)row * 2048 + col0 + bj * 128) = w; } }
    }
};

constexpr int VSTR = 144;
constexpr int ATT_WAVE_LDS = 32 * VSTR;
__device__ __forceinline__ int kappa(int r) { return (((r >> 2) & 1) << 4) + ((r >> 3) << 2) + (r & 3); }
struct KVTile { bf16x8 k[4]; v4u v[4]; };
typedef short v4i16_t __attribute__((ext_vector_type(4)));
__device__ __forceinline__ s16x4 vtr(const LAS unsigned char* p) { return __builtin_bit_cast(s16x4, __builtin_amdgcn_ds_read_tr16_b64_v4i16((LAS v4i16_t*)p)); }

__device__ __forceinline__ void kv_load(KVTile& t, const bf16* Kh, const bf16* Vh, int base_tok, int sshift, int lane) {
    const int r = lane & 31, h = lane >> 5;
    const bf16* kp = Kh + (size_t)(base_tok + (kappa(r) << sshift)) * 64 + 8 * h;
#pragma unroll
    for (int st = 0; st < 4; ++st) t.k[st] = *(const GAS bf16x8*)(kp + 16 * st);
#pragma unroll
    for (int i = 0; i < 4; ++i) t.v[i] = *(const GAS v4u*)(Vh + (size_t)(base_tok + (((lane >> 3) + 8 * i) << sshift)) * 64 + 8 * (lane & 7));
}
__device__ __forceinline__ void v_to_lds(const KVTile& t, LAS unsigned char* vl, int lane) {
#pragma unroll
    for (int i = 0; i < 4; ++i) *(LAS v4u*)(vl + ((lane >> 3) + 8 * i) * VSTR + 16 * (lane & 7)) = t.v[i];
}
__device__ __forceinline__ f32x16 qk_tile(const KVTile& t, const bf16x8 (&qf)[4]) {
    f32x16 s = {};
#pragma unroll
    for (int st = 0; st < 4; ++st) s = __builtin_amdgcn_mfma_f32_32x32x16_bf16(t.k[st], qf[st], s, 0, 0, 0);
    return s;
}
__device__ __forceinline__ void pv_tile(f32x16& o0, f32x16& o1, const float (&p)[16], const LAS unsigned char* vl, int lane) {
    const int g = lane >> 4, li = lane & 15, q = li >> 2, pp = li & 3, h = g >> 1;
    const LAS unsigned char* tb = vl + (16 * h + q) * VSTR + (16 * (g & 1) + 4 * pp) * 2;
    bf16x8 pf[2];
#pragma unroll
    for (int st = 0; st < 2; ++st) { v4u w; w.x = pk2(p[8 * st + 0], p[8 * st + 1]); w.y = pk2(p[8 * st + 2], p[8 * st + 3]); w.z = pk2(p[8 * st + 4], p[8 * st + 5]); w.w = pk2(p[8 * st + 6], p[8 * st + 7]); pf[st] = __builtin_bit_cast(bf16x8, w); }
#pragma unroll
    for (int db = 0; db < 2; ++db)
#pragma unroll
        for (int st = 0; st < 2; ++st) {
            const s16x4 lo = vtr(tb + (8 * st) * VSTR + 64 * db), hi = vtr(tb + (8 * st + 4) * VSTR + 64 * db);
            const bf16x8 vf = (bf16x8){lo[0], lo[1], lo[2], lo[3], hi[0], hi[1], hi[2], hi[3]};
            if (db == 0) o0 = __builtin_amdgcn_mfma_f32_32x32x16_bf16(vf, pf[st], o0, 0, 0, 0);
            else         o1 = __builtin_amdgcn_mfma_f32_32x32x16_bf16(vf, pf[st], o1, 0, 0, 0);
        }
}
__device__ __forceinline__ void o_store(bf16* orow, const f32x16& o0, const f32x16& o1, float sc, int hC) {
#pragma unroll
    for (int a = 0; a < 4; ++a) {
        v2u w0, w1; w0.x = pk2(o0[4 * a] * sc, o0[4 * a + 1] * sc); w0.y = pk2(o0[4 * a + 2] * sc, o0[4 * a + 3] * sc);
        w1.x = pk2(o1[4 * a] * sc, o1[4 * a + 1] * sc); w1.y = pk2(o1[4 * a + 2] * sc, o1[4 * a + 3] * sc);
        *(GAS v2u*)(orow + 8 * a + 4 * hC) = w0; *(GAS v2u*)(orow + 32 + 8 * a + 4 * hC) = w1; }
}

__device__ __forceinline__ void sb_task(const bf16* Qsb, const bf16* Ksb, const bf16* Vsb, bf16* Osb, int task, LAS unsigned char* vl, int lane) {
    const int qt = task & 255, bh = task >> 8, b = bh >> 3, h = bh & 7, t0 = qt * 32;
    const int q = lane & 31, hC = lane >> 5;
    const bf16* Kh = Ksb + (size_t)bh * SEQ * 64; const bf16* Vh = Vsb + (size_t)bh * SEQ * 64;
    bf16x8 qf[4];
    { const bf16* qp = Qsb + ((size_t)bh * SEQ + t0 + q) * 64 + 8 * hC;
#pragma unroll
      for (int st = 0; st < 4; ++st) qf[st] = *(const GAS bf16x8*)(qp + 16 * st); }
    f32x16 o0 = {}, o1 = {}; float carry = 0.f;
    KVTile nxt; kv_load(nxt, Kh, Vh, t0, 0, lane);
    for (int k0 = t0;; k0 -= 32) {
        KVTile cur = nxt;
        const bool more = k0 >= 32;
        if (more) kv_load(nxt, Kh, Vh, k0 - 32, 0, lane);
        v_to_lds(cur, vl, lane);
        const f32x16 s = qk_tile(cur, qf);
        const bool diag = (k0 == t0);
        float L[16], z[16];
#pragma unroll
        for (int r = 0; r < 16; ++r) { z[r] = __builtin_amdgcn_fmed3f(s[r], -120.f, 120.f); const float e = fast_exp2(z[r]); L[r] = -fast_log2(1.f + e);
            if (diag && !(16 * hC + r < q)) L[r] = 0.f; }
        float c[16]; c[15] = L[15];
#pragma unroll
        for (int r = 14; r >= 0; --r) c[r] = c[r + 1] + L[r];
        const float tot = c[0], oth = __shfl_xor(tot, 32);
        const float base = carry + (hC ? 0.f : oth);
        float p[16];
#pragma unroll
        for (int r = 0; r < 16; ++r) { p[r] = fast_exp2(z[r] + (base + c[r])); if (diag && !(16 * hC + r < q)) p[r] = 0.f; }
        carry += tot + oth;
        pv_tile(o0, o1, p, vl, lane);
        if (!more) break;
        if (__all(carry < -160.f)) break;
    }
    o_store(Osb + ((size_t)(b * SEQ + t0 + q)) * 512 + h * 64, o0, o1, 1.f, hC);
}

__device__ __forceinline__ void dil_task(const bf16* Qd, const bf16* Kd, const bf16* Vd, bf16* Od, int task, LAS unsigned char* vl, int lane) {
    const int it = task & 15, rho = (task >> 4) & 15, hg = (task >> 8) & 3, b = task >> 10;
    const int q = lane & 31, hC = lane >> 5, i0 = 32 * it;
    const int tq = 16 * (i0 + q) + rho;
    f32x16 o0 = {}, o1 = {}; float mrun = -1e30f, lsum = 0.f;
#pragma unroll
    for (int g = 0; g < 3; ++g) {
        bf16x8 qf[4];
        { const bf16* qp = Qd + ((size_t)(b * DILH + g * 4 + hg) * SEQ + tq) * 64 + 8 * hC;
#pragma unroll
          for (int st = 0; st < 4; ++st) qf[st] = *(const GAS bf16x8*)(qp + 16 * st); }
        const int rs = 2 * g, cg = 16 >> rs, rho_g = rho & ((1 << rs) - 1), og = rho >> rs;
        const bf16* Kh = Kd + (size_t)(b * DILH + g * 4 + hg) * SEQ * 64; const bf16* Vh = Vd + (size_t)(b * DILH + g * 4 + hg) * SEQ * 64;
        const int uq = cg * (i0 + q) + og;
        const int u_hi = cg * (i0 + 31) + og; int u_lo = cg * i0 + og - 128; u_lo = u_lo < 0 ? 0 : u_lo;
        const int ub_last = u_lo & ~31;
        int ub = u_hi & ~31;
        KVTile nxt; kv_load(nxt, Kh, Vh, (ub << rs) + rho_g, rs, lane);
        for (;; ub -= 32) {
            KVTile cur = nxt;
            const bool more = ub > ub_last;
            if (more) kv_load(nxt, Kh, Vh, ((ub - 32) << rs) + rho_g, rs, lane);
            v_to_lds(cur, vl, lane);
            const f32x16 s = qk_tile(cur, qf);
            float z[16]; float tmax = -1e30f;
            const int d0 = uq - (ub + 16 * hC);
#pragma unroll
            for (int r = 0; r < 16; ++r) { const bool valid = (unsigned)(d0 - r) <= 128u; z[r] = valid ? s[r] : -1e30f; tmax = fmaxf(tmax, z[r]); }
            tmax = fmaxf(tmax, __shfl_xor(tmax, 32));
            const float mnew = fmaxf(mrun, tmax); const float alpha = fast_exp2(mrun - mnew); mrun = mnew;
            float p[16]; float ps = 0.f;
#pragma unroll
            for (int r = 0; r < 16; ++r) { p[r] = (z[r] > -1e29f) ? fast_exp2(z[r] - mnew) : 0.f; ps += p[r]; }
            lsum = lsum * alpha + ps;
            if (!__all(alpha == 1.0f)) {
#pragma unroll
                for (int r = 0; r < 16; ++r) { o0[r] *= alpha; o1[r] *= alpha; }
            }
            pv_tile(o0, o1, p, vl, lane);
            if (!more) break;
        }
    }
    const float l = lsum + __shfl_xor(lsum, 32);
    o_store(Od + (size_t)(b * SEQ + tq) * 256 + hg * 64, o0, o1, 1.0f / l, hC);
}

__device__ __forceinline__ void p3_attention(const Args& A, Frame& F) {
    unsigned char* ws = A.ws;
    LAS unsigned char* vl = F.lds + F.wave * ATT_WAVE_LDS;
    const bf16 *Qsb = (const bf16*)(ws + A_QSB), *Ksb = (const bf16*)(ws + A_KSB), *Vsb = (const bf16*)(ws + A_VSB);
    const bf16 *Qd = (const bf16*)(ws + A_QD), *Kd = (const bf16*)(ws + A_KD), *Vd = (const bf16*)(ws + A_VD);
    bf16* Osb = (bf16*)((unsigned char*)A.out + O_OSB); bf16* Od = (bf16*)((unsigned char*)A.out + O_OD);
    constexpr int N_DIL = NB * 4 * 16 * 16, N_SB = NB * SBH * (SEQ / 32);
    for (int t = F.gw; t < N_DIL + N_SB; t += F.NGW) {
        if (t < N_DIL) dil_task(Qd, Kd, Vd, Od, t, vl, F.lane);
        else sb_task(Qsb, Ksb, Vsb, Osb, t - N_DIL, vl, F.lane);
    }
}

__device__ __forceinline__ unsigned sortable(float f) { const unsigned u = __float_as_uint(f); return u ^ ((unsigned)((int)u >> 31) | 0x80000000u); }
__device__ __forceinline__ float unsortable(unsigned s) { const unsigned u = (s & 0x80000000u) ? (s ^ 0x80000000u) : ~s; return __uint_as_float(u); }
__device__ __forceinline__ unsigned umax_(unsigned a, unsigned b) { return a > b ? a : b; }

__device__ __forceinline__ void top16_of_128(unsigned (&key)[64], LAS unsigned* top  , int lane) {
#pragma unroll
    for (int it = 0; it < 16; ++it) {
        unsigned m0 = key[0], m1 = key[1], m2 = key[2], m3 = key[3];
#pragma unroll
        for (int i = 4; i < 64; i += 4) { m0 = umax_(m0, key[i]); m1 = umax_(m1, key[i + 1]); m2 = umax_(m2, key[i + 2]); m3 = umax_(m3, key[i + 3]); }
        m0 = umax_(umax_(m0, m1), umax_(m2, m3));
        const unsigned best = umax_(m0, (unsigned)__shfl_xor((int)m0, 32));
        top[it * 64 + lane] = best;
#pragma unroll
        for (int i = 0; i < 64; ++i) key[i] = (key[i] == best) ? 0u : key[i];
    }
}
__device__ __forceinline__ unsigned pk_lookup(unsigned p0, unsigned p1, unsigned p2, unsigned p3, unsigned a) {
    const unsigned hi = a >> 2; unsigned d = p0; d = hi == 1 ? p1 : d; d = hi == 2 ? p2 : d; d = hi == 3 ? p3 : d;
    return (d >> (8 * (a & 3))) & 0xffu;
}
__device__ __forceinline__ unsigned pack4idx(unsigned t0, unsigned t1, unsigned t2, unsigned t3) { return (127u - (t0 & 127u)) | ((127u - (t1 & 127u)) << 8) | ((127u - (t2 & 127u)) << 16) | ((127u - (t3 & 127u)) << 24); }

__device__ __forceinline__ void topk_task(const bf16* Qp, const bf16* Kb, int* IDX, float* GATE, int task, int lane, LAS unsigned* tl  ) {
    const int ph = task & 7, t0 = (task >> 3) * 32;
    const int q = lane & 31, hC = lane >> 5;
#pragma unroll 1
    for (int half = 0; half < 2; ++half) {
        bf16x8 qf[8];
        { const bf16* qp = Qp + (size_t)(t0 + q) * 2048 + ph * 256 + half * 128 + 8 * hC;
#pragma unroll
          for (int st = 0; st < 8; ++st) qf[st] = *(const GAS bf16x8*)(qp + 16 * st); }
        f32x16 C[4] = {};
        const bf16* kpm[4];
#pragma unroll
        for (int mt = 0; mt < 4; ++mt) { kpm[mt] = Kb + ((size_t)(ph * 2 + half) * 128 + 32 * mt + q) * 128 + 8 * hC; asm volatile("" : "+v"(kpm[mt])); }
#pragma unroll
        for (int st = 0; st < 8; ++st) {
#pragma unroll
            for (int mt = 0; mt < 4; ++mt) { const bf16x8 kf = *(const GAS bf16x8*)(kpm[mt] + 16 * st); C[mt] = __builtin_amdgcn_mfma_f32_32x32x16_bf16(kf, qf[st], C[mt], 0, 0, 0); }
            if (st & 1) asm volatile("" ::: "memory"); }
        unsigned key[64];
#pragma unroll
        for (int mt = 0; mt < 4; ++mt)
#pragma unroll
            for (int r = 0; r < 16; ++r) { const int kidx = 32 * mt + (r & 3) + 8 * (r >> 2) + 4 * hC; key[16 * mt + r] = (sortable(C[mt][r]) & ~127u) | (unsigned)(127 - kidx); }
        top16_of_128(key, tl + half * 1024, lane);
    }
    unsigned tops[2][16];
#pragma unroll
    for (int a = 0; a < 16; ++a) { tops[0][a] = tl[a * 64 + lane]; tops[1][a] = tl[1024 + a * 64 + lane]; }
    float s0[16], s1[16];
#pragma unroll
    for (int a = 0; a < 16; ++a) { s0[a] = unsortable(tops[0][a] & ~127u); s1[a] = unsortable(tops[1][a] & ~127u); }
    const unsigned pa0 = pack4idx(tops[0][0], tops[0][1], tops[0][2], tops[0][3]), pa1 = pack4idx(tops[0][4], tops[0][5], tops[0][6], tops[0][7]),
                   pa2 = pack4idx(tops[0][8], tops[0][9], tops[0][10], tops[0][11]), pa3 = pack4idx(tops[0][12], tops[0][13], tops[0][14], tops[0][15]);
    const unsigned pb0 = pack4idx(tops[1][0], tops[1][1], tops[1][2], tops[1][3]), pb1 = pack4idx(tops[1][4], tops[1][5], tops[1][6], tops[1][7]),
                   pb2 = pack4idx(tops[1][8], tops[1][9], tops[1][10], tops[1][11]), pb3 = pack4idx(tops[1][12], tops[1][13], tops[1][14], tops[1][15]);
    unsigned cand[25];
    {
        int n = 0;
#pragma unroll
        for (int a = 0; a < 16; ++a)
#pragma unroll
            for (int bq = 0; bq < 16; ++bq) if ((a + 1) * (bq + 1) <= 16) {
                const unsigned ck = (sortable(s0[a] + s1[bq]) & ~255u) | (unsigned)(a * 16 + bq);
                if (n < 25) cand[n] = ck; else cand[n - 25] = hC ? ck : cand[n - 25];
                ++n; }
    }
    unsigned win[16];
#pragma unroll
    for (int it = 0; it < 16; ++it) {
        unsigned m = cand[0];
#pragma unroll
        for (int i = 1; i < 25; ++i) m = umax_(m, cand[i]);
        const unsigned best = umax_(m, (unsigned)__shfl_xor((int)m, 32));
        win[it] = best;
#pragma unroll
        for (int i = 0; i < 25; ++i) cand[i] = (cand[i] == best) ? 0u : cand[i];
    }
    float gv[16]; int eid[16]; float gs = 0.f;
    const float vmax = unsortable(win[0] & ~255u);
#pragma unroll
    for (int k = 0; k < 16; ++k) { const unsigned a = (win[k] >> 4) & 15u, bq = win[k] & 15u;
        eid[k] = (int)(pk_lookup(pa0, pa1, pa2, pa3, a) * 128u + pk_lookup(pb0, pb1, pb2, pb3, bq));
        gv[k] = fast_exp2((unsortable(win[k] & ~255u) - vmax) * LOG2E); gs += gv[k]; }
    const float ginv = 1.0f / gs;
    const size_t o = (size_t)(t0 + q) * 128 + ph * 16;
    if (hC == 0) {
#pragma unroll
        for (int k = 0; k < 16; k += 4) *(GAS v4u*)(IDX + o + k) = (v4u){(unsigned)eid[k], (unsigned)eid[k + 1], (unsigned)eid[k + 2], (unsigned)eid[k + 3]};
    } else {
#pragma unroll
        for (int k = 0; k < 16; k += 4) *(GAS f32x4*)(GATE + o + k) = (f32x4){gv[k] * ginv, gv[k + 1] * ginv, gv[k + 2] * ginv, gv[k + 3] * ginv};
    }
}

__device__ __forceinline__ float gelu_tanh(float x) {
    const float y2 = 2.0f * 0.7978845608028654f * (x + 0.044715f * x * x * x);
    return x * fast_rcp(1.f + fast_exp2(-y2 * LOG2E));
}
__device__ __forceinline__ void unpack8(const v4u w, float (&f)[8]) { f[0] = bflo(w.x); f[1] = bfhi(w.x); f[2] = bflo(w.y); f[3] = bfhi(w.y); f[4] = bflo(w.z); f[5] = bfhi(w.z); f[6] = bflo(w.w); f[7] = bfhi(w.w); }
__device__ __forceinline__ void unpack_fp8x16(const v4u w, float (&f)[16]) {
#pragma unroll
    for (int j = 0; j < 4; ++j) { const f32x2_t a = __builtin_amdgcn_cvt_pk_f32_fp8((int)w[j], false), b = __builtin_amdgcn_cvt_pk_f32_fp8((int)w[j], true);
        f[4 * j] = a.x; f[4 * j + 1] = a.y; f[4 * j + 2] = b.x; f[4 * j + 3] = b.y; }
}
__device__ __forceinline__ void peer_u_phase(const Args& A, Frame& F) {
    unsigned char* ws = A.ws;
    const int lane = F.lane, x = blockIdx.x & 7, wrk = (blockIdx.x >> 3) * NWAVES + F.wave, nwr = (F.G >> 3) * NWAVES;
    const bf16* X1M = (const bf16*)(ws + A_X1M); const unsigned char* U8 = ws + WS_UB; const float* UINV = (const float*)(ws + WS_UB + 16 * MiB); const float* VINV = (const float*)(ws + WS_VB + 16 * MiB);
    const int* IDX = (const int*)(ws + A_IDX); const float* GATE = (const float*)(ws + A_GATE); float* ACTG = (float*)(ws + A_ACTG);
    LAS unsigned* lst = (LAS unsigned*)(F.lds + F.wave * 2048);
    const int per = TOK / nwr;
    for (int t = wrk * per; t < (wrk + 1) * per; ++t) {
        const float* mod = (const float*)(ws + WS_MOD) + (size_t)(t >> 13) * NMOD;
        float r2; { const GAS f32x4* sp = (const GAS f32x4*)((const float*)(ws + WS_SSQ) + (size_t)t * 16); const f32x4 s4 = (sp[0] + sp[1]) + (sp[2] + sp[3]); r2 = 1.0f / sqrtf(((s4[0] + s4[1]) + (s4[2] + s4[3])) * (1.f / DM) + EPS); }
        float h2[16];
#pragma unroll
        for (int j = 0; j < 4; ++j) { const v2u w = *(const GAS v2u*)(X1M + (size_t)t * DM + 256 * j + 4 * lane); const f32x4 sh = *(const GAS f32x4*)(mod + 3 * DM + 256 * j + 4 * lane);
            h2[4 * j] = bflo(w.x) * r2 + sh[0]; h2[4 * j + 1] = bfhi(w.x) * r2 + sh[1]; h2[4 * j + 2] = bflo(w.y) * r2 + sh[2]; h2[4 * j + 3] = bfhi(w.y) * r2 + sh[3]; }
        const int id0 = IDX[(size_t)t * 128 + lane], id1 = IDX[(size_t)t * 128 + 64 + lane];
        const float g0 = GATE[(size_t)t * 128 + lane], g1 = GATE[(size_t)t * 128 + 64 + lane];
        const bool s0 = (id0 >> 11) == x, s1 = (id1 >> 11) == x;
        const unsigned long long m0 = __ballot(s0), m1 = __ballot(s1);
        const int n0 = __popcll(m0), n = n0 + __popcll(m1);
        const unsigned long long below = (1ull << lane) - 1ull;
        if (s0) { const int k = __popcll(m0 & below); lst[k] = (unsigned)id0; lst[128 + k] = __float_as_uint(g0); lst[256 + k] = (unsigned)lane; }
        if (s1) { const int k = n0 + __popcll(m1 & below); lst[k] = (unsigned)id1; lst[128 + k] = __float_as_uint(g1); lst[256 + k] = (unsigned)(64 + lane); }
        for (int j0 = 0; j0 < n; j0 += 8) {
            v4u row[8];
#pragma unroll
            for (int jj = 0; jj < 8; ++jj) { int j = j0 + jj; j = j < n ? j : n - 1; const unsigned e = lst[j]; row[jj] = *(const GAS v4u*)(U8 + (size_t)e * 1024 + 16 * lane); }
            float p[8];
#pragma unroll
            for (int jj = 0; jj < 8; ++jj) { float f[16]; unpack_fp8x16(row[jj], f); float d = 0.f;
#pragma unroll
                for (int i = 0; i < 16; ++i) d += f[i] * h2[i];
                p[jj] = d; }
            const bool b0 = lane & 1, b1 = lane & 2, b2 = lane & 4;
            float q4[4], q2[2], q1;
#pragma unroll
            for (int i = 0; i < 4; ++i) q4[i] = (b0 ? p[4 + i] : p[i]) + __shfl_xor(b0 ? p[i] : p[4 + i], 1);
#pragma unroll
            for (int i = 0; i < 2; ++i) q2[i] = (b1 ? q4[2 + i] : q4[i]) + __shfl_xor(b1 ? q4[i] : q4[2 + i], 2);
            q1 = (b2 ? q2[1] : q2[0]) + __shfl_xor(b2 ? q2[0] : q2[1], 4);
            q1 += __shfl_xor(q1, 8); q1 += __shfl_xor(q1, 16); q1 += __shfl_xor(q1, 32);
            const int jm = j0 + 4 * (lane & 1) + 2 * ((lane >> 1) & 1) + ((lane >> 2) & 1);
            if (lane < 8 && jm < n) { const unsigned e = lst[jm]; const float g = __uint_as_float(lst[128 + jm]); const unsigned slot = lst[256 + jm];
                ACTG[(size_t)t * 128 + slot] = gelu_tanh(q1 * UINV[e]) * g * VINV[e]; }
        }
    }
}
__device__ __forceinline__ void peer_v_phase(const Args& A, Frame& F) {
    unsigned char* ws = A.ws;
    const int lane = F.lane, x = blockIdx.x & 7, wrk = (blockIdx.x >> 3) * NWAVES + F.wave, nwr = (F.G >> 3) * NWAVES;
    const unsigned char* V8 = ws + WS_VB + (size_t)x * (2 * MiB) + 16 * (lane & 7);
    const int* IDX = (const int*)(ws + A_IDX); const float* ACTG = (const float*)(ws + A_ACTG); bf16* POUT = (bf16*)(ws + A_POUT);
    const int per = TOK / nwr, g = lane >> 3;
    for (int t = wrk * per; t < (wrk + 1) * per; ++t) {
        int id[16]; float ac[16];
#pragma unroll
        for (int k = 0; k < 4; ++k) { const v4u iv = *(const GAS v4u*)(IDX + (size_t)t * 128 + 16 * g + 4 * k); const f32x4 av = *(const GAS f32x4*)(ACTG + (size_t)t * 128 + 16 * g + 4 * k);
            id[4 * k] = (int)iv.x; id[4 * k + 1] = (int)iv.y; id[4 * k + 2] = (int)iv.z; id[4 * k + 3] = (int)iv.w; ac[4 * k] = av[0]; ac[4 * k + 1] = av[1]; ac[4 * k + 2] = av[2]; ac[4 * k + 3] = av[3]; }
        float acc[16];
#pragma unroll
        for (int i = 0; i < 16; ++i) acc[i] = 0.f;
#pragma unroll
        for (int h = 0; h < 2; ++h) {
            v4u row[8];
#pragma unroll
            for (int i = 0; i < 8; ++i) row[i] = *(const GAS v4u*)(V8 + (size_t)id[8 * h + i] * 128);
#pragma unroll
            for (int i = 0; i < 8; ++i) { float f[16]; unpack_fp8x16(row[i], f); const float a = ac[8 * h + i];
#pragma unroll
                for (int d = 0; d < 16; ++d) acc[d] += a * f[d]; }
        }
#pragma unroll
        for (int d = 0; d < 16; ++d) { float v = acc[d]; v += __shfl_xor(v, 8); v += __shfl_xor(v, 16); v += __shfl_xor(v, 32); acc[d] = v; }
        if (g == 0) { v4u w0, w1; w0.x = pk2(acc[0], acc[1]); w0.y = pk2(acc[2], acc[3]); w0.z = pk2(acc[4], acc[5]); w0.w = pk2(acc[6], acc[7]);
            w1.x = pk2(acc[8], acc[9]); w1.y = pk2(acc[10], acc[11]); w1.z = pk2(acc[12], acc[13]); w1.w = pk2(acc[14], acc[15]);
            bf16* o = POUT + (size_t)t * DM + 128 * x + 16 * (lane & 7); *(GAS v4u*)o = w0; *(GAS v4u*)(o + 8) = w1; }
    }
}
__device__ __forceinline__ void peer_final(const Args& A, int t, int lane) {
    unsigned char* ws = A.ws;
    const float* mod = (const float*)(ws + WS_MOD) + (size_t)(t >> 13) * NMOD; const bf16* POUT = (const bf16*)(ws + A_POUT);
    float* orow = A.out + (size_t)t * DM;
    f32x4 x2[4]; float s = 0.f;
#pragma unroll
    for (int j = 0; j < 4; ++j) { const int c = 256 * j + 4 * lane; const f32x4 x1 = *(const GAS f32x4*)(orow + c), gt = *(const GAS f32x4*)(mod + 5 * DM + c); const v2u w = *(const GAS v2u*)(POUT + (size_t)t * DM + c);
        f32x4 y; y[0] = x1[0] + gt[0] * bflo(w.x); y[1] = x1[1] + gt[1] * bfhi(w.x); y[2] = x1[2] + gt[2] * bflo(w.y); y[3] = x1[3] + gt[3] * bfhi(w.y);
        x2[j] = y; s += (y[0] * y[0] + y[1] * y[1]) + (y[2] * y[2] + y[3] * y[3]); }
    const float rr = 1.0f / sqrtf(wave_sum(s) * (1.f / DM) + EPS);
#pragma unroll
    for (int j = 0; j < 4; ++j) { const int c = 256 * j + 4 * lane; const f32x4 gf = *(const GAS f32x4*)(A.g_final + c); *(GAS f32x4*)(orow + c) = x2[j] * rr * gf; }
}

#ifndef MK_ONE_LAUNCH
#define MK_ONE_LAUNCH 1
#endif
constexpr int N_PHASES = 11;

__device__ __forceinline__ void biaspq_task(unsigned char* ws, int n, int lane) {
    const bf16* w = (const bf16*)(ws + WS_WPQ) + (size_t)n * DM + 16 * lane;
    float fa[8], fb[8]; unpack8(*(const GAS v4u*)w, fa); unpack8(*(const GAS v4u*)(w + 8), fb);
    float* bias = (float*)(ws + WS_BIASPQ);
#pragma unroll
    for (int b = 0; b < 4; ++b) { const GAS f32x4* sp = (const GAS f32x4*)((const float*)(ws + WS_MOD) + (size_t)b * NMOD + 3 * DM + 16 * lane);
        const f32x4 s0 = sp[0], s1 = sp[1], s2 = sp[2], s3 = sp[3]; float d = 0.f;
#pragma unroll
        for (int i = 0; i < 4; ++i) { d += fa[i] * s0[i]; d += fa[4 + i] * s1[i]; d += fb[i] * s2[i]; d += fb[4 + i] * s3[i]; }
        d = wave_sum(d); if (lane == 0) bias[b * 2048 + n] = d; }
}

__global__ void __launch_bounds__(NWAVES * 64, 2) mk_fwd(Args A) {
    extern __shared__ __attribute__((aligned(16))) unsigned char lds[];
    Frame F;
    F.lds = (LAS unsigned char*)lds;
    F.G = gridDim.x; { const int bx = blockIdx.x; F.vcu = (F.G % 8 == 0) ? (bx % 8) * (F.G / 8) + bx / 8 : bx; }
    F.NGW = F.G * NWAVES;
#define PHASE_BEGIN() do { int t_ = threadIdx.x; asm volatile("" : "+v"(t_)); F.tid = t_; F.lane = t_ & 63; F.wave = __builtin_amdgcn_readfirstlane(t_ >> 6); F.gw = F.vcu * NWAVES + F.wave; } while (0)
    PHASE_BEGIN();
    unsigned char* ws = A.ws;
    const int lo = A.ph_lo, hi = A.ph_hi;
#if MK_ONE_LAUNCH
    volatile LAS unsigned* MISC = (volatile LAS unsigned*)(F.lds + MISC_OFF);
    for (int u = F.tid; u < (LDS_BYTES - RING_BYTES) / 4; u += NWAVES * 64) ((LAS unsigned*)(F.lds + RING_BYTES))[u] = 0u;
    __syncthreads();
    XcdBarrier bar = xcd_barrier_post((unsigned*)(ws + WS_CTL) + CW_BAR, MISC + 8);
#define GRID_BAR() xcd_barrier(bar)
#else
#define GRID_BAR() do {} while (0)
#endif
#ifdef ONLY_PHASE
#define IN(k) ((k) == ONLY_PHASE && lo <= (k) && (k) < hi)
#else
#define IN(k) (lo <= (k) && (k) < hi)
#endif
#define BOTH(k) (IN(k) && IN((k) + 1))
#ifndef REPEAT_MASK
#define REPEAT_MASK 0
#endif
#define REPS(k) ((((REPEAT_MASK) >> (k)) & 1) + 1)

    if (IN(0)) for (int rep = 0; rep < REPS(0); ++rep) { PHASE_BEGIN(); if (rep) GRID_BAR(); p0_prologue(A, F); if (BOTH(0)) GRID_BAR(); }
    if (IN(1)) for (int rep = 0; rep < REPS(1); ++rep) { PHASE_BEGIN(); if (rep) GRID_BAR(); p1_hrows(A, F); if (BOTH(1)) GRID_BAR(); }
    if (IN(2)) for (int rep = 0; rep < REPS(2); ++rep) { PHASE_BEGIN(); if (rep) GRID_BAR();
        pg8::Gemm g{(const bf16*)((unsigned char*)A.out + O_H), (const bf16*)(ws + WS_WIN), TOK, NIN, DM}; pg8::StaticOrder S; S.init(TOK, NIN, F.G, (int)blockIdx.x);
        EpiG1 E{(bf16*)(ws + A_QSB), (bf16*)(ws + A_KSB), (bf16*)(ws + A_VSB), (bf16*)(ws + A_QD), (bf16*)(ws + A_KD), (bf16*)(ws + A_VD), (bf16*)(ws + A_GSB), (bf16*)(ws + A_GD),
                (const float*)(ws + WS_ROPEC), (const float*)(ws + WS_ROPES)};
        pg8::gemm_phase<EpiG1, pg8::StaticOrder, true, true>(F.lds, g, S, E);
        if (BOTH(2)) GRID_BAR();
    }
    if (IN(3)) for (int rep = 0; rep < REPS(3); ++rep) { PHASE_BEGIN(); if (rep) GRID_BAR(); p3_attention(A, F); if (BOTH(3)) GRID_BAR(); }
    if (IN(4)) for (int rep = 0; rep < REPS(4); ++rep) { PHASE_BEGIN(); if (rep) GRID_BAR();
        for (int n = F.gw; n < 2048; n += F.NGW) biaspq_task(ws, n, F.lane);
        __syncthreads();
        {   pg8::Gemm g{(const bf16*)((unsigned char*)A.out + O_OD), (const bf16*)(ws + WS_WDILO), TOK, DM, 256}; pg8::StaticOrder S; S.init(TOK, DM, F.G, (int)blockIdx.x);
            EpiMerge<false> E{(const bf16*)(ws + A_GD), (bf16*)(ws + A_MERGED)};
            pg8::gemm_phase<EpiMerge<false>, pg8::StaticOrder, true, true>(F.lds, g, S, E); }
        asm volatile("s_waitcnt vmcnt(0)" ::: "memory"); __syncthreads();
        {   pg8::Gemm g{(const bf16*)((unsigned char*)A.out + O_OSB), (const bf16*)(ws + WS_WSBO), TOK, DM, 512}; pg8::StaticOrder S; S.init(TOK, DM, F.G, (int)blockIdx.x);
            EpiMerge<true> E{(const bf16*)(ws + A_GSB), (bf16*)(ws + A_MERGED)};
            pg8::gemm_phase<EpiMerge<true>, pg8::StaticOrder, true, true>(F.lds, g, S, E); }
        if (BOTH(4)) GRID_BAR();
    }
    if (IN(5)) for (int rep = 0; rep < REPS(5); ++rep) { PHASE_BEGIN(); if (rep) GRID_BAR();
        pg8::Gemm g{(const bf16*)(ws + A_MERGED), (const bf16*)(ws + WS_WOUT), TOK, DM, DM}; pg8::StaticOrder S; S.init(TOK, DM, F.G, (int)blockIdx.x);
        EpiOut E{A.x, A.out, (bf16*)(ws + A_X1M), (float*)(ws + WS_SSQ), (const float*)(ws + WS_MOD), A.g_ffn};
        pg8::gemm_phase<EpiOut, pg8::StaticOrder, true, true>(F.lds, g, S, E);
        if (BOTH(5)) GRID_BAR();
    }
    if (IN(6)) for (int rep = 0; rep < REPS(6); ++rep) { PHASE_BEGIN(); if (rep) GRID_BAR();
        pg8::Gemm g{(const bf16*)(ws + A_X1M), (const bf16*)(ws + WS_WPQ), TOK, 2048, DM}; pg8::StaticOrder S; S.init(TOK, 2048, F.G, (int)blockIdx.x);
        EpiPq E{(const float*)(ws + WS_SSQ), (const float*)(ws + WS_BIASPQ), (bf16*)(ws + A_QPEER)};
        pg8::gemm_phase<EpiPq, pg8::StaticOrder, true, true>(F.lds, g, S, E);
        if (BOTH(6)) GRID_BAR();
    }
    if (IN(7)) for (int rep = 0; rep < REPS(7); ++rep) { PHASE_BEGIN(); if (rep) GRID_BAR();
        for (int t = F.gw; t < (TOK / 32) * 8; t += F.NGW) topk_task((const bf16*)(ws + A_QPEER), (const bf16*)(ws + WS_KEYS), (int*)(ws + A_IDX), (float*)(ws + A_GATE), t, F.lane, (LAS unsigned*)(F.lds + F.wave * 8192));
        if (BOTH(7)) GRID_BAR();
    }
    if (IN(8)) { PHASE_BEGIN(); peer_u_phase(A, F); if (BOTH(8)) GRID_BAR(); }
    if (IN(9)) { PHASE_BEGIN(); peer_v_phase(A, F); if (BOTH(9)) GRID_BAR(); }
    if (IN(10)) { PHASE_BEGIN();
        for (int t = F.gw; t < TOK; t += F.NGW) peer_final(A, t, F.lane);
    }
#undef IN
#undef BOTH
}

extern "C" void kernel_launch(void* const* d_in, const int* in_sizes, int n_in, void* d_out, int out_size, void* d_ws, size_t ws_size, hipStream_t stream) {
    static int grid = 0;
    if (grid == 0) {
        if (n_in != 15 || in_sizes[0] != TOK * DM || out_size != TOK * DM || ws_size < WS_END) { fprintf(stderr, "kernel_launch: unexpected shapes (n_in %d, in0 %d, out %d, ws %zu < %zu)\n", n_in, n_in > 0 ? in_sizes[0] : -1, out_size, ws_size, (size_t)WS_END); grid = -1; return; }
        int dev = 0, cus = 0, per_cu = 0;
        if (hipGetDevice(&dev) != hipSuccess || hipDeviceGetAttribute(&cus, hipDeviceAttributeMultiprocessorCount, dev) != hipSuccess) { grid = -1; return; }
        if (hipFuncSetAttribute((const void*)mk_fwd, hipFuncAttributeMaxDynamicSharedMemorySize, LDS_BYTES) != hipSuccess) { fprintf(stderr, "kernel_launch: hipFuncSetAttribute failed\n"); grid = -1; return; }
        if (hipOccupancyMaxActiveBlocksPerMultiprocessor(&per_cu, (const void*)mk_fwd, NWAVES * 64, LDS_BYTES) != hipSuccess || per_cu < 1) { fprintf(stderr, "kernel_launch: occupancy query says %d\n", per_cu); per_cu = 1; }
        (void)hipGetLastError();
        grid = cus;
    }
    if (grid < 0) return;
    (void)hipMemsetAsync((char*)d_ws + WS_CTL, 0, CTL_ZERO_BYTES, stream);
    Args a{};
    a.x = (const float*)d_in[0]; a.c = (const float*)d_in[1]; a.w_ada = (const float*)d_in[2]; a.b_ada = (const float*)d_in[3]; a.g_mix = (const float*)d_in[4];
    a.w_in = (const float*)d_in[5]; a.w_sb_o = (const float*)d_in[6]; a.w_dil_o = (const float*)d_in[7]; a.w_out = (const float*)d_in[8]; a.g_ffn = (const float*)d_in[9];
    a.w_pq = (const float*)d_in[10]; a.peer_keys = (const float*)d_in[11]; a.peer_u = (const float*)d_in[12]; a.peer_v = (const float*)d_in[13]; a.g_final = (const float*)d_in[14];
    a.out = (float*)d_out; a.ws = (unsigned char*)d_ws;
#if MK_ONE_LAUNCH
    a.ph_lo = 0; a.ph_hi = N_PHASES;
    void* args[] = {&a};
    hipError_t e = hipLaunchCooperativeKernel((const void*)mk_fwd, dim3(grid), dim3(NWAVES * 64), args, LDS_BYTES, stream);
    if (e != hipSuccess) fprintf(stderr, "kernel_launch: cooperative launch failed: %s (grid %d)\n", hipGetErrorString(e), grid);
#else
    for (int p = 0; p < N_PHASES; ++p) { a.ph_lo = p; a.ph_hi = p + 1; hipLaunchKernelGGL(mk_fwd, dim3(grid), dim3(NWAVES * 64), LDS_BYTES, stream, a); }
#endif
}
```

```cpp
#include <hip/hip_runtime.h>
#include <hip/hip_cooperative_groups.h>
#include <cstdio>
#include <cstdint>
namespace pg8 {
#define PG8_LAS __attribute__((address_space(3)))
typedef unsigned short bf16_t;
typedef short bf16x8 __attribute__((ext_vector_type(8)));
typedef float f32x4 __attribute__((ext_vector_type(4)));
typedef unsigned u32x4 __attribute__((ext_vector_type(4)));
constexpr int BM = 256, BK = 64, HALF = 128, HTB = HALF * BK * 2  , STAGE_BYTES = 8 * HTB, NXCD = 8, WGM = 8;

__host__ __device__ __forceinline__ int lds_byte(int r, int c) { const int st = (r >> 4) * 2 + (c >> 5), rr = r & 15, cc = c & 31, ob = rr * 64 + cc * 2; return st * 1024 + (ob ^ (((ob >> 9) & 1) << 5)); }
__host__ __device__ __forceinline__ void stage_rc(int b, int& R, int& C) { const int st = b / 1024, sb = b % 1024, swz = sb ^ (((sb >> 9) & 1) << 5); R = (st >> 1) * 16 + swz / 64; C = (st & 1) * 32 + (swz % 64) / 2; }
__host__ __device__ __forceinline__ int perm32(int rho) { const int n = rho >> 4, i = rho & 15; return 8 * (i >> 2) + 4 * n + (i & 3); }

struct Unit { int pm, pn; };
struct Gemm { const bf16_t* A; const bf16_t* Bt; int M, N, K; };

struct StaticOrder {
    int nM, nN, nwg, G, c;
    __host__ __device__ void init(int M, int N, int G_, int c_) { nM = M / BM; nN = N / BM; nwg = nM * nN; G = G_; c = c_; }
    __host__ __device__ bool next(int i, Unit& u) const {
        const long L = (long)i * G + c; if (L >= nwg) return false;
        int wgid = (int)L; { const int q = nwg / NXCD, r = nwg % NXCD, xcd = wgid % NXCD, off = wgid / NXCD; wgid = (xcd < r ? xcd * (q + 1) : r * (q + 1) + (xcd - r) * q) + off; }
        const int nig = WGM * nN, gid = wgid / nig, fm = gid * WGM, gsz = (nM - fm) < WGM ? (nM - fm) : WGM;
        u.pm = fm + ((wgid % nig) % gsz); u.pn = (wgid % nig) / gsz; return true;
    }
    __device__ __forceinline__ void a_ready(const Unit&) const {}
    __device__ __forceinline__ void done(const Unit&) const {}
};

__device__ __forceinline__ unsigned cvt_pk_bf16(float lo, float hi) { unsigned r; asm volatile("v_cvt_pk_bf16_f32 %0, %1, %2" : "=v"(r) : "v"(lo), "v"(hi)); return r; }
template <class Epi, class Sched, bool ALIGN_EPI = false, bool SP2 = false>
__device__ __forceinline__ void gemm_phase(PG8_LAS unsigned char* lds, const Gemm g, const Sched& S, const Epi& E) {
    int tid_ = threadIdx.x; asm volatile("" : "+v"(tid_));
    const int tid = tid_, wid = __builtin_amdgcn_readfirstlane(tid >> 6), lane = tid & 63, wr = wid >> 2, wc = wid & 3, fr = lane & 15, fq = lane >> 4;
    const int K = g.K, nt = K / BK;
    unsigned voffA[2], voffB[2];
#pragma unroll
    for (int i = 0; i < 2; ++i) { int R, C; stage_rc(tid * 16 + i * 8192, R, C); const int Rb = Epi::PERM ? ((R & ~31) + perm32(R & 31)) : R;
        voffA[i] = (unsigned)(R * K + C) * 2u; voffB[i] = (unsigned)(Rb * K + C) * 2u; }
    const size_t kstep = (size_t)(BK * 2);
    const size_t hstep = (size_t)HALF * K * 2;
    const size_t tstep = 2 * hstep;
    const unsigned ldsw = (unsigned)wid * 1024u;
    const int aoff = lds_byte(wr * 64 + fr, fq * 8), boff = lds_byte(wc * 32 + fr, fq * 8);
#define PG8_SA(b, h) (((b) * 2 + (h)) * HTB)
#define PG8_SB(b, h) ((4 + (b) * 2 + (h)) * HTB)
#define PG8_STAGE(bufoff, gbase, voff) do { _Pragma("unroll") for (int _i = 0; _i < 2; ++_i) \
        __builtin_amdgcn_global_load_lds((const unsigned*)((const char*)(gbase) + (voff)[_i]), (PG8_LAS unsigned*)(lds + (bufoff) + ldsw + _i * 8192), 16, 0, 0); } while (0)
#define PG8_LDA(dst, b, h) do { _Pragma("unroll") for (int m = 0; m < 4; ++m) _Pragma("unroll") for (int k = 0; k < 2; ++k) dst[m][k] = *(const PG8_LAS bf16x8*)(lds + PG8_SA(b, h) + aoff + m * 2048 + k * 1024); } while (0)
#define PG8_LDB(dst, b, h) do { _Pragma("unroll") for (int n = 0; n < 2; ++n) _Pragma("unroll") for (int k = 0; k < 2; ++k) dst[n][k] = *(const PG8_LAS bf16x8*)(lds + PG8_SB(b, h) + boff + n * 2048 + k * 1024); } while (0)
#define PG8_MMA(ai, bj, At, Bt) do { __builtin_amdgcn_s_setprio(1); _Pragma("unroll") for (int m = 0; m < 4; ++m) _Pragma("unroll") for (int n = 0; n < 2; ++n) _Pragma("unroll") for (int k = 0; k < 2; ++k) \
        acc[ai][bj][m][n] = __builtin_amdgcn_mfma_f32_16x16x32_bf16(Bt[n][k], At[m][k], acc[ai][bj][m][n], 0, 0, 0); __builtin_amdgcn_s_setprio(0); } while (0)
#define PG8_WAIT_V(n) asm volatile("s_waitcnt vmcnt(" #n ")" ::: "memory")
#define PG8_WAIT_L(n) asm volatile("s_waitcnt lgkmcnt(" #n ")" ::: "memory")
#define PG8_BAR __builtin_amdgcn_s_barrier()
#define PG8_SCHED __builtin_amdgcn_sched_barrier(0)
    Unit cur, nxt; int ui = 0;
    if (!S.next(0, cur)) return;
    f32x4 acc[2][2][4][2];
#pragma unroll
    for (int a = 0; a < 2; ++a)
#pragma unroll
        for (int b = 0; b < 2; ++b)
#pragma unroll
            for (int m = 0; m < 4; ++m)
#pragma unroll
                for (int n = 0; n < 2; ++n) acc[a][b][m][n] = (f32x4){0.f, 0.f, 0.f, 0.f};
    bf16x8 At[4][2], B0[2][2], B1[2][2];
    const char* cA = (const char*)g.A + (size_t)cur.pm * tstep; const char* cB = (const char*)g.Bt + (size_t)cur.pn * tstep;
    S.a_ready(cur);
    if constexpr (SP2) {
        PG8_STAGE(PG8_SB(0, 0), cB, voffB); PG8_STAGE(PG8_SB(0, 1), cB + hstep, voffB); PG8_STAGE(PG8_SA(0, 0), cA, voffA); PG8_STAGE(PG8_SA(0, 1), cA + hstep, voffA);
        if (wr == 1) PG8_BAR;
        PG8_WAIT_V(2); PG8_BAR;
        PG8_STAGE(PG8_SB(1, 0), cB + kstep, voffB); PG8_STAGE(PG8_SA(1, 0), cA + kstep, voffA); PG8_STAGE(PG8_SB(1, 1), cB + hstep + kstep, voffB);
        PG8_WAIT_V(6); PG8_BAR;
    } else {
        PG8_STAGE(PG8_SB(0, 0), cB, voffB); PG8_STAGE(PG8_SA(0, 0), cA, voffA); PG8_STAGE(PG8_SB(0, 1), cB + hstep, voffB); PG8_STAGE(PG8_SA(0, 1), cA + hstep, voffA);
        if (wr == 1) PG8_BAR;
        PG8_WAIT_V(4); PG8_BAR;
        PG8_STAGE(PG8_SB(1, 0), cB + kstep, voffB); PG8_STAGE(PG8_SA(1, 0), cA + kstep, voffA); PG8_STAGE(PG8_SB(1, 1), cB + hstep + kstep, voffB);
        PG8_WAIT_V(6); PG8_BAR;
    }
    for (;;) {
        const bool has_next = S.next(ui + 1, nxt);
        const char* nA = has_next ? (const char*)g.A + (size_t)nxt.pm * tstep : cA; const char* nB = has_next ? (const char*)g.Bt + (size_t)nxt.pn * tstep : cB;
        for (int t = 0; t < nt; t += 2) {
            const bool last = (t == nt - 2);
            const char* a1 = cA + (size_t)(t + 1) * kstep;
            const char* a2 = last ? nA : cA + (size_t)(t + 2) * kstep; const char* b2 = last ? nB : cB + (size_t)(t + 2) * kstep;
            const char* a3 = a2 + kstep; const char* b3 = b2 + kstep;
            if (last && has_next) S.a_ready(nxt);
            if constexpr (SP2) {
            PG8_LDB(B0, 0, 0); PG8_LDB(B1, 0, 1); PG8_SCHED; PG8_LDA(At, 0, 0); PG8_STAGE(PG8_SA(1, 1), a1 + hstep, voffA);
            PG8_WAIT_V(8); PG8_WAIT_L(0); PG8_BAR; PG8_MMA(0, 0, At, B0); PG8_MMA(0, 1, At, B1); PG8_BAR; PG8_SCHED;
            PG8_LDA(At, 0, 1); PG8_STAGE(PG8_SB(0, 0), b2, voffB); PG8_STAGE(PG8_SB(0, 1), b2 + hstep, voffB); PG8_STAGE(PG8_SA(0, 0), a2, voffA);
            PG8_WAIT_V(8); PG8_WAIT_L(0); PG8_BAR; PG8_MMA(1, 0, At, B0); PG8_MMA(1, 1, At, B1); PG8_BAR; PG8_SCHED;
            PG8_LDB(B0, 1, 0); PG8_LDB(B1, 1, 1); PG8_SCHED; PG8_LDA(At, 1, 0); PG8_STAGE(PG8_SA(0, 1), a2 + hstep, voffA);
            PG8_WAIT_V(8); PG8_WAIT_L(0); PG8_BAR; PG8_MMA(0, 0, At, B0); PG8_MMA(0, 1, At, B1); PG8_BAR; PG8_SCHED;
            PG8_LDA(At, 1, 1); PG8_STAGE(PG8_SB(1, 0), b3, voffB); PG8_STAGE(PG8_SB(1, 1), b3 + hstep, voffB); PG8_STAGE(PG8_SA(1, 0), a3, voffA);
            PG8_WAIT_V(8); PG8_WAIT_L(0); PG8_BAR; PG8_MMA(1, 0, At, B0); PG8_MMA(1, 1, At, B1); PG8_BAR; PG8_SCHED;
            } else {
            PG8_LDB(B0, 0, 0); PG8_SCHED; PG8_LDA(At, 0, 0); PG8_STAGE(PG8_SA(1, 1), a1 + hstep, voffA);
            PG8_WAIT_L(8); PG8_BAR; PG8_WAIT_L(0); PG8_MMA(0, 0, At, B0); PG8_BAR; PG8_SCHED;
            PG8_LDB(B1, 0, 1); PG8_STAGE(PG8_SB(0, 0), b2, voffB);
            PG8_BAR; PG8_WAIT_L(0); PG8_MMA(0, 1, At, B1); PG8_BAR;
            PG8_LDA(At, 0, 1); PG8_STAGE(PG8_SA(0, 0), a2, voffA);
            PG8_BAR; PG8_WAIT_L(0); PG8_MMA(1, 0, At, B0); PG8_BAR; PG8_SCHED;
            PG8_STAGE(PG8_SB(0, 1), b2 + hstep, voffB);
            PG8_WAIT_V(6); PG8_BAR; PG8_MMA(1, 1, At, B1); PG8_BAR;
            PG8_LDB(B0, 1, 0); PG8_SCHED; PG8_LDA(At, 1, 0); PG8_STAGE(PG8_SA(0, 1), a2 + hstep, voffA);
            PG8_WAIT_L(8); PG8_BAR; PG8_WAIT_L(0); PG8_MMA(0, 0, At, B0); PG8_BAR; PG8_SCHED;
            PG8_LDB(B1, 1, 1); PG8_STAGE(PG8_SB(1, 0), b3, voffB);
            PG8_BAR; PG8_WAIT_L(0); PG8_MMA(0, 1, At, B1); PG8_BAR;
            PG8_LDA(At, 1, 1); PG8_STAGE(PG8_SA(1, 0), a3, voffA);
            PG8_BAR; PG8_WAIT_L(0); PG8_MMA(1, 0, At, B0); PG8_BAR; PG8_SCHED;
            PG8_STAGE(PG8_SB(1, 1), b3 + hstep, voffB);
            PG8_WAIT_V(6); PG8_BAR; PG8_MMA(1, 1, At, B1); PG8_BAR;
            }
        }
        if constexpr (ALIGN_EPI) { if (wr == 0) PG8_BAR; }
        if constexpr (!Epi::AFTER_DRAIN) { E(acc, cur, wr, wc, fr, fq); S.done(cur); }
        if (!has_next) break;
#pragma unroll
        for (int a = 0; a < 2; ++a)
#pragma unroll
            for (int b = 0; b < 2; ++b)
#pragma unroll
                for (int m = 0; m < 4; ++m)
#pragma unroll
                    for (int n = 0; n < 2; ++n) acc[a][b][m][n] = (f32x4){0.f, 0.f, 0.f, 0.f};
        cur = nxt; cA = nA; cB = nB; ++ui;
        if constexpr (ALIGN_EPI) { if (wr == 1) PG8_BAR; }
    }
    PG8_WAIT_V(0);
    if constexpr (!ALIGN_EPI) { if (wr == 0) PG8_BAR; }
    PG8_BAR;
    if constexpr (Epi::AFTER_DRAIN) { E.fused(acc, cur, wr, wc, fr, fq, lds, wid, lane); S.done(cur); }
#undef PG8_SA
#undef PG8_SB
#undef PG8_STAGE
#undef PG8_LDA
#undef PG8_LDB
#undef PG8_MMA
#undef PG8_WAIT_V
#undef PG8_WAIT_L
#undef PG8_BAR
#undef PG8_SCHED
}
}

#define GAS __attribute__((address_space(1)))
#define LAS __attribute__((address_space(3)))
typedef unsigned short bf16;
typedef unsigned v4u __attribute__((ext_vector_type(4)));
typedef unsigned v2u __attribute__((ext_vector_type(2)));
typedef float f32x4 __attribute__((ext_vector_type(4)));
typedef float f32x16 __attribute__((ext_vector_type(16)));
typedef short bf16x8 __attribute__((ext_vector_type(8)));
typedef short s16x4 __attribute__((ext_vector_type(4)));

constexpr int NWAVES = 8;
constexpr int NB = 4, SEQ = 8192, DM = 1024, TOK = NB * SEQ;
constexpr int NIN = 5888;
constexpr int SBH = 8, DILH = 12;
constexpr int NMOD = 6 * DM;
constexpr int KSPLIT = 16;
constexpr float EPS = 1e-6f;
constexpr float LOG2E = 1.4426950408889634f;
constexpr float C2 = 0.125f * LOG2E;
constexpr int PEER_E = 16384;

constexpr size_t MiB = 1u << 20;
constexpr size_t WS_CTL = 0, CTL_ZERO_BYTES = 1 * MiB;
constexpr size_t WS_MODP = 1 * MiB;
constexpr size_t WS_MOD = 2 * MiB + 512 * 1024;
constexpr size_t WS_BIASPQ = 2 * MiB + 768 * 1024;
constexpr size_t WS_ROPEC = 3 * MiB, WS_ROPES = 4 * MiB;
constexpr size_t WS_SSQ = 5 * MiB;
constexpr size_t WS_KEYS = 7 * MiB;
constexpr size_t WS_WIN = 8 * MiB;
constexpr size_t WS_WSBO = 20 * MiB;
constexpr size_t WS_WDILO = 21 * MiB;
constexpr size_t WS_WOUT = 22 * MiB;
constexpr size_t WS_WPQ = 24 * MiB;
constexpr size_t WS_UB = 32 * MiB, WS_VB = 64 * MiB;
constexpr size_t WS_ACT = 96 * MiB;
constexpr size_t A_QSB = WS_ACT, A_KSB = WS_ACT + 32 * MiB, A_VSB = WS_ACT + 64 * MiB;
constexpr size_t A_QD = WS_ACT + 96 * MiB, A_KD = WS_ACT + 144 * MiB, A_VD = WS_ACT + 192 * MiB;
constexpr size_t A_GSB = WS_ACT + 240 * MiB, A_GD = WS_ACT + 304 * MiB;
constexpr size_t A_MERGED = WS_ACT;
constexpr size_t A_X1M = WS_ACT + 64 * MiB;
constexpr size_t A_QPEER = WS_ACT + 128 * MiB;
constexpr size_t A_IDX = WS_ACT + 256 * MiB;
constexpr size_t A_GATE = WS_ACT + 272 * MiB;
constexpr size_t A_ACTG = WS_ACT + 288 * MiB;
constexpr size_t A_PART = WS_ACT + 128 * MiB;
constexpr size_t WS_R2 = 7 * MiB + 512 * 1024;
constexpr size_t A_POUT = WS_ACT;
constexpr size_t WS_END = WS_ACT + 368 * MiB;
constexpr size_t O_H = 0, O_OSB = 64 * MiB, O_OD = 96 * MiB;

constexpr int CW_BAR = 4096;

constexpr int RING_BYTES = 131072;
constexpr int MISC_OFF = RING_BYTES + 320;
constexpr int LDS_BYTES = 147456;

#define RLX_AGENT __ATOMIC_RELAXED, __HIP_MEMORY_SCOPE_AGENT
__device__ __forceinline__ unsigned f2bf(float f) { unsigned u = __builtin_bit_cast(unsigned, f); return (u + 0x7fffu + ((u >> 16) & 1u)) >> 16; }
typedef float f32x2_t __attribute__((ext_vector_type(2))); typedef __bf16 bf16x2_t __attribute__((ext_vector_type(2)));
__device__ __forceinline__ unsigned pk2(float lo, float hi) { f32x2_t v = {lo, hi}; bf16x2_t b = __builtin_convertvector(v, bf16x2_t); return __builtin_bit_cast(unsigned, b); }
__device__ __forceinline__ float bflo(unsigned w) { return __uint_as_float(w << 16); }
__device__ __forceinline__ float bfhi(unsigned w) { return __uint_as_float(w & 0xffff0000u); }
__device__ __forceinline__ float wave_sum(float v) {
#pragma unroll
    for (int o = 1; o < 64; o <<= 1) v += __shfl_xor(v, o);
    return v;
}
__device__ __forceinline__ float fast_exp2(float x) { return __builtin_amdgcn_exp2f(x); }
__device__ __forceinline__ float fast_log2(float x) { return __builtin_amdgcn_logf(x); }
__device__ __forceinline__ float fast_rcp(float x) { return __builtin_amdgcn_rcpf(x); }
__device__ __forceinline__ float sigmoidf_(float x) { return fast_rcp(1.f + fast_exp2(-x * LOG2E)); }
#define XB_TMO      128
#define XB_XCNT(j)  (256  + 64 * (j))
#define XB_XSUB(j)  (1280 + 64 * (j))
#define XB_XGEN(j)  (2304 + 64 * (j))
#define XB_TOP      3328
#define XB_TOPGEN   3392
#define XCD_BAR_WORDS 3456
#define XB_SPIN_CAP (1u << 18)

__device__ __forceinline__ unsigned xb_ld(unsigned* p)              { return __hip_atomic_load(p, __ATOMIC_RELAXED, __HIP_MEMORY_SCOPE_AGENT); }
__device__ __forceinline__ unsigned xb_add(unsigned* p, unsigned v) { return __hip_atomic_fetch_add(p, v, __ATOMIC_RELAXED, __HIP_MEMORY_SCOPE_AGENT); }
__device__ __forceinline__ unsigned xb_xcc_id() { return (unsigned)__builtin_amdgcn_s_getreg((3 << 11) | 20) & 0xFu; }
#define XB_SPIN(cond, bar) do { unsigned _sp = 0; while (cond) { __builtin_amdgcn_s_sleep(1); \
    if ((++_sp & 255u) == 0u) { if (xb_ld(&(bar)[XB_TMO])) break; if (_sp > XB_SPIN_CAP) { atomicAdd(&(bar)[XB_TMO], 1u); break; } } } } while (0)

struct XcdBarrier {
    unsigned* bar; unsigned x;
    volatile LAS unsigned* st;
};

__device__ __forceinline__ XcdBarrier xcd_barrier_post(unsigned* bar, volatile LAS unsigned* st) {
    XcdBarrier b; b.bar = bar; b.x = xb_xcc_id(); b.st = st;
    if (threadIdx.x == 0) (void)xb_add(&bar[XB_XCNT(b.x)], 1u);
    return b;
}
__device__ __forceinline__ void xcd_barrier_complete(unsigned* bar, unsigned x, unsigned& nloc, unsigned& nx) {
    const unsigned G = gridDim.x * gridDim.y * gridDim.z;
    unsigned sum, cnt, mine, sp = 0u;
    for (;;) {
        sum = 0u; cnt = 0u; mine = 0u;
#pragma unroll
        for (unsigned j = 0; j < 16; ++j) { const unsigned c = xb_ld(&bar[XB_XCNT(j)]); sum += c; cnt += (c > 0u) ? 1u : 0u; mine = (j == x) ? c : mine; }
        if (sum == G) break;
        __builtin_amdgcn_s_sleep(1);
        if ((++sp & 255u) == 0u) { if (xb_ld(&bar[XB_TMO])) break; if (sp > XB_SPIN_CAP) { atomicAdd(&bar[XB_TMO], 1u); break; } }
    }
    nloc = mine > 0u ? mine : 1u; nx = cnt > 0u ? cnt : 1u;
}

__device__ __forceinline__ void xcd_barrier(const XcdBarrier& b) {
    asm volatile("s_waitcnt vmcnt(0)" ::: "memory");
    __syncthreads();
    if (threadIdx.x == 0) {
        unsigned* bar = b.bar;
        __builtin_amdgcn_s_waitcnt(0);
        unsigned nloc = b.st[0], nx = b.st[1];
        if (nloc == 0u) { xcd_barrier_complete(bar, b.x, nloc, nx); b.st[0] = nloc; b.st[1] = nx; }
        const unsigned old = xb_add(&bar[XB_XSUB(b.x)], 1u);
        const unsigned gen = old / nloc;
        if (old + 1u == (gen + 1u) * nloc) {
            __builtin_amdgcn_fence(__ATOMIC_RELEASE, "agent");
            asm volatile("s_waitcnt vmcnt(0)" ::: "memory");
            const unsigned og = xb_add(&bar[XB_TOP], 1u);
            const unsigned tg = og / nx;
            if (og + 1u == (tg + 1u) * nx) xb_add(&bar[XB_TOPGEN], 1u);
            else XB_SPIN(xb_ld(&bar[XB_TOPGEN]) == tg, bar);
            __builtin_amdgcn_fence(__ATOMIC_ACQUIRE, "agent");
            xb_add(&bar[XB_XGEN(b.x)], 1u);
            asm volatile("s_waitcnt vmcnt(0)" ::: "memory");
        } else {
            XB_SPIN(xb_ld(&bar[XB_XGEN(b.x)]) == gen, bar);
            __builtin_amdgcn_fence(__ATOMIC_ACQUIRE, "agent");
            asm volatile("s_waitcnt vmcnt(0)" ::: "memory");
        }
    }
    __syncthreads();
}

struct Args {
    const float* x; const float* c; const float* w_ada; const float* b_ada; const float* g_mix; const float* w_in; const float* w_sb_o; const float* w_dil_o;
    const float* w_out; const float* g_ffn; const float* w_pq; const float* peer_keys; const float* peer_u; const float* peer_v; const float* g_final;
    float* out; unsigned char* ws; int ph_lo, ph_hi;
};
struct Frame {
    LAS unsigned char* lds;
    int tid, lane, wave, vcu, G, gw, NGW;
};

__device__ __forceinline__ int win_row(int ncol) {
    const int tile = ncol >> 8;
    if (tile >= 6 && tile < 12) { const int d = ncol & 63; const int j = (d & 31) >> 2, i = (d & 3) + ((d >> 5) << 2); return (ncol & ~63) + 8 * j + i; }
    return ncol;
}
template <bool MAPWIN>
__device__ __forceinline__ void p0_transpose_item(const float* W, int K, int N, bf16* WT, LAS float* scr, int item, int lane) {
    const int nblk = N / 32, kb = item / nblk, nb = item % nblk, k0 = 64 * kb, n0 = 32 * nb;
#pragma unroll 8
    for (int i = 0; i < 32; ++i) { const int kk = 2 * i + (lane >> 5); scr[kk * 33 + (lane & 31)] = W[(size_t)(k0 + kk) * N + n0 + (lane & 31)]; }
    asm volatile("s_waitcnt lgkmcnt(0)" ::: "memory");
    const int c = lane & 7;
#pragma unroll
    for (int j = 0; j < 4; ++j) { const int n = (lane >> 3) + 8 * j; const LAS float* s = scr + (8 * c) * 33 + n;
        v4u o; o.x = pk2(s[0 * 33], s[1 * 33]); o.y = pk2(s[2 * 33], s[3 * 33]); o.z = pk2(s[4 * 33], s[5 * 33]); o.w = pk2(s[6 * 33], s[7 * 33]);
        const int rowo = MAPWIN ? win_row(n0 + n) : (n0 + n);
        *(GAS v4u*)(WT + (size_t)rowo * K + k0 + 8 * c) = o; }
    asm volatile("s_waitcnt lgkmcnt(0)" ::: "memory");
}
__device__ __forceinline__ void cvt_row_1024(const float* src, bf16* dst, int lane) {
    const GAS f32x4* s = (const GAS f32x4*)src + lane; GAS v2u* d = (GAS v2u*)dst + lane;
    f32x4 v[4];
#pragma unroll
    for (int j = 0; j < 4; ++j) v[j] = s[64 * j];
#pragma unroll
    for (int j = 0; j < 4; ++j) { v2u o; o.x = pk2(v[j].x, v[j].y); o.y = pk2(v[j].z, v[j].w); d[64 * j] = o; }
}
template <bool SLICED>
__device__ __forceinline__ void cvt_row_fp8(const float* src, unsigned char* dst, float* inv, int e, int lane) {
    const GAS f32x4* s = (const GAS f32x4*)src + lane;
    f32x4 v[4]; float m = 0.f;
#pragma unroll
    for (int j = 0; j < 4; ++j) { v[j] = s[64 * j]; m = fmaxf(m, fmaxf(fmaxf(fabsf(v[j].x), fabsf(v[j].y)), fmaxf(fabsf(v[j].z), fabsf(v[j].w)))); }
#pragma unroll
    for (int o = 1; o < 64; o <<= 1) m = fmaxf(m, __shfl_xor(m, o));
    m = fmaxf(m, 1e-30f);
    const int ex = (int)((__float_as_uint(m) >> 23) & 0xff) - 127;
    const float scale = __uint_as_float((unsigned)(127 + 7 - ex) << 23);
    const float iscale = __uint_as_float((unsigned)(127 - 7 + ex) << 23);
    unsigned w[4];
#pragma unroll
    for (int j = 0; j < 4; ++j) { int t = __builtin_amdgcn_cvt_pk_fp8_f32(v[j].x * scale, v[j].y * scale, 0, false); t = __builtin_amdgcn_cvt_pk_fp8_f32(v[j].z * scale, v[j].w * scale, t, true); w[j] = (unsigned)t; }
    if (!SLICED) { *(GAS v4u*)(dst + (size_t)e * 1024 + 16 * lane) = (v4u){w[0], w[1], w[2], w[3]}; }
    else {
#pragma unroll
        for (int j = 0; j < 4; ++j) *(GAS unsigned*)(dst + (size_t)(2 * j + (lane >> 5)) * (2 * MiB) + (size_t)e * 128 + 4 * (lane & 31)) = w[j]; }
    if (lane == 0) inv[e] = iscale;
}
__device__ __forceinline__ void sincos_d(double a, float& sn, float& cs) {
    const double TWO_PI = 6.283185307179586476925286766559;
    const double k = __builtin_rint(a / TWO_PI); const double r = a - k * TWO_PI; const double r2 = r * r;
    double ts = 1.0, tc = 1.0, ss = 1.0, cc = 1.0;
#pragma unroll
    for (int n = 1; n <= 14; ++n) { tc = -tc * r2 / (double)((2 * n - 1) * (2 * n)); ts = -ts * r2 / (double)((2 * n) * (2 * n + 1)); cc += tc; ss += ts; }
    sn = (float)(r * ss); cs = (float)cc;
}

__device__ __forceinline__ void p0_prologue(const Args& A, Frame& F) {
    unsigned char* ws = A.ws;
    LAS float* scr = (LAS float*)(F.lds + F.wave * 16384);
    const int lane = F.lane;
    constexpr int I_MOD = KSPLIT * 24;
    constexpr int I_WIN = (DM / 64) * (NIN / 32);
    constexpr int I_SBO = (512 / 64) * (DM / 32), I_DILO = (256 / 64) * (DM / 32), I_OUT = (DM / 64) * (DM / 32), I_PQ = (DM / 64) * (2048 / 32);
    constexpr int I_KEYS = 256, I_TAB = 2 * PEER_E, I_ROPE = SEQ * 32 / 64;
    constexpr int NITEMS = I_MOD + I_WIN + I_SBO + I_DILO + I_OUT + I_PQ + I_KEYS + I_TAB + I_ROPE;
    for (int it = F.gw; it < NITEMS; it += F.NGW) {
        int r = it;
        if (r < I_MOD) {
            const int ks = r / 24, cc = r % 24, col = 256 * cc + 4 * lane, k0 = 64 * ks;
            float sv[4];
#pragma unroll
            for (int b = 0; b < 4; ++b) { const float cv = A.c[b * DM + k0 + lane]; sv[b] = cv * sigmoidf_(cv); }
            f32x4 acc[4];
#pragma unroll
            for (int b = 0; b < 4; ++b) acc[b] = (f32x4){0.f, 0.f, 0.f, 0.f};
            const GAS f32x4* wp = (const GAS f32x4*)(A.w_ada + (size_t)k0 * NMOD + col);
#pragma unroll 8
            for (int kk = 0; kk < 64; ++kk) { const f32x4 w4 = wp[(size_t)kk * (NMOD / 4)];
#pragma unroll
                for (int b = 0; b < 4; ++b) { const float s = __uint_as_float(__builtin_amdgcn_readlane(__float_as_uint(sv[b]), kk)); acc[b] += w4 * s; } }
            float* mp = (float*)(ws + WS_MODP);
#pragma unroll
            for (int b = 0; b < 4; ++b) *(GAS f32x4*)(mp + ((size_t)(ks * 4 + b)) * NMOD + col) = acc[b];
            continue;
        }
        r -= I_MOD;
        if (r < I_WIN) { p0_transpose_item<true>(A.w_in, DM, NIN, (bf16*)(ws + WS_WIN), scr, r, lane); continue; } r -= I_WIN;
        if (r < I_SBO) { p0_transpose_item<false>(A.w_sb_o, 512, DM, (bf16*)(ws + WS_WSBO), scr, r, lane); continue; } r -= I_SBO;
        if (r < I_DILO) { p0_transpose_item<false>(A.w_dil_o, 256, DM, (bf16*)(ws + WS_WDILO), scr, r, lane); continue; } r -= I_DILO;
        if (r < I_OUT) { p0_transpose_item<false>(A.w_out, DM, DM, (bf16*)(ws + WS_WOUT), scr, r, lane); continue; } r -= I_OUT;
        if (r < I_PQ) { p0_transpose_item<false>(A.w_pq, DM, 2048, (bf16*)(ws + WS_WPQ), scr, r, lane); continue; } r -= I_PQ;
        if (r < I_KEYS) { cvt_row_1024(A.peer_keys + (size_t)r * 1024, (bf16*)(ws + WS_KEYS) + (size_t)r * 1024, lane); continue; } r -= I_KEYS;
        if (r < I_TAB) { if (r < PEER_E) cvt_row_fp8<true>(A.peer_u + (size_t)r * 1024, ws + WS_UB, (float*)(ws + WS_UB + 16 * MiB), r, lane);
                         else cvt_row_fp8<true>(A.peer_v + (size_t)(r - PEER_E) * 1024, ws + WS_VB, (float*)(ws + WS_VB + 16 * MiB), r - PEER_E, lane); continue; } r -= I_TAB;
        {
            const int idx = r * 64 + lane, s = idx >> 5, j = idx & 31;
            const float inv = (float)exp2(-(double)j * (13.287712379549449 / 32.0));
            const float ang = (float)s * inv;
            float sn, cs; sincos_d((double)ang, sn, cs);
            ((float*)(ws + WS_ROPEC))[idx] = cs; ((float*)(ws + WS_ROPES))[idx] = sn;
        }
    }
}

__device__ __forceinline__ void p1_hrows(const Args& A, Frame& F) {
    unsigned char* ws = A.ws;
    LAS float* mult = (LAS float*)F.lds; LAS float* addv = mult + DM;
    const float* mp = (const float*)(ws + WS_MODP);
    float* mod = (float*)(ws + WS_MOD);
    bf16* H = (bf16*)((unsigned char*)A.out + O_H);
    for (int ch = F.vcu; ch < TOK / 128; ch += F.G) {
        const int b = (ch * 128) / SEQ;
        __syncthreads();
        for (int k = F.tid; k < DM; k += NWAVES * 64) {
            float sh = A.b_ada[k], sc = A.b_ada[DM + k];
#pragma unroll
            for (int ks = 0; ks < KSPLIT; ++ks) { sh += mp[(size_t)(ks * 4 + b) * NMOD + k]; sc += mp[(size_t)(ks * 4 + b) * NMOD + DM + k]; }
            mult[k] = A.g_mix[k] * (1.f + sc); addv[k] = sh;
        }
        if ((ch * 128) % SEQ == 0) {
            for (int j = F.tid; j < NMOD; j += NWAVES * 64) { float v = A.b_ada[j];
#pragma unroll
                for (int ks = 0; ks < KSPLIT; ++ks) v += mp[(size_t)(ks * 4 + b) * NMOD + j];
                mod[b * NMOD + j] = v; }
        }
        __syncthreads();
        for (int i = 0; i < 16; ++i) {
            const int row = ch * 128 + F.wave * 16 + i;
            const GAS f32x4* xr = (const GAS f32x4*)(A.x + (size_t)row * DM) + F.lane;
            f32x4 v[4]; float s = 0.f;
#pragma unroll
            for (int j = 0; j < 4; ++j) { v[j] = xr[64 * j]; s += (v[j].x * v[j].x + v[j].y * v[j].y) + (v[j].z * v[j].z + v[j].w * v[j].w); }
            const float rr = 1.0f / sqrtf(wave_sum(s) * (1.f / DM) + EPS);
            GAS v2u* o8 = (GAS v2u*)(H + (size_t)row * DM) + F.lane;
#pragma unroll
            for (int j = 0; j < 4; ++j) { const f32x4 mu = *(const LAS f32x4*)(mult + 256 * j + 4 * F.lane), ad = *(const LAS f32x4*)(addv + 256 * j + 4 * F.lane);
                const f32x4 hh = v[j] * rr * mu + ad; v2u o; o.x = pk2(hh.x, hh.y); o.y = pk2(hh.z, hh.w); o8[64 * j] = o; }
        }
    }
}

typedef pg8::f32x4 pf4;
struct EpiG1 {
    static constexpr bool PERM = true, AFTER_DRAIN = false;
    bf16 *Qsb, *Ksb, *Vsb, *Qd, *Kd, *Vd, *Gsb, *Gd; const float* ropeC; const float* ropeS;
    __device__ __forceinline__ void operator()(const pf4 (&acc)[2][2][4][2], const pg8::Unit& u, int wr, int wc, int fr, int fq) const {
        const int pn = u.pn;
        const int row0 = u.pm * 256 + wr * 64 + fr;
        const int b = (u.pm * 256) >> 13;
        if (pn < 6 || (pn >= 12 && pn < 15)) {
            bf16* base; int H, head0; float sc = 1.f;
            if (pn < 2) { base = Qsb; H = SBH; head0 = 4 * pn; sc = C2; }
            else if (pn < 4) { base = Ksb; H = SBH; head0 = 4 * (pn - 2); }
            else if (pn < 6) { base = Vsb; H = SBH; head0 = 4 * (pn - 4); }
            else { base = Vd; H = DILH; head0 = 4 * (pn - 12); }
            const int d0 = 32 * (wc & 1) + 8 * fq;
#pragma unroll
            for (int ai = 0; ai < 2; ++ai)
#pragma unroll
                for (int m = 0; m < 4; ++m) { const int s = (row0 + ai * 128 + m * 16) & (SEQ - 1);
#pragma unroll
                    for (int bj = 0; bj < 2; ++bj) { const int head = head0 + 2 * bj + (wc >> 1);
                        const pf4 v0 = acc[ai][bj][m][0] * sc, v1 = acc[ai][bj][m][1] * sc;
                        v4u w; w.x = pk2(v0[0], v0[1]); w.y = pk2(v0[2], v0[3]); w.z = pk2(v1[0], v1[1]); w.w = pk2(v1[2], v1[3]);
                        *(GAS v4u*)(base + ((size_t)(b * H + head) * SEQ + s) * 64 + d0) = w; } }
        } else if (pn < 12) {
            bf16* base; int head0; float sc = 1.f;
            if (pn < 9) { base = Qd; head0 = 4 * (pn - 6); sc = C2; } else { base = Kd; head0 = 4 * (pn - 9); }
            const int j4 = 4 * (4 * (wc & 1) + fq);
#pragma unroll
            for (int ai = 0; ai < 2; ++ai)
#pragma unroll
                for (int m = 0; m < 4; ++m) { const int s = (row0 + ai * 128 + m * 16) & (SEQ - 1);
                    const pf4 cs = *(const GAS pf4*)(ropeC + s * 32 + j4) * sc, sn = *(const GAS pf4*)(ropeS + s * 32 + j4) * sc;
#pragma unroll
                    for (int bj = 0; bj < 2; ++bj) { const int head = head0 + 2 * bj + (wc >> 1);
                        const pf4 x1 = acc[ai][bj][m][0], x2 = acc[ai][bj][m][1];
                        const pf4 o1 = x1 * cs - x2 * sn, o2 = x1 * sn + x2 * cs;
                        bf16* p = base + ((size_t)(b * DILH + head) * SEQ + s) * 64 + j4;
                        v2u w1, w2; w1.x = pk2(o1[0], o1[1]); w1.y = pk2(o1[2], o1[3]); w2.x = pk2(o2[0], o2[1]); w2.y = pk2(o2[2], o2[3]);
                        *(GAS v2u*)p = w1; *(GAS v2u*)(p + 32) = w2; } }
        } else {
            bf16* base = pn < 19 ? Gsb : Gd; const int ct = (pn < 19 ? pn - 15 : pn - 19) * 256 + wc * 32 + 8 * fq;
#pragma unroll
            for (int ai = 0; ai < 2; ++ai)
#pragma unroll
                for (int m = 0; m < 4; ++m) { const size_t row = (size_t)(row0 + ai * 128 + m * 16);
#pragma unroll
                    for (int bj = 0; bj < 2; ++bj) { const pf4 v0 = acc[ai][bj][m][0], v1 = acc[ai][bj][m][1];
                        v4u w; w.x = pk2(sigmoidf_(v0[0]), sigmoidf_(v0[1])); w.y = pk2(sigmoidf_(v0[2]), sigmoidf_(v0[3]));
                        w.z = pk2(sigmoidf_(v1[0]), sigmoidf_(v1[1])); w.w = pk2(sigmoidf_(v1[2]), sigmoidf_(v1[3]));
                        *(GAS v4u*)(base + row * DM + ct + bj * 128) = w; } }
        }
    }
};
template <bool SECOND> struct EpiMerge {
    static constexpr bool PERM = true, AFTER_DRAIN = false;
    const bf16* G; bf16* Mg;
    __device__ __forceinline__ void operator()(const pf4 (&acc)[2][2][4][2], const pg8::Unit& u, int wr, int wc, int fr, int fq) const {
        const int row0 = u.pm * 256 + wr * 64 + fr, col0 = u.pn * 256 + wc * 32 + 8 * fq;
#pragma unroll
        for (int ai = 0; ai < 2; ++ai)
#pragma unroll
            for (int m = 0; m < 4; ++m) { const size_t off = (size_t)(row0 + ai * 128 + m * 16) * DM + col0;
#pragma unroll
                for (int bj = 0; bj < 2; ++bj) { const v4u g = *(const GAS v4u*)(G + off + bj * 128);
                    pf4 v0 = acc[ai][bj][m][0], v1 = acc[ai][bj][m][1];
                    v0[0] *= bflo(g.x); v0[1] *= bfhi(g.x); v0[2] *= bflo(g.y); v0[3] *= bfhi(g.y); v1[0] *= bflo(g.z); v1[1] *= bfhi(g.z); v1[2] *= bflo(g.w); v1[3] *= bfhi(g.w);
                    if (SECOND) { const v4u t = *(const GAS v4u*)(Mg + off + bj * 128);
                        v0[0] += bflo(t.x); v0[1] += bfhi(t.x); v0[2] += bflo(t.y); v0[3] += bfhi(t.y); v1[0] += bflo(t.z); v1[1] += bfhi(t.z); v1[2] += bflo(t.w); v1[3] += bfhi(t.w); }
                    v4u w; w.x = pk2(v0[0], v0[1]); w.y = pk2(v0[2], v0[3]); w.z = pk2(v1[0], v1[1]); w.w = pk2(v1[2], v1[3]);
                    *(GAS v4u*)(Mg + off + bj * 128) = w; }
                asm volatile("" ::: "memory"); }
    }
};
struct EpiOut {
    static constexpr bool PERM = true, AFTER_DRAIN = false;
    const float* x; float* x1; bf16* x1m; float* ssq; const float* mod; const float* g_ffn;
    __device__ __forceinline__ void operator()(const pf4 (&acc)[2][2][4][2], const pg8::Unit& u, int wr, int wc, int fr, int fq) const {
        const int row0 = u.pm * 256 + wr * 64 + fr, col0 = u.pn * 256 + wc * 32 + 8 * fq;
        const int b = (u.pm * 256) >> 13; const float* mb = mod + (size_t)b * NMOD;
        pf4 gt[2][2], mm[2][2];
#pragma unroll
        for (int bj = 0; bj < 2; ++bj)
#pragma unroll
            for (int n = 0; n < 2; ++n) { const int c = col0 + bj * 128 + 4 * n; gt[bj][n] = *(const GAS pf4*)(mb + 2 * DM + c);
                mm[bj][n] = *(const GAS pf4*)(g_ffn + c) * (*(const GAS pf4*)(mb + 4 * DM + c) + 1.0f); }
#pragma unroll
        for (int ai = 0; ai < 2; ++ai)
#pragma unroll
            for (int m = 0; m < 4; ++m) { const int row = row0 + ai * 128 + m * 16; const size_t off = (size_t)row * DM + col0; float s = 0.f;
#pragma unroll
                for (int bj = 0; bj < 2; ++bj) {
                    const pf4 a0 = *(const GAS pf4*)(x + off + bj * 128), a1 = *(const GAS pf4*)(x + off + bj * 128 + 4);
                    const pf4 y0 = a0 + gt[bj][0] * acc[ai][bj][m][0], y1 = a1 + gt[bj][1] * acc[ai][bj][m][1];
                    *(GAS pf4*)(x1 + off + bj * 128) = y0; *(GAS pf4*)(x1 + off + bj * 128 + 4) = y1;
                    s += (y0[0] * y0[0] + y0[1] * y0[1]) + (y0[2] * y0[2] + y0[3] * y0[3]) + (y1[0] * y1[0] + y1[1] * y1[1]) + (y1[2] * y1[2] + y1[3] * y1[3]);
                    const pf4 z0 = y0 * mm[bj][0], z1 = y1 * mm[bj][1];
                    v4u w; w.x = pk2(z0[0], z0[1]); w.y = pk2(z0[2], z0[3]); w.z = pk2(z1[0], z1[1]); w.w = pk2(z1[2], z1[3]);
                    *(GAS v4u*)(x1m + off + bj * 128) = w; }
                s += __shfl_xor(s, 16); s += __shfl_xor(s, 32);
                if (fq == 0) ssq[(size_t)row * 16 + 4 * u.pn + wc] = s; }
    }
};
struct EpiPq {
    static constexpr bool PERM = true, AFTER_DRAIN = false;
    const float* ssq; const float* bias; bf16* Q; float* r2out;
    __device__ __forceinline__ void operator()(const pf4 (&acc)[2][2][4][2], const pg8::Unit& u, int wr, int wc, int fr, int fq) const {
        const int row0 = u.pm * 256 + wr * 64 + fr, col0 = u.pn * 256 + wc * 32 + 8 * fq;
        const int b = (u.pm * 256) >> 13; const float* bb = bias + (size_t)b * 2048;
        pf4 bv[2][2];
#pragma unroll
        for (int bj = 0; bj < 2; ++bj)
#pragma unroll
            for (int n = 0; n < 2; ++n) bv[bj][n] = *(const GAS pf4*)(bb + col0 + bj * 128 + 4 * n);
#pragma unroll
        for (int ai = 0; ai < 2; ++ai)
#pragma unroll
            for (int m = 0; m < 4; ++m) { const int row = row0 + ai * 128 + m * 16;
                const GAS pf4* sp = (const GAS pf4*)(ssq + (size_t)row * 16);
                const pf4 s4 = (sp[0] + sp[1]) + (sp[2] + sp[3]);
                const float r2 = 1.0f / sqrtf(((s4[0] + s4[1]) + (s4[2] + s4[3])) * (1.f / DM) + EPS);
                if (u.pn == 0 && wc == 0 && fq == 0) r2out[row] = r2;
#pragma unroll
                for (int bj = 0; bj < 2; ++bj) { const pf4 v0 = acc[ai][bj][m][0] * r2 + bv[bj][0], v1 = acc[ai][bj][m][1] * r2 + bv[bj][1];
                    v4u w; w.x = pk2(v0[0], v0[1]); w.y = pk2(v0[2], v0[3]); w.z = pk2(v1[0], v1[1]); w.w = pk2(v1[2], v1[3]);
                    *(GAS v4u*)(Q + (size_t)row * 2048 + col0 + bj * 128) = w; } }
    }
};

constexpr int VSTR = 144;
constexpr int ATT_WAVE_LDS = 32 * VSTR;
__device__ __forceinline__ int kappa(int r) { return (((r >> 2) & 1) << 4) + ((r >> 3) << 2) + (r & 3); }
struct KVTile { bf16x8 k[4]; v4u v[4]; };
typedef short v4i16_t __attribute__((ext_vector_type(4)));
__device__ __forceinline__ s16x4 vtr(const LAS unsigned char* p) { return __builtin_bit_cast(s16x4, __builtin_amdgcn_ds_read_tr16_b64_v4i16((LAS v4i16_t*)p)); }

__device__ __forceinline__ void kv_load(KVTile& t, const bf16* Kh, const bf16* Vh, int base_tok, int sshift, int lane) {
    const int r = lane & 31, h = lane >> 5;
    const bf16* kp = Kh + (size_t)(base_tok + (kappa(r) << sshift)) * 64 + 8 * h;
#pragma unroll
    for (int st = 0; st < 4; ++st) t.k[st] = *(const GAS bf16x8*)(kp + 16 * st);
#pragma unroll
    for (int i = 0; i < 4; ++i) t.v[i] = *(const GAS v4u*)(Vh + (size_t)(base_tok + (((lane >> 3) + 8 * i) << sshift)) * 64 + 8 * (lane & 7));
}
__device__ __forceinline__ void v_to_lds(const KVTile& t, LAS unsigned char* vl, int lane) {
#pragma unroll
    for (int i = 0; i < 4; ++i) *(LAS v4u*)(vl + ((lane >> 3) + 8 * i) * VSTR + 16 * (lane & 7)) = t.v[i];
}
__device__ __forceinline__ f32x16 qk_tile(const KVTile& t, const bf16x8 (&qf)[4]) {
    f32x16 s = {};
#pragma unroll
    for (int st = 0; st < 4; ++st) s = __builtin_amdgcn_mfma_f32_32x32x16_bf16(t.k[st], qf[st], s, 0, 0, 0);
    return s;
}
__device__ __forceinline__ void pv_tile(f32x16& o0, f32x16& o1, const float (&p)[16], const LAS unsigned char* vl, int lane) {
    const int g = lane >> 4, li = lane & 15, q = li >> 2, pp = li & 3, h = g >> 1;
    const LAS unsigned char* tb = vl + (16 * h + q) * VSTR + (16 * (g & 1) + 4 * pp) * 2;
    bf16x8 pf[2];
#pragma unroll
    for (int st = 0; st < 2; ++st) { v4u w; w.x = pk2(p[8 * st + 0], p[8 * st + 1]); w.y = pk2(p[8 * st + 2], p[8 * st + 3]); w.z = pk2(p[8 * st + 4], p[8 * st + 5]); w.w = pk2(p[8 * st + 6], p[8 * st + 7]); pf[st] = __builtin_bit_cast(bf16x8, w); }
#pragma unroll
    for (int db = 0; db < 2; ++db)
#pragma unroll
        for (int st = 0; st < 2; ++st) {
            const s16x4 lo = vtr(tb + (8 * st) * VSTR + 64 * db), hi = vtr(tb + (8 * st + 4) * VSTR + 64 * db);
            const bf16x8 vf = (bf16x8){lo[0], lo[1], lo[2], lo[3], hi[0], hi[1], hi[2], hi[3]};
            if (db == 0) o0 = __builtin_amdgcn_mfma_f32_32x32x16_bf16(vf, pf[st], o0, 0, 0, 0);
            else         o1 = __builtin_amdgcn_mfma_f32_32x32x16_bf16(vf, pf[st], o1, 0, 0, 0);
        }
}
__device__ __forceinline__ void o_store(bf16* orow, const f32x16& o0, const f32x16& o1, float sc, int hC) {
#pragma unroll
    for (int a = 0; a < 4; ++a) {
        v2u w0, w1; w0.x = pk2(o0[4 * a] * sc, o0[4 * a + 1] * sc); w0.y = pk2(o0[4 * a + 2] * sc, o0[4 * a + 3] * sc);
        w1.x = pk2(o1[4 * a] * sc, o1[4 * a + 1] * sc); w1.y = pk2(o1[4 * a + 2] * sc, o1[4 * a + 3] * sc);
        *(GAS v2u*)(orow + 8 * a + 4 * hC) = w0; *(GAS v2u*)(orow + 32 + 8 * a + 4 * hC) = w1; }
}

__device__ __forceinline__ void sb_task(const bf16* Qsb, const bf16* Ksb, const bf16* Vsb, bf16* Osb, int task, LAS unsigned char* vl, int lane) {
    const int qt = task & 255, bh = task >> 8, b = bh >> 3, h = bh & 7, t0 = qt * 32;
    const int q = lane & 31, hC = lane >> 5;
    const bf16* Kh = Ksb + (size_t)bh * SEQ * 64; const bf16* Vh = Vsb + (size_t)bh * SEQ * 64;
    bf16x8 qf[4];
    { const bf16* qp = Qsb + ((size_t)bh * SEQ + t0 + q) * 64 + 8 * hC;
#pragma unroll
      for (int st = 0; st < 4; ++st) qf[st] = *(const GAS bf16x8*)(qp + 16 * st); }
    f32x16 o0 = {}, o1 = {}; float carry = 0.f;
    KVTile nxt; kv_load(nxt, Kh, Vh, t0, 0, lane);
    for (int k0 = t0;; k0 -= 32) {
        KVTile cur = nxt;
        const bool more = k0 >= 32;
        if (more) kv_load(nxt, Kh, Vh, k0 - 32, 0, lane);
        v_to_lds(cur, vl, lane);
        const f32x16 s = qk_tile(cur, qf);
        const bool diag = (k0 == t0);
        float L[16], z[16];
#pragma unroll
        for (int r = 0; r < 16; ++r) { z[r] = __builtin_amdgcn_fmed3f(s[r], -120.f, 120.f); const float e = fast_exp2(z[r]); L[r] = -fast_log2(1.f + e);
            if (diag && !(16 * hC + r < q)) L[r] = 0.f; }
        float c[16]; c[15] = L[15];
#pragma unroll
        for (int r = 14; r >= 0; --r) c[r] = c[r + 1] + L[r];
        const float tot = c[0], oth = __shfl_xor(tot, 32);
        const float base = carry + (hC ? 0.f : oth);
        float p[16];
#pragma unroll
        for (int r = 0; r < 16; ++r) { p[r] = fast_exp2(z[r] + (base + c[r])); if (diag && !(16 * hC + r < q)) p[r] = 0.f; }
        carry += tot + oth;
        pv_tile(o0, o1, p, vl, lane);
        if (!more) break;
        if (__all(carry < -160.f)) break;
    }
    o_store(Osb + ((size_t)(b * SEQ + t0 + q)) * 512 + h * 64, o0, o1, 1.f, hC);
}

__device__ __forceinline__ void dil_task(const bf16* Qd, const bf16* Kd, const bf16* Vd, bf16* Od, int task, LAS unsigned char* vl, int lane) {
    const int it = task & 15, rho = (task >> 4) & 15, hg = (task >> 8) & 3, b = task >> 10;
    const int q = lane & 31, hC = lane >> 5, i0 = 32 * it;
    const int tq = 16 * (i0 + q) + rho;
    f32x16 o0 = {}, o1 = {}; float mrun = -1e30f, lsum = 0.f;
#pragma unroll
    for (int g = 0; g < 3; ++g) {
        bf16x8 qf[4];
        { const bf16* qp = Qd + ((size_t)(b * DILH + g * 4 + hg) * SEQ + tq) * 64 + 8 * hC;
#pragma unroll
          for (int st = 0; st < 4; ++st) qf[st] = *(const GAS bf16x8*)(qp + 16 * st); }
        const int rs = 2 * g, cg = 16 >> rs, rho_g = rho & ((1 << rs) - 1), og = rho >> rs;
        const bf16* Kh = Kd + (size_t)(b * DILH + g * 4 + hg) * SEQ * 64; const bf16* Vh = Vd + (size_t)(b * DILH + g * 4 + hg) * SEQ * 64;
        const int uq = cg * (i0 + q) + og;
        const int u_hi = cg * (i0 + 31) + og; int u_lo = cg * i0 + og - 128; u_lo = u_lo < 0 ? 0 : u_lo;
        const int ub_last = u_lo & ~31;
        int ub = u_hi & ~31;
        KVTile nxt; kv_load(nxt, Kh, Vh, (ub << rs) + rho_g, rs, lane);
        for (;; ub -= 32) {
            KVTile cur = nxt;
            const bool more = ub > ub_last;
            if (more) kv_load(nxt, Kh, Vh, ((ub - 32) << rs) + rho_g, rs, lane);
            v_to_lds(cur, vl, lane);
            const f32x16 s = qk_tile(cur, qf);
            float z[16]; float tmax = -1e30f;
            const int d0 = uq - (ub + 16 * hC);
#pragma unroll
            for (int r = 0; r < 16; ++r) { const bool valid = (unsigned)(d0 - r) <= 128u; z[r] = valid ? s[r] : -1e30f; tmax = fmaxf(tmax, z[r]); }
            tmax = fmaxf(tmax, __shfl_xor(tmax, 32));
            const float mnew = fmaxf(mrun, tmax); const float alpha = fast_exp2(mrun - mnew); mrun = mnew;
            float p[16]; float ps = 0.f;
#pragma unroll
            for (int r = 0; r < 16; ++r) { p[r] = (z[r] > -1e29f) ? fast_exp2(z[r] - mnew) : 0.f; ps += p[r]; }
            lsum = lsum * alpha + ps;
            if (!__all(alpha == 1.0f)) {
#pragma unroll
                for (int r = 0; r < 16; ++r) { o0[r] *= alpha; o1[r] *= alpha; }
            }
            pv_tile(o0, o1, p, vl, lane);
            if (!more) break;
        }
    }
    const float l = lsum + __shfl_xor(lsum, 32);
    o_store(Od + (size_t)(b * SEQ + tq) * 256 + hg * 64, o0, o1, 1.0f / l, hC);
}

__device__ __forceinline__ void p3_attention(const Args& A, Frame& F) {
    unsigned char* ws = A.ws;
    LAS unsigned char* vl = F.lds + F.wave * ATT_WAVE_LDS;
    const bf16 *Qsb = (const bf16*)(ws + A_QSB), *Ksb = (const bf16*)(ws + A_KSB), *Vsb = (const bf16*)(ws + A_VSB);
    const bf16 *Qd = (const bf16*)(ws + A_QD), *Kd = (const bf16*)(ws + A_KD), *Vd = (const bf16*)(ws + A_VD);
    bf16* Osb = (bf16*)((unsigned char*)A.out + O_OSB); bf16* Od = (bf16*)((unsigned char*)A.out + O_OD);
    constexpr int N_DIL = NB * 4 * 16 * 16, N_SB = NB * SBH * (SEQ / 32);
    for (int t = F.gw; t < N_DIL + N_SB; t += F.NGW) {
        if (t < N_DIL) dil_task(Qd, Kd, Vd, Od, t, vl, F.lane);
        else sb_task(Qsb, Ksb, Vsb, Osb, t - N_DIL, vl, F.lane);
    }
}

__device__ __forceinline__ unsigned sortable(float f) { const unsigned u = __float_as_uint(f); return u ^ ((unsigned)((int)u >> 31) | 0x80000000u); }
__device__ __forceinline__ float unsortable(unsigned s) { const unsigned u = (s & 0x80000000u) ? (s ^ 0x80000000u) : ~s; return __uint_as_float(u); }
__device__ __forceinline__ unsigned umax_(unsigned a, unsigned b) { return a > b ? a : b; }

__device__ __forceinline__ void top16_of_128(unsigned (&key)[64], LAS unsigned* top  , int lane) {
#pragma unroll
    for (int it = 0; it < 16; ++it) {
        unsigned m0 = key[0], m1 = key[1], m2 = key[2], m3 = key[3];
#pragma unroll
        for (int i = 4; i < 64; i += 4) { m0 = umax_(m0, key[i]); m1 = umax_(m1, key[i + 1]); m2 = umax_(m2, key[i + 2]); m3 = umax_(m3, key[i + 3]); }
        m0 = umax_(umax_(m0, m1), umax_(m2, m3));
        const unsigned best = umax_(m0, (unsigned)__shfl_xor((int)m0, 32));
        top[it * 64 + lane] = best;
#pragma unroll
        for (int i = 0; i < 64; ++i) key[i] = (key[i] == best) ? 0u : key[i];
    }
}
__device__ __forceinline__ unsigned pk_lookup(unsigned p0, unsigned p1, unsigned p2, unsigned p3, unsigned a) {
    const unsigned hi = a >> 2; unsigned d = p0; d = hi == 1 ? p1 : d; d = hi == 2 ? p2 : d; d = hi == 3 ? p3 : d;
    return (d >> (8 * (a & 3))) & 0xffu;
}
__device__ __forceinline__ unsigned pack4idx(unsigned t0, unsigned t1, unsigned t2, unsigned t3) { return (127u - (t0 & 127u)) | ((127u - (t1 & 127u)) << 8) | ((127u - (t2 & 127u)) << 16) | ((127u - (t3 & 127u)) << 24); }

__device__ __forceinline__ void topk_task(const bf16* Qp, const bf16* Kb, unsigned short* IDX, float* GATE, int task, int lane, LAS unsigned* tl  ) {
    const int ph = task & 7, t0 = (task >> 3) * 32;
    const int q = lane & 31, hC = lane >> 5;
#pragma unroll 1
    for (int half = 0; half < 2; ++half) {
        bf16x8 qf[8];
        { const bf16* qp = Qp + (size_t)(t0 + q) * 2048 + ph * 256 + half * 128 + 8 * hC;
#pragma unroll
          for (int st = 0; st < 8; ++st) qf[st] = *(const GAS bf16x8*)(qp + 16 * st); }
        f32x16 C[4] = {};
        const bf16* kpm[4];
#pragma unroll
        for (int mt = 0; mt < 4; ++mt) { kpm[mt] = Kb + ((size_t)(ph * 2 + half) * 128 + 32 * mt + q) * 128 + 8 * hC; asm volatile("" : "+v"(kpm[mt])); }
#pragma unroll
        for (int st = 0; st < 8; ++st) {
#pragma unroll
            for (int mt = 0; mt < 4; ++mt) { const bf16x8 kf = *(const GAS bf16x8*)(kpm[mt] + 16 * st); C[mt] = __builtin_amdgcn_mfma_f32_32x32x16_bf16(kf, qf[st], C[mt], 0, 0, 0); }
            if (st & 1) asm volatile("" ::: "memory"); }
        unsigned key[64];
#pragma unroll
        for (int mt = 0; mt < 4; ++mt)
#pragma unroll
            for (int r = 0; r < 16; ++r) { const int kidx = 32 * mt + (r & 3) + 8 * (r >> 2) + 4 * hC; key[16 * mt + r] = (sortable(C[mt][r]) & ~127u) | (unsigned)(127 - kidx); }
        top16_of_128(key, tl + half * 1024, lane);
    }
    unsigned tops[2][16];
#pragma unroll
    for (int a = 0; a < 16; ++a) { tops[0][a] = tl[a * 64 + lane]; tops[1][a] = tl[1024 + a * 64 + lane]; }
    float s0[16], s1[16];
#pragma unroll
    for (int a = 0; a < 16; ++a) { s0[a] = unsortable(tops[0][a] & ~127u); s1[a] = unsortable(tops[1][a] & ~127u); }
    const unsigned pa0 = pack4idx(tops[0][0], tops[0][1], tops[0][2], tops[0][3]), pa1 = pack4idx(tops[0][4], tops[0][5], tops[0][6], tops[0][7]),
                   pa2 = pack4idx(tops[0][8], tops[0][9], tops[0][10], tops[0][11]), pa3 = pack4idx(tops[0][12], tops[0][13], tops[0][14], tops[0][15]);
    const unsigned pb0 = pack4idx(tops[1][0], tops[1][1], tops[1][2], tops[1][3]), pb1 = pack4idx(tops[1][4], tops[1][5], tops[1][6], tops[1][7]),
                   pb2 = pack4idx(tops[1][8], tops[1][9], tops[1][10], tops[1][11]), pb3 = pack4idx(tops[1][12], tops[1][13], tops[1][14], tops[1][15]);
    unsigned cand[25];
    {
        int n = 0;
#pragma unroll
        for (int a = 0; a < 16; ++a)
#pragma unroll
            for (int bq = 0; bq < 16; ++bq) if ((a + 1) * (bq + 1) <= 16) {
                const unsigned ck = (sortable(s0[a] + s1[bq]) & ~255u) | (unsigned)(a * 16 + bq);
                if (n < 25) cand[n] = ck; else cand[n - 25] = hC ? ck : cand[n - 25];
                ++n; }
    }
    unsigned win[16];
#pragma unroll
    for (int it = 0; it < 16; ++it) {
        unsigned m = cand[0];
#pragma unroll
        for (int i = 1; i < 25; ++i) m = umax_(m, cand[i]);
        const unsigned best = umax_(m, (unsigned)__shfl_xor((int)m, 32));
        win[it] = best;
#pragma unroll
        for (int i = 0; i < 25; ++i) cand[i] = (cand[i] == best) ? 0u : cand[i];
    }
    float gv[16]; int eid[16]; float gs = 0.f;
    const float vmax = unsortable(win[0] & ~255u);
#pragma unroll
    for (int k = 0; k < 16; ++k) { const unsigned a = (win[k] >> 4) & 15u, bq = win[k] & 15u;
        eid[k] = (int)(pk_lookup(pa0, pa1, pa2, pa3, a) * 128u + pk_lookup(pb0, pb1, pb2, pb3, bq));
        gv[k] = fast_exp2((unsortable(win[k] & ~255u) - vmax) * LOG2E); gs += gv[k]; }
    const float ginv = 1.0f / gs;
    const size_t o = (size_t)(t0 + q) * 128 + ph * 16;
    if (hC == 0) {
#pragma unroll
        for (int k = 0; k < 16; k += 8) *(GAS v4u*)(IDX + o + k) = (v4u){(unsigned)eid[k] | ((unsigned)eid[k + 1] << 16), (unsigned)eid[k + 2] | ((unsigned)eid[k + 3] << 16),
                                                                         (unsigned)eid[k + 4] | ((unsigned)eid[k + 5] << 16), (unsigned)eid[k + 6] | ((unsigned)eid[k + 7] << 16)};
    } else {
#pragma unroll
        for (int k = 0; k < 16; k += 4) *(GAS f32x4*)(GATE + o + k) = (f32x4){gv[k] * ginv, gv[k + 1] * ginv, gv[k + 2] * ginv, gv[k + 3] * ginv};
    }
}

__device__ __forceinline__ float gelu_tanh(float x) {
    const float y2 = 2.0f * 0.7978845608028654f * (x + 0.044715f * x * x * x);
    return x * fast_rcp(1.f + fast_exp2(-y2 * LOG2E));
}
__device__ __forceinline__ void unpack8(const v4u w, float (&f)[8]) { f[0] = bflo(w.x); f[1] = bfhi(w.x); f[2] = bflo(w.y); f[3] = bfhi(w.y); f[4] = bflo(w.z); f[5] = bfhi(w.z); f[6] = bflo(w.w); f[7] = bfhi(w.w); }
__device__ __forceinline__ void unpack_fp8x16(const v4u w, float (&f)[16]) {
#pragma unroll
    for (int j = 0; j < 4; ++j) { const f32x2_t a = __builtin_amdgcn_cvt_pk_f32_fp8((int)w[j], false), b = __builtin_amdgcn_cvt_pk_f32_fp8((int)w[j], true);
        f[4 * j] = a.x; f[4 * j + 1] = a.y; f[4 * j + 2] = b.x; f[4 * j + 3] = b.y; }
}
__device__ __forceinline__ void peer_u_phase(const Args& A, Frame& F) {
    unsigned char* ws = A.ws;
    const int lane = F.lane, x = blockIdx.x & 7, wrk = (blockIdx.x >> 3) * NWAVES + F.wave, nwr = (F.G >> 3) * NWAVES, g = lane >> 3, c = lane & 7;
    const unsigned char* U8 = ws + WS_UB + (size_t)x * (2 * MiB); const unsigned c16 = 16u * c, g32 = 32u * g;
    const unsigned char* X1M = ws + A_X1M + 256 * x; const unsigned char* IDX = ws + A_IDX; const float* R2 = (const float*)(ws + WS_R2);
    float* PART = (float*)(ws + A_PART) + (size_t)x * TOK * 128;
    const int per = TOK / nwr, tb = wrk * per;
    float sh[16];
    { const float* mod = (const float*)(ws + WS_MOD) + (size_t)(tb >> 13) * NMOD + 3 * DM + 128 * x + 16 * c;
#pragma unroll
      for (int k = 0; k < 4; ++k) { const f32x4 v = *(const GAS f32x4*)(mod + 4 * k); sh[4 * k] = v[0]; sh[4 * k + 1] = v[1]; sh[4 * k + 2] = v[2]; sh[4 * k + 3] = v[3]; } }
    v4u idC[2], idN[2], xC[2], xN[2]; float rC, rN;
#define SLOT_ID(ID, sl) (((ID)[(sl) >> 3][((sl) >> 1) & 3] >> (16 * ((sl) & 1))) & 0xffffu)
#define LD_TOK(ID, XV, RV, T) do { const unsigned char* ib_ = IDX + (size_t)(T) * 256; const unsigned char* xb_ = X1M + (size_t)(T) * (DM * 2); \
        ID[0] = *(const GAS v4u*)(ib_ + g32); ID[1] = *(const GAS v4u*)(ib_ + (g32 + 16u)); \
        XV[0] = *(const GAS v4u*)(xb_ + 2u * c16); XV[1] = *(const GAS v4u*)(xb_ + (2u * c16 + 16u)); RV = R2[T]; } while (0)
#define LD_ROWS(R, ID, H) do { _Pragma("unroll") for (int i = 0; i < 8; ++i) R[i] = *(const GAS v4u*)(U8 + (SLOT_ID(ID, 8 * (H) + i) * 128u + c16)); } while (0)
    LD_TOK(idC, xC, rC, tb);
    v4u R0[8], R1[8];
    LD_ROWS(R0, idC, 0);
    LD_TOK(idN, xN, rN, tb + 1 < TOK ? tb + 1 : tb);
    for (int t = tb; t < tb + per; ++t) {
        LD_ROWS(R1, idC, 1);
        float h2[16];
        { float fa[8], fb[8]; unpack8(xC[0], fa); unpack8(xC[1], fb);
#pragma unroll
          for (int i = 0; i < 8; ++i) { h2[i] = fa[i] * rC + sh[i]; h2[8 + i] = fb[i] * rC + sh[8 + i]; } }
        float p[16];
#pragma unroll
        for (int i = 0; i < 8; ++i) { float f[16]; unpack_fp8x16(R0[i], f); float d = 0.f;
#pragma unroll
            for (int k = 0; k < 16; ++k) d += f[k] * h2[k];
            p[i] = d; }
        LD_ROWS(R0, idN, 0);
#pragma unroll
        for (int i = 0; i < 8; ++i) { float f[16]; unpack_fp8x16(R1[i], f); float d = 0.f;
#pragma unroll
            for (int k = 0; k < 16; ++k) d += f[k] * h2[k];
            p[8 + i] = d; }
        idC[0] = idN[0]; idC[1] = idN[1];
        xC[0] = xN[0]; xC[1] = xN[1]; rC = rN;
        { const int tn = t + 2 < tb + per ? t + 2 : tb + per - 1; LD_TOK(idN, xN, rN, tn); }
        const bool b0 = lane & 1, b1 = lane & 2, b2 = lane & 4;
        float q8[8], q4[4], q2[2];
#pragma unroll
        for (int i = 0; i < 8; ++i) q8[i] = (b0 ? p[8 + i] : p[i]) + __shfl_xor(b0 ? p[i] : p[8 + i], 1);
#pragma unroll
        for (int i = 0; i < 4; ++i) q4[i] = (b1 ? q8[4 + i] : q8[i]) + __shfl_xor(b1 ? q8[i] : q8[4 + i], 2);
#pragma unroll
        for (int i = 0; i < 2; ++i) q2[i] = (b2 ? q4[2 + i] : q4[i]) + __shfl_xor(b2 ? q4[i] : q4[2 + i], 4);
        const int slot = 16 * g + 8 * (lane & 1) + 4 * ((lane >> 1) & 1) + 2 * ((lane >> 2) & 1);
        *(GAS f32x2_t*)(PART + (size_t)t * 128 + slot) = (f32x2_t){q2[0], q2[1]};
    }
#undef LD_TOK
#undef LD_ROWS
#undef SLOT_ID
}
__device__ __forceinline__ void peer_act_phase(const Args& A, Frame& F) {
    unsigned char* ws = A.ws;
    const float* PART = (const float*)(ws + A_PART); const unsigned short* IDX = (const unsigned short*)(ws + A_IDX); const float* GATE = (const float*)(ws + A_GATE); bf16* ACTG = (bf16*)(ws + A_ACTG);
    const float* UINV = (const float*)(ws + WS_UB + 16 * MiB); const float* VINV = (const float*)(ws + WS_VB + 16 * MiB);
    const size_t n4 = (size_t)TOK * 128 / 4;
    for (size_t i = (size_t)F.vcu * (NWAVES * 64) + F.tid; i < n4; i += (size_t)F.G * NWAVES * 64) {
        f32x4 d = *(const GAS f32x4*)(PART + 4 * i);
#pragma unroll
        for (int xx = 1; xx < 8; ++xx) d += *(const GAS f32x4*)(PART + (size_t)xx * TOK * 128 + 4 * i);
        const v2u ew = *(const GAS v2u*)(IDX + 4 * i); const f32x4 gt = *(const GAS f32x4*)(GATE + 4 * i);
        const unsigned e[4] = {ew.x & 0xffffu, ew.x >> 16, ew.y & 0xffffu, ew.y >> 16};
        float o[4];
#pragma unroll
        for (int k = 0; k < 4; ++k) o[k] = gelu_tanh(d[k] * UINV[e[k]]) * gt[k] * VINV[e[k]];
        *(GAS v2u*)(ACTG + 4 * i) = (v2u){pk2(o[0], o[1]), pk2(o[2], o[3])};
    }
}
__device__ __forceinline__ void peer_v_phase(const Args& A, Frame& F) {
    unsigned char* ws = A.ws;
    const int lane = F.lane, x = blockIdx.x & 7, wrk = (blockIdx.x >> 3) * NWAVES + F.wave, nwr = (F.G >> 3) * NWAVES, g = lane >> 3, c = lane & 7;
    const unsigned char* V8 = ws + WS_VB + (size_t)x * (2 * MiB); const unsigned c16 = 16u * c, g32 = 32u * g;
    const unsigned char* IDX = ws + A_IDX; const unsigned char* ACTG = ws + A_ACTG; unsigned char* POUT = ws + A_POUT + 256 * x;
    const int per = TOK / nwr, tb = wrk * per;
    v4u idC[2], idN[2], aC[2], aN[2];
#define SLOT_ID(ID, sl) (((ID)[(sl) >> 3][((sl) >> 1) & 3] >> (16 * ((sl) & 1))) & 0xffffu)
#define SLOT_ACT(AV, sl) (((sl) & 1) ? bfhi((AV)[(sl) >> 3][((sl) >> 1) & 3]) : bflo((AV)[(sl) >> 3][((sl) >> 1) & 3]))
#define LD_TOK(ID, AV, T) do { const unsigned char* ib_ = IDX + (size_t)(T) * 256; const unsigned char* ab_ = ACTG + (size_t)(T) * 256; \
        ID[0] = *(const GAS v4u*)(ib_ + g32); ID[1] = *(const GAS v4u*)(ib_ + (g32 + 16u)); AV[0] = *(const GAS v4u*)(ab_ + g32); AV[1] = *(const GAS v4u*)(ab_ + (g32 + 16u)); } while (0)
#define LD_ROWS(R, ID, H) do { _Pragma("unroll") for (int i = 0; i < 8; ++i) R[i] = *(const GAS v4u*)(V8 + (SLOT_ID(ID, 8 * (H) + i) * 128u + c16)); } while (0)
    LD_TOK(idC, aC, tb);
    v4u R0[8], R1[8];
    LD_ROWS(R0, idC, 0);
    LD_TOK(idN, aN, tb + 1 < TOK ? tb + 1 : tb);
    for (int t = tb; t < tb + per; ++t) {
        LD_ROWS(R1, idC, 1);
        float acc[16];
#pragma unroll
        for (int d = 0; d < 16; ++d) acc[d] = 0.f;
#pragma unroll
        for (int i = 0; i < 8; ++i) { float f[16]; unpack_fp8x16(R0[i], f); const float a = SLOT_ACT(aC, i);
#pragma unroll
            for (int d = 0; d < 16; ++d) acc[d] += a * f[d]; }
        LD_ROWS(R0, idN, 0);
#pragma unroll
        for (int i = 0; i < 8; ++i) { float f[16]; unpack_fp8x16(R1[i], f); const float a = SLOT_ACT(aC, 8 + i);
#pragma unroll
            for (int d = 0; d < 16; ++d) acc[d] += a * f[d]; }
        idC[0] = idN[0]; idC[1] = idN[1]; aC[0] = aN[0]; aC[1] = aN[1];
        { const int tn = t + 2 < tb + per ? t + 2 : tb + per - 1; LD_TOK(idN, aN, tn); }
#pragma unroll
        for (int d = 0; d < 16; ++d) { float v = acc[d]; v += __shfl_xor(v, 8); v += __shfl_xor(v, 16); v += __shfl_xor(v, 32); acc[d] = v; }
        if (g == 0) { v4u w0, w1; w0.x = pk2(acc[0], acc[1]); w0.y = pk2(acc[2], acc[3]); w0.z = pk2(acc[4], acc[5]); w0.w = pk2(acc[6], acc[7]);
            w1.x = pk2(acc[8], acc[9]); w1.y = pk2(acc[10], acc[11]); w1.z = pk2(acc[12], acc[13]); w1.w = pk2(acc[14], acc[15]);
            unsigned char* o = POUT + (size_t)t * (DM * 2); *(GAS v4u*)(o + 2u * c16) = w0; *(GAS v4u*)(o + (2u * c16 + 16u)) = w1; }
    }
#undef LD_TOK
#undef LD_ROWS
#undef SLOT_ID
#undef SLOT_ACT
}
__device__ __forceinline__ void peer_final(const Args& A, int t, int lane) {
    unsigned char* ws = A.ws;
    const float* mod = (const float*)(ws + WS_MOD) + (size_t)(t >> 13) * NMOD; const bf16* POUT = (const bf16*)(ws + A_POUT);
    float* orow = A.out + (size_t)t * DM;
    f32x4 x2[4]; float s = 0.f;
#pragma unroll
    for (int j = 0; j < 4; ++j) { const int c = 256 * j + 4 * lane; const f32x4 x1 = *(const GAS f32x4*)(orow + c), gt = *(const GAS f32x4*)(mod + 5 * DM + c); const v2u w = *(const GAS v2u*)(POUT + (size_t)t * DM + c);
        f32x4 y; y[0] = x1[0] + gt[0] * bflo(w.x); y[1] = x1[1] + gt[1] * bfhi(w.x); y[2] = x1[2] + gt[2] * bflo(w.y); y[3] = x1[3] + gt[3] * bfhi(w.y);
        x2[j] = y; s += (y[0] * y[0] + y[1] * y[1]) + (y[2] * y[2] + y[3] * y[3]); }
    const float rr = 1.0f / sqrtf(wave_sum(s) * (1.f / DM) + EPS);
#pragma unroll
    for (int j = 0; j < 4; ++j) { const int c = 256 * j + 4 * lane; const f32x4 gf = *(const GAS f32x4*)(A.g_final + c); *(GAS f32x4*)(orow + c) = x2[j] * rr * gf; }
}

#ifndef MK_ONE_LAUNCH
#define MK_ONE_LAUNCH 1
#endif
constexpr int N_PHASES = 12;

__device__ __forceinline__ void biaspq_task(unsigned char* ws, int n, int lane) {
    const bf16* w = (const bf16*)(ws + WS_WPQ) + (size_t)n * DM + 16 * lane;
    float fa[8], fb[8]; unpack8(*(const GAS v4u*)w, fa); unpack8(*(const GAS v4u*)(w + 8), fb);
    float* bias = (float*)(ws + WS_BIASPQ);
#pragma unroll
    for (int b = 0; b < 4; ++b) { const GAS f32x4* sp = (const GAS f32x4*)((const float*)(ws + WS_MOD) + (size_t)b * NMOD + 3 * DM + 16 * lane);
        const f32x4 s0 = sp[0], s1 = sp[1], s2 = sp[2], s3 = sp[3]; float d = 0.f;
#pragma unroll
        for (int i = 0; i < 4; ++i) { d += fa[i] * s0[i]; d += fa[4 + i] * s1[i]; d += fb[i] * s2[i]; d += fb[4 + i] * s3[i]; }
        d = wave_sum(d); if (lane == 0) bias[b * 2048 + n] = d; }
}

__global__ void __launch_bounds__(NWAVES * 64, 2) mk_fwd(Args A) {
    extern __shared__ __attribute__((aligned(16))) unsigned char lds[];
    Frame F;
    F.lds = (LAS unsigned char*)lds;
    F.G = gridDim.x; { const int bx = blockIdx.x; F.vcu = (F.G % 8 == 0) ? (bx % 8) * (F.G / 8) + bx / 8 : bx; }
    F.NGW = F.G * NWAVES;
#define PHASE_BEGIN() do { int t_ = threadIdx.x; asm volatile("" : "+v"(t_)); F.tid = t_; F.lane = t_ & 63; F.wave = __builtin_amdgcn_readfirstlane(t_ >> 6); F.gw = F.vcu * NWAVES + F.wave; } while (0)
    PHASE_BEGIN();
    unsigned char* ws = A.ws;
    const int lo = A.ph_lo, hi = A.ph_hi;
#if MK_ONE_LAUNCH
    volatile LAS unsigned* MISC = (volatile LAS unsigned*)(F.lds + MISC_OFF);
    for (int u = F.tid; u < (LDS_BYTES - RING_BYTES) / 4; u += NWAVES * 64) ((LAS unsigned*)(F.lds + RING_BYTES))[u] = 0u;
    __syncthreads();
    XcdBarrier bar = xcd_barrier_post((unsigned*)(ws + WS_CTL) + CW_BAR, MISC + 8);
#define GRID_BAR() xcd_barrier(bar)
#else
#define GRID_BAR() do {} while (0)
#endif
#ifdef ONLY_PHASE
#define IN(k) ((k) == ONLY_PHASE && lo <= (k) && (k) < hi)
#else
#define IN(k) (lo <= (k) && (k) < hi)
#endif
#define BOTH(k) (IN(k) && IN((k) + 1))
#ifndef REPEAT_MASK
#define REPEAT_MASK 0
#endif
#define REPS(k) ((((REPEAT_MASK) >> (k)) & 1) + 1)

    if (IN(0)) for (int rep = 0; rep < REPS(0); ++rep) { PHASE_BEGIN(); if (rep) GRID_BAR(); p0_prologue(A, F); if (BOTH(0)) GRID_BAR(); }
    if (IN(1)) for (int rep = 0; rep < REPS(1); ++rep) { PHASE_BEGIN(); if (rep) GRID_BAR(); p1_hrows(A, F); if (BOTH(1)) GRID_BAR(); }
    if (IN(2)) for (int rep = 0; rep < REPS(2); ++rep) { PHASE_BEGIN(); if (rep) GRID_BAR();
        pg8::Gemm g{(const bf16*)((unsigned char*)A.out + O_H), (const bf16*)(ws + WS_WIN), TOK, NIN, DM}; pg8::StaticOrder S; S.init(TOK, NIN, F.G, (int)blockIdx.x);
        EpiG1 E{(bf16*)(ws + A_QSB), (bf16*)(ws + A_KSB), (bf16*)(ws + A_VSB), (bf16*)(ws + A_QD), (bf16*)(ws + A_KD), (bf16*)(ws + A_VD), (bf16*)(ws + A_GSB), (bf16*)(ws + A_GD),
                (const float*)(ws + WS_ROPEC), (const float*)(ws + WS_ROPES)};
        pg8::gemm_phase<EpiG1, pg8::StaticOrder, true, true>(F.lds, g, S, E);
        if (BOTH(2)) GRID_BAR();
    }
    if (IN(3)) for (int rep = 0; rep < REPS(3); ++rep) { PHASE_BEGIN(); if (rep) GRID_BAR(); p3_attention(A, F); if (BOTH(3)) GRID_BAR(); }
    if (IN(4)) for (int rep = 0; rep < REPS(4); ++rep) { PHASE_BEGIN(); if (rep) GRID_BAR();
        for (int n = F.gw; n < 2048; n += F.NGW) biaspq_task(ws, n, F.lane);
        __syncthreads();
        {   pg8::Gemm g{(const bf16*)((unsigned char*)A.out + O_OD), (const bf16*)(ws + WS_WDILO), TOK, DM, 256}; pg8::StaticOrder S; S.init(TOK, DM, F.G, (int)blockIdx.x);
            EpiMerge<false> E{(const bf16*)(ws + A_GD), (bf16*)(ws + A_MERGED)};
            pg8::gemm_phase<EpiMerge<false>, pg8::StaticOrder, true, true>(F.lds, g, S, E); }
        asm volatile("s_waitcnt vmcnt(0)" ::: "memory"); __syncthreads();
        {   pg8::Gemm g{(const bf16*)((unsigned char*)A.out + O_OSB), (const bf16*)(ws + WS_WSBO), TOK, DM, 512}; pg8::StaticOrder S; S.init(TOK, DM, F.G, (int)blockIdx.x);
            EpiMerge<true> E{(const bf16*)(ws + A_GSB), (bf16*)(ws + A_MERGED)};
            pg8::gemm_phase<EpiMerge<true>, pg8::StaticOrder, true, true>(F.lds, g, S, E); }
        if (BOTH(4)) GRID_BAR();
    }
    if (IN(5)) for (int rep = 0; rep < REPS(5); ++rep) { PHASE_BEGIN(); if (rep) GRID_BAR();
        pg8::Gemm g{(const bf16*)(ws + A_MERGED), (const bf16*)(ws + WS_WOUT), TOK, DM, DM}; pg8::StaticOrder S; S.init(TOK, DM, F.G, (int)blockIdx.x);
        EpiOut E{A.x, A.out, (bf16*)(ws + A_X1M), (float*)(ws + WS_SSQ), (const float*)(ws + WS_MOD), A.g_ffn};
        pg8::gemm_phase<EpiOut, pg8::StaticOrder, true, true>(F.lds, g, S, E);
        if (BOTH(5)) GRID_BAR();
    }
    if (IN(6)) for (int rep = 0; rep < REPS(6); ++rep) { PHASE_BEGIN(); if (rep) GRID_BAR();
        pg8::Gemm g{(const bf16*)(ws + A_X1M), (const bf16*)(ws + WS_WPQ), TOK, 2048, DM}; pg8::StaticOrder S; S.init(TOK, 2048, F.G, (int)blockIdx.x);
        EpiPq E{(const float*)(ws + WS_SSQ), (const float*)(ws + WS_BIASPQ), (bf16*)(ws + A_QPEER), (float*)(ws + WS_R2)};
        pg8::gemm_phase<EpiPq, pg8::StaticOrder, true, true>(F.lds, g, S, E);
        if (BOTH(6)) GRID_BAR();
    }
    if (IN(7)) for (int rep = 0; rep < REPS(7); ++rep) { PHASE_BEGIN(); if (rep) GRID_BAR();
        for (int t = F.gw; t < (TOK / 32) * 8; t += F.NGW) topk_task((const bf16*)(ws + A_QPEER), (const bf16*)(ws + WS_KEYS), (unsigned short*)(ws + A_IDX), (float*)(ws + A_GATE), t, F.lane, (LAS unsigned*)(F.lds + F.wave * 8192));
        if (BOTH(7)) GRID_BAR();
    }
    if (IN(8)) for (int rep = 0; rep < REPS(8); ++rep) { PHASE_BEGIN(); if (rep) GRID_BAR(); peer_u_phase(A, F); if (BOTH(8)) GRID_BAR(); }
    if (IN(9)) { PHASE_BEGIN(); peer_act_phase(A, F); if (BOTH(9)) GRID_BAR(); }
    if (IN(10)) for (int rep = 0; rep < REPS(10); ++rep) { PHASE_BEGIN(); if (rep) GRID_BAR(); peer_v_phase(A, F); if (BOTH(10)) GRID_BAR(); }
    if (IN(11)) { PHASE_BEGIN();
        for (int t = F.gw; t < TOK; t += F.NGW) peer_final(A, t, F.lane);
    }
#undef IN
#undef BOTH
}

extern "C" void kernel_launch(void* const* d_in, const int* in_sizes, int n_in, void* d_out, int out_size, void* d_ws, size_t ws_size, hipStream_t stream) {
    static int grid = 0;
    if (grid == 0) {
        if (n_in != 15 || in_sizes[0] != TOK * DM || out_size != TOK * DM || ws_size < WS_END) { fprintf(stderr, "kernel_launch: unexpected shapes (n_in %d, in0 %d, out %d, ws %zu < %zu)\n", n_in, n_in > 0 ? in_sizes[0] : -1, out_size, ws_size, (size_t)WS_END); grid = -1; return; }
        int dev = 0, cus = 0, per_cu = 0;
        if (hipGetDevice(&dev) != hipSuccess || hipDeviceGetAttribute(&cus, hipDeviceAttributeMultiprocessorCount, dev) != hipSuccess) { grid = -1; return; }
        if (hipFuncSetAttribute((const void*)mk_fwd, hipFuncAttributeMaxDynamicSharedMemorySize, LDS_BYTES) != hipSuccess) { fprintf(stderr, "kernel_launch: hipFuncSetAttribute failed\n"); grid = -1; return; }
        if (hipOccupancyMaxActiveBlocksPerMultiprocessor(&per_cu, (const void*)mk_fwd, NWAVES * 64, LDS_BYTES) != hipSuccess || per_cu < 1) { fprintf(stderr, "kernel_launch: occupancy query says %d\n", per_cu); per_cu = 1; }
        (void)hipGetLastError();
        grid = cus;
    }
    if (grid < 0) return;
    (void)hipMemsetAsync((char*)d_ws + WS_CTL, 0, CTL_ZERO_BYTES, stream);
    Args a{};
    a.x = (const float*)d_in[0]; a.c = (const float*)d_in[1]; a.w_ada = (const float*)d_in[2]; a.b_ada = (const float*)d_in[3]; a.g_mix = (const float*)d_in[4];
    a.w_in = (const float*)d_in[5]; a.w_sb_o = (const float*)d_in[6]; a.w_dil_o = (const float*)d_in[7]; a.w_out = (const float*)d_in[8]; a.g_ffn = (const float*)d_in[9];
    a.w_pq = (const float*)d_in[10]; a.peer_keys = (const float*)d_in[11]; a.peer_u = (const float*)d_in[12]; a.peer_v = (const float*)d_in[13]; a.g_final = (const float*)d_in[14];
    a.out = (float*)d_out; a.ws = (unsigned char*)d_ws;
#if MK_ONE_LAUNCH
    a.ph_lo = 0; a.ph_hi = N_PHASES;
    void* args[] = {&a};
    hipError_t e = hipLaunchCooperativeKernel((const void*)mk_fwd, dim3(grid), dim3(NWAVES * 64), args, LDS_BYTES, stream);
    if (e != hipSuccess) fprintf(stderr, "kernel_launch: cooperative launch failed: %s (grid %d)\n", hipGetErrorString(e), grid);
#else
    for (int p = 0; p < N_PHASES; ++p) { a.ph_lo = p; a.ph_hi = p + 1; hipLaunchKernelGGL(mk_fwd, dim3(grid), dim3(NWAVES * 64), LDS_BYTES, stream, a); }
#endif
}
```

```cpp
#include <hip/hip_runtime.h>
#include <hip/hip_cooperative_groups.h>
#include <cstdio>
#include <cstdint>
namespace pg8 {
#define PG8_LAS __attribute__((address_space(3)))
typedef unsigned short bf16_t;
typedef short bf16x8 __attribute__((ext_vector_type(8)));
typedef float f32x4 __attribute__((ext_vector_type(4)));
typedef unsigned u32x4 __attribute__((ext_vector_type(4)));
constexpr int BM = 256, BK = 64, HALF = 128, HTB = HALF * BK * 2  , STAGE_BYTES = 8 * HTB, NXCD = 8, WGM = 8;

__host__ __device__ __forceinline__ int lds_byte(int r, int c) { const int st = (r >> 4) * 2 + (c >> 5), rr = r & 15, cc = c & 31, ob = rr * 64 + cc * 2; return st * 1024 + (ob ^ (((ob >> 9) & 1) << 5)); }
__host__ __device__ __forceinline__ void stage_rc(int b, int& R, int& C) { const int st = b / 1024, sb = b % 1024, swz = sb ^ (((sb >> 9) & 1) << 5); R = (st >> 1) * 16 + swz / 64; C = (st & 1) * 32 + (swz % 64) / 2; }
__host__ __device__ __forceinline__ int perm32(int rho) { const int n = rho >> 4, i = rho & 15; return 8 * (i >> 2) + 4 * n + (i & 3); }

struct Unit { int pm, pn; };
struct Gemm { const bf16_t* A; const bf16_t* Bt; int M, N, K; };

struct StaticOrder {
    int nM, nN, nwg, G, c;
    __host__ __device__ void init(int M, int N, int G_, int c_) { nM = M / BM; nN = N / BM; nwg = nM * nN; G = G_; c = c_; }
    __host__ __device__ bool next(int i, Unit& u) const {
        const long L = (long)i * G + c; if (L >= nwg) return false;
        int wgid = (int)L; { const int q = nwg / NXCD, r = nwg % NXCD, xcd = wgid % NXCD, off = wgid / NXCD; wgid = (xcd < r ? xcd * (q + 1) : r * (q + 1) + (xcd - r) * q) + off; }
        const int nig = WGM * nN, gid = wgid / nig, fm = gid * WGM, gsz = (nM - fm) < WGM ? (nM - fm) : WGM;
        u.pm = fm + ((wgid % nig) % gsz); u.pn = (wgid % nig) / gsz; return true;
    }
    __device__ __forceinline__ void a_ready(const Unit&) const {}
    __device__ __forceinline__ void done(const Unit&) const {}
};

__device__ __forceinline__ unsigned cvt_pk_bf16(float lo, float hi) { unsigned r; asm volatile("v_cvt_pk_bf16_f32 %0, %1, %2" : "=v"(r) : "v"(lo), "v"(hi)); return r; }
template <class Epi, class Sched, bool ALIGN_EPI = false, bool SP2 = false>
__device__ __forceinline__ void gemm_phase(PG8_LAS unsigned char* lds, const Gemm g, const Sched& S, const Epi& E) {
    int tid_ = threadIdx.x; asm volatile("" : "+v"(tid_));
    const int tid = tid_, wid = __builtin_amdgcn_readfirstlane(tid >> 6), lane = tid & 63, wr = wid >> 2, wc = wid & 3, fr = lane & 15, fq = lane >> 4;
    const int K = g.K, nt = K / BK;
    unsigned voffA[2], voffB[2];
#pragma unroll
    for (int i = 0; i < 2; ++i) { int R, C; stage_rc(tid * 16 + i * 8192, R, C); const int Rb = Epi::PERM ? ((R & ~31) + perm32(R & 31)) : R;
        voffA[i] = (unsigned)(R * K + C) * 2u; voffB[i] = (unsigned)(Rb * K + C) * 2u; }
    const size_t kstep = (size_t)(BK * 2);
    const size_t hstep = (size_t)HALF * K * 2;
    const size_t tstep = 2 * hstep;
    const unsigned ldsw = (unsigned)wid * 1024u;
    const int aoff = lds_byte(wr * 64 + fr, fq * 8), boff = lds_byte(wc * 32 + fr, fq * 8);
#define PG8_SA(b, h) (((b) * 2 + (h)) * HTB)
#define PG8_SB(b, h) ((4 + (b) * 2 + (h)) * HTB)
#define PG8_STAGE(bufoff, gbase, voff) do { _Pragma("unroll") for (int _i = 0; _i < 2; ++_i) \
        __builtin_amdgcn_global_load_lds((const unsigned*)((const char*)(gbase) + (voff)[_i]), (PG8_LAS unsigned*)(lds + (bufoff) + ldsw + _i * 8192), 16, 0, 0); } while (0)
#define PG8_LDA(dst, b, h) do { _Pragma("unroll") for (int m = 0; m < 4; ++m) _Pragma("unroll") for (int k = 0; k < 2; ++k) dst[m][k] = *(const PG8_LAS bf16x8*)(lds + PG8_SA(b, h) + aoff + m * 2048 + k * 1024); } while (0)
#define PG8_LDB(dst, b, h) do { _Pragma("unroll") for (int n = 0; n < 2; ++n) _Pragma("unroll") for (int k = 0; k < 2; ++k) dst[n][k] = *(const PG8_LAS bf16x8*)(lds + PG8_SB(b, h) + boff + n * 2048 + k * 1024); } while (0)
#define PG8_MMA(ai, bj, At, Bt) do { __builtin_amdgcn_s_setprio(1); _Pragma("unroll") for (int m = 0; m < 4; ++m) _Pragma("unroll") for (int n = 0; n < 2; ++n) _Pragma("unroll") for (int k = 0; k < 2; ++k) \
        acc[ai][bj][m][n] = __builtin_amdgcn_mfma_f32_16x16x32_bf16(Bt[n][k], At[m][k], acc[ai][bj][m][n], 0, 0, 0); __builtin_amdgcn_s_setprio(0); } while (0)
#define PG8_WAIT_V(n) asm volatile("s_waitcnt vmcnt(" #n ")" ::: "memory")
#define PG8_WAIT_L(n) asm volatile("s_waitcnt lgkmcnt(" #n ")" ::: "memory")
#define PG8_BAR __builtin_amdgcn_s_barrier()
#define PG8_SCHED __builtin_amdgcn_sched_barrier(0)
    Unit cur, nxt; int ui = 0;
    if (!S.next(0, cur)) return;
    f32x4 acc[2][2][4][2];
#pragma unroll
    for (int a = 0; a < 2; ++a)
#pragma unroll
        for (int b = 0; b < 2; ++b)
#pragma unroll
            for (int m = 0; m < 4; ++m)
#pragma unroll
                for (int n = 0; n < 2; ++n) acc[a][b][m][n] = (f32x4){0.f, 0.f, 0.f, 0.f};
    bf16x8 At[4][2], B0[2][2], B1[2][2];
    const char* cA = (const char*)g.A + (size_t)cur.pm * tstep; const char* cB = (const char*)g.Bt + (size_t)cur.pn * tstep;
    S.a_ready(cur);
    if constexpr (SP2) {
        PG8_STAGE(PG8_SB(0, 0), cB, voffB); PG8_STAGE(PG8_SB(0, 1), cB + hstep, voffB); PG8_STAGE(PG8_SA(0, 0), cA, voffA); PG8_STAGE(PG8_SA(0, 1), cA + hstep, voffA);
        if (wr == 1) PG8_BAR;
        PG8_WAIT_V(2); PG8_BAR;
        PG8_STAGE(PG8_SB(1, 0), cB + kstep, voffB); PG8_STAGE(PG8_SA(1, 0), cA + kstep, voffA); PG8_STAGE(PG8_SB(1, 1), cB + hstep + kstep, voffB);
        PG8_WAIT_V(6); PG8_BAR;
    } else {
        PG8_STAGE(PG8_SB(0, 0), cB, voffB); PG8_STAGE(PG8_SA(0, 0), cA, voffA); PG8_STAGE(PG8_SB(0, 1), cB + hstep, voffB); PG8_STAGE(PG8_SA(0, 1), cA + hstep, voffA);
        if (wr == 1) PG8_BAR;
        PG8_WAIT_V(4); PG8_BAR;
        PG8_STAGE(PG8_SB(1, 0), cB + kstep, voffB); PG8_STAGE(PG8_SA(1, 0), cA + kstep, voffA); PG8_STAGE(PG8_SB(1, 1), cB + hstep + kstep, voffB);
        PG8_WAIT_V(6); PG8_BAR;
    }
    for (;;) {
        const bool has_next = S.next(ui + 1, nxt);
        const char* nA = has_next ? (const char*)g.A + (size_t)nxt.pm * tstep : cA; const char* nB = has_next ? (const char*)g.Bt + (size_t)nxt.pn * tstep : cB;
        for (int t = 0; t < nt; t += 2) {
            const bool last = (t == nt - 2);
            const char* a1 = cA + (size_t)(t + 1) * kstep;
            const char* a2 = last ? nA : cA + (size_t)(t + 2) * kstep; const char* b2 = last ? nB : cB + (size_t)(t + 2) * kstep;
            const char* a3 = a2 + kstep; const char* b3 = b2 + kstep;
            if (last && has_next) S.a_ready(nxt);
            if constexpr (SP2) {
            PG8_LDB(B0, 0, 0); PG8_LDB(B1, 0, 1); PG8_SCHED; PG8_LDA(At, 0, 0); PG8_STAGE(PG8_SA(1, 1), a1 + hstep, voffA);
            PG8_WAIT_V(8); PG8_WAIT_L(0); PG8_BAR; PG8_MMA(0, 0, At, B0); PG8_MMA(0, 1, At, B1); PG8_BAR; PG8_SCHED;
            PG8_LDA(At, 0, 1); PG8_STAGE(PG8_SB(0, 0), b2, voffB); PG8_STAGE(PG8_SB(0, 1), b2 + hstep, voffB); PG8_STAGE(PG8_SA(0, 0), a2, voffA);
            PG8_WAIT_V(8); PG8_WAIT_L(0); PG8_BAR; PG8_MMA(1, 0, At, B0); PG8_MMA(1, 1, At, B1); PG8_BAR; PG8_SCHED;
            PG8_LDB(B0, 1, 0); PG8_LDB(B1, 1, 1); PG8_SCHED; PG8_LDA(At, 1, 0); PG8_STAGE(PG8_SA(0, 1), a2 + hstep, voffA);
            PG8_WAIT_V(8); PG8_WAIT_L(0); PG8_BAR; PG8_MMA(0, 0, At, B0); PG8_MMA(0, 1, At, B1); PG8_BAR; PG8_SCHED;
            PG8_LDA(At, 1, 1); PG8_STAGE(PG8_SB(1, 0), b3, voffB); PG8_STAGE(PG8_SB(1, 1), b3 + hstep, voffB); PG8_STAGE(PG8_SA(1, 0), a3, voffA);
            PG8_WAIT_V(8); PG8_WAIT_L(0); PG8_BAR; PG8_MMA(1, 0, At, B0); PG8_MMA(1, 1, At, B1); PG8_BAR; PG8_SCHED;
            } else {
            PG8_LDB(B0, 0, 0); PG8_SCHED; PG8_LDA(At, 0, 0); PG8_STAGE(PG8_SA(1, 1), a1 + hstep, voffA);
            PG8_WAIT_L(8); PG8_BAR; PG8_WAIT_L(0); PG8_MMA(0, 0, At, B0); PG8_BAR; PG8_SCHED;
            PG8_LDB(B1, 0, 1); PG8_STAGE(PG8_SB(0, 0), b2, voffB);
            PG8_BAR; PG8_WAIT_L(0); PG8_MMA(0, 1, At, B1); PG8_BAR;
            PG8_LDA(At, 0, 1); PG8_STAGE(PG8_SA(0, 0), a2, voffA);
            PG8_BAR; PG8_WAIT_L(0); PG8_MMA(1, 0, At, B0); PG8_BAR; PG8_SCHED;
            PG8_STAGE(PG8_SB(0, 1), b2 + hstep, voffB);
            PG8_WAIT_V(6); PG8_BAR; PG8_MMA(1, 1, At, B1); PG8_BAR;
            PG8_LDB(B0, 1, 0); PG8_SCHED; PG8_LDA(At, 1, 0); PG8_STAGE(PG8_SA(0, 1), a2 + hstep, voffA);
            PG8_WAIT_L(8); PG8_BAR; PG8_WAIT_L(0); PG8_MMA(0, 0, At, B0); PG8_BAR; PG8_SCHED;
            PG8_LDB(B1, 1, 1); PG8_STAGE(PG8_SB(1, 0), b3, voffB);
            PG8_BAR; PG8_WAIT_L(0); PG8_MMA(0, 1, At, B1); PG8_BAR;
            PG8_LDA(At, 1, 1); PG8_STAGE(PG8_SA(1, 0), a3, voffA);
            PG8_BAR; PG8_WAIT_L(0); PG8_MMA(1, 0, At, B0); PG8_BAR; PG8_SCHED;
            PG8_STAGE(PG8_SB(1, 1), b3 + hstep, voffB);
            PG8_WAIT_V(6); PG8_BAR; PG8_MMA(1, 1, At, B1); PG8_BAR;
            }
        }
        if constexpr (ALIGN_EPI) { if (wr == 0) PG8_BAR; }
        if constexpr (!Epi::AFTER_DRAIN) { E(acc, cur, wr, wc, fr, fq); S.done(cur); }
        if (!has_next) break;
#pragma unroll
        for (int a = 0; a < 2; ++a)
#pragma unroll
            for (int b = 0; b < 2; ++b)
#pragma unroll
                for (int m = 0; m < 4; ++m)
#pragma unroll
                    for (int n = 0; n < 2; ++n) acc[a][b][m][n] = (f32x4){0.f, 0.f, 0.f, 0.f};
        cur = nxt; cA = nA; cB = nB; ++ui;
        if constexpr (ALIGN_EPI) { if (wr == 1) PG8_BAR; }
    }
    PG8_WAIT_V(0);
    if constexpr (!ALIGN_EPI) { if (wr == 0) PG8_BAR; }
    PG8_BAR;
    if constexpr (Epi::AFTER_DRAIN) { E.fused(acc, cur, wr, wc, fr, fq, lds, wid, lane); S.done(cur); }
#undef PG8_SA
#undef PG8_SB
#undef PG8_STAGE
#undef PG8_LDA
#undef PG8_LDB
#undef PG8_MMA
#undef PG8_WAIT_V
#undef PG8_WAIT_L
#undef PG8_BAR
#undef PG8_SCHED
}
}

#define GAS __attribute__((address_space(1)))
#define LAS __attribute__((address_space(3)))
typedef unsigned short bf16;
typedef unsigned v4u __attribute__((ext_vector_type(4)));
typedef unsigned v2u __attribute__((ext_vector_type(2)));
typedef float f32x4 __attribute__((ext_vector_type(4)));
typedef float f32x16 __attribute__((ext_vector_type(16)));
typedef short bf16x8 __attribute__((ext_vector_type(8)));
typedef short s16x4 __attribute__((ext_vector_type(4)));

constexpr int NWAVES = 8;
constexpr int NB = 4, SEQ = 8192, DM = 1024, TOK = NB * SEQ;
constexpr int NIN = 5888;
constexpr int SBH = 8, DILH = 12;
constexpr int NMOD = 6 * DM;
constexpr int KSPLIT = 16;
constexpr float EPS = 1e-6f;
constexpr float LOG2E = 1.4426950408889634f;
constexpr float C2 = 0.125f * LOG2E;
constexpr int PEER_E = 16384;

constexpr size_t MiB = 1u << 20;
constexpr size_t WS_CTL = 0, CTL_ZERO_BYTES = 1 * MiB;
constexpr size_t WS_MODP = 1 * MiB;
constexpr size_t WS_MOD = 2 * MiB + 512 * 1024;
constexpr size_t WS_BIASPQ = 2 * MiB + 768 * 1024;
constexpr size_t WS_ROPEC = 3 * MiB, WS_ROPES = 4 * MiB;
constexpr size_t WS_SSQ = 5 * MiB;
constexpr size_t WS_KEYS = 7 * MiB;
constexpr size_t WS_WIN = 8 * MiB;
constexpr size_t WS_WSBO = 20 * MiB;
constexpr size_t WS_WDILO = 21 * MiB;
constexpr size_t WS_WOUT = 22 * MiB;
constexpr size_t WS_WPQ = 24 * MiB;
constexpr size_t WS_UB = 32 * MiB, WS_VB = 64 * MiB;
constexpr size_t WS_ACT = 96 * MiB;
constexpr size_t A_QSB = WS_ACT, A_KSB = WS_ACT + 32 * MiB, A_VSB = WS_ACT + 64 * MiB;
constexpr size_t A_QD = WS_ACT + 96 * MiB, A_KD = WS_ACT + 144 * MiB, A_VD = WS_ACT + 192 * MiB;
constexpr size_t A_GSB = WS_ACT + 240 * MiB, A_GD = WS_ACT + 304 * MiB;
constexpr size_t A_MERGED = WS_ACT;
constexpr size_t A_X1M = WS_ACT + 64 * MiB;
constexpr size_t A_QPEER = WS_ACT + 128 * MiB;
constexpr size_t A_IDX = WS_ACT + 256 * MiB;
constexpr size_t A_GATE = WS_ACT + 272 * MiB;
constexpr size_t A_ACTG = WS_ACT + 288 * MiB;
constexpr size_t A_PART = WS_ACT + 128 * MiB;
constexpr size_t A_H2F8 = WS_ACT + 304 * MiB;
constexpr size_t WS_DUMP = 7 * MiB + 768 * 1024;
constexpr size_t WS_R2 = 7 * MiB + 512 * 1024;
constexpr size_t A_POUT = WS_ACT;
constexpr size_t WS_END = WS_ACT + 368 * MiB;
constexpr size_t O_H = 0, O_OSB = 64 * MiB, O_OD = 96 * MiB;

constexpr int CW_BAR = 4096;

constexpr int RING_BYTES = 131072;
constexpr int MISC_OFF = RING_BYTES + 320;
constexpr int LDS_BYTES = 147456;

#define RLX_AGENT __ATOMIC_RELAXED, __HIP_MEMORY_SCOPE_AGENT
__device__ __forceinline__ unsigned f2bf(float f) { unsigned u = __builtin_bit_cast(unsigned, f); return (u + 0x7fffu + ((u >> 16) & 1u)) >> 16; }
typedef float f32x2_t __attribute__((ext_vector_type(2))); typedef __bf16 bf16x2_t __attribute__((ext_vector_type(2)));
__device__ __forceinline__ unsigned pk2(float lo, float hi) { f32x2_t v = {lo, hi}; bf16x2_t b = __builtin_convertvector(v, bf16x2_t); return __builtin_bit_cast(unsigned, b); }
__device__ __forceinline__ float bflo(unsigned w) { return __uint_as_float(w << 16); }
__device__ __forceinline__ float bfhi(unsigned w) { return __uint_as_float(w & 0xffff0000u); }
__device__ __forceinline__ float wave_sum(float v) {
#pragma unroll
    for (int o = 1; o < 64; o <<= 1) v += __shfl_xor(v, o);
    return v;
}
__device__ __forceinline__ float fast_exp2(float x) { return __builtin_amdgcn_exp2f(x); }
__device__ __forceinline__ float fast_log2(float x) { return __builtin_amdgcn_logf(x); }
__device__ __forceinline__ float fast_rcp(float x) { return __builtin_amdgcn_rcpf(x); }
__device__ __forceinline__ float sigmoidf_(float x) { return fast_rcp(1.f + fast_exp2(-x * LOG2E)); }
#define XB_TMO      128
#define XB_XCNT(j)  (256  + 64 * (j))
#define XB_XSUB(j)  (1280 + 64 * (j))
#define XB_XGEN(j)  (2304 + 64 * (j))
#define XB_TOP      3328
#define XB_TOPGEN   3392
#define XCD_BAR_WORDS 3456
#define XB_SPIN_CAP (1u << 18)

__device__ __forceinline__ unsigned xb_ld(unsigned* p)              { return __hip_atomic_load(p, __ATOMIC_RELAXED, __HIP_MEMORY_SCOPE_AGENT); }
__device__ __forceinline__ unsigned xb_add(unsigned* p, unsigned v) { return __hip_atomic_fetch_add(p, v, __ATOMIC_RELAXED, __HIP_MEMORY_SCOPE_AGENT); }
__device__ __forceinline__ unsigned xb_xcc_id() { return (unsigned)__builtin_amdgcn_s_getreg((3 << 11) | 20) & 0xFu; }
#define XB_SPIN(cond, bar) do { unsigned _sp = 0; while (cond) { __builtin_amdgcn_s_sleep(1); \
    if ((++_sp & 255u) == 0u) { if (xb_ld(&(bar)[XB_TMO])) break; if (_sp > XB_SPIN_CAP) { atomicAdd(&(bar)[XB_TMO], 1u); break; } } } } while (0)

struct XcdBarrier {
    unsigned* bar; unsigned x;
    volatile LAS unsigned* st;
};

__device__ __forceinline__ XcdBarrier xcd_barrier_post(unsigned* bar, volatile LAS unsigned* st) {
    XcdBarrier b; b.bar = bar; b.x = xb_xcc_id(); b.st = st;
    if (threadIdx.x == 0) (void)xb_add(&bar[XB_XCNT(b.x)], 1u);
    return b;
}
__device__ __forceinline__ void xcd_barrier_complete(unsigned* bar, unsigned x, unsigned& nloc, unsigned& nx) {
    const unsigned G = gridDim.x * gridDim.y * gridDim.z;
    unsigned sum, cnt, mine, sp = 0u;
    for (;;) {
        sum = 0u; cnt = 0u; mine = 0u;
#pragma unroll
        for (unsigned j = 0; j < 16; ++j) { const unsigned c = xb_ld(&bar[XB_XCNT(j)]); sum += c; cnt += (c > 0u) ? 1u : 0u; mine = (j == x) ? c : mine; }
        if (sum == G) break;
        __builtin_amdgcn_s_sleep(1);
        if ((++sp & 255u) == 0u) { if (xb_ld(&bar[XB_TMO])) break; if (sp > XB_SPIN_CAP) { atomicAdd(&bar[XB_TMO], 1u); break; } }
    }
    nloc = mine > 0u ? mine : 1u; nx = cnt > 0u ? cnt : 1u;
}

__device__ __forceinline__ void xcd_barrier(const XcdBarrier& b) {
    asm volatile("s_waitcnt vmcnt(0)" ::: "memory");
    __syncthreads();
    if (threadIdx.x == 0) {
        unsigned* bar = b.bar;
        __builtin_amdgcn_s_waitcnt(0);
        unsigned nloc = b.st[0], nx = b.st[1];
        if (nloc == 0u) { xcd_barrier_complete(bar, b.x, nloc, nx); b.st[0] = nloc; b.st[1] = nx; }
        const unsigned old = xb_add(&bar[XB_XSUB(b.x)], 1u);
        const unsigned gen = old / nloc;
        if (old + 1u == (gen + 1u) * nloc) {
            __builtin_amdgcn_fence(__ATOMIC_RELEASE, "agent");
            asm volatile("s_waitcnt vmcnt(0)" ::: "memory");
            const unsigned og = xb_add(&bar[XB_TOP], 1u);
            const unsigned tg = og / nx;
            if (og + 1u == (tg + 1u) * nx) xb_add(&bar[XB_TOPGEN], 1u);
            else XB_SPIN(xb_ld(&bar[XB_TOPGEN]) == tg, bar);
            __builtin_amdgcn_fence(__ATOMIC_ACQUIRE, "agent");
            xb_add(&bar[XB_XGEN(b.x)], 1u);
            asm volatile("s_waitcnt vmcnt(0)" ::: "memory");
        } else {
            XB_SPIN(xb_ld(&bar[XB_XGEN(b.x)]) == gen, bar);
            __builtin_amdgcn_fence(__ATOMIC_ACQUIRE, "agent");
            asm volatile("s_waitcnt vmcnt(0)" ::: "memory");
        }
    }
    __syncthreads();
}

struct Args {
    const float* x; const float* c; const float* w_ada; const float* b_ada; const float* g_mix; const float* w_in; const float* w_sb_o; const float* w_dil_o;
    const float* w_out; const float* g_ffn; const float* w_pq; const float* peer_keys; const float* peer_u; const float* peer_v; const float* g_final;
    float* out; unsigned char* ws; int ph_lo, ph_hi;
};
struct Frame {
    LAS unsigned char* lds;
    int tid, lane, wave, vcu, G, gw, NGW;
};

__device__ __forceinline__ int win_row(int ncol) {
    const int tile = ncol >> 8;
    if (tile >= 6 && tile < 12) { const int d = ncol & 63; const int j = (d & 31) >> 2, i = (d & 3) + ((d >> 5) << 2); return (ncol & ~63) + 8 * j + i; }
    return ncol;
}
template <bool MAPWIN>
__device__ __forceinline__ void p0_transpose_item(const float* W, int K, int N, bf16* WT, LAS float* scr, int item, int lane) {
    const int nblk = N / 32, kb = item / nblk, nb = item % nblk, k0 = 64 * kb, n0 = 32 * nb;
#pragma unroll 8
    for (int i = 0; i < 32; ++i) { const int kk = 2 * i + (lane >> 5); scr[kk * 33 + (lane & 31)] = W[(size_t)(k0 + kk) * N + n0 + (lane & 31)]; }
    asm volatile("s_waitcnt lgkmcnt(0)" ::: "memory");
    const int c = lane & 7;
#pragma unroll
    for (int j = 0; j < 4; ++j) { const int n = (lane >> 3) + 8 * j; const LAS float* s = scr + (8 * c) * 33 + n;
        v4u o; o.x = pk2(s[0 * 33], s[1 * 33]); o.y = pk2(s[2 * 33], s[3 * 33]); o.z = pk2(s[4 * 33], s[5 * 33]); o.w = pk2(s[6 * 33], s[7 * 33]);
        const int rowo = MAPWIN ? win_row(n0 + n) : (n0 + n);
        *(GAS v4u*)(WT + (size_t)rowo * K + k0 + 8 * c) = o; }
    asm volatile("s_waitcnt lgkmcnt(0)" ::: "memory");
}
__device__ __forceinline__ void cvt_row_1024(const float* src, bf16* dst, int lane) {
    const GAS f32x4* s = (const GAS f32x4*)src + lane; GAS v2u* d = (GAS v2u*)dst + lane;
    f32x4 v[4];
#pragma unroll
    for (int j = 0; j < 4; ++j) v[j] = s[64 * j];
#pragma unroll
    for (int j = 0; j < 4; ++j) { v2u o; o.x = pk2(v[j].x, v[j].y); o.y = pk2(v[j].z, v[j].w); d[64 * j] = o; }
}
template <bool SLICED>
__device__ __forceinline__ void cvt_row_fp8(const float* src, unsigned char* dst, float* inv, int e, int lane) {
    const GAS f32x4* s = (const GAS f32x4*)src + lane;
    f32x4 v[4]; float m = 0.f;
#pragma unroll
    for (int j = 0; j < 4; ++j) { v[j] = s[64 * j]; m = fmaxf(m, fmaxf(fmaxf(fabsf(v[j].x), fabsf(v[j].y)), fmaxf(fabsf(v[j].z), fabsf(v[j].w)))); }
#pragma unroll
    for (int o = 1; o < 64; o <<= 1) m = fmaxf(m, __shfl_xor(m, o));
    m = fmaxf(m, 1e-30f);
    const int ex = (int)((__float_as_uint(m) >> 23) & 0xff) - 127;
    const float scale = __uint_as_float((unsigned)(127 + 7 - ex) << 23);
    const float iscale = __uint_as_float((unsigned)(127 - 7 + ex) << 23);
    unsigned w[4];
#pragma unroll
    for (int j = 0; j < 4; ++j) { int t = __builtin_amdgcn_cvt_pk_fp8_f32(v[j].x * scale, v[j].y * scale, 0, false); t = __builtin_amdgcn_cvt_pk_fp8_f32(v[j].z * scale, v[j].w * scale, t, true); w[j] = (unsigned)t; }
    if (!SLICED) { *(GAS v4u*)(dst + (size_t)e * 1024 + 16 * lane) = (v4u){w[0], w[1], w[2], w[3]}; }
    else {
#pragma unroll
        for (int j = 0; j < 4; ++j) *(GAS unsigned*)(dst + (size_t)(2 * j + (lane >> 5)) * (2 * MiB) + (size_t)e * 128 + 4 * (lane & 31)) = w[j]; }
    if (lane == 0) inv[e] = iscale;
}
__device__ __forceinline__ void sincos_d(double a, float& sn, float& cs) {
    const double TWO_PI = 6.283185307179586476925286766559;
    const double k = __builtin_rint(a / TWO_PI); const double r = a - k * TWO_PI; const double r2 = r * r;
    double ts = 1.0, tc = 1.0, ss = 1.0, cc = 1.0;
#pragma unroll
    for (int n = 1; n <= 14; ++n) { tc = -tc * r2 / (double)((2 * n - 1) * (2 * n)); ts = -ts * r2 / (double)((2 * n) * (2 * n + 1)); cc += tc; ss += ts; }
    sn = (float)(r * ss); cs = (float)cc;
}

__device__ __forceinline__ void p0_prologue(const Args& A, Frame& F) {
    unsigned char* ws = A.ws;
    LAS float* scr = (LAS float*)(F.lds + F.wave * 16384);
    const int lane = F.lane;
    constexpr int I_MOD = KSPLIT * 24;
    constexpr int I_WIN = (DM / 64) * (NIN / 32);
    constexpr int I_SBO = (512 / 64) * (DM / 32), I_DILO = (256 / 64) * (DM / 32), I_OUT = (DM / 64) * (DM / 32), I_PQ = (DM / 64) * (2048 / 32);
    constexpr int I_KEYS = 256, I_TAB = 2 * PEER_E, I_ROPE = SEQ * 32 / 64;
    constexpr int NITEMS = I_MOD + I_WIN + I_SBO + I_DILO + I_OUT + I_PQ + I_KEYS + I_TAB + I_ROPE;
    for (int it = F.gw; it < NITEMS; it += F.NGW) {
        int r = it;
        if (r < I_MOD) {
            const int ks = r / 24, cc = r % 24, col = 256 * cc + 4 * lane, k0 = 64 * ks;
            float sv[4];
#pragma unroll
            for (int b = 0; b < 4; ++b) { const float cv = A.c[b * DM + k0 + lane]; sv[b] = cv * sigmoidf_(cv); }
            f32x4 acc[4];
#pragma unroll
            for (int b = 0; b < 4; ++b) acc[b] = (f32x4){0.f, 0.f, 0.f, 0.f};
            const GAS f32x4* wp = (const GAS f32x4*)(A.w_ada + (size_t)k0 * NMOD + col);
#pragma unroll 8
            for (int kk = 0; kk < 64; ++kk) { const f32x4 w4 = wp[(size_t)kk * (NMOD / 4)];
#pragma unroll
                for (int b = 0; b < 4; ++b) { const float s = __uint_as_float(__builtin_amdgcn_readlane(__float_as_uint(sv[b]), kk)); acc[b] += w4 * s; } }
            float* mp = (float*)(ws + WS_MODP);
#pragma unroll
            for (int b = 0; b < 4; ++b) *(GAS f32x4*)(mp + ((size_t)(ks * 4 + b)) * NMOD + col) = acc[b];
            continue;
        }
        r -= I_MOD;
        if (r < I_WIN) { p0_transpose_item<true>(A.w_in, DM, NIN, (bf16*)(ws + WS_WIN), scr, r, lane); continue; } r -= I_WIN;
        if (r < I_SBO) { p0_transpose_item<false>(A.w_sb_o, 512, DM, (bf16*)(ws + WS_WSBO), scr, r, lane); continue; } r -= I_SBO;
        if (r < I_DILO) { p0_transpose_item<false>(A.w_dil_o, 256, DM, (bf16*)(ws + WS_WDILO), scr, r, lane); continue; } r -= I_DILO;
        if (r < I_OUT) { p0_transpose_item<false>(A.w_out, DM, DM, (bf16*)(ws + WS_WOUT), scr, r, lane); continue; } r -= I_OUT;
        if (r < I_PQ) { p0_transpose_item<false>(A.w_pq, DM, 2048, (bf16*)(ws + WS_WPQ), scr, r, lane); continue; } r -= I_PQ;
        if (r < I_KEYS) { cvt_row_1024(A.peer_keys + (size_t)r * 1024, (bf16*)(ws + WS_KEYS) + (size_t)r * 1024, lane); continue; } r -= I_KEYS;
        if (r < I_TAB) { if (r < PEER_E) cvt_row_fp8<true>(A.peer_u + (size_t)r * 1024, ws + WS_UB, (float*)(ws + WS_UB + 16 * MiB), r, lane);
                         else cvt_row_fp8<true>(A.peer_v + (size_t)(r - PEER_E) * 1024, ws + WS_VB, (float*)(ws + WS_VB + 16 * MiB), r - PEER_E, lane); continue; } r -= I_TAB;
        {
            const int idx = r * 64 + lane, s = idx >> 5, j = idx & 31;
            const float inv = (float)exp2(-(double)j * (13.287712379549449 / 32.0));
            const float ang = (float)s * inv;
            float sn, cs; sincos_d((double)ang, sn, cs);
            ((float*)(ws + WS_ROPEC))[idx] = cs; ((float*)(ws + WS_ROPES))[idx] = sn;
        }
    }
}

__device__ __forceinline__ void p1_hrows(const Args& A, Frame& F) {
    unsigned char* ws = A.ws;
    LAS float* mult = (LAS float*)F.lds; LAS float* addv = mult + DM;
    const float* mp = (const float*)(ws + WS_MODP);
    float* mod = (float*)(ws + WS_MOD);
    bf16* H = (bf16*)((unsigned char*)A.out + O_H);
    for (int ch = F.vcu; ch < TOK / 128; ch += F.G) {
        const int b = (ch * 128) / SEQ;
        __syncthreads();
        for (int k = F.tid; k < DM; k += NWAVES * 64) {
            float sh = A.b_ada[k], sc = A.b_ada[DM + k];
#pragma unroll
            for (int ks = 0; ks < KSPLIT; ++ks) { sh += mp[(size_t)(ks * 4 + b) * NMOD + k]; sc += mp[(size_t)(ks * 4 + b) * NMOD + DM + k]; }
            mult[k] = A.g_mix[k] * (1.f + sc); addv[k] = sh;
        }
        if ((ch * 128) % SEQ == 0) {
            for (int j = F.tid; j < NMOD; j += NWAVES * 64) { float v = A.b_ada[j];
#pragma unroll
                for (int ks = 0; ks < KSPLIT; ++ks) v += mp[(size_t)(ks * 4 + b) * NMOD + j];
                mod[b * NMOD + j] = v; }
        }
        __syncthreads();
        for (int i = 0; i < 16; ++i) {
            const int row = ch * 128 + F.wave * 16 + i;
            const GAS f32x4* xr = (const GAS f32x4*)(A.x + (size_t)row * DM) + F.lane;
            f32x4 v[4]; float s = 0.f;
#pragma unroll
            for (int j = 0; j < 4; ++j) { v[j] = xr[64 * j]; s += (v[j].x * v[j].x + v[j].y * v[j].y) + (v[j].z * v[j].z + v[j].w * v[j].w); }
            const float rr = 1.0f / sqrtf(wave_sum(s) * (1.f / DM) + EPS);
            GAS v2u* o8 = (GAS v2u*)(H + (size_t)row * DM) + F.lane;
#pragma unroll
            for (int j = 0; j < 4; ++j) { const f32x4 mu = *(const LAS f32x4*)(mult + 256 * j + 4 * F.lane), ad = *(const LAS f32x4*)(addv + 256 * j + 4 * F.lane);
                const f32x4 hh = v[j] * rr * mu + ad; v2u o; o.x = pk2(hh.x, hh.y); o.y = pk2(hh.z, hh.w); o8[64 * j] = o; }
        }
    }
}

typedef pg8::f32x4 pf4;
struct EpiG1 {
    static constexpr bool PERM = true, AFTER_DRAIN = false;
    bf16 *Qsb, *Ksb, *Vsb, *Qd, *Kd, *Vd, *Gsb, *Gd; const float* ropeC; const float* ropeS;
    __device__ __forceinline__ void operator()(const pf4 (&acc)[2][2][4][2], const pg8::Unit& u, int wr, int wc, int fr, int fq) const {
        const int pn = u.pn;
        const int row0 = u.pm * 256 + wr * 64 + fr;
        const int b = (u.pm * 256) >> 13;
        if (pn < 6 || (pn >= 12 && pn < 15)) {
            bf16* base; int H, head0; float sc = 1.f;
            if (pn < 2) { base = Qsb; H = SBH; head0 = 4 * pn; sc = C2; }
            else if (pn < 4) { base = Ksb; H = SBH; head0 = 4 * (pn - 2); }
            else if (pn < 6) { base = Vsb; H = SBH; head0 = 4 * (pn - 4); }
            else { base = Vd; H = DILH; head0 = 4 * (pn - 12); }
            const int d0 = 32 * (wc & 1) + 8 * fq;
#pragma unroll
            for (int ai = 0; ai < 2; ++ai)
#pragma unroll
                for (int m = 0; m < 4; ++m) { const int s = (row0 + ai * 128 + m * 16) & (SEQ - 1);
#pragma unroll
                    for (int bj = 0; bj < 2; ++bj) { const int head = head0 + 2 * bj + (wc >> 1);
                        const pf4 v0 = acc[ai][bj][m][0] * sc, v1 = acc[ai][bj][m][1] * sc;
                        v4u w; w.x = pk2(v0[0], v0[1]); w.y = pk2(v0[2], v0[3]); w.z = pk2(v1[0], v1[1]); w.w = pk2(v1[2], v1[3]);
                        *(GAS v4u*)(base + ((size_t)(b * H + head) * SEQ + s) * 64 + d0) = w; } }
        } else if (pn < 12) {
            bf16* base; int head0; float sc = 1.f;
            if (pn < 9) { base = Qd; head0 = 4 * (pn - 6); sc = C2; } else { base = Kd; head0 = 4 * (pn - 9); }
            const int j4 = 4 * (4 * (wc & 1) + fq);
#pragma unroll
            for (int ai = 0; ai < 2; ++ai)
#pragma unroll
                for (int m = 0; m < 4; ++m) { const int s = (row0 + ai * 128 + m * 16) & (SEQ - 1);
                    const pf4 cs = *(const GAS pf4*)(ropeC + s * 32 + j4) * sc, sn = *(const GAS pf4*)(ropeS + s * 32 + j4) * sc;
#pragma unroll
                    for (int bj = 0; bj < 2; ++bj) { const int head = head0 + 2 * bj + (wc >> 1);
                        const pf4 x1 = acc[ai][bj][m][0], x2 = acc[ai][bj][m][1];
                        const pf4 o1 = x1 * cs - x2 * sn, o2 = x1 * sn + x2 * cs;
                        bf16* p = base + ((size_t)(b * DILH + head) * SEQ + s) * 64 + j4;
                        v2u w1, w2; w1.x = pk2(o1[0], o1[1]); w1.y = pk2(o1[2], o1[3]); w2.x = pk2(o2[0], o2[1]); w2.y = pk2(o2[2], o2[3]);
                        *(GAS v2u*)p = w1; *(GAS v2u*)(p + 32) = w2; } }
        } else {
            bf16* base = pn < 19 ? Gsb : Gd; const int ct = (pn < 19 ? pn - 15 : pn - 19) * 256 + wc * 32 + 8 * fq;
#pragma unroll
            for (int ai = 0; ai < 2; ++ai)
#pragma unroll
                for (int m = 0; m < 4; ++m) { const size_t row = (size_t)(row0 + ai * 128 + m * 16);
#pragma unroll
                    for (int bj = 0; bj < 2; ++bj) { const pf4 v0 = acc[ai][bj][m][0], v1 = acc[ai][bj][m][1];
                        v4u w; w.x = pk2(sigmoidf_(v0[0]), sigmoidf_(v0[1])); w.y = pk2(sigmoidf_(v0[2]), sigmoidf_(v0[3]));
                        w.z = pk2(sigmoidf_(v1[0]), sigmoidf_(v1[1])); w.w = pk2(sigmoidf_(v1[2]), sigmoidf_(v1[3]));
                        *(GAS v4u*)(base + row * DM + ct + bj * 128) = w; } }
        }
    }
};
template <bool SECOND> struct EpiMerge {
    static constexpr bool PERM = true, AFTER_DRAIN = false;
    const bf16* G; bf16* Mg;
    __device__ __forceinline__ void operator()(const pf4 (&acc)[2][2][4][2], const pg8::Unit& u, int wr, int wc, int fr, int fq) const {
        const int row0 = u.pm * 256 + wr * 64 + fr, col0 = u.pn * 256 + wc * 32 + 8 * fq;
#pragma unroll
        for (int ai = 0; ai < 2; ++ai)
#pragma unroll
            for (int m = 0; m < 4; ++m) { const size_t off = (size_t)(row0 + ai * 128 + m * 16) * DM + col0;
#pragma unroll
                for (int bj = 0; bj < 2; ++bj) { const v4u g = *(const GAS v4u*)(G + off + bj * 128);
                    pf4 v0 = acc[ai][bj][m][0], v1 = acc[ai][bj][m][1];
                    v0[0] *= bflo(g.x); v0[1] *= bfhi(g.x); v0[2] *= bflo(g.y); v0[3] *= bfhi(g.y); v1[0] *= bflo(g.z); v1[1] *= bfhi(g.z); v1[2] *= bflo(g.w); v1[3] *= bfhi(g.w);
                    if (SECOND) { const v4u t = *(const GAS v4u*)(Mg + off + bj * 128);
                        v0[0] += bflo(t.x); v0[1] += bfhi(t.x); v0[2] += bflo(t.y); v0[3] += bfhi(t.y); v1[0] += bflo(t.z); v1[1] += bfhi(t.z); v1[2] += bflo(t.w); v1[3] += bfhi(t.w); }
                    v4u w; w.x = pk2(v0[0], v0[1]); w.y = pk2(v0[2], v0[3]); w.z = pk2(v1[0], v1[1]); w.w = pk2(v1[2], v1[3]);
                    *(GAS v4u*)(Mg + off + bj * 128) = w; }
                asm volatile("" ::: "memory"); }
    }
};
struct EpiOut {
    static constexpr bool PERM = true, AFTER_DRAIN = false;
    const float* x; float* x1; bf16* x1m; float* ssq; const float* mod; const float* g_ffn;
    __device__ __forceinline__ void operator()(const pf4 (&acc)[2][2][4][2], const pg8::Unit& u, int wr, int wc, int fr, int fq) const {
        const int row0 = u.pm * 256 + wr * 64 + fr, col0 = u.pn * 256 + wc * 32 + 8 * fq;
        const int b = (u.pm * 256) >> 13; const float* mb = mod + (size_t)b * NMOD;
        pf4 gt[2][2], mm[2][2];
#pragma unroll
        for (int bj = 0; bj < 2; ++bj)
#pragma unroll
            for (int n = 0; n < 2; ++n) { const int c = col0 + bj * 128 + 4 * n; gt[bj][n] = *(const GAS pf4*)(mb + 2 * DM + c);
                mm[bj][n] = *(const GAS pf4*)(g_ffn + c) * (*(const GAS pf4*)(mb + 4 * DM + c) + 1.0f); }
#pragma unroll
        for (int ai = 0; ai < 2; ++ai)
#pragma unroll
            for (int m = 0; m < 4; ++m) { const int row = row0 + ai * 128 + m * 16; const size_t off = (size_t)row * DM + col0; float s = 0.f;
#pragma unroll
                for (int bj = 0; bj < 2; ++bj) {
                    const pf4 a0 = *(const GAS pf4*)(x + off + bj * 128), a1 = *(const GAS pf4*)(x + off + bj * 128 + 4);
                    const pf4 y0 = a0 + gt[bj][0] * acc[ai][bj][m][0], y1 = a1 + gt[bj][1] * acc[ai][bj][m][1];
                    *(GAS pf4*)(x1 + off + bj * 128) = y0; *(GAS pf4*)(x1 + off + bj * 128 + 4) = y1;
                    s += (y0[0] * y0[0] + y0[1] * y0[1]) + (y0[2] * y0[2] + y0[3] * y0[3]) + (y1[0] * y1[0] + y1[1] * y1[1]) + (y1[2] * y1[2] + y1[3] * y1[3]);
                    const pf4 z0 = y0 * mm[bj][0], z1 = y1 * mm[bj][1];
                    v4u w; w.x = pk2(z0[0], z0[1]); w.y = pk2(z0[2], z0[3]); w.z = pk2(z1[0], z1[1]); w.w = pk2(z1[2], z1[3]);
                    *(GAS v4u*)(x1m + off + bj * 128) = w; }
                s += __shfl_xor(s, 16); s += __shfl_xor(s, 32);
                if (fq == 0) ssq[(size_t)row * 16 + 4 * u.pn + wc] = s; }
    }
};
struct EpiPq {
    static constexpr bool PERM = true, AFTER_DRAIN = false;
    const float* ssq; const float* bias; bf16* Q; float* r2out;
    __device__ __forceinline__ void operator()(const pf4 (&acc)[2][2][4][2], const pg8::Unit& u, int wr, int wc, int fr, int fq) const {
        const int row0 = u.pm * 256 + wr * 64 + fr, col0 = u.pn * 256 + wc * 32 + 8 * fq;
        const int b = (u.pm * 256) >> 13; const float* bb = bias + (size_t)b * 2048;
        pf4 bv[2][2];
#pragma unroll
        for (int bj = 0; bj < 2; ++bj)
#pragma unroll
            for (int n = 0; n < 2; ++n) bv[bj][n] = *(const GAS pf4*)(bb + col0 + bj * 128 + 4 * n);
#pragma unroll
        for (int ai = 0; ai < 2; ++ai)
#pragma unroll
            for (int m = 0; m < 4; ++m) { const int row = row0 + ai * 128 + m * 16;
                const GAS pf4* sp = (const GAS pf4*)(ssq + (size_t)row * 16);
                const pf4 s4 = (sp[0] + sp[1]) + (sp[2] + sp[3]);
                const float r2 = 1.0f / sqrtf(((s4[0] + s4[1]) + (s4[2] + s4[3])) * (1.f / DM) + EPS);
                if (u.pn == 0 && wc == 0 && fq == 0) r2out[row] = r2;
#pragma unroll
                for (int bj = 0; bj < 2; ++bj) { const pf4 v0 = acc[ai][bj][m][0] * r2 + bv[bj][0], v1 = acc[ai][bj][m][1] * r2 + bv[bj][1];
                    v4u w; w.x = pk2(v0[0], v0[1]); w.y = pk2(v0[2], v0[3]); w.z = pk2(v1[0], v1[1]); w.w = pk2(v1[2], v1[3]);
                    *(GAS v4u*)(Q + (size_t)row * 2048 + col0 + bj * 128) = w; } }
    }
};

constexpr int VSTR = 144;
constexpr int ATT_WAVE_LDS = 32 * VSTR;
__device__ __forceinline__ int kappa(int r) { return (((r >> 2) & 1) << 4) + ((r >> 3) << 2) + (r & 3); }
struct KVTile { bf16x8 k[4]; v4u v[4]; };
typedef short v4i16_t __attribute__((ext_vector_type(4)));
__device__ __forceinline__ s16x4 vtr(const LAS unsigned char* p) { return __builtin_bit_cast(s16x4, __builtin_amdgcn_ds_read_tr16_b64_v4i16((LAS v4i16_t*)p)); }

__device__ __forceinline__ void kv_load(KVTile& t, const bf16* Kh, const bf16* Vh, int base_tok, int sshift, int lane) {
    const int r = lane & 31, h = lane >> 5;
    const bf16* kp = Kh + (size_t)(base_tok + (kappa(r) << sshift)) * 64 + 8 * h;
#pragma unroll
    for (int st = 0; st < 4; ++st) t.k[st] = *(const GAS bf16x8*)(kp + 16 * st);
#pragma unroll
    for (int i = 0; i < 4; ++i) t.v[i] = *(const GAS v4u*)(Vh + (size_t)(base_tok + (((lane >> 3) + 8 * i) << sshift)) * 64 + 8 * (lane & 7));
}
__device__ __forceinline__ void v_to_lds(const KVTile& t, LAS unsigned char* vl, int lane) {
#pragma unroll
    for (int i = 0; i < 4; ++i) *(LAS v4u*)(vl + ((lane >> 3) + 8 * i) * VSTR + 16 * (lane & 7)) = t.v[i];
}
__device__ __forceinline__ f32x16 qk_tile(const KVTile& t, const bf16x8 (&qf)[4]) {
    f32x16 s = {};
#pragma unroll
    for (int st = 0; st < 4; ++st) s = __builtin_amdgcn_mfma_f32_32x32x16_bf16(t.k[st], qf[st], s, 0, 0, 0);
    return s;
}
__device__ __forceinline__ void pv_tile(f32x16& o0, f32x16& o1, const float (&p)[16], const LAS unsigned char* vl, int lane) {
    const int g = lane >> 4, li = lane & 15, q = li >> 2, pp = li & 3, h = g >> 1;
    const LAS unsigned char* tb = vl + (16 * h + q) * VSTR + (16 * (g & 1) + 4 * pp) * 2;
    bf16x8 pf[2];
#pragma unroll
    for (int st = 0; st < 2; ++st) { v4u w; w.x = pk2(p[8 * st + 0], p[8 * st + 1]); w.y = pk2(p[8 * st + 2], p[8 * st + 3]); w.z = pk2(p[8 * st + 4], p[8 * st + 5]); w.w = pk2(p[8 * st + 6], p[8 * st + 7]); pf[st] = __builtin_bit_cast(bf16x8, w); }
#pragma unroll
    for (int db = 0; db < 2; ++db)
#pragma unroll
        for (int st = 0; st < 2; ++st) {
            const s16x4 lo = vtr(tb + (8 * st) * VSTR + 64 * db), hi = vtr(tb + (8 * st + 4) * VSTR + 64 * db);
            const bf16x8 vf = (bf16x8){lo[0], lo[1], lo[2], lo[3], hi[0], hi[1], hi[2], hi[3]};
            if (db == 0) o0 = __builtin_amdgcn_mfma_f32_32x32x16_bf16(vf, pf[st], o0, 0, 0, 0);
            else         o1 = __builtin_amdgcn_mfma_f32_32x32x16_bf16(vf, pf[st], o1, 0, 0, 0);
        }
}
__device__ __forceinline__ void o_store(bf16* orow, const f32x16& o0, const f32x16& o1, float sc, int hC) {
#pragma unroll
    for (int a = 0; a < 4; ++a) {
        v2u w0, w1; w0.x = pk2(o0[4 * a] * sc, o0[4 * a + 1] * sc); w0.y = pk2(o0[4 * a + 2] * sc, o0[4 * a + 3] * sc);
        w1.x = pk2(o1[4 * a] * sc, o1[4 * a + 1] * sc); w1.y = pk2(o1[4 * a + 2] * sc, o1[4 * a + 3] * sc);
        *(GAS v2u*)(orow + 8 * a + 4 * hC) = w0; *(GAS v2u*)(orow + 32 + 8 * a + 4 * hC) = w1; }
}

__device__ __forceinline__ void sb_task(const bf16* Qsb, const bf16* Ksb, const bf16* Vsb, bf16* Osb, int task, LAS unsigned char* vl, int lane) {
    const int qt = task & 255, bh = task >> 8, b = bh >> 3, h = bh & 7, t0 = qt * 32;
    const int q = lane & 31, hC = lane >> 5;
    const bf16* Kh = Ksb + (size_t)bh * SEQ * 64; const bf16* Vh = Vsb + (size_t)bh * SEQ * 64;
    bf16x8 qf[4];
    { const bf16* qp = Qsb + ((size_t)bh * SEQ + t0 + q) * 64 + 8 * hC;
#pragma unroll
      for (int st = 0; st < 4; ++st) qf[st] = *(const GAS bf16x8*)(qp + 16 * st); }
    f32x16 o0 = {}, o1 = {}; float carry = 0.f;
    KVTile nxt; kv_load(nxt, Kh, Vh, t0, 0, lane);
    for (int k0 = t0;; k0 -= 32) {
        KVTile cur = nxt;
        const bool more = k0 >= 32;
        if (more) kv_load(nxt, Kh, Vh, k0 - 32, 0, lane);
        v_to_lds(cur, vl, lane);
        const f32x16 s = qk_tile(cur, qf);
        const bool diag = (k0 == t0);
        float L[16], z[16];
#pragma unroll
        for (int r = 0; r < 16; ++r) { z[r] = __builtin_amdgcn_fmed3f(s[r], -120.f, 120.f); const float e = fast_exp2(z[r]); L[r] = -fast_log2(1.f + e);
            if (diag && !(16 * hC + r < q)) L[r] = 0.f; }
        float c[16]; c[15] = L[15];
#pragma unroll
        for (int r = 14; r >= 0; --r) c[r] = c[r + 1] + L[r];
        const float tot = c[0], oth = __shfl_xor(tot, 32);
        const float base = carry + (hC ? 0.f : oth);
        float p[16];
#pragma unroll
        for (int r = 0; r < 16; ++r) { p[r] = fast_exp2(z[r] + (base + c[r])); if (diag && !(16 * hC + r < q)) p[r] = 0.f; }
        carry += tot + oth;
        pv_tile(o0, o1, p, vl, lane);
        if (!more) break;
        if (__all(carry < -160.f)) break;
    }
    o_store(Osb + ((size_t)(b * SEQ + t0 + q)) * 512 + h * 64, o0, o1, 1.f, hC);
}

__device__ __forceinline__ void dil_task(const bf16* Qd, const bf16* Kd, const bf16* Vd, bf16* Od, int task, LAS unsigned char* vl, int lane) {
    const int it = task & 15, rho = (task >> 4) & 15, hg = (task >> 8) & 3, b = task >> 10;
    const int q = lane & 31, hC = lane >> 5, i0 = 32 * it;
    const int tq = 16 * (i0 + q) + rho;
    f32x16 o0 = {}, o1 = {}; float mrun = -1e30f, lsum = 0.f;
#pragma unroll
    for (int g = 0; g < 3; ++g) {
        bf16x8 qf[4];
        { const bf16* qp = Qd + ((size_t)(b * DILH + g * 4 + hg) * SEQ + tq) * 64 + 8 * hC;
#pragma unroll
          for (int st = 0; st < 4; ++st) qf[st] = *(const GAS bf16x8*)(qp + 16 * st); }
        const int rs = 2 * g, cg = 16 >> rs, rho_g = rho & ((1 << rs) - 1), og = rho >> rs;
        const bf16* Kh = Kd + (size_t)(b * DILH + g * 4 + hg) * SEQ * 64; const bf16* Vh = Vd + (size_t)(b * DILH + g * 4 + hg) * SEQ * 64;
        const int uq = cg * (i0 + q) + og;
        const int u_hi = cg * (i0 + 31) + og; int u_lo = cg * i0 + og - 128; u_lo = u_lo < 0 ? 0 : u_lo;
        const int ub_last = u_lo & ~31;
        int ub = u_hi & ~31;
        KVTile nxt; kv_load(nxt, Kh, Vh, (ub << rs) + rho_g, rs, lane);
        for (;; ub -= 32) {
            KVTile cur = nxt;
            const bool more = ub > ub_last;
            if (more) kv_load(nxt, Kh, Vh, ((ub - 32) << rs) + rho_g, rs, lane);
            v_to_lds(cur, vl, lane);
            const f32x16 s = qk_tile(cur, qf);
            float z[16]; float tmax = -1e30f;
            const int d0 = uq - (ub + 16 * hC);
#pragma unroll
            for (int r = 0; r < 16; ++r) { const bool valid = (unsigned)(d0 - r) <= 128u; z[r] = valid ? s[r] : -1e30f; tmax = fmaxf(tmax, z[r]); }
            tmax = fmaxf(tmax, __shfl_xor(tmax, 32));
            const float mnew = fmaxf(mrun, tmax); const float alpha = fast_exp2(mrun - mnew); mrun = mnew;
            float p[16]; float ps = 0.f;
#pragma unroll
            for (int r = 0; r < 16; ++r) { p[r] = (z[r] > -1e29f) ? fast_exp2(z[r] - mnew) : 0.f; ps += p[r]; }
            lsum = lsum * alpha + ps;
            if (!__all(alpha == 1.0f)) {
#pragma unroll
                for (int r = 0; r < 16; ++r) { o0[r] *= alpha; o1[r] *= alpha; }
            }
            pv_tile(o0, o1, p, vl, lane);
            if (!more) break;
        }
    }
    const float l = lsum + __shfl_xor(lsum, 32);
    o_store(Od + (size_t)(b * SEQ + tq) * 256 + hg * 64, o0, o1, 1.0f / l, hC);
}

__device__ __forceinline__ void p3_attention(const Args& A, Frame& F) {
    unsigned char* ws = A.ws;
    LAS unsigned char* vl = F.lds + F.wave * ATT_WAVE_LDS;
    const bf16 *Qsb = (const bf16*)(ws + A_QSB), *Ksb = (const bf16*)(ws + A_KSB), *Vsb = (const bf16*)(ws + A_VSB);
    const bf16 *Qd = (const bf16*)(ws + A_QD), *Kd = (const bf16*)(ws + A_KD), *Vd = (const bf16*)(ws + A_VD);
    bf16* Osb = (bf16*)((unsigned char*)A.out + O_OSB); bf16* Od = (bf16*)((unsigned char*)A.out + O_OD);
    constexpr int N_DIL = NB * 4 * 16 * 16, N_SB = NB * SBH * (SEQ / 32);
    for (int t = F.gw; t < N_DIL + N_SB; t += F.NGW) {
        if (t < N_DIL) dil_task(Qd, Kd, Vd, Od, t, vl, F.lane);
        else sb_task(Qsb, Ksb, Vsb, Osb, t - N_DIL, vl, F.lane);
    }
}

__device__ __forceinline__ unsigned sortable(float f) { const unsigned u = __float_as_uint(f); return u ^ ((unsigned)((int)u >> 31) | 0x80000000u); }
__device__ __forceinline__ float unsortable(unsigned s) { const unsigned u = (s & 0x80000000u) ? (s ^ 0x80000000u) : ~s; return __uint_as_float(u); }
__device__ __forceinline__ unsigned umax_(unsigned a, unsigned b) { return a > b ? a : b; }

#define CE_(a, b) do { const unsigned hi_ = umax_(a, b), lo_ = umin_(a, b); a = hi_; b = lo_; } while (0)
__device__ __forceinline__ unsigned umin_(unsigned a, unsigned b) { return a < b ? a : b; }
template <int N, int OFF, int TOT> __device__ __forceinline__ void bitonic_sort_desc(unsigned (&v)[TOT]) {
#pragma unroll
    for (int k = 2; k <= N; k <<= 1)
#pragma unroll
        for (int j = k >> 1; j > 0; j >>= 1)
#pragma unroll
            for (int i = 0; i < N; ++i) { const int l = i ^ j; if (l > i) { if ((i & k) == 0) CE_(v[OFF + i], v[OFF + l]); else CE_(v[OFF + l], v[OFF + i]); } }
}
__device__ __forceinline__ void bitonic_merge16_desc(unsigned (&t)[16]) {
#pragma unroll
    for (int j = 8; j > 0; j >>= 1)
#pragma unroll
        for (int i = 0; i < 16; ++i) { const int l = i ^ j; if (l > i) CE_(t[i], t[l]); }
}
__device__ __forceinline__ void merge_top16(unsigned (&out)[16], const unsigned* a, const unsigned* b) {
#pragma unroll
    for (int i = 0; i < 16; ++i) out[i] = umax_(a[i], b[15 - i]);
    bitonic_merge16_desc(out);
}
__device__ __forceinline__ void cross_lane_top16(unsigned (&top)[16]) {
    unsigned t[16];
#pragma unroll
    for (int i = 0; i < 16; ++i) t[i] = umax_(top[i], (unsigned)__shfl_xor((int)top[15 - i], 32));
    bitonic_merge16_desc(t);
#pragma unroll
    for (int i = 0; i < 16; ++i) top[i] = t[i];
}
__device__ __forceinline__ void top16_of_128(unsigned (&key)[64], LAS unsigned* top  , int lane) {
    bitonic_sort_desc<16, 0, 64>(key); bitonic_sort_desc<16, 16, 64>(key); bitonic_sort_desc<16, 32, 64>(key); bitonic_sort_desc<16, 48, 64>(key);
    unsigned m0[16], m1[16], m[16];
    merge_top16(m0, &key[0], &key[16]); merge_top16(m1, &key[32], &key[48]); merge_top16(m, m0, m1);
    cross_lane_top16(m);
#pragma unroll
    for (int it = 0; it < 16; ++it) top[it * 64 + lane] = m[it];
}
__device__ __forceinline__ unsigned pk_lookup(unsigned p0, unsigned p1, unsigned p2, unsigned p3, unsigned a) {
    const unsigned hi = a >> 2; unsigned d = p0; d = hi == 1 ? p1 : d; d = hi == 2 ? p2 : d; d = hi == 3 ? p3 : d;
    return (d >> (8 * (a & 3))) & 0xffu;
}
__device__ __forceinline__ unsigned pack4idx(unsigned t0, unsigned t1, unsigned t2, unsigned t3) { return (127u - (t0 & 127u)) | ((127u - (t1 & 127u)) << 8) | ((127u - (t2 & 127u)) << 16) | ((127u - (t3 & 127u)) << 24); }

__device__ __forceinline__ void topk_task(const bf16* Qp, const bf16* Kb, unsigned short* IDX, float* GATE, int task, int lane, LAS unsigned* tl  ) {
    const int ph = task & 7, t0 = (task >> 3) * 32;
    const int q = lane & 31, hC = lane >> 5;
#ifdef P7_TIME_SORT
    unsigned long long tsort = 0;
#endif
#pragma unroll 1
    for (int half = 0; half < 2; ++half) {
        bf16x8 qf[8];
        { const bf16* qp = Qp + (size_t)(t0 + q) * 2048 + ph * 256 + half * 128 + 8 * hC;
#pragma unroll
          for (int st = 0; st < 8; ++st) qf[st] = *(const GAS bf16x8*)(qp + 16 * st); }
        f32x16 C[4] = {};
        const bf16* kpm[4];
#pragma unroll
        for (int mt = 0; mt < 4; ++mt) { kpm[mt] = Kb + ((size_t)(ph * 2 + half) * 128 + 32 * mt + q) * 128 + 8 * hC; asm volatile("" : "+v"(kpm[mt])); }
        bf16x8 kfa[8], kfb[8];
#define LDK(dst, grp) do { _Pragma("unroll") for (int i_ = 0; i_ < 8; ++i_) dst[i_] = *(const GAS bf16x8*)(kpm[i_ & 3] + 16 * (2 * (grp) + (i_ >> 2))); } while (0)
#define MMK(src, grp) do { _Pragma("unroll") for (int i_ = 0; i_ < 8; ++i_) C[i_ & 3] = __builtin_amdgcn_mfma_f32_32x32x16_bf16(src[i_], qf[2 * (grp) + (i_ >> 2)], C[i_ & 3], 0, 0, 0); } while (0)
#define SB_ __builtin_amdgcn_sched_barrier(0)
        LDK(kfa, 0); LDK(kfb, 1); SB_;
        MMK(kfa, 0); SB_; LDK(kfa, 2); SB_;
        MMK(kfb, 1); SB_; LDK(kfb, 3); SB_;
        MMK(kfa, 2); SB_; MMK(kfb, 3); SB_;
#undef SB_
#undef LDK
#undef MMK
        unsigned key[64];
#pragma unroll
        for (int mt = 0; mt < 4; ++mt)
#pragma unroll
            for (int r = 0; r < 16; ++r) { const int kidx = 32 * mt + (r & 3) + 8 * (r >> 2) + 4 * hC; key[16 * mt + r] = (sortable(C[mt][r]) & ~127u) | (unsigned)(127 - kidx); }
#ifdef P7_TIME_SORT
        const unsigned long long ts0_ = __builtin_amdgcn_s_memrealtime();
#endif
        top16_of_128(key, tl + half * 1024, lane);
#ifdef P7_TIME_SORT
        asm volatile("s_waitcnt lgkmcnt(0)" ::: "memory");
        tsort += __builtin_amdgcn_s_memrealtime() - ts0_;
#endif
    }
    unsigned tops[2][16];
#pragma unroll
    for (int a = 0; a < 16; ++a) { tops[0][a] = tl[a * 64 + lane]; tops[1][a] = tl[1024 + a * 64 + lane]; }
    float s0[16], s1[16];
#pragma unroll
    for (int a = 0; a < 16; ++a) { s0[a] = unsortable(tops[0][a] & ~127u); s1[a] = unsortable(tops[1][a] & ~127u); }
    const unsigned pa0 = pack4idx(tops[0][0], tops[0][1], tops[0][2], tops[0][3]), pa1 = pack4idx(tops[0][4], tops[0][5], tops[0][6], tops[0][7]),
                   pa2 = pack4idx(tops[0][8], tops[0][9], tops[0][10], tops[0][11]), pa3 = pack4idx(tops[0][12], tops[0][13], tops[0][14], tops[0][15]);
    const unsigned pb0 = pack4idx(tops[1][0], tops[1][1], tops[1][2], tops[1][3]), pb1 = pack4idx(tops[1][4], tops[1][5], tops[1][6], tops[1][7]),
                   pb2 = pack4idx(tops[1][8], tops[1][9], tops[1][10], tops[1][11]), pb3 = pack4idx(tops[1][12], tops[1][13], tops[1][14], tops[1][15]);
    unsigned cand[32];
    {
        int n = 0;
#pragma unroll
        for (int a = 0; a < 16; ++a)
#pragma unroll
            for (int bq = 0; bq < 16; ++bq) if ((a + 1) * (bq + 1) <= 16) {
                const unsigned ck = (sortable(s0[a] + s1[bq]) & ~255u) | (unsigned)(a * 16 + bq);
                if (n < 25) cand[n] = ck; else cand[n - 25] = hC ? ck : cand[n - 25];
                ++n; }
#pragma unroll
        for (int i = 25; i < 32; ++i) cand[i] = 0u;
    }
    bitonic_sort_desc<32, 0, 32>(cand);
    unsigned win[16];
#pragma unroll
    for (int i = 0; i < 16; ++i) win[i] = cand[i];
    cross_lane_top16(win);
    float gv[16]; int eid[16]; float gs = 0.f;
    const float vmax = unsortable(win[0] & ~255u);
#pragma unroll
    for (int k = 0; k < 16; ++k) { const unsigned a = (win[k] >> 4) & 15u, bq = win[k] & 15u;
        eid[k] = (int)(pk_lookup(pa0, pa1, pa2, pa3, a) * 128u + pk_lookup(pb0, pb1, pb2, pb3, bq));
        gv[k] = fast_exp2((unsortable(win[k] & ~255u) - vmax) * LOG2E); gs += gv[k]; }
    const float ginv = 1.0f / gs;
#ifdef P7_TIME_SORT
    { const unsigned long long t1_ = __builtin_amdgcn_s_memrealtime(); while (__builtin_amdgcn_s_memrealtime() - t1_ < 4ull * tsort) __builtin_amdgcn_s_sleep(1); }
#endif
    const size_t o = (size_t)(t0 + q) * 128 + ph * 16;
    if (hC == 0) {
#pragma unroll
        for (int k = 0; k < 16; k += 8) *(GAS v4u*)(IDX + o + k) = (v4u){(unsigned)eid[k] | ((unsigned)eid[k + 1] << 16), (unsigned)eid[k + 2] | ((unsigned)eid[k + 3] << 16),
                                                                         (unsigned)eid[k + 4] | ((unsigned)eid[k + 5] << 16), (unsigned)eid[k + 6] | ((unsigned)eid[k + 7] << 16)};
    } else {
#pragma unroll
        for (int k = 0; k < 16; k += 4) *(GAS f32x4*)(GATE + o + k) = (f32x4){gv[k] * ginv, gv[k + 1] * ginv, gv[k + 2] * ginv, gv[k + 3] * ginv};
    }
}

__device__ __forceinline__ float gelu_tanh(float x) {
    const float y2 = 2.0f * 0.7978845608028654f * (x + 0.044715f * x * x * x);
    return x * fast_rcp(1.f + fast_exp2(-y2 * LOG2E));
}
__device__ __forceinline__ void unpack8(const v4u w, float (&f)[8]) { f[0] = bflo(w.x); f[1] = bfhi(w.x); f[2] = bflo(w.y); f[3] = bfhi(w.y); f[4] = bflo(w.z); f[5] = bfhi(w.z); f[6] = bflo(w.w); f[7] = bfhi(w.w); }
__device__ __forceinline__ void h2f8_row(unsigned char* ws, int t, int lane) {
    const bf16* xr = (const bf16*)(ws + A_X1M) + (size_t)t * DM + 16 * lane; const float* sh = (const float*)(ws + WS_MOD) + (size_t)(t >> 13) * NMOD + 3 * DM + 16 * lane;
    const float r2 = ((const float*)(ws + WS_R2))[t];
    float fa[8], fb[8]; unpack8(*(const GAS v4u*)xr, fa); unpack8(*(const GAS v4u*)(xr + 8), fb);
    float h[16];
#pragma unroll
    for (int k = 0; k < 2; ++k) { const f32x4 s0 = *(const GAS f32x4*)(sh + 4 * k), s1 = *(const GAS f32x4*)(sh + 8 + 4 * k);
#pragma unroll
        for (int i = 0; i < 4; ++i) { h[4 * k + i] = fa[4 * k + i] * r2 + s0[i]; h[8 + 4 * k + i] = fb[4 * k + i] * r2 + s1[i]; } }
    unsigned w[4];
#pragma unroll
    for (int j = 0; j < 4; ++j) { int tt = __builtin_amdgcn_cvt_pk_fp8_f32(h[4 * j], h[4 * j + 1], 0, false); tt = __builtin_amdgcn_cvt_pk_fp8_f32(h[4 * j + 2], h[4 * j + 3], tt, true); w[j] = (unsigned)tt; }
    *(GAS v4u*)(ws + A_H2F8 + (size_t)t * DM + 16 * lane) = (v4u){w[0], w[1], w[2], w[3]};
}
__device__ __forceinline__ void unpack_fp8x16(const v4u w, float (&f)[16]) {
#pragma unroll
    for (int j = 0; j < 4; ++j) { const f32x2_t a = __builtin_amdgcn_cvt_pk_f32_fp8((int)w[j], false), b = __builtin_amdgcn_cvt_pk_f32_fp8((int)w[j], true);
        f[4 * j] = a.x; f[4 * j + 1] = a.y; f[4 * j + 2] = b.x; f[4 * j + 3] = b.y; }
}
__device__ __forceinline__ void peer_u_phase(const Args& A, Frame& F) {
    unsigned char* ws = A.ws;
    const int lane = F.lane, x = blockIdx.x & 7, wrk = (blockIdx.x >> 3) * NWAVES + F.wave, nwr = (F.G >> 3) * NWAVES, g = lane >> 3, c = lane & 7;
    const unsigned char* U8 = ws + WS_UB + (size_t)x * (2 * MiB); const unsigned c16 = 16u * c, g32 = 32u * g;
    const unsigned char* X1M = ws + A_X1M + 256 * x; const unsigned char* IDX = ws + A_IDX; const float* R2 = (const float*)(ws + WS_R2);
    bf16* PART = (bf16*)(ws + A_PART) + (size_t)x * TOK * 128;
    const int per = TOK / nwr, tb = wrk * per;
    float sh[16];
    { const float* mod = (const float*)(ws + WS_MOD) + (size_t)(tb >> 13) * NMOD + 3 * DM + 128 * x + 16 * c;
#pragma unroll
      for (int k = 0; k < 4; ++k) { const f32x4 v = *(const GAS f32x4*)(mod + 4 * k); sh[4 * k] = v[0]; sh[4 * k + 1] = v[1]; sh[4 * k + 2] = v[2]; sh[4 * k + 3] = v[3]; } }
    v4u idC[2], idN[2], xC[2], xN[2]; float rC, rN;
#define SLOT_ID(ID, sl) (((ID)[(sl) >> 3][((sl) >> 1) & 3] >> (16 * ((sl) & 1))) & 0xffffu)
#define LD_TOK(ID, XV, RV, T) do { const unsigned char* ib_ = IDX + (size_t)(T) * 256; const unsigned char* xb_ = X1M + (size_t)(T) * (DM * 2); \
        ID[0] = *(const GAS v4u*)(ib_ + g32); ID[1] = *(const GAS v4u*)(ib_ + (g32 + 16u)); \
        XV[0] = *(const GAS v4u*)(xb_ + 2u * c16); XV[1] = *(const GAS v4u*)(xb_ + (2u * c16 + 16u)); RV = R2[T]; } while (0)
#define LD_ROWS(R, ID, H) do { _Pragma("unroll") for (int i = 0; i < 8; ++i) R[i] = *(const GAS v4u*)(U8 + (SLOT_ID(ID, 8 * (H) + i) * 128u + c16)); } while (0)
    LD_TOK(idC, xC, rC, tb);
    v4u R0[8], R1[8];
    LD_ROWS(R0, idC, 0);
    LD_TOK(idN, xN, rN, tb + 1 < TOK ? tb + 1 : tb);
    for (int t = tb; t < tb + per; ++t) {
        LD_ROWS(R1, idC, 1);
        float h2[16];
        { float fa[8], fb[8]; unpack8(xC[0], fa); unpack8(xC[1], fb);
#pragma unroll
          for (int i = 0; i < 8; ++i) { h2[i] = fa[i] * rC + sh[i]; h2[8 + i] = fb[i] * rC + sh[8 + i]; } }
        float p[16];
#pragma unroll
        for (int i = 0; i < 8; ++i) { float f[16]; unpack_fp8x16(R0[i], f); float d = 0.f;
#pragma unroll
            for (int k = 0; k < 16; ++k) d += f[k] * h2[k];
            p[i] = d; }
        LD_ROWS(R0, idN, 0);
#pragma unroll
        for (int i = 0; i < 8; ++i) { float f[16]; unpack_fp8x16(R1[i], f); float d = 0.f;
#pragma unroll
            for (int k = 0; k < 16; ++k) d += f[k] * h2[k];
            p[8 + i] = d; }
        idC[0] = idN[0]; idC[1] = idN[1];
        xC[0] = xN[0]; xC[1] = xN[1]; rC = rN;
        { const int tn = t + 2 < tb + per ? t + 2 : tb + per - 1; LD_TOK(idN, xN, rN, tn); }
        const bool b0 = lane & 1, b1 = lane & 2, b2 = lane & 4;
        float q8[8], q4[4], q2[2];
#pragma unroll
        for (int i = 0; i < 8; ++i) q8[i] = (b0 ? p[8 + i] : p[i]) + __shfl_xor(b0 ? p[i] : p[8 + i], 1);
#pragma unroll
        for (int i = 0; i < 4; ++i) q4[i] = (b1 ? q8[4 + i] : q8[i]) + __shfl_xor(b1 ? q8[i] : q8[4 + i], 2);
#pragma unroll
        for (int i = 0; i < 2; ++i) q2[i] = (b2 ? q4[2 + i] : q4[i]) + __shfl_xor(b2 ? q4[i] : q4[2 + i], 4);
        const int slot = 16 * g + 8 * (lane & 1) + 4 * ((lane >> 1) & 1) + 2 * ((lane >> 2) & 1);
        *(GAS unsigned*)(PART + (size_t)t * 128 + slot) = pk2(q2[0], q2[1]);
    }
#undef LD_TOK
#undef LD_ROWS
#undef SLOT_ID
}
__device__ __forceinline__ void peer_act_phase(const Args& A, Frame& F) {
    unsigned char* ws = A.ws;
    const bf16* PART = (const bf16*)(ws + A_PART); const unsigned short* IDX = (const unsigned short*)(ws + A_IDX); const float* GATE = (const float*)(ws + A_GATE); bf16* ACTG = (bf16*)(ws + A_ACTG);
    const float* UINV = (const float*)(ws + WS_UB + 16 * MiB); const float* VINV = (const float*)(ws + WS_VB + 16 * MiB);
    const size_t n4 = (size_t)TOK * 128 / 4;
    for (size_t i = (size_t)F.vcu * (NWAVES * 64) + F.tid; i < n4; i += (size_t)F.G * NWAVES * 64) {
        f32x4 d = {0.f, 0.f, 0.f, 0.f};
#pragma unroll
        for (int xx = 0; xx < 8; ++xx) { const v2u w = *(const GAS v2u*)(PART + (size_t)xx * TOK * 128 + 4 * i); d[0] += bflo(w.x); d[1] += bfhi(w.x); d[2] += bflo(w.y); d[3] += bfhi(w.y); }
        const v2u ew = *(const GAS v2u*)(IDX + 4 * i); const f32x4 gt = *(const GAS f32x4*)(GATE + 4 * i);
        const unsigned e[4] = {ew.x & 0xffffu, ew.x >> 16, ew.y & 0xffffu, ew.y >> 16};
        float o[4];
#pragma unroll
        for (int k = 0; k < 4; ++k) o[k] = gelu_tanh(d[k] * UINV[e[k]]) * gt[k] * VINV[e[k]];
        *(GAS v2u*)(ACTG + 4 * i) = (v2u){pk2(o[0], o[1]), pk2(o[2], o[3])};
    }
}
__device__ __forceinline__ void peer_v_phase(const Args& A, Frame& F) {
    unsigned char* ws = A.ws;
    const int lane = F.lane, x = blockIdx.x & 7, wrk = (blockIdx.x >> 3) * NWAVES + F.wave, nwr = (F.G >> 3) * NWAVES, g = lane >> 3, c = lane & 7;
    const unsigned char* V8 = ws + WS_VB + (size_t)x * (2 * MiB); const unsigned c16 = 16u * c, g32 = 32u * g;
    const unsigned char* IDX = ws + A_IDX; const unsigned char* ACTG = ws + A_ACTG; unsigned char* POUT = ws + A_POUT + 256 * x;
    const int per = TOK / nwr, tb = wrk * per;
    v4u idC[2], idN[2], aC[2], aN[2];
#define SLOT_ID(ID, sl) (((ID)[(sl) >> 3][((sl) >> 1) & 3] >> (16 * ((sl) & 1))) & 0xffffu)
#define SLOT_ACT(AV, sl) (((sl) & 1) ? bfhi((AV)[(sl) >> 3][((sl) >> 1) & 3]) : bflo((AV)[(sl) >> 3][((sl) >> 1) & 3]))
#define LD_TOK(ID, AV, T) do { const unsigned char* ib_ = IDX + (size_t)(T) * 256; const unsigned char* ab_ = ACTG + (size_t)(T) * 256; \
        ID[0] = *(const GAS v4u*)(ib_ + g32); ID[1] = *(const GAS v4u*)(ib_ + (g32 + 16u)); AV[0] = *(const GAS v4u*)(ab_ + g32); AV[1] = *(const GAS v4u*)(ab_ + (g32 + 16u)); } while (0)
#define LD_ROWS(R, ID, H) do { _Pragma("unroll") for (int i = 0; i < 8; ++i) R[i] = *(const GAS v4u*)(V8 + (SLOT_ID(ID, 8 * (H) + i) * 128u + c16)); } while (0)
    LD_TOK(idC, aC, tb);
    v4u R0[8], R1[8];
    LD_ROWS(R0, idC, 0);
    LD_TOK(idN, aN, tb + 1 < TOK ? tb + 1 : tb);
    for (int t = tb; t < tb + per; ++t) {
        LD_ROWS(R1, idC, 1);
        float acc[16];
#pragma unroll
        for (int d = 0; d < 16; ++d) acc[d] = 0.f;
#pragma unroll
        for (int i = 0; i < 8; ++i) { float f[16]; unpack_fp8x16(R0[i], f); const float a = SLOT_ACT(aC, i);
#pragma unroll
            for (int d = 0; d < 16; ++d) acc[d] += a * f[d]; }
        LD_ROWS(R0, idN, 0);
#pragma unroll
        for (int i = 0; i < 8; ++i) { float f[16]; unpack_fp8x16(R1[i], f); const float a = SLOT_ACT(aC, 8 + i);
#pragma unroll
            for (int d = 0; d < 16; ++d) acc[d] += a * f[d]; }
        idC[0] = idN[0]; idC[1] = idN[1]; aC[0] = aN[0]; aC[1] = aN[1];
        { const int tn = t + 2 < tb + per ? t + 2 : tb + per - 1; LD_TOK(idN, aN, tn); }
#pragma unroll
        for (int d = 0; d < 16; ++d) { float v = acc[d]; v += __shfl_xor(v, 8); v += __shfl_xor(v, 16); v += __shfl_xor(v, 32); acc[d] = v; }
        if (g == 0) { v4u w0, w1; w0.x = pk2(acc[0], acc[1]); w0.y = pk2(acc[2], acc[3]); w0.z = pk2(acc[4], acc[5]); w0.w = pk2(acc[6], acc[7]);
            w1.x = pk2(acc[8], acc[9]); w1.y = pk2(acc[10], acc[11]); w1.z = pk2(acc[12], acc[13]); w1.w = pk2(acc[14], acc[15]);
            unsigned char* o = POUT + (size_t)t * (DM * 2); *(GAS v4u*)(o + 2u * c16) = w0; *(GAS v4u*)(o + (2u * c16 + 16u)) = w1; }
    }
#undef LD_TOK
#undef LD_ROWS
#undef SLOT_ID
#undef SLOT_ACT
}
__device__ __forceinline__ void peer_final(const Args& A, int t, int lane) {
    unsigned char* ws = A.ws;
    const float* mod = (const float*)(ws + WS_MOD) + (size_t)(t >> 13) * NMOD; const bf16* POUT = (const bf16*)(ws + A_POUT);
    float* orow = A.out + (size_t)t * DM;
    f32x4 x2[4]; float s = 0.f;
#pragma unroll
    for (int j = 0; j < 4; ++j) { const int c = 256 * j + 4 * lane; const f32x4 x1 = *(const GAS f32x4*)(orow + c), gt = *(const GAS f32x4*)(mod + 5 * DM + c); const v2u w = *(const GAS v2u*)(POUT + (size_t)t * DM + c);
        f32x4 y; y[0] = x1[0] + gt[0] * bflo(w.x); y[1] = x1[1] + gt[1] * bfhi(w.x); y[2] = x1[2] + gt[2] * bflo(w.y); y[3] = x1[3] + gt[3] * bfhi(w.y);
        x2[j] = y; s += (y[0] * y[0] + y[1] * y[1]) + (y[2] * y[2] + y[3] * y[3]); }
    const float rr = 1.0f / sqrtf(wave_sum(s) * (1.f / DM) + EPS);
#pragma unroll
    for (int j = 0; j < 4; ++j) { const int c = 256 * j + 4 * lane; const f32x4 gf = *(const GAS f32x4*)(A.g_final + c); *(GAS f32x4*)(orow + c) = x2[j] * rr * gf; }
}

#ifndef MK_ONE_LAUNCH
#define MK_ONE_LAUNCH 1
#endif
constexpr int N_PHASES = 12;

__device__ __forceinline__ void biaspq_task(unsigned char* ws, int n, int lane) {
    const bf16* w = (const bf16*)(ws + WS_WPQ) + (size_t)n * DM + 16 * lane;
    float fa[8], fb[8]; unpack8(*(const GAS v4u*)w, fa); unpack8(*(const GAS v4u*)(w + 8), fb);
    float* bias = (float*)(ws + WS_BIASPQ);
#pragma unroll
    for (int b = 0; b < 4; ++b) { const GAS f32x4* sp = (const GAS f32x4*)((const float*)(ws + WS_MOD) + (size_t)b * NMOD + 3 * DM + 16 * lane);
        const f32x4 s0 = sp[0], s1 = sp[1], s2 = sp[2], s3 = sp[3]; float d = 0.f;
#pragma unroll
        for (int i = 0; i < 4; ++i) { d += fa[i] * s0[i]; d += fa[4 + i] * s1[i]; d += fb[i] * s2[i]; d += fb[4 + i] * s3[i]; }
        d = wave_sum(d); if (lane == 0) bias[b * 2048 + n] = d; }
}

__global__ void __launch_bounds__(NWAVES * 64, 2) mk_fwd(Args A) {
    extern __shared__ __attribute__((aligned(16))) unsigned char lds[];
    Frame F;
    F.lds = (LAS unsigned char*)lds;
    F.G = gridDim.x; { const int bx = blockIdx.x; F.vcu = (F.G % 8 == 0) ? (bx % 8) * (F.G / 8) + bx / 8 : bx; }
    F.NGW = F.G * NWAVES;
#define PHASE_BEGIN() do { int t_ = threadIdx.x; asm volatile("" : "+v"(t_)); F.tid = t_; F.lane = t_ & 63; F.wave = __builtin_amdgcn_readfirstlane(t_ >> 6); F.gw = F.vcu * NWAVES + F.wave; } while (0)
    PHASE_BEGIN();
    unsigned char* ws = A.ws;
    const int lo = A.ph_lo, hi = A.ph_hi;
#if MK_ONE_LAUNCH
    volatile LAS unsigned* MISC = (volatile LAS unsigned*)(F.lds + MISC_OFF);
    for (int u = F.tid; u < (LDS_BYTES - RING_BYTES) / 4; u += NWAVES * 64) ((LAS unsigned*)(F.lds + RING_BYTES))[u] = 0u;
    __syncthreads();
    XcdBarrier bar = xcd_barrier_post((unsigned*)(ws + WS_CTL) + CW_BAR, MISC + 8);
#define GRID_BAR() xcd_barrier(bar)
#else
#define GRID_BAR() do {} while (0)
#endif
#ifdef ONLY_PHASE
#define IN(k) ((k) == ONLY_PHASE && lo <= (k) && (k) < hi)
#else
#define IN(k) (lo <= (k) && (k) < hi)
#endif
#define BOTH(k) (IN(k) && IN((k) + 1))
#ifndef REPEAT_MASK
#define REPEAT_MASK 0
#endif
#define REPS(k) ((((REPEAT_MASK) >> (k)) & 1) + 1)

    if (IN(0)) for (int rep = 0; rep < REPS(0); ++rep) { PHASE_BEGIN(); if (rep) GRID_BAR(); p0_prologue(A, F); if (BOTH(0)) GRID_BAR(); }
    if (IN(1)) for (int rep = 0; rep < REPS(1); ++rep) { PHASE_BEGIN(); if (rep) GRID_BAR(); p1_hrows(A, F); if (BOTH(1)) GRID_BAR(); }
    if (IN(2)) for (int rep = 0; rep < REPS(2); ++rep) { PHASE_BEGIN(); if (rep) GRID_BAR();
        pg8::Gemm g{(const bf16*)((unsigned char*)A.out + O_H), (const bf16*)(ws + WS_WIN), TOK, NIN, DM}; pg8::StaticOrder S; S.init(TOK, NIN, F.G, (int)blockIdx.x);
        EpiG1 E{(bf16*)(ws + A_QSB), (bf16*)(ws + A_KSB), (bf16*)(ws + A_VSB), (bf16*)(ws + A_QD), (bf16*)(ws + A_KD), (bf16*)(ws + A_VD), (bf16*)(ws + A_GSB), (bf16*)(ws + A_GD),
                (const float*)(ws + WS_ROPEC), (const float*)(ws + WS_ROPES)};
        pg8::gemm_phase<EpiG1, pg8::StaticOrder, true, true>(F.lds, g, S, E);
        if (BOTH(2)) GRID_BAR();
    }
    if (IN(3)) for (int rep = 0; rep < REPS(3); ++rep) { PHASE_BEGIN(); if (rep) GRID_BAR(); p3_attention(A, F); if (BOTH(3)) GRID_BAR(); }
    if (IN(4)) for (int rep = 0; rep < REPS(4); ++rep) { PHASE_BEGIN(); if (rep) GRID_BAR();
        for (int n = F.gw; n < 2048; n += F.NGW) biaspq_task(ws, n, F.lane);
        __syncthreads();
        {   pg8::Gemm g{(const bf16*)((unsigned char*)A.out + O_OD), (const bf16*)(ws + WS_WDILO), TOK, DM, 256}; pg8::StaticOrder S; S.init(TOK, DM, F.G, (int)blockIdx.x);
            EpiMerge<false> E{(const bf16*)(ws + A_GD), (bf16*)(ws + A_MERGED)};
            pg8::gemm_phase<EpiMerge<false>, pg8::StaticOrder, true, true>(F.lds, g, S, E); }
        asm volatile("s_waitcnt vmcnt(0)" ::: "memory"); __syncthreads();
        {   pg8::Gemm g{(const bf16*)((unsigned char*)A.out + O_OSB), (const bf16*)(ws + WS_WSBO), TOK, DM, 512}; pg8::StaticOrder S; S.init(TOK, DM, F.G, (int)blockIdx.x);
            EpiMerge<true> E{(const bf16*)(ws + A_GSB), (bf16*)(ws + A_MERGED)};
            pg8::gemm_phase<EpiMerge<true>, pg8::StaticOrder, true, true>(F.lds, g, S, E); }
        if (BOTH(4)) GRID_BAR();
    }
    if (IN(5)) for (int rep = 0; rep < REPS(5); ++rep) { PHASE_BEGIN(); if (rep) GRID_BAR();
        pg8::Gemm g{(const bf16*)(ws + A_MERGED), (const bf16*)(ws + WS_WOUT), TOK, DM, DM}; pg8::StaticOrder S; S.init(TOK, DM, F.G, (int)blockIdx.x);
        EpiOut E{A.x, A.out, (bf16*)(ws + A_X1M), (float*)(ws + WS_SSQ), (const float*)(ws + WS_MOD), A.g_ffn};
        pg8::gemm_phase<EpiOut, pg8::StaticOrder, true, true>(F.lds, g, S, E);
        if (BOTH(5)) GRID_BAR();
    }
    if (IN(6)) for (int rep = 0; rep < REPS(6); ++rep) { PHASE_BEGIN(); if (rep) GRID_BAR();
        pg8::Gemm g{(const bf16*)(ws + A_X1M), (const bf16*)(ws + WS_WPQ), TOK, 2048, DM}; pg8::StaticOrder S; S.init(TOK, 2048, F.G, (int)blockIdx.x);
        EpiPq E{(const float*)(ws + WS_SSQ), (const float*)(ws + WS_BIASPQ), (bf16*)(ws + A_QPEER), (float*)(ws + WS_R2)};
        pg8::gemm_phase<EpiPq, pg8::StaticOrder, true, true>(F.lds, g, S, E);
        if (BOTH(6)) GRID_BAR();
    }
    if (IN(7)) for (int rep = 0; rep < REPS(7); ++rep) { PHASE_BEGIN(); if (rep) GRID_BAR();
        for (int t = F.gw; t < (TOK / 32) * 8; t += F.NGW) topk_task((const bf16*)(ws + A_QPEER), (const bf16*)(ws + WS_KEYS), (unsigned short*)(ws + A_IDX), (float*)(ws + A_GATE), t, F.lane, (LAS unsigned*)(F.lds + F.wave * 8192));
        if (BOTH(7)) GRID_BAR();
    }
    if (IN(8)) for (int rep = 0; rep < REPS(8); ++rep) { PHASE_BEGIN(); if (rep) GRID_BAR();
        peer_u_phase(A, F); if (BOTH(8)) GRID_BAR(); }
    if (IN(9)) { PHASE_BEGIN();
#ifdef VALU_PROBE
        { float a0 = F.lane, a1 = a0 + 1, a2 = a0 + 2, a3 = a0 + 3; unsigned w0 = F.tid * 2654435761u, w1 = w0 ^ 0x3c3c3c3cu, w2 = w0 + 77u, w3 = w0 + 99u;
          f32x2_t p0 = {a0, a1}, p1 = {a2, a3}, p2 = {a1, a2}, p3 = {a3, a0};
          for (int it = 0; it < 4096; ++it) {
#if VALU_PROBE == 1
              f32x2_t c0 = __builtin_amdgcn_cvt_pk_f32_fp8((int)w0, false), c1 = __builtin_amdgcn_cvt_pk_f32_fp8((int)w1, true), c2 = __builtin_amdgcn_cvt_pk_f32_fp8((int)w2, false), c3 = __builtin_amdgcn_cvt_pk_f32_fp8((int)w3, true);
              f32x2_t c4 = __builtin_amdgcn_cvt_pk_f32_fp8((int)w0, true), c5 = __builtin_amdgcn_cvt_pk_f32_fp8((int)w1, false), c6 = __builtin_amdgcn_cvt_pk_f32_fp8((int)w2, true), c7 = __builtin_amdgcn_cvt_pk_f32_fp8((int)w3, false);
              w0 ^= __float_as_uint(c0.x) ^ __float_as_uint(c4.y); w1 ^= __float_as_uint(c1.x) ^ __float_as_uint(c5.y); w2 ^= __float_as_uint(c2.x) ^ __float_as_uint(c6.y); w3 ^= __float_as_uint(c3.x) ^ __float_as_uint(c7.y);
#elif VALU_PROBE == 2
              p0 = p0 * p1 + p2; p1 = p1 * p2 + p3; p2 = p2 * p3 + p0; p3 = p3 * p0 + p1; p0 = p0 * p2 + p1; p1 = p1 * p3 + p2; p2 = p2 * p0 + p3; p3 = p3 * p1 + p0;
#else
              a0 = a0 * a1 + a2; a1 = a1 * a2 + a3; a2 = a2 * a3 + a0; a3 = a3 * a0 + a1; a0 = a0 * a2 + a1; a1 = a1 * a3 + a2; a2 = a2 * a0 + a3; a3 = a3 * a1 + a0;
#endif
          }
          if (a0 + a1 + a2 + a3 + p0.x + p1.y + p2.x + p3.y == 1.2345e33f || (w0 ^ w1 ^ w2 ^ w3) == 0x12345u) ((float*)(ws + WS_DUMP))[F.lane] = a0; }
#endif
#ifdef ICACHE_PROBE
        asm volatile(".rept 8000\n s_nop 0\n .endr" ::: "memory");
#endif
        peer_act_phase(A, F); if (BOTH(9)) GRID_BAR(); }
    if (IN(10)) for (int rep = 0; rep < REPS(10); ++rep) { PHASE_BEGIN(); if (rep) GRID_BAR(); peer_v_phase(A, F); if (BOTH(10)) GRID_BAR(); }
    if (IN(11)) { PHASE_BEGIN();
        for (int t = F.gw; t < TOK; t += F.NGW) peer_final(A, t, F.lane);
    }
#undef IN
#undef BOTH
}

extern "C" void kernel_launch(void* const* d_in, const int* in_sizes, int n_in, void* d_out, int out_size, void* d_ws, size_t ws_size, hipStream_t stream) {
    static int grid = 0;
    if (grid == 0) {
        if (n_in != 15 || in_sizes[0] != TOK * DM || out_size != TOK * DM || ws_size < WS_END) { fprintf(stderr, "kernel_launch: unexpected shapes (n_in %d, in0 %d, out %d, ws %zu < %zu)\n", n_in, n_in > 0 ? in_sizes[0] : -1, out_size, ws_size, (size_t)WS_END); grid = -1; return; }
        int dev = 0, cus = 0, per_cu = 0;
        if (hipGetDevice(&dev) != hipSuccess || hipDeviceGetAttribute(&cus, hipDeviceAttributeMultiprocessorCount, dev) != hipSuccess) { grid = -1; return; }
        if (hipFuncSetAttribute((const void*)mk_fwd, hipFuncAttributeMaxDynamicSharedMemorySize, LDS_BYTES) != hipSuccess) { fprintf(stderr, "kernel_launch: hipFuncSetAttribute failed\n"); grid = -1; return; }
        if (hipOccupancyMaxActiveBlocksPerMultiprocessor(&per_cu, (const void*)mk_fwd, NWAVES * 64, LDS_BYTES) != hipSuccess || per_cu < 1) { fprintf(stderr, "kernel_launch: occupancy query says %d\n", per_cu); per_cu = 1; }
        (void)hipGetLastError();
        grid = cus;
    }
    if (grid < 0) return;
    (void)hipMemsetAsync((char*)d_ws + WS_CTL, 0, CTL_ZERO_BYTES, stream);
    Args a{};
    a.x = (const float*)d_in[0]; a.c = (const float*)d_in[1]; a.w_ada = (const float*)d_in[2]; a.b_ada = (const float*)d_in[3]; a.g_mix = (const float*)d_in[4];
    a.w_in = (const float*)d_in[5]; a.w_sb_o = (const float*)d_in[6]; a.w_dil_o = (const float*)d_in[7]; a.w_out = (const float*)d_in[8]; a.g_ffn = (const float*)d_in[9];
    a.w_pq = (const float*)d_in[10]; a.peer_keys = (const float*)d_in[11]; a.peer_u = (const float*)d_in[12]; a.peer_v = (const float*)d_in[13]; a.g_final = (const float*)d_in[14];
    a.out = (float*)d_out; a.ws = (unsigned char*)d_ws;
#if MK_ONE_LAUNCH
    a.ph_lo = 0; a.ph_hi = N_PHASES;
    void* args[] = {&a};
    hipError_t e = hipLaunchCooperativeKernel((const void*)mk_fwd, dim3(grid), dim3(NWAVES * 64), args, LDS_BYTES, stream);
    if (e != hipSuccess) fprintf(stderr, "kernel_launch: cooperative launch failed: %s (grid %d)\n", hipGetErrorString(e), grid);
#else
    for (int p = 0; p < N_PHASES; ++p) { a.ph_lo = p; a.ph_hi = p + 1; hipLaunchKernelGGL(mk_fwd, dim3(grid), dim3(NWAVES * 64), LDS_BYTES, stream, a); }
#endif
}
```

```cpp
#include <hip/hip_runtime.h>
#include <hip/hip_cooperative_groups.h>
#include <cstdio>
#include <cstdint>
namespace pg8 {
#define PG8_LAS __attribute__((address_space(3)))
typedef unsigned short bf16_t;
typedef short bf16x8 __attribute__((ext_vector_type(8)));
typedef float f32x4 __attribute__((ext_vector_type(4)));
typedef unsigned u32x4 __attribute__((ext_vector_type(4)));
constexpr int BM = 256, BK = 64, HALF = 128, HTB = HALF * BK * 2  , STAGE_BYTES = 8 * HTB, NXCD = 8, WGM = 8;

__host__ __device__ __forceinline__ int lds_byte(int r, int c) { const int st = (r >> 4) * 2 + (c >> 5), rr = r & 15, cc = c & 31, ob = rr * 64 + cc * 2; return st * 1024 + (ob ^ (((ob >> 9) & 1) << 5)); }
__host__ __device__ __forceinline__ void stage_rc(int b, int& R, int& C) { const int st = b / 1024, sb = b % 1024, swz = sb ^ (((sb >> 9) & 1) << 5); R = (st >> 1) * 16 + swz / 64; C = (st & 1) * 32 + (swz % 64) / 2; }
__host__ __device__ __forceinline__ int perm32(int rho) { const int n = rho >> 4, i = rho & 15; return 8 * (i >> 2) + 4 * n + (i & 3); }

struct Unit { int pm, pn; };
struct Gemm { const bf16_t* A; const bf16_t* Bt; int M, N, K; };

struct StaticOrder {
    int nM, nN, nwg, G, c;
    __host__ __device__ void init(int M, int N, int G_, int c_) { nM = M / BM; nN = N / BM; nwg = nM * nN; G = G_; c = c_; }
    __host__ __device__ bool next(int i, Unit& u) const {
        const long L = (long)i * G + c; if (L >= nwg) return false;
        int wgid = (int)L; { const int q = nwg / NXCD, r = nwg % NXCD, xcd = wgid % NXCD, off = wgid / NXCD; wgid = (xcd < r ? xcd * (q + 1) : r * (q + 1) + (xcd - r) * q) + off; }
        const int nig = WGM * nN, gid = wgid / nig, fm = gid * WGM, gsz = (nM - fm) < WGM ? (nM - fm) : WGM;
        u.pm = fm + ((wgid % nig) % gsz); u.pn = (wgid % nig) / gsz; return true;
    }
    __device__ __forceinline__ void a_ready(const Unit&) const {}
    __device__ __forceinline__ void done(const Unit&) const {}
};

__device__ __forceinline__ unsigned cvt_pk_bf16(float lo, float hi) { unsigned r; asm volatile("v_cvt_pk_bf16_f32 %0, %1, %2" : "=v"(r) : "v"(lo), "v"(hi)); return r; }
template <class Epi, class Sched, bool ALIGN_EPI = false, bool SP2 = false>
__device__ __forceinline__ void gemm_phase(PG8_LAS unsigned char* lds, const Gemm g, const Sched& S, const Epi& E) {
    int tid_ = threadIdx.x; asm volatile("" : "+v"(tid_));
    const int tid = tid_, wid = __builtin_amdgcn_readfirstlane(tid >> 6), lane = tid & 63, wr = wid >> 2, wc = wid & 3, fr = lane & 15, fq = lane >> 4;
    const int K = g.K, nt = K / BK;
    unsigned voffA[2], voffB[2];
#pragma unroll
    for (int i = 0; i < 2; ++i) { int R, C; stage_rc(tid * 16 + i * 8192, R, C); const int Rb = Epi::PERM ? ((R & ~31) + perm32(R & 31)) : R;
        voffA[i] = (unsigned)(R * K + C) * 2u; voffB[i] = (unsigned)(Rb * K + C) * 2u; }
    const size_t kstep = (size_t)(BK * 2);
    const size_t hstep = (size_t)HALF * K * 2;
    const size_t tstep = 2 * hstep;
    const unsigned ldsw = (unsigned)wid * 1024u;
    const int aoff = lds_byte(wr * 64 + fr, fq * 8), boff = lds_byte(wc * 32 + fr, fq * 8);
#define PG8_SA(b, h) (((b) * 2 + (h)) * HTB)
#define PG8_SB(b, h) ((4 + (b) * 2 + (h)) * HTB)
#define PG8_STAGE(bufoff, gbase, voff) do { _Pragma("unroll") for (int _i = 0; _i < 2; ++_i) \
        __builtin_amdgcn_global_load_lds((const unsigned*)((const char*)(gbase) + (voff)[_i]), (PG8_LAS unsigned*)(lds + (bufoff) + ldsw + _i * 8192), 16, 0, 0); } while (0)
#define PG8_LDA(dst, b, h) do { _Pragma("unroll") for (int m = 0; m < 4; ++m) _Pragma("unroll") for (int k = 0; k < 2; ++k) dst[m][k] = *(const PG8_LAS bf16x8*)(lds + PG8_SA(b, h) + aoff + m * 2048 + k * 1024); } while (0)
#define PG8_LDB(dst, b, h) do { _Pragma("unroll") for (int n = 0; n < 2; ++n) _Pragma("unroll") for (int k = 0; k < 2; ++k) dst[n][k] = *(const PG8_LAS bf16x8*)(lds + PG8_SB(b, h) + boff + n * 2048 + k * 1024); } while (0)
#define PG8_MMA(ai, bj, At, Bt) do { __builtin_amdgcn_s_setprio(1); _Pragma("unroll") for (int m = 0; m < 4; ++m) _Pragma("unroll") for (int n = 0; n < 2; ++n) _Pragma("unroll") for (int k = 0; k < 2; ++k) \
        acc[ai][bj][m][n] = __builtin_amdgcn_mfma_f32_16x16x32_bf16(Bt[n][k], At[m][k], acc[ai][bj][m][n], 0, 0, 0); __builtin_amdgcn_s_setprio(0); } while (0)
#define PG8_WAIT_V(n) asm volatile("s_waitcnt vmcnt(" #n ")" ::: "memory")
#define PG8_WAIT_L(n) asm volatile("s_waitcnt lgkmcnt(" #n ")" ::: "memory")
#define PG8_BAR __builtin_amdgcn_s_barrier()
#define PG8_SCHED __builtin_amdgcn_sched_barrier(0)
    Unit cur, nxt; int ui = 0;
    if (!S.next(0, cur)) return;
    f32x4 acc[2][2][4][2];
#pragma unroll
    for (int a = 0; a < 2; ++a)
#pragma unroll
        for (int b = 0; b < 2; ++b)
#pragma unroll
            for (int m = 0; m < 4; ++m)
#pragma unroll
                for (int n = 0; n < 2; ++n) acc[a][b][m][n] = (f32x4){0.f, 0.f, 0.f, 0.f};
    bf16x8 At[4][2], B0[2][2], B1[2][2];
    const char* cA = (const char*)g.A + (size_t)cur.pm * tstep; const char* cB = (const char*)g.Bt + (size_t)cur.pn * tstep;
    S.a_ready(cur);
    if constexpr (SP2) {
        PG8_STAGE(PG8_SB(0, 0), cB, voffB); PG8_STAGE(PG8_SB(0, 1), cB + hstep, voffB); PG8_STAGE(PG8_SA(0, 0), cA, voffA); PG8_STAGE(PG8_SA(0, 1), cA + hstep, voffA);
        if (wr == 1) PG8_BAR;
        PG8_WAIT_V(2); PG8_BAR;
        PG8_STAGE(PG8_SB(1, 0), cB + kstep, voffB); PG8_STAGE(PG8_SA(1, 0), cA + kstep, voffA); PG8_STAGE(PG8_SB(1, 1), cB + hstep + kstep, voffB);
        PG8_WAIT_V(6); PG8_BAR;
    } else {
        PG8_STAGE(PG8_SB(0, 0), cB, voffB); PG8_STAGE(PG8_SA(0, 0), cA, voffA); PG8_STAGE(PG8_SB(0, 1), cB + hstep, voffB); PG8_STAGE(PG8_SA(0, 1), cA + hstep, voffA);
        if (wr == 1) PG8_BAR;
        PG8_WAIT_V(4); PG8_BAR;
        PG8_STAGE(PG8_SB(1, 0), cB + kstep, voffB); PG8_STAGE(PG8_SA(1, 0), cA + kstep, voffA); PG8_STAGE(PG8_SB(1, 1), cB + hstep + kstep, voffB);
        PG8_WAIT_V(6); PG8_BAR;
    }
    for (;;) {
        const bool has_next = S.next(ui + 1, nxt);
        const char* nA = has_next ? (const char*)g.A + (size_t)nxt.pm * tstep : cA; const char* nB = has_next ? (const char*)g.Bt + (size_t)nxt.pn * tstep : cB;
        for (int t = 0; t < nt; t += 2) {
            const bool last = (t == nt - 2);
            const char* a1 = cA + (size_t)(t + 1) * kstep;
            const char* a2 = last ? nA : cA + (size_t)(t + 2) * kstep; const char* b2 = last ? nB : cB + (size_t)(t + 2) * kstep;
            const char* a3 = a2 + kstep; const char* b3 = b2 + kstep;
            if (last && has_next) S.a_ready(nxt);
            if constexpr (SP2) {
            PG8_LDB(B0, 0, 0); PG8_LDB(B1, 0, 1); PG8_SCHED; PG8_LDA(At, 0, 0); PG8_STAGE(PG8_SA(1, 1), a1 + hstep, voffA);
            PG8_WAIT_V(8); PG8_WAIT_L(0); PG8_BAR; PG8_MMA(0, 0, At, B0); PG8_MMA(0, 1, At, B1); PG8_BAR; PG8_SCHED;
            PG8_LDA(At, 0, 1); PG8_STAGE(PG8_SB(0, 0), b2, voffB); PG8_STAGE(PG8_SB(0, 1), b2 + hstep, voffB); PG8_STAGE(PG8_SA(0, 0), a2, voffA);
            PG8_WAIT_V(8); PG8_WAIT_L(0); PG8_BAR; PG8_MMA(1, 0, At, B0); PG8_MMA(1, 1, At, B1); PG8_BAR; PG8_SCHED;
            PG8_LDB(B0, 1, 0); PG8_LDB(B1, 1, 1); PG8_SCHED; PG8_LDA(At, 1, 0); PG8_STAGE(PG8_SA(0, 1), a2 + hstep, voffA);
            PG8_WAIT_V(8); PG8_WAIT_L(0); PG8_BAR; PG8_MMA(0, 0, At, B0); PG8_MMA(0, 1, At, B1); PG8_BAR; PG8_SCHED;
            PG8_LDA(At, 1, 1); PG8_STAGE(PG8_SB(1, 0), b3, voffB); PG8_STAGE(PG8_SB(1, 1), b3 + hstep, voffB); PG8_STAGE(PG8_SA(1, 0), a3, voffA);
            PG8_WAIT_V(8); PG8_WAIT_L(0); PG8_BAR; PG8_MMA(1, 0, At, B0); PG8_MMA(1, 1, At, B1); PG8_BAR; PG8_SCHED;
            } else {
            PG8_LDB(B0, 0, 0); PG8_SCHED; PG8_LDA(At, 0, 0); PG8_STAGE(PG8_SA(1, 1), a1 + hstep, voffA);
            PG8_WAIT_L(8); PG8_BAR; PG8_WAIT_L(0); PG8_MMA(0, 0, At, B0); PG8_BAR; PG8_SCHED;
            PG8_LDB(B1, 0, 1); PG8_STAGE(PG8_SB(0, 0), b2, voffB);
            PG8_BAR; PG8_WAIT_L(0); PG8_MMA(0, 1, At, B1); PG8_BAR;
            PG8_LDA(At, 0, 1); PG8_STAGE(PG8_SA(0, 0), a2, voffA);
            PG8_BAR; PG8_WAIT_L(0); PG8_MMA(1, 0, At, B0); PG8_BAR; PG8_SCHED;
            PG8_STAGE(PG8_SB(0, 1), b2 + hstep, voffB);
            PG8_WAIT_V(6); PG8_BAR; PG8_MMA(1, 1, At, B1); PG8_BAR;
            PG8_LDB(B0, 1, 0); PG8_SCHED; PG8_LDA(At, 1, 0); PG8_STAGE(PG8_SA(0, 1), a2 + hstep, voffA);
            PG8_WAIT_L(8); PG8_BAR; PG8_WAIT_L(0); PG8_MMA(0, 0, At, B0); PG8_BAR; PG8_SCHED;
            PG8_LDB(B1, 1, 1); PG8_STAGE(PG8_SB(1, 0), b3, voffB);
            PG8_BAR; PG8_WAIT_L(0); PG8_MMA(0, 1, At, B1); PG8_BAR;
            PG8_LDA(At, 1, 1); PG8_STAGE(PG8_SA(1, 0), a3, voffA);
            PG8_BAR; PG8_WAIT_L(0); PG8_MMA(1, 0, At, B0); PG8_BAR; PG8_SCHED;
            PG8_STAGE(PG8_SB(1, 1), b3 + hstep, voffB);
            PG8_WAIT_V(6); PG8_BAR; PG8_MMA(1, 1, At, B1); PG8_BAR;
            }
        }
        if constexpr (ALIGN_EPI) { if (wr == 0) PG8_BAR; }
        if constexpr (!Epi::AFTER_DRAIN) { E(acc, cur, wr, wc, fr, fq); S.done(cur); }
        if (!has_next) break;
#pragma unroll
        for (int a = 0; a < 2; ++a)
#pragma unroll
            for (int b = 0; b < 2; ++b)
#pragma unroll
                for (int m = 0; m < 4; ++m)
#pragma unroll
                    for (int n = 0; n < 2; ++n) acc[a][b][m][n] = (f32x4){0.f, 0.f, 0.f, 0.f};
        cur = nxt; cA = nA; cB = nB; ++ui;
        if constexpr (ALIGN_EPI) { if (wr == 1) PG8_BAR; }
    }
    PG8_WAIT_V(0);
    if constexpr (!ALIGN_EPI) { if (wr == 0) PG8_BAR; }
    PG8_BAR;
    if constexpr (Epi::AFTER_DRAIN) { E.fused(acc, cur, wr, wc, fr, fq, lds, wid, lane); S.done(cur); }
#undef PG8_SA
#undef PG8_SB
#undef PG8_STAGE
#undef PG8_LDA
#undef PG8_LDB
#undef PG8_MMA
#undef PG8_WAIT_V
#undef PG8_WAIT_L
#undef PG8_BAR
#undef PG8_SCHED
}
}

#define GAS __attribute__((address_space(1)))
#define LAS __attribute__((address_space(3)))
typedef unsigned short bf16;
typedef unsigned v4u __attribute__((ext_vector_type(4)));
typedef unsigned v2u __attribute__((ext_vector_type(2)));
typedef float f32x4 __attribute__((ext_vector_type(4)));
typedef float f32x16 __attribute__((ext_vector_type(16)));
typedef short bf16x8 __attribute__((ext_vector_type(8)));
typedef short s16x4 __attribute__((ext_vector_type(4)));

constexpr int NWAVES = 8;
constexpr int NB = 4, SEQ = 8192, DM = 1024, TOK = NB * SEQ;
constexpr int NIN = 5888;
constexpr int SBH = 8, DILH = 12;
constexpr int NMOD = 6 * DM;
constexpr int KSPLIT = 16;
constexpr float EPS = 1e-6f;
constexpr float LOG2E = 1.4426950408889634f;
constexpr float C2 = 0.125f * LOG2E;
constexpr int PEER_E = 16384;

constexpr size_t MiB = 1u << 20;
constexpr size_t WS_CTL = 0, CTL_ZERO_BYTES = 1 * MiB;
constexpr size_t WS_MODP = 1 * MiB;
constexpr size_t WS_MOD = 2 * MiB + 512 * 1024;
constexpr size_t WS_BIASPQ = 2 * MiB + 768 * 1024;
constexpr size_t WS_ROPEC = 3 * MiB, WS_ROPES = 4 * MiB;
constexpr size_t WS_SSQ = 5 * MiB;
constexpr size_t WS_KEYS = 7 * MiB;
constexpr size_t WS_WIN = 8 * MiB;
constexpr size_t WS_WSBO = 20 * MiB;
constexpr size_t WS_WDILO = 21 * MiB;
constexpr size_t WS_WOUT = 22 * MiB;
constexpr size_t WS_WPQ = 24 * MiB;
constexpr size_t WS_UB = 32 * MiB, WS_VB = 64 * MiB;
constexpr size_t WS_ACT = 96 * MiB;
constexpr size_t A_QSB = WS_ACT, A_KSB = WS_ACT + 32 * MiB, A_VSB = WS_ACT + 64 * MiB;
constexpr size_t A_QD = WS_ACT + 96 * MiB, A_KD = WS_ACT + 144 * MiB, A_VD = WS_ACT + 192 * MiB;
constexpr size_t A_GSB = WS_ACT + 240 * MiB, A_GD = WS_ACT + 304 * MiB;
constexpr size_t A_MERGED = WS_ACT;
constexpr size_t A_X1M = WS_ACT + 64 * MiB;
constexpr size_t A_QPEER = WS_ACT + 128 * MiB;
constexpr size_t A_IDX = WS_ACT + 256 * MiB;
constexpr size_t A_GATE = WS_ACT + 272 * MiB;
constexpr size_t A_ACTG = WS_ACT + 288 * MiB;
constexpr size_t A_PART = WS_ACT + 128 * MiB;
constexpr size_t A_H2F8 = WS_ACT + 304 * MiB;
constexpr size_t WS_DUMP = 7 * MiB + 768 * 1024;
constexpr size_t WS_R2 = 7 * MiB + 512 * 1024;
constexpr size_t A_POUT = WS_ACT;
constexpr size_t WS_END = WS_ACT + 368 * MiB;
constexpr size_t O_H = 0, O_OSB = 64 * MiB, O_OD = 96 * MiB;

constexpr int CW_BAR = 4096;

constexpr int RING_BYTES = 131072;
constexpr int MISC_OFF = RING_BYTES + 320;
constexpr int LDS_BYTES = 147456;

#define RLX_AGENT __ATOMIC_RELAXED, __HIP_MEMORY_SCOPE_AGENT
__device__ __forceinline__ unsigned f2bf(float f) { unsigned u = __builtin_bit_cast(unsigned, f); return (u + 0x7fffu + ((u >> 16) & 1u)) >> 16; }
typedef float f32x2_t __attribute__((ext_vector_type(2))); typedef __bf16 bf16x2_t __attribute__((ext_vector_type(2)));
__device__ __forceinline__ unsigned pk2(float lo, float hi) { f32x2_t v = {lo, hi}; bf16x2_t b = __builtin_convertvector(v, bf16x2_t); return __builtin_bit_cast(unsigned, b); }
__device__ __forceinline__ float bflo(unsigned w) { return __uint_as_float(w << 16); }
__device__ __forceinline__ float bfhi(unsigned w) { return __uint_as_float(w & 0xffff0000u); }
__device__ __forceinline__ float wave_sum(float v) {
#pragma unroll
    for (int o = 1; o < 64; o <<= 1) v += __shfl_xor(v, o);
    return v;
}
__device__ __forceinline__ float fast_exp2(float x) { return __builtin_amdgcn_exp2f(x); }
__device__ __forceinline__ float fast_log2(float x) { return __builtin_amdgcn_logf(x); }
__device__ __forceinline__ float fast_rcp(float x) { return __builtin_amdgcn_rcpf(x); }
__device__ __forceinline__ float sigmoidf_(float x) { return fast_rcp(1.f + fast_exp2(-x * LOG2E)); }
#define XB_TMO      128
#define XB_XCNT(j)  (256  + 64 * (j))
#define XB_XSUB(j)  (1280 + 64 * (j))
#define XB_XGEN(j)  (2304 + 64 * (j))
#define XB_TOP      3328
#define XB_TOPGEN   3392
#define XCD_BAR_WORDS 3456
#define XB_SPIN_CAP (1u << 18)

__device__ __forceinline__ unsigned xb_ld(unsigned* p)              { return __hip_atomic_load(p, __ATOMIC_RELAXED, __HIP_MEMORY_SCOPE_AGENT); }
__device__ __forceinline__ unsigned xb_add(unsigned* p, unsigned v) { return __hip_atomic_fetch_add(p, v, __ATOMIC_RELAXED, __HIP_MEMORY_SCOPE_AGENT); }
__device__ __forceinline__ unsigned xb_xcc_id() { return (unsigned)__builtin_amdgcn_s_getreg((3 << 11) | 20) & 0xFu; }
#define XB_SPIN(cond, bar) do { unsigned _sp = 0; while (cond) { __builtin_amdgcn_s_sleep(1); \
    if ((++_sp & 255u) == 0u) { if (xb_ld(&(bar)[XB_TMO])) break; if (_sp > XB_SPIN_CAP) { atomicAdd(&(bar)[XB_TMO], 1u); break; } } } } while (0)

struct XcdBarrier {
    unsigned* bar; unsigned x;
    volatile LAS unsigned* st;
};

__device__ __forceinline__ XcdBarrier xcd_barrier_post(unsigned* bar, volatile LAS unsigned* st) {
    XcdBarrier b; b.bar = bar; b.x = xb_xcc_id(); b.st = st;
    if (threadIdx.x == 0) (void)xb_add(&bar[XB_XCNT(b.x)], 1u);
    return b;
}
__device__ __forceinline__ void xcd_barrier_complete(unsigned* bar, unsigned x, unsigned& nloc, unsigned& nx) {
    const unsigned G = gridDim.x * gridDim.y * gridDim.z;
    unsigned sum, cnt, mine, sp = 0u;
    for (;;) {
        sum = 0u; cnt = 0u; mine = 0u;
#pragma unroll
        for (unsigned j = 0; j < 16; ++j) { const unsigned c = xb_ld(&bar[XB_XCNT(j)]); sum += c; cnt += (c > 0u) ? 1u : 0u; mine = (j == x) ? c : mine; }
        if (sum == G) break;
        __builtin_amdgcn_s_sleep(1);
        if ((++sp & 255u) == 0u) { if (xb_ld(&bar[XB_TMO])) break; if (sp > XB_SPIN_CAP) { atomicAdd(&bar[XB_TMO], 1u); break; } }
    }
    nloc = mine > 0u ? mine : 1u; nx = cnt > 0u ? cnt : 1u;
}

__device__ __forceinline__ void xcd_barrier(const XcdBarrier& b) {
    asm volatile("s_waitcnt vmcnt(0)" ::: "memory");
    __syncthreads();
    if (threadIdx.x == 0) {
        unsigned* bar = b.bar;
        __builtin_amdgcn_s_waitcnt(0);
        unsigned nloc = b.st[0], nx = b.st[1];
        if (nloc == 0u) { xcd_barrier_complete(bar, b.x, nloc, nx); b.st[0] = nloc; b.st[1] = nx; }
        const unsigned old = xb_add(&bar[XB_XSUB(b.x)], 1u);
        const unsigned gen = old / nloc;
        if (old + 1u == (gen + 1u) * nloc) {
            __builtin_amdgcn_fence(__ATOMIC_RELEASE, "agent");
            asm volatile("s_waitcnt vmcnt(0)" ::: "memory");
            const unsigned og = xb_add(&bar[XB_TOP], 1u);
            const unsigned tg = og / nx;
            if (og + 1u == (tg + 1u) * nx) xb_add(&bar[XB_TOPGEN], 1u);
            else XB_SPIN(xb_ld(&bar[XB_TOPGEN]) == tg, bar);
            __builtin_amdgcn_fence(__ATOMIC_ACQUIRE, "agent");
            xb_add(&bar[XB_XGEN(b.x)], 1u);
            asm volatile("s_waitcnt vmcnt(0)" ::: "memory");
        } else {
            XB_SPIN(xb_ld(&bar[XB_XGEN(b.x)]) == gen, bar);
            __builtin_amdgcn_fence(__ATOMIC_ACQUIRE, "agent");
            asm volatile("s_waitcnt vmcnt(0)" ::: "memory");
        }
    }
    __syncthreads();
}

struct Args {
    const float* x; const float* c; const float* w_ada; const float* b_ada; const float* g_mix; const float* w_in; const float* w_sb_o; const float* w_dil_o;
    const float* w_out; const float* g_ffn; const float* w_pq; const float* peer_keys; const float* peer_u; const float* peer_v; const float* g_final;
    float* out; unsigned char* ws; int ph_lo, ph_hi;
};
struct Frame {
    LAS unsigned char* lds;
    int tid, lane, wave, vcu, G, gw, NGW;
};

__device__ __forceinline__ int win_row(int ncol) {
    const int tile = ncol >> 8;
    if (tile >= 6 && tile < 12) { const int d = ncol & 63; const int j = (d & 31) >> 2, i = (d & 3) + ((d >> 5) << 2); return (ncol & ~63) + 8 * j + i; }
    return ncol;
}
template <bool MAPWIN>
__device__ __forceinline__ void p0_transpose_item(const float* W, int K, int N, bf16* WT, LAS float* scr, int item, int lane) {
    const int nblk = N / 32, kb = item / nblk, nb = item % nblk, k0 = 64 * kb, n0 = 32 * nb;
#pragma unroll 8
    for (int i = 0; i < 32; ++i) { const int kk = 2 * i + (lane >> 5); scr[kk * 33 + (lane & 31)] = W[(size_t)(k0 + kk) * N + n0 + (lane & 31)]; }
    asm volatile("s_waitcnt lgkmcnt(0)" ::: "memory");
    const int c = lane & 7;
#pragma unroll
    for (int j = 0; j < 4; ++j) { const int n = (lane >> 3) + 8 * j; const LAS float* s = scr + (8 * c) * 33 + n;
        v4u o; o.x = pk2(s[0 * 33], s[1 * 33]); o.y = pk2(s[2 * 33], s[3 * 33]); o.z = pk2(s[4 * 33], s[5 * 33]); o.w = pk2(s[6 * 33], s[7 * 33]);
        const int rowo = MAPWIN ? win_row(n0 + n) : (n0 + n);
        *(GAS v4u*)(WT + (size_t)rowo * K + k0 + 8 * c) = o; }
    asm volatile("s_waitcnt lgkmcnt(0)" ::: "memory");
}
__device__ __forceinline__ void cvt_row_1024(const float* src, bf16* dst, int lane) {
    const GAS f32x4* s = (const GAS f32x4*)src + lane; GAS v2u* d = (GAS v2u*)dst + lane;
    f32x4 v[4];
#pragma unroll
    for (int j = 0; j < 4; ++j) v[j] = s[64 * j];
#pragma unroll
    for (int j = 0; j < 4; ++j) { v2u o; o.x = pk2(v[j].x, v[j].y); o.y = pk2(v[j].z, v[j].w); d[64 * j] = o; }
}
template <bool SLICED>
__device__ __forceinline__ void cvt_row_fp8(const float* src, unsigned char* dst, float* inv, int e, int lane) {
    const GAS f32x4* s = (const GAS f32x4*)src + lane;
    f32x4 v[4]; float m = 0.f;
#pragma unroll
    for (int j = 0; j < 4; ++j) { v[j] = s[64 * j]; m = fmaxf(m, fmaxf(fmaxf(fabsf(v[j].x), fabsf(v[j].y)), fmaxf(fabsf(v[j].z), fabsf(v[j].w)))); }
#pragma unroll
    for (int o = 1; o < 64; o <<= 1) m = fmaxf(m, __shfl_xor(m, o));
    m = fmaxf(m, 1e-30f);
    const int ex = (int)((__float_as_uint(m) >> 23) & 0xff) - 127;
    const float scale = __uint_as_float((unsigned)(127 + 7 - ex) << 23);
    const float iscale = __uint_as_float((unsigned)(127 - 7 + ex) << 23);
    unsigned w[4];
#pragma unroll
    for (int j = 0; j < 4; ++j) { int t = __builtin_amdgcn_cvt_pk_fp8_f32(v[j].x * scale, v[j].y * scale, 0, false); t = __builtin_amdgcn_cvt_pk_fp8_f32(v[j].z * scale, v[j].w * scale, t, true); w[j] = (unsigned)t; }
    if (!SLICED) { *(GAS v4u*)(dst + (size_t)e * 1024 + 16 * lane) = (v4u){w[0], w[1], w[2], w[3]}; }
    else {
#pragma unroll
        for (int j = 0; j < 4; ++j) *(GAS unsigned*)(dst + (size_t)(2 * j + (lane >> 5)) * (2 * MiB) + (size_t)e * 128 + 4 * (lane & 31)) = w[j]; }
    if (lane == 0) inv[e] = iscale;
}
__device__ __forceinline__ void sincos_d(double a, float& sn, float& cs) {
    const double TWO_PI = 6.283185307179586476925286766559;
    const double k = __builtin_rint(a / TWO_PI); const double r = a - k * TWO_PI; const double r2 = r * r;
    double ts = 1.0, tc = 1.0, ss = 1.0, cc = 1.0;
#pragma unroll
    for (int n = 1; n <= 14; ++n) { tc = -tc * r2 / (double)((2 * n - 1) * (2 * n)); ts = -ts * r2 / (double)((2 * n) * (2 * n + 1)); cc += tc; ss += ts; }
    sn = (float)(r * ss); cs = (float)cc;
}

__device__ __forceinline__ void p0_prologue(const Args& A, Frame& F) {
    unsigned char* ws = A.ws;
    LAS float* scr = (LAS float*)(F.lds + F.wave * 16384);
    const int lane = F.lane;
    constexpr int I_MOD = KSPLIT * 24;
    constexpr int I_WIN = (DM / 64) * (NIN / 32);
    constexpr int I_SBO = (512 / 64) * (DM / 32), I_DILO = (256 / 64) * (DM / 32), I_OUT = (DM / 64) * (DM / 32), I_PQ = (DM / 64) * (2048 / 32);
    constexpr int I_KEYS = 256, I_TAB = 2 * PEER_E, I_ROPE = SEQ * 32 / 64;
    constexpr int NITEMS = I_MOD + I_WIN + I_SBO + I_DILO + I_OUT + I_PQ + I_KEYS + I_TAB + I_ROPE;
    for (int it = F.gw; it < NITEMS; it += F.NGW) {
        int r = it;
        if (r < I_MOD) {
            const int ks = r / 24, cc = r % 24, col = 256 * cc + 4 * lane, k0 = 64 * ks;
            float sv[4];
#pragma unroll
            for (int b = 0; b < 4; ++b) { const float cv = A.c[b * DM + k0 + lane]; sv[b] = cv * sigmoidf_(cv); }
            f32x4 acc[4];
#pragma unroll
            for (int b = 0; b < 4; ++b) acc[b] = (f32x4){0.f, 0.f, 0.f, 0.f};
            const GAS f32x4* wp = (const GAS f32x4*)(A.w_ada + (size_t)k0 * NMOD + col);
#pragma unroll 8
            for (int kk = 0; kk < 64; ++kk) { const f32x4 w4 = wp[(size_t)kk * (NMOD / 4)];
#pragma unroll
                for (int b = 0; b < 4; ++b) { const float s = __uint_as_float(__builtin_amdgcn_readlane(__float_as_uint(sv[b]), kk)); acc[b] += w4 * s; } }
            float* mp = (float*)(ws + WS_MODP);
#pragma unroll
            for (int b = 0; b < 4; ++b) *(GAS f32x4*)(mp + ((size_t)(ks * 4 + b)) * NMOD + col) = acc[b];
            continue;
        }
        r -= I_MOD;
        if (r < I_WIN) { p0_transpose_item<true>(A.w_in, DM, NIN, (bf16*)(ws + WS_WIN), scr, r, lane); continue; } r -= I_WIN;
        if (r < I_SBO) { p0_transpose_item<false>(A.w_sb_o, 512, DM, (bf16*)(ws + WS_WSBO), scr, r, lane); continue; } r -= I_SBO;
        if (r < I_DILO) { p0_transpose_item<false>(A.w_dil_o, 256, DM, (bf16*)(ws + WS_WDILO), scr, r, lane); continue; } r -= I_DILO;
        if (r < I_OUT) { p0_transpose_item<false>(A.w_out, DM, DM, (bf16*)(ws + WS_WOUT), scr, r, lane); continue; } r -= I_OUT;
        if (r < I_PQ) { p0_transpose_item<false>(A.w_pq, DM, 2048, (bf16*)(ws + WS_WPQ), scr, r, lane); continue; } r -= I_PQ;
        if (r < I_KEYS) { cvt_row_1024(A.peer_keys + (size_t)r * 1024, (bf16*)(ws + WS_KEYS) + (size_t)r * 1024, lane); continue; } r -= I_KEYS;
        if (r < I_TAB) { if (r < PEER_E) cvt_row_fp8<true>(A.peer_u + (size_t)r * 1024, ws + WS_UB, (float*)(ws + WS_UB + 16 * MiB), r, lane);
                         else cvt_row_fp8<true>(A.peer_v + (size_t)(r - PEER_E) * 1024, ws + WS_VB, (float*)(ws + WS_VB + 16 * MiB), r - PEER_E, lane); continue; } r -= I_TAB;
        {
            const int idx = r * 64 + lane, s = idx >> 5, j = idx & 31;
            const float inv = (float)exp2(-(double)j * (13.287712379549449 / 32.0));
            const float ang = (float)s * inv;
            float sn, cs; sincos_d((double)ang, sn, cs);
            ((float*)(ws + WS_ROPEC))[idx] = cs; ((float*)(ws + WS_ROPES))[idx] = sn;
        }
    }
}

__device__ __forceinline__ void p1_hrows(const Args& A, Frame& F) {
    unsigned char* ws = A.ws;
    LAS float* mult = (LAS float*)F.lds; LAS float* addv = mult + DM;
    const float* mp = (const float*)(ws + WS_MODP);
    float* mod = (float*)(ws + WS_MOD);
    bf16* H = (bf16*)((unsigned char*)A.out + O_H);
    for (int ch = F.vcu; ch < TOK / 128; ch += F.G) {
        const int b = (ch * 128) / SEQ;
        __syncthreads();
        for (int k = F.tid; k < DM; k += NWAVES * 64) {
            float sh = A.b_ada[k], sc = A.b_ada[DM + k];
#pragma unroll
            for (int ks = 0; ks < KSPLIT; ++ks) { sh += mp[(size_t)(ks * 4 + b) * NMOD + k]; sc += mp[(size_t)(ks * 4 + b) * NMOD + DM + k]; }
            mult[k] = A.g_mix[k] * (1.f + sc); addv[k] = sh;
        }
        if ((ch * 128) % SEQ == 0) {
            for (int j = F.tid; j < NMOD; j += NWAVES * 64) { float v = A.b_ada[j];
#pragma unroll
                for (int ks = 0; ks < KSPLIT; ++ks) v += mp[(size_t)(ks * 4 + b) * NMOD + j];
                mod[b * NMOD + j] = v; }
        }
        __syncthreads();
        for (int i = 0; i < 16; ++i) {
            const int row = ch * 128 + F.wave * 16 + i;
            const GAS f32x4* xr = (const GAS f32x4*)(A.x + (size_t)row * DM) + F.lane;
            f32x4 v[4]; float s = 0.f;
#pragma unroll
            for (int j = 0; j < 4; ++j) { v[j] = xr[64 * j]; s += (v[j].x * v[j].x + v[j].y * v[j].y) + (v[j].z * v[j].z + v[j].w * v[j].w); }
            const float rr = 1.0f / sqrtf(wave_sum(s) * (1.f / DM) + EPS);
            GAS v2u* o8 = (GAS v2u*)(H + (size_t)row * DM) + F.lane;
#pragma unroll
            for (int j = 0; j < 4; ++j) { const f32x4 mu = *(const LAS f32x4*)(mult + 256 * j + 4 * F.lane), ad = *(const LAS f32x4*)(addv + 256 * j + 4 * F.lane);
                const f32x4 hh = v[j] * rr * mu + ad; v2u o; o.x = pk2(hh.x, hh.y); o.y = pk2(hh.z, hh.w); o8[64 * j] = o; }
        }
    }
}

typedef pg8::f32x4 pf4;
struct EpiG1 {
    static constexpr bool PERM = true, AFTER_DRAIN = false;
    bf16 *Qsb, *Ksb, *Vsb, *Qd, *Kd, *Vd, *Gsb, *Gd; const float* ropeC; const float* ropeS;
    __device__ __forceinline__ void operator()(const pf4 (&acc)[2][2][4][2], const pg8::Unit& u, int wr, int wc, int fr, int fq) const {
        const int pn = u.pn;
        const int row0 = u.pm * 256 + wr * 64 + fr;
        const int b = (u.pm * 256) >> 13;
        if (pn < 6 || (pn >= 12 && pn < 15)) {
            bf16* base; int H, head0; float sc = 1.f;
            if (pn < 2) { base = Qsb; H = SBH; head0 = 4 * pn; sc = C2; }
            else if (pn < 4) { base = Ksb; H = SBH; head0 = 4 * (pn - 2); }
            else if (pn < 6) { base = Vsb; H = SBH; head0 = 4 * (pn - 4); }
            else { base = Vd; H = DILH; head0 = 4 * (pn - 12); }
            const int d0 = 32 * (wc & 1) + 8 * fq;
#pragma unroll
            for (int ai = 0; ai < 2; ++ai)
#pragma unroll
                for (int m = 0; m < 4; ++m) { const int s = (row0 + ai * 128 + m * 16) & (SEQ - 1);
#pragma unroll
                    for (int bj = 0; bj < 2; ++bj) { const int head = head0 + 2 * bj + (wc >> 1);
                        const pf4 v0 = acc[ai][bj][m][0] * sc, v1 = acc[ai][bj][m][1] * sc;
                        v4u w; w.x = pk2(v0[0], v0[1]); w.y = pk2(v0[2], v0[3]); w.z = pk2(v1[0], v1[1]); w.w = pk2(v1[2], v1[3]);
                        *(GAS v4u*)(base + ((size_t)(b * H + head) * SEQ + s) * 64 + d0) = w; } }
        } else if (pn < 12) {
            bf16* base; int head0; float sc = 1.f;
            if (pn < 9) { base = Qd; head0 = 4 * (pn - 6); sc = C2; } else { base = Kd; head0 = 4 * (pn - 9); }
            const int j4 = 4 * (4 * (wc & 1) + fq);
#pragma unroll
            for (int ai = 0; ai < 2; ++ai)
#pragma unroll
                for (int m = 0; m < 4; ++m) { const int s = (row0 + ai * 128 + m * 16) & (SEQ - 1);
                    const pf4 cs = *(const GAS pf4*)(ropeC + s * 32 + j4) * sc, sn = *(const GAS pf4*)(ropeS + s * 32 + j4) * sc;
#pragma unroll
                    for (int bj = 0; bj < 2; ++bj) { const int head = head0 + 2 * bj + (wc >> 1);
                        const pf4 x1 = acc[ai][bj][m][0], x2 = acc[ai][bj][m][1];
                        const pf4 o1 = x1 * cs - x2 * sn, o2 = x1 * sn + x2 * cs;
                        bf16* p = base + ((size_t)(b * DILH + head) * SEQ + s) * 64 + j4;
                        v2u w1, w2; w1.x = pk2(o1[0], o1[1]); w1.y = pk2(o1[2], o1[3]); w2.x = pk2(o2[0], o2[1]); w2.y = pk2(o2[2], o2[3]);
                        *(GAS v2u*)p = w1; *(GAS v2u*)(p + 32) = w2; } }
        } else {
            bf16* base = pn < 19 ? Gsb : Gd; const int ct = (pn < 19 ? pn - 15 : pn - 19) * 256 + wc * 32 + 8 * fq;
#pragma unroll
            for (int ai = 0; ai < 2; ++ai)
#pragma unroll
                for (int m = 0; m < 4; ++m) { const size_t row = (size_t)(row0 + ai * 128 + m * 16);
#pragma unroll
                    for (int bj = 0; bj < 2; ++bj) { const pf4 v0 = acc[ai][bj][m][0], v1 = acc[ai][bj][m][1];
                        v4u w; w.x = pk2(sigmoidf_(v0[0]), sigmoidf_(v0[1])); w.y = pk2(sigmoidf_(v0[2]), sigmoidf_(v0[3]));
                        w.z = pk2(sigmoidf_(v1[0]), sigmoidf_(v1[1])); w.w = pk2(sigmoidf_(v1[2]), sigmoidf_(v1[3]));
                        *(GAS v4u*)(base + row * DM + ct + bj * 128) = w; } }
        }
    }
};
template <bool SECOND> struct EpiMerge {
    static constexpr bool PERM = true, AFTER_DRAIN = false;
    const bf16* G; bf16* Mg;
    __device__ __forceinline__ void operator()(const pf4 (&acc)[2][2][4][2], const pg8::Unit& u, int wr, int wc, int fr, int fq) const {
        const int row0 = u.pm * 256 + wr * 64 + fr, col0 = u.pn * 256 + wc * 32 + 8 * fq;
#pragma unroll
        for (int ai = 0; ai < 2; ++ai)
#pragma unroll
            for (int m = 0; m < 4; ++m) { const size_t off = (size_t)(row0 + ai * 128 + m * 16) * DM + col0;
#pragma unroll
                for (int bj = 0; bj < 2; ++bj) { const v4u g = *(const GAS v4u*)(G + off + bj * 128);
                    pf4 v0 = acc[ai][bj][m][0], v1 = acc[ai][bj][m][1];
                    v0[0] *= bflo(g.x); v0[1] *= bfhi(g.x); v0[2] *= bflo(g.y); v0[3] *= bfhi(g.y); v1[0] *= bflo(g.z); v1[1] *= bfhi(g.z); v1[2] *= bflo(g.w); v1[3] *= bfhi(g.w);
                    if (SECOND) { const v4u t = *(const GAS v4u*)(Mg + off + bj * 128);
                        v0[0] += bflo(t.x); v0[1] += bfhi(t.x); v0[2] += bflo(t.y); v0[3] += bfhi(t.y); v1[0] += bflo(t.z); v1[1] += bfhi(t.z); v1[2] += bflo(t.w); v1[3] += bfhi(t.w); }
                    v4u w; w.x = pk2(v0[0], v0[1]); w.y = pk2(v0[2], v0[3]); w.z = pk2(v1[0], v1[1]); w.w = pk2(v1[2], v1[3]);
                    *(GAS v4u*)(Mg + off + bj * 128) = w; }
                asm volatile("" ::: "memory"); }
    }
};
struct EpiOut {
    static constexpr bool PERM = true, AFTER_DRAIN = false;
    const float* x; float* x1; bf16* x1m; float* ssq; const float* mod; const float* g_ffn;
    __device__ __forceinline__ void operator()(const pf4 (&acc)[2][2][4][2], const pg8::Unit& u, int wr, int wc, int fr, int fq) const {
        const int row0 = u.pm * 256 + wr * 64 + fr, col0 = u.pn * 256 + wc * 32 + 8 * fq;
        const int b = (u.pm * 256) >> 13; const float* mb = mod + (size_t)b * NMOD;
        pf4 gt[2][2], mm[2][2];
#pragma unroll
        for (int bj = 0; bj < 2; ++bj)
#pragma unroll
            for (int n = 0; n < 2; ++n) { const int c = col0 + bj * 128 + 4 * n; gt[bj][n] = *(const GAS pf4*)(mb + 2 * DM + c);
                mm[bj][n] = *(const GAS pf4*)(g_ffn + c) * (*(const GAS pf4*)(mb + 4 * DM + c) + 1.0f); }
#pragma unroll
        for (int ai = 0; ai < 2; ++ai)
#pragma unroll
            for (int m = 0; m < 4; ++m) { const int row = row0 + ai * 128 + m * 16; const size_t off = (size_t)row * DM + col0; float s = 0.f;
#pragma unroll
                for (int bj = 0; bj < 2; ++bj) {
                    const pf4 a0 = *(const GAS pf4*)(x + off + bj * 128), a1 = *(const GAS pf4*)(x + off + bj * 128 + 4);
                    const pf4 y0 = a0 + gt[bj][0] * acc[ai][bj][m][0], y1 = a1 + gt[bj][1] * acc[ai][bj][m][1];
                    *(GAS pf4*)(x1 + off + bj * 128) = y0; *(GAS pf4*)(x1 + off + bj * 128 + 4) = y1;
                    s += (y0[0] * y0[0] + y0[1] * y0[1]) + (y0[2] * y0[2] + y0[3] * y0[3]) + (y1[0] * y1[0] + y1[1] * y1[1]) + (y1[2] * y1[2] + y1[3] * y1[3]);
                    const pf4 z0 = y0 * mm[bj][0], z1 = y1 * mm[bj][1];
                    v4u w; w.x = pk2(z0[0], z0[1]); w.y = pk2(z0[2], z0[3]); w.z = pk2(z1[0], z1[1]); w.w = pk2(z1[2], z1[3]);
                    *(GAS v4u*)(x1m + off + bj * 128) = w; }
                s += __shfl_xor(s, 16); s += __shfl_xor(s, 32);
                if (fq == 0) ssq[(size_t)row * 16 + 4 * u.pn + wc] = s; }
    }
};
struct EpiPq {
    static constexpr bool PERM = true, AFTER_DRAIN = false;
    const float* ssq; const float* bias; bf16* Q; float* r2out;
    __device__ __forceinline__ void operator()(const pf4 (&acc)[2][2][4][2], const pg8::Unit& u, int wr, int wc, int fr, int fq) const {
        const int row0 = u.pm * 256 + wr * 64 + fr, col0 = u.pn * 256 + wc * 32 + 8 * fq;
        const int b = (u.pm * 256) >> 13; const float* bb = bias + (size_t)b * 2048;
        pf4 bv[2][2];
#pragma unroll
        for (int bj = 0; bj < 2; ++bj)
#pragma unroll
            for (int n = 0; n < 2; ++n) bv[bj][n] = *(const GAS pf4*)(bb + col0 + bj * 128 + 4 * n);
#pragma unroll
        for (int ai = 0; ai < 2; ++ai)
#pragma unroll
            for (int m = 0; m < 4; ++m) { const int row = row0 + ai * 128 + m * 16;
                const GAS pf4* sp = (const GAS pf4*)(ssq + (size_t)row * 16);
                const pf4 s4 = (sp[0] + sp[1]) + (sp[2] + sp[3]);
                const float r2 = 1.0f / sqrtf(((s4[0] + s4[1]) + (s4[2] + s4[3])) * (1.f / DM) + EPS);
                if (u.pn == 0 && wc == 0 && fq == 0) r2out[row] = r2;
#pragma unroll
                for (int bj = 0; bj < 2; ++bj) { const pf4 v0 = acc[ai][bj][m][0] * r2 + bv[bj][0], v1 = acc[ai][bj][m][1] * r2 + bv[bj][1];
                    v4u w; w.x = pk2(v0[0], v0[1]); w.y = pk2(v0[2], v0[3]); w.z = pk2(v1[0], v1[1]); w.w = pk2(v1[2], v1[3]);
                    *(GAS v4u*)(Q + (size_t)row * 2048 + col0 + bj * 128) = w; } }
    }
};

constexpr int VSTR = 144;
constexpr int ATT_WAVE_LDS = 2 * 32 * VSTR;
__device__ __forceinline__ int kappa(int r) { return (((r >> 2) & 1) << 4) + ((r >> 3) << 2) + (r & 3); }
struct KVTile { v4u k[4]; v4u v[4]; };
typedef short v4i16_t __attribute__((ext_vector_type(4)));
__device__ __forceinline__ s16x4 vtr(const LAS unsigned char* p) { return __builtin_bit_cast(s16x4, __builtin_amdgcn_ds_read_tr16_b64_v4i16((LAS v4i16_t*)p)); }

__device__ __forceinline__ void kv_load(KVTile& t, const bf16* Kh, const bf16* Vh, int base_tok, int sshift, int lane) {
#pragma unroll
    for (int i = 0; i < 4; ++i) { const size_t off = (size_t)(base_tok + (((lane >> 3) + 8 * i) << sshift)) * 64 + 8 * (lane & 7);
        t.k[i] = *(const GAS v4u*)(Kh + off); t.v[i] = *(const GAS v4u*)(Vh + off); }
}
__device__ __forceinline__ void v_to_lds(const KVTile& t, LAS unsigned char* vl, int lane) {
#pragma unroll
    for (int i = 0; i < 4; ++i) { const int o = ((lane >> 3) + 8 * i) * VSTR + 16 * (lane & 7); *(LAS v4u*)(vl + o) = t.k[i]; *(LAS v4u*)(vl + 32 * VSTR + o) = t.v[i]; }
}
__device__ __forceinline__ f32x16 qk_tile(const LAS unsigned char* vl, const bf16x8 (&qf)[4], int lane) {
    const LAS unsigned char* kp = vl + kappa(lane & 31) * VSTR + 16 * (lane >> 5);
    f32x16 s = {};
#pragma unroll
    for (int st = 0; st < 4; ++st) s = __builtin_amdgcn_mfma_f32_32x32x16_bf16(*(const LAS bf16x8*)(kp + 32 * st), qf[st], s, 0, 0, 0);
    return s;
}
__device__ __forceinline__ void pv_tile(f32x16& o0, f32x16& o1, const float (&p)[16], const LAS unsigned char* vl, int lane) {
    const int g = lane >> 4, li = lane & 15, q = li >> 2, pp = li & 3, h = g >> 1;
    const LAS unsigned char* tb = vl + 32 * VSTR + (16 * h + q) * VSTR + (16 * (g & 1) + 4 * pp) * 2;
    bf16x8 pf[2];
#pragma unroll
    for (int st = 0; st < 2; ++st) { v4u w; w.x = pk2(p[8 * st + 0], p[8 * st + 1]); w.y = pk2(p[8 * st + 2], p[8 * st + 3]); w.z = pk2(p[8 * st + 4], p[8 * st + 5]); w.w = pk2(p[8 * st + 6], p[8 * st + 7]); pf[st] = __builtin_bit_cast(bf16x8, w); }
#pragma unroll
    for (int db = 0; db < 2; ++db)
#pragma unroll
        for (int st = 0; st < 2; ++st) {
            const s16x4 lo = vtr(tb + (8 * st) * VSTR + 64 * db), hi = vtr(tb + (8 * st + 4) * VSTR + 64 * db);
            const bf16x8 vf = (bf16x8){lo[0], lo[1], lo[2], lo[3], hi[0], hi[1], hi[2], hi[3]};
            if (db == 0) o0 = __builtin_amdgcn_mfma_f32_32x32x16_bf16(vf, pf[st], o0, 0, 0, 0);
            else         o1 = __builtin_amdgcn_mfma_f32_32x32x16_bf16(vf, pf[st], o1, 0, 0, 0);
        }
}
__device__ __forceinline__ void o_store(bf16* orow, const f32x16& o0, const f32x16& o1, float sc, int hC) {
#pragma unroll
    for (int a = 0; a < 4; ++a) {
        v2u w0, w1; w0.x = pk2(o0[4 * a] * sc, o0[4 * a + 1] * sc); w0.y = pk2(o0[4 * a + 2] * sc, o0[4 * a + 3] * sc);
        w1.x = pk2(o1[4 * a] * sc, o1[4 * a + 1] * sc); w1.y = pk2(o1[4 * a + 2] * sc, o1[4 * a + 3] * sc);
        *(GAS v2u*)(orow + 8 * a + 4 * hC) = w0; *(GAS v2u*)(orow + 32 + 8 * a + 4 * hC) = w1; }
}

__device__ __forceinline__ void sb_task(const bf16* Qsb, const bf16* Ksb, const bf16* Vsb, bf16* Osb, int task, LAS unsigned char* vl, int lane) {
    const int qt = task & 255, bh = task >> 8, b = bh >> 3, h = bh & 7, t0 = qt * 32;
    const int q = lane & 31, hC = lane >> 5;
    const bf16* Kh = Ksb + (size_t)bh * SEQ * 64; const bf16* Vh = Vsb + (size_t)bh * SEQ * 64;
    bf16x8 qf[4];
    { const bf16* qp = Qsb + ((size_t)bh * SEQ + t0 + q) * 64 + 8 * hC;
#pragma unroll
      for (int st = 0; st < 4; ++st) qf[st] = *(const GAS bf16x8*)(qp + 16 * st); }
    f32x16 o0 = {}, o1 = {}; float carry = 0.f;
    KVTile nxt; kv_load(nxt, Kh, Vh, t0, 0, lane);
    for (int k0 = t0;; k0 -= 32) {
        KVTile cur = nxt;
        const bool more = k0 >= 32;
        if (more) kv_load(nxt, Kh, Vh, k0 - 32, 0, lane);
        v_to_lds(cur, vl, lane);
        const f32x16 s = qk_tile(vl, qf, lane);
        const bool diag = (k0 == t0);
        float L[16], z[16];
#pragma unroll
        for (int r = 0; r < 16; ++r) { z[r] = __builtin_amdgcn_fmed3f(s[r], -120.f, 120.f); const float e = fast_exp2(z[r]); L[r] = -fast_log2(1.f + e);
            if (diag && !(16 * hC + r < q)) L[r] = 0.f; }
        float c[16]; c[15] = L[15];
#pragma unroll
        for (int r = 14; r >= 0; --r) c[r] = c[r + 1] + L[r];
        const float tot = c[0], oth = __shfl_xor(tot, 32);
        const float base = carry + (hC ? 0.f : oth);
        float p[16];
#pragma unroll
        for (int r = 0; r < 16; ++r) { p[r] = fast_exp2(z[r] + (base + c[r])); if (diag && !(16 * hC + r < q)) p[r] = 0.f; }
        carry += tot + oth;
        pv_tile(o0, o1, p, vl, lane);
        if (!more) break;
        if (__all(carry < -160.f)) break;
    }
    o_store(Osb + ((size_t)(b * SEQ + t0 + q)) * 512 + h * 64, o0, o1, 1.f, hC);
}

__device__ __forceinline__ void dil_task(const bf16* Qd, const bf16* Kd, const bf16* Vd, bf16* Od, int task, LAS unsigned char* vl, int lane) {
    const int it = task & 15, rho = (task >> 4) & 15, hg = (task >> 8) & 3, b = task >> 10;
    const int q = lane & 31, hC = lane >> 5, i0 = 32 * it;
    const int tq = 16 * (i0 + q) + rho;
    f32x16 o0 = {}, o1 = {}; float mrun = -1e30f, lsum = 0.f;
#pragma unroll
    for (int g = 0; g < 3; ++g) {
        bf16x8 qf[4];
        { const bf16* qp = Qd + ((size_t)(b * DILH + g * 4 + hg) * SEQ + tq) * 64 + 8 * hC;
#pragma unroll
          for (int st = 0; st < 4; ++st) qf[st] = *(const GAS bf16x8*)(qp + 16 * st); }
        const int rs = 2 * g, cg = 16 >> rs, rho_g = rho & ((1 << rs) - 1), og = rho >> rs;
        const bf16* Kh = Kd + (size_t)(b * DILH + g * 4 + hg) * SEQ * 64; const bf16* Vh = Vd + (size_t)(b * DILH + g * 4 + hg) * SEQ * 64;
        const int uq = cg * (i0 + q) + og;
        const int u_hi = cg * (i0 + 31) + og; int u_lo = cg * i0 + og - 128; u_lo = u_lo < 0 ? 0 : u_lo;
        const int ub_last = u_lo & ~31;
        int ub = u_hi & ~31;
        KVTile nxt; kv_load(nxt, Kh, Vh, (ub << rs) + rho_g, rs, lane);
        for (;; ub -= 32) {
            KVTile cur = nxt;
            const bool more = ub > ub_last;
            if (more) kv_load(nxt, Kh, Vh, ((ub - 32) << rs) + rho_g, rs, lane);
            v_to_lds(cur, vl, lane);
            const f32x16 s = qk_tile(vl, qf, lane);
            float z[16]; float tmax = -1e30f;
            const int d0 = uq - (ub + 16 * hC);
#pragma unroll
            for (int r = 0; r < 16; ++r) { const bool valid = (unsigned)(d0 - r) <= 128u; z[r] = valid ? s[r] : -1e30f; tmax = fmaxf(tmax, z[r]); }
            tmax = fmaxf(tmax, __shfl_xor(tmax, 32));
            const float mnew = fmaxf(mrun, tmax); const float alpha = fast_exp2(mrun - mnew); mrun = mnew;
            float p[16]; float ps = 0.f;
#pragma unroll
            for (int r = 0; r < 16; ++r) { p[r] = (z[r] > -1e29f) ? fast_exp2(z[r] - mnew) : 0.f; ps += p[r]; }
            lsum = lsum * alpha + ps;
            if (!__all(alpha == 1.0f)) {
#pragma unroll
                for (int r = 0; r < 16; ++r) { o0[r] *= alpha; o1[r] *= alpha; }
            }
            pv_tile(o0, o1, p, vl, lane);
            if (!more) break;
        }
    }
    const float l = lsum + __shfl_xor(lsum, 32);
    o_store(Od + (size_t)(b * SEQ + tq) * 256 + hg * 64, o0, o1, 1.0f / l, hC);
}

__device__ __forceinline__ void p3_attention(const Args& A, Frame& F) {
    unsigned char* ws = A.ws;
    LAS unsigned char* vl = F.lds + F.wave * ATT_WAVE_LDS;
    const bf16 *Qsb = (const bf16*)(ws + A_QSB), *Ksb = (const bf16*)(ws + A_KSB), *Vsb = (const bf16*)(ws + A_VSB);
    const bf16 *Qd = (const bf16*)(ws + A_QD), *Kd = (const bf16*)(ws + A_KD), *Vd = (const bf16*)(ws + A_VD);
    bf16* Osb = (bf16*)((unsigned char*)A.out + O_OSB); bf16* Od = (bf16*)((unsigned char*)A.out + O_OD);
    constexpr int N_DIL = NB * 4 * 16 * 16, N_SB = NB * SBH * (SEQ / 32);
    for (int t = F.gw; t < N_DIL + N_SB; t += F.NGW) {
        if (t < N_DIL) dil_task(Qd, Kd, Vd, Od, t, vl, F.lane);
        else sb_task(Qsb, Ksb, Vsb, Osb, t - N_DIL, vl, F.lane);
    }
}

__device__ __forceinline__ unsigned sortable(float f) { const unsigned u = __float_as_uint(f); return u ^ ((unsigned)((int)u >> 31) | 0x80000000u); }
__device__ __forceinline__ float unsortable(unsigned s) { const unsigned u = (s & 0x80000000u) ? (s ^ 0x80000000u) : ~s; return __uint_as_float(u); }
__device__ __forceinline__ unsigned umax_(unsigned a, unsigned b) { return a > b ? a : b; }

#define CE_(a, b) do { const unsigned hi_ = umax_(a, b), lo_ = umin_(a, b); a = hi_; b = lo_; } while (0)
__device__ __forceinline__ unsigned umin_(unsigned a, unsigned b) { return a < b ? a : b; }
template <int N, int OFF, int TOT> __device__ __forceinline__ void bitonic_sort_desc(unsigned (&v)[TOT]) {
#pragma unroll
    for (int k = 2; k <= N; k <<= 1)
#pragma unroll
        for (int j = k >> 1; j > 0; j >>= 1)
#pragma unroll
            for (int i = 0; i < N; ++i) { const int l = i ^ j; if (l > i) { if ((i & k) == 0) CE_(v[OFF + i], v[OFF + l]); else CE_(v[OFF + l], v[OFF + i]); } }
}
__device__ __forceinline__ void bitonic_merge16_desc(unsigned (&t)[16]) {
#pragma unroll
    for (int j = 8; j > 0; j >>= 1)
#pragma unroll
        for (int i = 0; i < 16; ++i) { const int l = i ^ j; if (l > i) CE_(t[i], t[l]); }
}
__device__ __forceinline__ void merge_top16(unsigned (&out)[16], const unsigned* a, const unsigned* b) {
#pragma unroll
    for (int i = 0; i < 16; ++i) out[i] = umax_(a[i], b[15 - i]);
    bitonic_merge16_desc(out);
}
__device__ __forceinline__ void cross_lane_top16(unsigned (&top)[16]) {
    unsigned t[16];
#pragma unroll
    for (int i = 0; i < 16; ++i) t[i] = umax_(top[i], (unsigned)__shfl_xor((int)top[15 - i], 32));
    bitonic_merge16_desc(t);
#pragma unroll
    for (int i = 0; i < 16; ++i) top[i] = t[i];
}
__device__ __forceinline__ void top16_of_128(unsigned (&key)[64], LAS unsigned* top  , int lane) {
    bitonic_sort_desc<16, 0, 64>(key); bitonic_sort_desc<16, 16, 64>(key); bitonic_sort_desc<16, 32, 64>(key); bitonic_sort_desc<16, 48, 64>(key);
    unsigned m0[16], m1[16], m[16];
    merge_top16(m0, &key[0], &key[16]); merge_top16(m1, &key[32], &key[48]); merge_top16(m, m0, m1);
    cross_lane_top16(m);
#pragma unroll
    for (int it = 0; it < 16; ++it) top[it * 64 + lane] = m[it];
}
__device__ __forceinline__ unsigned pk_lookup(unsigned p0, unsigned p1, unsigned p2, unsigned p3, unsigned a) {
    const unsigned hi = a >> 2; unsigned d = p0; d = hi == 1 ? p1 : d; d = hi == 2 ? p2 : d; d = hi == 3 ? p3 : d;
    return (d >> (8 * (a & 3))) & 0xffu;
}
__device__ __forceinline__ unsigned pack4idx(unsigned t0, unsigned t1, unsigned t2, unsigned t3) { return (127u - (t0 & 127u)) | ((127u - (t1 & 127u)) << 8) | ((127u - (t2 & 127u)) << 16) | ((127u - (t3 & 127u)) << 24); }

__device__ __forceinline__ void topk_task(const bf16* Qp, const bf16* Kb, unsigned short* IDX, float* GATE, int task, int lane, LAS unsigned* tl  ) {
    const int ph = task & 7, t0 = (task >> 3) * 32;
    const int q = lane & 31, hC = lane >> 5;
#ifdef P7_TIME_SORT
    unsigned long long tsort = 0;
#endif
#pragma unroll 1
    for (int half = 0; half < 2; ++half) {
        bf16x8 qf[8];
        { const bf16* qp = Qp + (size_t)(t0 + q) * 2048 + ph * 256 + half * 128 + 8 * hC;
#pragma unroll
          for (int st = 0; st < 8; ++st) qf[st] = *(const GAS bf16x8*)(qp + 16 * st); }
        f32x16 C[4] = {};
        const bf16* kpm[4];
#pragma unroll
        for (int mt = 0; mt < 4; ++mt) { kpm[mt] = Kb + ((size_t)(ph * 2 + half) * 128 + 32 * mt + q) * 128 + 8 * hC; asm volatile("" : "+v"(kpm[mt])); }
        bf16x8 kfa[8], kfb[8];
#define LDK(dst, grp) do { _Pragma("unroll") for (int i_ = 0; i_ < 8; ++i_) dst[i_] = *(const GAS bf16x8*)(kpm[i_ & 3] + 16 * (2 * (grp) + (i_ >> 2))); } while (0)
#define MMK(src, grp) do { _Pragma("unroll") for (int i_ = 0; i_ < 8; ++i_) C[i_ & 3] = __builtin_amdgcn_mfma_f32_32x32x16_bf16(src[i_], qf[2 * (grp) + (i_ >> 2)], C[i_ & 3], 0, 0, 0); } while (0)
#define SB_ __builtin_amdgcn_sched_barrier(0)
        LDK(kfa, 0); LDK(kfb, 1); SB_;
        MMK(kfa, 0); SB_; LDK(kfa, 2); SB_;
        MMK(kfb, 1); SB_; LDK(kfb, 3); SB_;
        MMK(kfa, 2); SB_; MMK(kfb, 3); SB_;
#undef SB_
#undef LDK
#undef MMK
        unsigned key[64];
#pragma unroll
        for (int mt = 0; mt < 4; ++mt)
#pragma unroll
            for (int r = 0; r < 16; ++r) { const int kidx = 32 * mt + (r & 3) + 8 * (r >> 2) + 4 * hC; key[16 * mt + r] = (sortable(C[mt][r]) & ~127u) | (unsigned)(127 - kidx); }
#ifdef P7_TIME_SORT
        const unsigned long long ts0_ = __builtin_amdgcn_s_memrealtime();
#endif
        top16_of_128(key, tl + half * 1024, lane);
#ifdef P7_TIME_SORT
        asm volatile("s_waitcnt lgkmcnt(0)" ::: "memory");
        tsort += __builtin_amdgcn_s_memrealtime() - ts0_;
#endif
    }
    unsigned tops[2][16];
#pragma unroll
    for (int a = 0; a < 16; ++a) { tops[0][a] = tl[a * 64 + lane]; tops[1][a] = tl[1024 + a * 64 + lane]; }
    float s0[16], s1[16];
#pragma unroll
    for (int a = 0; a < 16; ++a) { s0[a] = unsortable(tops[0][a] & ~127u); s1[a] = unsortable(tops[1][a] & ~127u); }
    const unsigned pa0 = pack4idx(tops[0][0], tops[0][1], tops[0][2], tops[0][3]), pa1 = pack4idx(tops[0][4], tops[0][5], tops[0][6], tops[0][7]),
                   pa2 = pack4idx(tops[0][8], tops[0][9], tops[0][10], tops[0][11]), pa3 = pack4idx(tops[0][12], tops[0][13], tops[0][14], tops[0][15]);
    const unsigned pb0 = pack4idx(tops[1][0], tops[1][1], tops[1][2], tops[1][3]), pb1 = pack4idx(tops[1][4], tops[1][5], tops[1][6], tops[1][7]),
                   pb2 = pack4idx(tops[1][8], tops[1][9], tops[1][10], tops[1][11]), pb3 = pack4idx(tops[1][12], tops[1][13], tops[1][14], tops[1][15]);
    unsigned cand[32];
    {
        int n = 0;
#pragma unroll
        for (int a = 0; a < 16; ++a)
#pragma unroll
            for (int bq = 0; bq < 16; ++bq) if ((a + 1) * (bq + 1) <= 16) {
                const unsigned ck = (sortable(s0[a] + s1[bq]) & ~255u) | (unsigned)(a * 16 + bq);
                if (n < 25) cand[n] = ck; else cand[n - 25] = hC ? ck : cand[n - 25];
                ++n; }
#pragma unroll
        for (int i = 25; i < 32; ++i) cand[i] = 0u;
    }
    bitonic_sort_desc<32, 0, 32>(cand);
    unsigned win[16];
#pragma unroll
    for (int i = 0; i < 16; ++i) win[i] = cand[i];
    cross_lane_top16(win);
    float gv[16]; int eid[16]; float gs = 0.f;
    const float vmax = unsortable(win[0] & ~255u);
#pragma unroll
    for (int k = 0; k < 16; ++k) { const unsigned a = (win[k] >> 4) & 15u, bq = win[k] & 15u;
        eid[k] = (int)(pk_lookup(pa0, pa1, pa2, pa3, a) * 128u + pk_lookup(pb0, pb1, pb2, pb3, bq));
        gv[k] = fast_exp2((unsortable(win[k] & ~255u) - vmax) * LOG2E); gs += gv[k]; }
    const float ginv = 1.0f / gs;
#ifdef P7_TIME_SORT
    { const unsigned long long t1_ = __builtin_amdgcn_s_memrealtime(); while (__builtin_amdgcn_s_memrealtime() - t1_ < 4ull * tsort) __builtin_amdgcn_s_sleep(1); }
#endif
    const size_t o = (size_t)(t0 + q) * 128 + ph * 16;
    if (hC == 0) {
#pragma unroll
        for (int k = 0; k < 16; k += 8) *(GAS v4u*)(IDX + o + k) = (v4u){(unsigned)eid[k] | ((unsigned)eid[k + 1] << 16), (unsigned)eid[k + 2] | ((unsigned)eid[k + 3] << 16),
                                                                         (unsigned)eid[k + 4] | ((unsigned)eid[k + 5] << 16), (unsigned)eid[k + 6] | ((unsigned)eid[k + 7] << 16)};
    } else {
#pragma unroll
        for (int k = 0; k < 16; k += 4) *(GAS f32x4*)(GATE + o + k) = (f32x4){gv[k] * ginv, gv[k + 1] * ginv, gv[k + 2] * ginv, gv[k + 3] * ginv};
    }
}

__device__ __forceinline__ float gelu_tanh(float x) {
    const float y2 = 2.0f * 0.7978845608028654f * (x + 0.044715f * x * x * x);
    return x * fast_rcp(1.f + fast_exp2(-y2 * LOG2E));
}
__device__ __forceinline__ void unpack8(const v4u w, float (&f)[8]) { f[0] = bflo(w.x); f[1] = bfhi(w.x); f[2] = bflo(w.y); f[3] = bfhi(w.y); f[4] = bflo(w.z); f[5] = bfhi(w.z); f[6] = bflo(w.w); f[7] = bfhi(w.w); }
__device__ __forceinline__ void h2f8_row(unsigned char* ws, int t, int lane) {
    const bf16* xr = (const bf16*)(ws + A_X1M) + (size_t)t * DM + 16 * lane; const float* sh = (const float*)(ws + WS_MOD) + (size_t)(t >> 13) * NMOD + 3 * DM + 16 * lane;
    const float r2 = ((const float*)(ws + WS_R2))[t];
    float fa[8], fb[8]; unpack8(*(const GAS v4u*)xr, fa); unpack8(*(const GAS v4u*)(xr + 8), fb);
    float h[16];
#pragma unroll
    for (int k = 0; k < 2; ++k) { const f32x4 s0 = *(const GAS f32x4*)(sh + 4 * k), s1 = *(const GAS f32x4*)(sh + 8 + 4 * k);
#pragma unroll
        for (int i = 0; i < 4; ++i) { h[4 * k + i] = fa[4 * k + i] * r2 + s0[i]; h[8 + 4 * k + i] = fb[4 * k + i] * r2 + s1[i]; } }
    unsigned w[4];
#pragma unroll
    for (int j = 0; j < 4; ++j) { int tt = __builtin_amdgcn_cvt_pk_fp8_f32(h[4 * j], h[4 * j + 1], 0, false); tt = __builtin_amdgcn_cvt_pk_fp8_f32(h[4 * j + 2], h[4 * j + 3], tt, true); w[j] = (unsigned)tt; }
    *(GAS v4u*)(ws + A_H2F8 + (size_t)t * DM + 16 * lane) = (v4u){w[0], w[1], w[2], w[3]};
}
__device__ __forceinline__ void unpack_fp8x16(const v4u w, float (&f)[16]) {
#pragma unroll
    for (int j = 0; j < 4; ++j) { const f32x2_t a = __builtin_amdgcn_cvt_pk_f32_fp8((int)w[j], false), b = __builtin_amdgcn_cvt_pk_f32_fp8((int)w[j], true);
        f[4 * j] = a.x; f[4 * j + 1] = a.y; f[4 * j + 2] = b.x; f[4 * j + 3] = b.y; }
}
__device__ __forceinline__ void peer_u_phase(const Args& A, Frame& F) {
    unsigned char* ws = A.ws;
    const int lane = F.lane, x = blockIdx.x & 7, wrk = (blockIdx.x >> 3) * NWAVES + F.wave, nwr = (F.G >> 3) * NWAVES, g = lane >> 3, c = lane & 7;
    const unsigned char* U8 = ws + WS_UB + (size_t)x * (2 * MiB); const unsigned c16 = 16u * c, g32 = 32u * g;
    const unsigned char* X1M = ws + A_X1M + 256 * x; const unsigned char* IDX = ws + A_IDX; const float* R2 = (const float*)(ws + WS_R2);
    bf16* PART = (bf16*)(ws + A_PART) + (size_t)x * TOK * 128;
    const int per = TOK / nwr, tb = wrk * per;
    float sh[16];
    { const float* mod = (const float*)(ws + WS_MOD) + (size_t)(tb >> 13) * NMOD + 3 * DM + 128 * x + 16 * c;
#pragma unroll
      for (int k = 0; k < 4; ++k) { const f32x4 v = *(const GAS f32x4*)(mod + 4 * k); sh[4 * k] = v[0]; sh[4 * k + 1] = v[1]; sh[4 * k + 2] = v[2]; sh[4 * k + 3] = v[3]; } }
    v4u idC[2], idN[2], xC[2], xN[2]; float rC, rN;
#define SLOT_ID(ID, sl) (((ID)[(sl) >> 3][((sl) >> 1) & 3] >> (16 * ((sl) & 1))) & 0xffffu)
#define LD_TOK(ID, XV, RV, T) do { const unsigned char* ib_ = IDX + (size_t)(T) * 256; const unsigned char* xb_ = X1M + (size_t)(T) * (DM * 2); \
        ID[0] = *(const GAS v4u*)(ib_ + g32); ID[1] = *(const GAS v4u*)(ib_ + (g32 + 16u)); \
        XV[0] = *(const GAS v4u*)(xb_ + 2u * c16); XV[1] = *(const GAS v4u*)(xb_ + (2u * c16 + 16u)); RV = R2[T]; } while (0)
#define LD_ROWS(R, ID, H) do { _Pragma("unroll") for (int i = 0; i < 8; ++i) R[i] = *(const GAS v4u*)(U8 + (SLOT_ID(ID, 8 * (H) + i) * 128u + c16)); } while (0)
    LD_TOK(idC, xC, rC, tb);
    v4u R0[8], R1[8];
    LD_ROWS(R0, idC, 0);
    LD_TOK(idN, xN, rN, tb + 1 < TOK ? tb + 1 : tb);
    for (int t = tb; t < tb + per; ++t) {
        LD_ROWS(R1, idC, 1);
        float h2[16];
        { float fa[8], fb[8]; unpack8(xC[0], fa); unpack8(xC[1], fb);
#pragma unroll
          for (int i = 0; i < 8; ++i) { h2[i] = fa[i] * rC + sh[i]; h2[8 + i] = fb[i] * rC + sh[8 + i]; } }
        float p[16];
#pragma unroll
        for (int i = 0; i < 8; ++i) { float f[16]; unpack_fp8x16(R0[i], f); float d = 0.f;
#pragma unroll
            for (int k = 0; k < 16; ++k) d += f[k] * h2[k];
            p[i] = d; }
        LD_ROWS(R0, idN, 0);
#pragma unroll
        for (int i = 0; i < 8; ++i) { float f[16]; unpack_fp8x16(R1[i], f); float d = 0.f;
#pragma unroll
            for (int k = 0; k < 16; ++k) d += f[k] * h2[k];
            p[8 + i] = d; }
        idC[0] = idN[0]; idC[1] = idN[1];
        xC[0] = xN[0]; xC[1] = xN[1]; rC = rN;
        { const int tn = t + 2 < tb + per ? t + 2 : tb + per - 1; LD_TOK(idN, xN, rN, tn); }
        const bool b0 = lane & 1, b1 = lane & 2, b2 = lane & 4;
        float q8[8], q4[4], q2[2];
#pragma unroll
        for (int i = 0; i < 8; ++i) q8[i] = (b0 ? p[8 + i] : p[i]) + __shfl_xor(b0 ? p[i] : p[8 + i], 1);
#pragma unroll
        for (int i = 0; i < 4; ++i) q4[i] = (b1 ? q8[4 + i] : q8[i]) + __shfl_xor(b1 ? q8[i] : q8[4 + i], 2);
#pragma unroll
        for (int i = 0; i < 2; ++i) q2[i] = (b2 ? q4[2 + i] : q4[i]) + __shfl_xor(b2 ? q4[i] : q4[2 + i], 4);
        const int slot = 16 * g + 8 * (lane & 1) + 4 * ((lane >> 1) & 1) + 2 * ((lane >> 2) & 1);
        *(GAS unsigned*)(PART + (size_t)t * 128 + slot) = pk2(q2[0], q2[1]);
    }
#undef LD_TOK
#undef LD_ROWS
#undef SLOT_ID
}
__device__ __forceinline__ void peer_act_phase(const Args& A, Frame& F) {
    unsigned char* ws = A.ws;
    const bf16* PART = (const bf16*)(ws + A_PART); const unsigned short* IDX = (const unsigned short*)(ws + A_IDX); const float* GATE = (const float*)(ws + A_GATE); bf16* ACTG = (bf16*)(ws + A_ACTG);
    const float* UINV = (const float*)(ws + WS_UB + 16 * MiB); const float* VINV = (const float*)(ws + WS_VB + 16 * MiB);
    const size_t n4 = (size_t)TOK * 128 / 4;
    for (size_t i = (size_t)F.vcu * (NWAVES * 64) + F.tid; i < n4; i += (size_t)F.G * NWAVES * 64) {
        f32x4 d = {0.f, 0.f, 0.f, 0.f};
#pragma unroll
        for (int xx = 0; xx < 8; ++xx) { const v2u w = *(const GAS v2u*)(PART + (size_t)xx * TOK * 128 + 4 * i); d[0] += bflo(w.x); d[1] += bfhi(w.x); d[2] += bflo(w.y); d[3] += bfhi(w.y); }
        const v2u ew = *(const GAS v2u*)(IDX + 4 * i); const f32x4 gt = *(const GAS f32x4*)(GATE + 4 * i);
        const unsigned e[4] = {ew.x & 0xffffu, ew.x >> 16, ew.y & 0xffffu, ew.y >> 16};
        float o[4];
#pragma unroll
        for (int k = 0; k < 4; ++k) o[k] = gelu_tanh(d[k] * UINV[e[k]]) * gt[k] * VINV[e[k]];
        *(GAS v2u*)(ACTG + 4 * i) = (v2u){pk2(o[0], o[1]), pk2(o[2], o[3])};
    }
}
__device__ __forceinline__ void peer_v_phase(const Args& A, Frame& F) {
    unsigned char* ws = A.ws;
    const int lane = F.lane, x = blockIdx.x & 7, wrk = (blockIdx.x >> 3) * NWAVES + F.wave, nwr = (F.G >> 3) * NWAVES, g = lane >> 3, c = lane & 7;
    const unsigned char* V8 = ws + WS_VB + (size_t)x * (2 * MiB); const unsigned c16 = 16u * c, g32 = 32u * g;
    const unsigned char* IDX = ws + A_IDX; const unsigned char* ACTG = ws + A_ACTG; unsigned char* POUT = ws + A_POUT + 256 * x;
    const int per = TOK / nwr, tb = wrk * per;
    v4u idC[2], idN[2], aC[2], aN[2];
#define SLOT_ID(ID, sl) (((ID)[(sl) >> 3][((sl) >> 1) & 3] >> (16 * ((sl) & 1))) & 0xffffu)
#define SLOT_ACT(AV, sl) (((sl) & 1) ? bfhi((AV)[(sl) >> 3][((sl) >> 1) & 3]) : bflo((AV)[(sl) >> 3][((sl) >> 1) & 3]))
#define LD_TOK(ID, AV, T) do { const unsigned char* ib_ = IDX + (size_t)(T) * 256; const unsigned char* ab_ = ACTG + (size_t)(T) * 256; \
        ID[0] = *(const GAS v4u*)(ib_ + g32); ID[1] = *(const GAS v4u*)(ib_ + (g32 + 16u)); AV[0] = *(const GAS v4u*)(ab_ + g32); AV[1] = *(const GAS v4u*)(ab_ + (g32 + 16u)); } while (0)
#define LD_ROWS(R, ID, H) do { _Pragma("unroll") for (int i = 0; i < 8; ++i) R[i] = *(const GAS v4u*)(V8 + (SLOT_ID(ID, 8 * (H) + i) * 128u + c16)); } while (0)
    LD_TOK(idC, aC, tb);
    v4u R0[8], R1[8];
    LD_ROWS(R0, idC, 0);
    LD_TOK(idN, aN, tb + 1 < TOK ? tb + 1 : tb);
    for (int t = tb; t < tb + per; ++t) {
        LD_ROWS(R1, idC, 1);
        float acc[16];
#pragma unroll
        for (int d = 0; d < 16; ++d) acc[d] = 0.f;
#pragma unroll
        for (int i = 0; i < 8; ++i) { float f[16]; unpack_fp8x16(R0[i], f); const float a = SLOT_ACT(aC, i);
#pragma unroll
            for (int d = 0; d < 16; ++d) acc[d] += a * f[d]; }
        LD_ROWS(R0, idN, 0);
#pragma unroll
        for (int i = 0; i < 8; ++i) { float f[16]; unpack_fp8x16(R1[i], f); const float a = SLOT_ACT(aC, 8 + i);
#pragma unroll
            for (int d = 0; d < 16; ++d) acc[d] += a * f[d]; }
        idC[0] = idN[0]; idC[1] = idN[1]; aC[0] = aN[0]; aC[1] = aN[1];
        { const int tn = t + 2 < tb + per ? t + 2 : tb + per - 1; LD_TOK(idN, aN, tn); }
#pragma unroll
        for (int d = 0; d < 16; ++d) { float v = acc[d]; v += __shfl_xor(v, 8); v += __shfl_xor(v, 16); v += __shfl_xor(v, 32); acc[d] = v; }
        if (g == 0) { v4u w0, w1; w0.x = pk2(acc[0], acc[1]); w0.y = pk2(acc[2], acc[3]); w0.z = pk2(acc[4], acc[5]); w0.w = pk2(acc[6], acc[7]);
            w1.x = pk2(acc[8], acc[9]); w1.y = pk2(acc[10], acc[11]); w1.z = pk2(acc[12], acc[13]); w1.w = pk2(acc[14], acc[15]);
            unsigned char* o = POUT + (size_t)t * (DM * 2); *(GAS v4u*)(o + 2u * c16) = w0; *(GAS v4u*)(o + (2u * c16 + 16u)) = w1; }
    }
#undef LD_TOK
#undef LD_ROWS
#undef SLOT_ID
#undef SLOT_ACT
}
__device__ __forceinline__ void peer_final(const Args& A, int t, int lane) {
    unsigned char* ws = A.ws;
    const float* mod = (const float*)(ws + WS_MOD) + (size_t)(t >> 13) * NMOD; const bf16* POUT = (const bf16*)(ws + A_POUT);
    float* orow = A.out + (size_t)t * DM;
    f32x4 x2[4]; float s = 0.f;
#pragma unroll
    for (int j = 0; j < 4; ++j) { const int c = 256 * j + 4 * lane; const f32x4 x1 = *(const GAS f32x4*)(orow + c), gt = *(const GAS f32x4*)(mod + 5 * DM + c); const v2u w = *(const GAS v2u*)(POUT + (size_t)t * DM + c);
        f32x4 y; y[0] = x1[0] + gt[0] * bflo(w.x); y[1] = x1[1] + gt[1] * bfhi(w.x); y[2] = x1[2] + gt[2] * bflo(w.y); y[3] = x1[3] + gt[3] * bfhi(w.y);
        x2[j] = y; s += (y[0] * y[0] + y[1] * y[1]) + (y[2] * y[2] + y[3] * y[3]); }
    const float rr = 1.0f / sqrtf(wave_sum(s) * (1.f / DM) + EPS);
#pragma unroll
    for (int j = 0; j < 4; ++j) { const int c = 256 * j + 4 * lane; const f32x4 gf = *(const GAS f32x4*)(A.g_final + c); *(GAS f32x4*)(orow + c) = x2[j] * rr * gf; }
}

#ifndef MK_ONE_LAUNCH
#define MK_ONE_LAUNCH 1
#endif
constexpr int N_PHASES = 12;

__device__ __forceinline__ void biaspq_task(unsigned char* ws, int n, int lane) {
    const bf16* w = (const bf16*)(ws + WS_WPQ) + (size_t)n * DM + 16 * lane;
    float fa[8], fb[8]; unpack8(*(const GAS v4u*)w, fa); unpack8(*(const GAS v4u*)(w + 8), fb);
    float* bias = (float*)(ws + WS_BIASPQ);
#pragma unroll
    for (int b = 0; b < 4; ++b) { const GAS f32x4* sp = (const GAS f32x4*)((const float*)(ws + WS_MOD) + (size_t)b * NMOD + 3 * DM + 16 * lane);
        const f32x4 s0 = sp[0], s1 = sp[1], s2 = sp[2], s3 = sp[3]; float d = 0.f;
#pragma unroll
        for (int i = 0; i < 4; ++i) { d += fa[i] * s0[i]; d += fa[4 + i] * s1[i]; d += fb[i] * s2[i]; d += fb[4 + i] * s3[i]; }
        d = wave_sum(d); if (lane == 0) bias[b * 2048 + n] = d; }
}

__global__ void __launch_bounds__(NWAVES * 64, 2) mk_fwd(Args A) {
    extern __shared__ __attribute__((aligned(16))) unsigned char lds[];
    Frame F;
    F.lds = (LAS unsigned char*)lds;
    F.G = gridDim.x; { const int bx = blockIdx.x; F.vcu = (F.G % 8 == 0) ? (bx % 8) * (F.G / 8) + bx / 8 : bx; }
    F.NGW = F.G * NWAVES;
#define PHASE_BEGIN() do { int t_ = threadIdx.x; asm volatile("" : "+v"(t_)); F.tid = t_; F.lane = t_ & 63; F.wave = __builtin_amdgcn_readfirstlane(t_ >> 6); F.gw = F.vcu * NWAVES + F.wave; } while (0)
    PHASE_BEGIN();
    unsigned char* ws = A.ws;
    const int lo = A.ph_lo, hi = A.ph_hi;
#if MK_ONE_LAUNCH
    volatile LAS unsigned* MISC = (volatile LAS unsigned*)(F.lds + MISC_OFF);
    for (int u = F.tid; u < (LDS_BYTES - RING_BYTES) / 4; u += NWAVES * 64) ((LAS unsigned*)(F.lds + RING_BYTES))[u] = 0u;
    __syncthreads();
    XcdBarrier bar = xcd_barrier_post((unsigned*)(ws + WS_CTL) + CW_BAR, MISC + 8);
#define GRID_BAR() xcd_barrier(bar)
#else
#define GRID_BAR() do {} while (0)
#endif
#ifdef ONLY_PHASE
#define IN(k) ((k) == ONLY_PHASE && lo <= (k) && (k) < hi)
#else
#define IN(k) (lo <= (k) && (k) < hi)
#endif
#define BOTH(k) (IN(k) && IN((k) + 1))
#ifndef REPEAT_MASK
#define REPEAT_MASK 0
#endif
#define REPS(k) ((((REPEAT_MASK) >> (k)) & 1) + 1)

    if (IN(0)) for (int rep = 0; rep < REPS(0); ++rep) { PHASE_BEGIN(); if (rep) GRID_BAR(); p0_prologue(A, F); if (BOTH(0)) GRID_BAR(); }
    if (IN(1)) for (int rep = 0; rep < REPS(1); ++rep) { PHASE_BEGIN(); if (rep) GRID_BAR(); p1_hrows(A, F); if (BOTH(1)) GRID_BAR(); }
    if (IN(2)) for (int rep = 0; rep < REPS(2); ++rep) { PHASE_BEGIN(); if (rep) GRID_BAR();
        pg8::Gemm g{(const bf16*)((unsigned char*)A.out + O_H), (const bf16*)(ws + WS_WIN), TOK, NIN, DM}; pg8::StaticOrder S; S.init(TOK, NIN, F.G, (int)blockIdx.x);
        EpiG1 E{(bf16*)(ws + A_QSB), (bf16*)(ws + A_KSB), (bf16*)(ws + A_VSB), (bf16*)(ws + A_QD), (bf16*)(ws + A_KD), (bf16*)(ws + A_VD), (bf16*)(ws + A_GSB), (bf16*)(ws + A_GD),
                (const float*)(ws + WS_ROPEC), (const float*)(ws + WS_ROPES)};
        pg8::gemm_phase<EpiG1, pg8::StaticOrder, true, true>(F.lds, g, S, E);
        if (BOTH(2)) GRID_BAR();
    }
    if (IN(3)) for (int rep = 0; rep < REPS(3); ++rep) { PHASE_BEGIN(); if (rep) GRID_BAR(); p3_attention(A, F); if (BOTH(3)) GRID_BAR(); }
    if (IN(4)) for (int rep = 0; rep < REPS(4); ++rep) { PHASE_BEGIN(); if (rep) GRID_BAR();
        for (int n = F.gw; n < 2048; n += F.NGW) biaspq_task(ws, n, F.lane);
        __syncthreads();
        {   pg8::Gemm g{(const bf16*)((unsigned char*)A.out + O_OD), (const bf16*)(ws + WS_WDILO), TOK, DM, 256}; pg8::StaticOrder S; S.init(TOK, DM, F.G, (int)blockIdx.x);
            EpiMerge<false> E{(const bf16*)(ws + A_GD), (bf16*)(ws + A_MERGED)};
            pg8::gemm_phase<EpiMerge<false>, pg8::StaticOrder, true, true>(F.lds, g, S, E); }
        asm volatile("s_waitcnt vmcnt(0)" ::: "memory"); __syncthreads();
        {   pg8::Gemm g{(const bf16*)((unsigned char*)A.out + O_OSB), (const bf16*)(ws + WS_WSBO), TOK, DM, 512}; pg8::StaticOrder S; S.init(TOK, DM, F.G, (int)blockIdx.x);
            EpiMerge<true> E{(const bf16*)(ws + A_GSB), (bf16*)(ws + A_MERGED)};
            pg8::gemm_phase<EpiMerge<true>, pg8::StaticOrder, true, true>(F.lds, g, S, E); }
        if (BOTH(4)) GRID_BAR();
    }
    if (IN(5)) for (int rep = 0; rep < REPS(5); ++rep) { PHASE_BEGIN(); if (rep) GRID_BAR();
        pg8::Gemm g{(const bf16*)(ws + A_MERGED), (const bf16*)(ws + WS_WOUT), TOK, DM, DM}; pg8::StaticOrder S; S.init(TOK, DM, F.G, (int)blockIdx.x);
        EpiOut E{A.x, A.out, (bf16*)(ws + A_X1M), (float*)(ws + WS_SSQ), (const float*)(ws + WS_MOD), A.g_ffn};
        pg8::gemm_phase<EpiOut, pg8::StaticOrder, true, true>(F.lds, g, S, E);
        if (BOTH(5)) GRID_BAR();
    }
    if (IN(6)) for (int rep = 0; rep < REPS(6); ++rep) { PHASE_BEGIN(); if (rep) GRID_BAR();
        pg8::Gemm g{(const bf16*)(ws + A_X1M), (const bf16*)(ws + WS_WPQ), TOK, 2048, DM}; pg8::StaticOrder S; S.init(TOK, 2048, F.G, (int)blockIdx.x);
        EpiPq E{(const float*)(ws + WS_SSQ), (const float*)(ws + WS_BIASPQ), (bf16*)(ws + A_QPEER), (float*)(ws + WS_R2)};
        pg8::gemm_phase<EpiPq, pg8::StaticOrder, true, true>(F.lds, g, S, E);
        if (BOTH(6)) GRID_BAR();
    }
    if (IN(7)) for (int rep = 0; rep < REPS(7); ++rep) { PHASE_BEGIN(); if (rep) GRID_BAR();
        for (int t = F.gw; t < (TOK / 32) * 8; t += F.NGW) topk_task((const bf16*)(ws + A_QPEER), (const bf16*)(ws + WS_KEYS), (unsigned short*)(ws + A_IDX), (float*)(ws + A_GATE), t, F.lane, (LAS unsigned*)(F.lds + F.wave * 8192));
        if (BOTH(7)) GRID_BAR();
    }
    if (IN(8)) for (int rep = 0; rep < REPS(8); ++rep) { PHASE_BEGIN(); if (rep) GRID_BAR();
        peer_u_phase(A, F); if (BOTH(8)) GRID_BAR(); }
    if (IN(9)) { PHASE_BEGIN();
#ifdef VALU_PROBE
        { float a0 = F.lane, a1 = a0 + 1, a2 = a0 + 2, a3 = a0 + 3; unsigned w0 = F.tid * 2654435761u, w1 = w0 ^ 0x3c3c3c3cu, w2 = w0 + 77u, w3 = w0 + 99u;
          f32x2_t p0 = {a0, a1}, p1 = {a2, a3}, p2 = {a1, a2}, p3 = {a3, a0};
          for (int it = 0; it < 4096; ++it) {
#if VALU_PROBE == 1
              f32x2_t c0 = __builtin_amdgcn_cvt_pk_f32_fp8((int)w0, false), c1 = __builtin_amdgcn_cvt_pk_f32_fp8((int)w1, true), c2 = __builtin_amdgcn_cvt_pk_f32_fp8((int)w2, false), c3 = __builtin_amdgcn_cvt_pk_f32_fp8((int)w3, true);
              f32x2_t c4 = __builtin_amdgcn_cvt_pk_f32_fp8((int)w0, true), c5 = __builtin_amdgcn_cvt_pk_f32_fp8((int)w1, false), c6 = __builtin_amdgcn_cvt_pk_f32_fp8((int)w2, true), c7 = __builtin_amdgcn_cvt_pk_f32_fp8((int)w3, false);
              w0 ^= __float_as_uint(c0.x) ^ __float_as_uint(c4.y); w1 ^= __float_as_uint(c1.x) ^ __float_as_uint(c5.y); w2 ^= __float_as_uint(c2.x) ^ __float_as_uint(c6.y); w3 ^= __float_as_uint(c3.x) ^ __float_as_uint(c7.y);
#elif VALU_PROBE == 2
              p0 = p0 * p1 + p2; p1 = p1 * p2 + p3; p2 = p2 * p3 + p0; p3 = p3 * p0 + p1; p0 = p0 * p2 + p1; p1 = p1 * p3 + p2; p2 = p2 * p0 + p3; p3 = p3 * p1 + p0;
#else
              a0 = a0 * a1 + a2; a1 = a1 * a2 + a3; a2 = a2 * a3 + a0; a3 = a3 * a0 + a1; a0 = a0 * a2 + a1; a1 = a1 * a3 + a2; a2 = a2 * a0 + a3; a3 = a3 * a1 + a0;
#endif
          }
          if (a0 + a1 + a2 + a3 + p0.x + p1.y + p2.x + p3.y == 1.2345e33f || (w0 ^ w1 ^ w2 ^ w3) == 0x12345u) ((float*)(ws + WS_DUMP))[F.lane] = a0; }
#endif
#ifdef ICACHE_PROBE
        asm volatile(".rept 8000\n s_nop 0\n .endr" ::: "memory");
#endif
        peer_act_phase(A, F); if (BOTH(9)) GRID_BAR(); }
    if (IN(10)) for (int rep = 0; rep < REPS(10); ++rep) { PHASE_BEGIN(); if (rep) GRID_BAR(); peer_v_phase(A, F); if (BOTH(10)) GRID_BAR(); }
    if (IN(11)) { PHASE_BEGIN();
        for (int t = F.gw; t < TOK; t += F.NGW) peer_final(A, t, F.lane);
    }
#undef IN
#undef BOTH
}

extern "C" void kernel_launch(void* const* d_in, const int* in_sizes, int n_in, void* d_out, int out_size, void* d_ws, size_t ws_size, hipStream_t stream) {
    static int grid = 0;
    if (grid == 0) {
        if (n_in != 15 || in_sizes[0] != TOK * DM || out_size != TOK * DM || ws_size < WS_END) { fprintf(stderr, "kernel_launch: unexpected shapes (n_in %d, in0 %d, out %d, ws %zu < %zu)\n", n_in, n_in > 0 ? in_sizes[0] : -1, out_size, ws_size, (size_t)WS_END); grid = -1; return; }
        int dev = 0, cus = 0, per_cu = 0;
        if (hipGetDevice(&dev) != hipSuccess || hipDeviceGetAttribute(&cus, hipDeviceAttributeMultiprocessorCount, dev) != hipSuccess) { grid = -1; return; }
        if (hipFuncSetAttribute((const void*)mk_fwd, hipFuncAttributeMaxDynamicSharedMemorySize, LDS_BYTES) != hipSuccess) { fprintf(stderr, "kernel_launch: hipFuncSetAttribute failed\n"); grid = -1; return; }
        if (hipOccupancyMaxActiveBlocksPerMultiprocessor(&per_cu, (const void*)mk_fwd, NWAVES * 64, LDS_BYTES) != hipSuccess || per_cu < 1) { fprintf(stderr, "kernel_launch: occupancy query says %d\n", per_cu); per_cu = 1; }
        (void)hipGetLastError();
        grid = cus;
    }
    if (grid < 0) return;
    (void)hipMemsetAsync((char*)d_ws + WS_CTL, 0, CTL_ZERO_BYTES, stream);
    Args a{};
    a.x = (const float*)d_in[0]; a.c = (const float*)d_in[1]; a.w_ada = (const float*)d_in[2]; a.b_ada = (const float*)d_in[3]; a.g_mix = (const float*)d_in[4];
    a.w_in = (const float*)d_in[5]; a.w_sb_o = (const float*)d_in[6]; a.w_dil_o = (const float*)d_in[7]; a.w_out = (const float*)d_in[8]; a.g_ffn = (const float*)d_in[9];
    a.w_pq = (const float*)d_in[10]; a.peer_keys = (const float*)d_in[11]; a.peer_u = (const float*)d_in[12]; a.peer_v = (const float*)d_in[13]; a.g_final = (const float*)d_in[14];
    a.out = (float*)d_out; a.ws = (unsigned char*)d_ws;
#if MK_ONE_LAUNCH
    a.ph_lo = 0; a.ph_hi = N_PHASES;
    void* args[] = {&a};
    hipError_t e = hipLaunchCooperativeKernel((const void*)mk_fwd, dim3(grid), dim3(NWAVES * 64), args, LDS_BYTES, stream);
    if (e != hipSuccess) fprintf(stderr, "kernel_launch: cooperative launch failed: %s (grid %d)\n", hipGetErrorString(e), grid);
#else
    for (int p = 0; p < N_PHASES; ++p) { a.ph_lo = p; a.ph_hi = p + 1; hipLaunchKernelGGL(mk_fwd, dim3(grid), dim3(NWAVES * 64), LDS_BYTES, stream, a); }
#endif
}
```

```cpp
#include <hip/hip_runtime.h>
#include <hip/hip_cooperative_groups.h>
#include <cstdio>
#include <cstdint>
namespace pg8 {
#define PG8_LAS __attribute__((address_space(3)))
typedef unsigned short bf16_t;
typedef short bf16x8 __attribute__((ext_vector_type(8)));
typedef float f32x4 __attribute__((ext_vector_type(4)));
typedef unsigned u32x4 __attribute__((ext_vector_type(4)));
constexpr int BM = 256, BK = 64, HALF = 128, HTB = HALF * BK * 2  , STAGE_BYTES = 8 * HTB, NXCD = 8, WGM = 8;

__host__ __device__ __forceinline__ int lds_byte(int r, int c) { const int st = (r >> 4) * 2 + (c >> 5), rr = r & 15, cc = c & 31, ob = rr * 64 + cc * 2; return st * 1024 + (ob ^ (((ob >> 9) & 1) << 5)); }
__host__ __device__ __forceinline__ void stage_rc(int b, int& R, int& C) { const int st = b / 1024, sb = b % 1024, swz = sb ^ (((sb >> 9) & 1) << 5); R = (st >> 1) * 16 + swz / 64; C = (st & 1) * 32 + (swz % 64) / 2; }
__host__ __device__ __forceinline__ int perm32(int rho) { const int n = rho >> 4, i = rho & 15; return 8 * (i >> 2) + 4 * n + (i & 3); }

struct Unit { int pm, pn; };
struct Gemm { const bf16_t* A; const bf16_t* Bt; int M, N, K; };

struct StaticOrder {
    int nM, nN, nwg, G, c;
    __host__ __device__ void init(int M, int N, int G_, int c_) { nM = M / BM; nN = N / BM; nwg = nM * nN; G = G_; c = c_; }
    __host__ __device__ bool next(int i, Unit& u) const {
        const long L = (long)i * G + c; if (L >= nwg) return false;
        int wgid = (int)L; { const int q = nwg / NXCD, r = nwg % NXCD, xcd = wgid % NXCD, off = wgid / NXCD; wgid = (xcd < r ? xcd * (q + 1) : r * (q + 1) + (xcd - r) * q) + off; }
        const int nig = WGM * nN, gid = wgid / nig, fm = gid * WGM, gsz = (nM - fm) < WGM ? (nM - fm) : WGM;
        u.pm = fm + ((wgid % nig) % gsz); u.pn = (wgid % nig) / gsz; return true;
    }
    __device__ __forceinline__ void a_ready(const Unit&) const {}
    __device__ __forceinline__ void done(const Unit&) const {}
};

__device__ __forceinline__ unsigned cvt_pk_bf16(float lo, float hi) { unsigned r; asm volatile("v_cvt_pk_bf16_f32 %0, %1, %2" : "=v"(r) : "v"(lo), "v"(hi)); return r; }
template <class Epi, class Sched, bool ALIGN_EPI = false, bool SP2 = false>
__device__ __forceinline__ void gemm_phase(PG8_LAS unsigned char* lds, const Gemm g, const Sched& S, const Epi& E) {
    int tid_ = threadIdx.x; asm volatile("" : "+v"(tid_));
    const int tid = tid_, wid = __builtin_amdgcn_readfirstlane(tid >> 6), lane = tid & 63, wr = wid >> 2, wc = wid & 3, fr = lane & 15, fq = lane >> 4;
    const int K = g.K, nt = K / BK;
    unsigned voffA[2], voffB[2];
#pragma unroll
    for (int i = 0; i < 2; ++i) { int R, C; stage_rc(tid * 16 + i * 8192, R, C); const int Rb = Epi::PERM ? ((R & ~31) + perm32(R & 31)) : R;
        voffA[i] = (unsigned)(R * K + C) * 2u; voffB[i] = (unsigned)(Rb * K + C) * 2u; }
    const size_t kstep = (size_t)(BK * 2);
    const size_t hstep = (size_t)HALF * K * 2;
    const size_t tstep = 2 * hstep;
    const unsigned ldsw = (unsigned)wid * 1024u;
    const int aoff = lds_byte(wr * 64 + fr, fq * 8), boff = lds_byte(wc * 32 + fr, fq * 8);
#define PG8_SA(b, h) (((b) * 2 + (h)) * HTB)
#define PG8_SB(b, h) ((4 + (b) * 2 + (h)) * HTB)
#define PG8_STAGE(bufoff, gbase, voff) do { _Pragma("unroll") for (int _i = 0; _i < 2; ++_i) \
        __builtin_amdgcn_global_load_lds((const unsigned*)((const char*)(gbase) + (voff)[_i]), (PG8_LAS unsigned*)(lds + (bufoff) + ldsw + _i * 8192), 16, 0, 0); } while (0)
#define PG8_LDA(dst, b, h) do { _Pragma("unroll") for (int m = 0; m < 4; ++m) _Pragma("unroll") for (int k = 0; k < 2; ++k) dst[m][k] = *(const PG8_LAS bf16x8*)(lds + PG8_SA(b, h) + aoff + m * 2048 + k * 1024); } while (0)
#define PG8_LDB(dst, b, h) do { _Pragma("unroll") for (int n = 0; n < 2; ++n) _Pragma("unroll") for (int k = 0; k < 2; ++k) dst[n][k] = *(const PG8_LAS bf16x8*)(lds + PG8_SB(b, h) + boff + n * 2048 + k * 1024); } while (0)
#define PG8_MMA(ai, bj, At, Bt) do { __builtin_amdgcn_s_setprio(1); _Pragma("unroll") for (int m = 0; m < 4; ++m) _Pragma("unroll") for (int n = 0; n < 2; ++n) _Pragma("unroll") for (int k = 0; k < 2; ++k) \
        acc[ai][bj][m][n] = __builtin_amdgcn_mfma_f32_16x16x32_bf16(Bt[n][k], At[m][k], acc[ai][bj][m][n], 0, 0, 0); __builtin_amdgcn_s_setprio(0); } while (0)
#define PG8_WAIT_V(n) asm volatile("s_waitcnt vmcnt(" #n ")" ::: "memory")
#define PG8_WAIT_L(n) asm volatile("s_waitcnt lgkmcnt(" #n ")" ::: "memory")
#define PG8_BAR __builtin_amdgcn_s_barrier()
#define PG8_SCHED __builtin_amdgcn_sched_barrier(0)
    Unit cur, nxt; int ui = 0;
    if (!S.next(0, cur)) return;
    f32x4 acc[2][2][4][2];
#pragma unroll
    for (int a = 0; a < 2; ++a)
#pragma unroll
        for (int b = 0; b < 2; ++b)
#pragma unroll
            for (int m = 0; m < 4; ++m)
#pragma unroll
                for (int n = 0; n < 2; ++n) acc[a][b][m][n] = (f32x4){0.f, 0.f, 0.f, 0.f};
    bf16x8 At[4][2], B0[2][2], B1[2][2];
    const char* cA = (const char*)g.A + (size_t)cur.pm * tstep; const char* cB = (const char*)g.Bt + (size_t)cur.pn * tstep;
    S.a_ready(cur);
    if constexpr (SP2) {
        PG8_STAGE(PG8_SB(0, 0), cB, voffB); PG8_STAGE(PG8_SB(0, 1), cB + hstep, voffB); PG8_STAGE(PG8_SA(0, 0), cA, voffA); PG8_STAGE(PG8_SA(0, 1), cA + hstep, voffA);
        if (wr == 1) PG8_BAR;
        PG8_WAIT_V(2); PG8_BAR;
        PG8_STAGE(PG8_SB(1, 0), cB + kstep, voffB); PG8_STAGE(PG8_SA(1, 0), cA + kstep, voffA); PG8_STAGE(PG8_SB(1, 1), cB + hstep + kstep, voffB);
        PG8_WAIT_V(6); PG8_BAR;
    } else {
        PG8_STAGE(PG8_SB(0, 0), cB, voffB); PG8_STAGE(PG8_SA(0, 0), cA, voffA); PG8_STAGE(PG8_SB(0, 1), cB + hstep, voffB); PG8_STAGE(PG8_SA(0, 1), cA + hstep, voffA);
        if (wr == 1) PG8_BAR;
        PG8_WAIT_V(4); PG8_BAR;
        PG8_STAGE(PG8_SB(1, 0), cB + kstep, voffB); PG8_STAGE(PG8_SA(1, 0), cA + kstep, voffA); PG8_STAGE(PG8_SB(1, 1), cB + hstep + kstep, voffB);
        PG8_WAIT_V(6); PG8_BAR;
    }
    for (;;) {
        const bool has_next = S.next(ui + 1, nxt);
        const char* nA = has_next ? (const char*)g.A + (size_t)nxt.pm * tstep : cA; const char* nB = has_next ? (const char*)g.Bt + (size_t)nxt.pn * tstep : cB;
        for (int t = 0; t < nt; t += 2) {
            const bool last = (t == nt - 2);
            const char* a1 = cA + (size_t)(t + 1) * kstep;
            const char* a2 = last ? nA : cA + (size_t)(t + 2) * kstep; const char* b2 = last ? nB : cB + (size_t)(t + 2) * kstep;
            const char* a3 = a2 + kstep; const char* b3 = b2 + kstep;
            if (last && has_next) S.a_ready(nxt);
            if constexpr (SP2) {
            PG8_LDB(B0, 0, 0); PG8_LDB(B1, 0, 1); PG8_SCHED; PG8_LDA(At, 0, 0); PG8_STAGE(PG8_SA(1, 1), a1 + hstep, voffA);
            PG8_WAIT_V(8); PG8_WAIT_L(0); PG8_BAR; PG8_MMA(0, 0, At, B0); PG8_MMA(0, 1, At, B1); PG8_BAR; PG8_SCHED;
            PG8_LDA(At, 0, 1); PG8_STAGE(PG8_SB(0, 0), b2, voffB); PG8_STAGE(PG8_SB(0, 1), b2 + hstep, voffB); PG8_STAGE(PG8_SA(0, 0), a2, voffA);
            PG8_WAIT_V(8); PG8_WAIT_L(0); PG8_BAR; PG8_MMA(1, 0, At, B0); PG8_MMA(1, 1, At, B1); PG8_BAR; PG8_SCHED;
            PG8_LDB(B0, 1, 0); PG8_LDB(B1, 1, 1); PG8_SCHED; PG8_LDA(At, 1, 0); PG8_STAGE(PG8_SA(0, 1), a2 + hstep, voffA);
            PG8_WAIT_V(8); PG8_WAIT_L(0); PG8_BAR; PG8_MMA(0, 0, At, B0); PG8_MMA(0, 1, At, B1); PG8_BAR; PG8_SCHED;
            PG8_LDA(At, 1, 1); PG8_STAGE(PG8_SB(1, 0), b3, voffB); PG8_STAGE(PG8_SB(1, 1), b3 + hstep, voffB); PG8_STAGE(PG8_SA(1, 0), a3, voffA);
            PG8_WAIT_V(8); PG8_WAIT_L(0); PG8_BAR; PG8_MMA(1, 0, At, B0); PG8_MMA(1, 1, At, B1); PG8_BAR; PG8_SCHED;
            } else {
            PG8_LDB(B0, 0, 0); PG8_SCHED; PG8_LDA(At, 0, 0); PG8_STAGE(PG8_SA(1, 1), a1 + hstep, voffA);
            PG8_WAIT_L(8); PG8_BAR; PG8_WAIT_L(0); PG8_MMA(0, 0, At, B0); PG8_BAR; PG8_SCHED;
            PG8_LDB(B1, 0, 1); PG8_STAGE(PG8_SB(0, 0), b2, voffB);
            PG8_BAR; PG8_WAIT_L(0); PG8_MMA(0, 1, At, B1); PG8_BAR;
            PG8_LDA(At, 0, 1); PG8_STAGE(PG8_SA(0, 0), a2, voffA);
            PG8_BAR; PG8_WAIT_L(0); PG8_MMA(1, 0, At, B0); PG8_BAR; PG8_SCHED;
            PG8_STAGE(PG8_SB(0, 1), b2 + hstep, voffB);
            PG8_WAIT_V(6); PG8_BAR; PG8_MMA(1, 1, At, B1); PG8_BAR;
            PG8_LDB(B0, 1, 0); PG8_SCHED; PG8_LDA(At, 1, 0); PG8_STAGE(PG8_SA(0, 1), a2 + hstep, voffA);
            PG8_WAIT_L(8); PG8_BAR; PG8_WAIT_L(0); PG8_MMA(0, 0, At, B0); PG8_BAR; PG8_SCHED;
            PG8_LDB(B1, 1, 1); PG8_STAGE(PG8_SB(1, 0), b3, voffB);
            PG8_BAR; PG8_WAIT_L(0); PG8_MMA(0, 1, At, B1); PG8_BAR;
            PG8_LDA(At, 1, 1); PG8_STAGE(PG8_SA(1, 0), a3, voffA);
            PG8_BAR; PG8_WAIT_L(0); PG8_MMA(1, 0, At, B0); PG8_BAR; PG8_SCHED;
            PG8_STAGE(PG8_SB(1, 1), b3 + hstep, voffB);
            PG8_WAIT_V(6); PG8_BAR; PG8_MMA(1, 1, At, B1); PG8_BAR;
            }
        }
        if constexpr (ALIGN_EPI) { if (wr == 0) PG8_BAR; }
        if constexpr (!Epi::AFTER_DRAIN) { E(acc, cur, wr, wc, fr, fq); S.done(cur); }
        if (!has_next) break;
#pragma unroll
        for (int a = 0; a < 2; ++a)
#pragma unroll
            for (int b = 0; b < 2; ++b)
#pragma unroll
                for (int m = 0; m < 4; ++m)
#pragma unroll
                    for (int n = 0; n < 2; ++n) acc[a][b][m][n] = (f32x4){0.f, 0.f, 0.f, 0.f};
        cur = nxt; cA = nA; cB = nB; ++ui;
        if constexpr (ALIGN_EPI) { if (wr == 1) PG8_BAR; }
    }
    PG8_WAIT_V(0);
    if constexpr (!ALIGN_EPI) { if (wr == 0) PG8_BAR; }
    PG8_BAR;
    if constexpr (Epi::AFTER_DRAIN) { E.fused(acc, cur, wr, wc, fr, fq, lds, wid, lane); S.done(cur); }
#undef PG8_SA
#undef PG8_SB
#undef PG8_STAGE
#undef PG8_LDA
#undef PG8_LDB
#undef PG8_MMA
#undef PG8_WAIT_V
#undef PG8_WAIT_L
#undef PG8_BAR
#undef PG8_SCHED
}
}

#define GAS __attribute__((address_space(1)))
#define LAS __attribute__((address_space(3)))
typedef unsigned short bf16;
typedef unsigned v4u __attribute__((ext_vector_type(4)));
typedef unsigned v2u __attribute__((ext_vector_type(2)));
typedef float f32x4 __attribute__((ext_vector_type(4)));
typedef float f32x16 __attribute__((ext_vector_type(16)));
typedef short bf16x8 __attribute__((ext_vector_type(8)));
typedef short s16x4 __attribute__((ext_vector_type(4)));

constexpr int NWAVES = 8;
constexpr int NB = 4, SEQ = 8192, DM = 1024, TOK = NB * SEQ;
constexpr int NIN = 5888;
constexpr int SBH = 8, DILH = 12;
constexpr int NMOD = 6 * DM;
constexpr int KSPLIT = 16;
constexpr float EPS = 1e-6f;
constexpr float LOG2E = 1.4426950408889634f;
constexpr float C2 = 0.125f * LOG2E;
constexpr int PEER_E = 16384;

constexpr size_t MiB = 1u << 20;
constexpr size_t WS_CTL = 0, CTL_ZERO_BYTES = 1 * MiB;
constexpr size_t WS_MODP = 1 * MiB;
constexpr size_t WS_MOD = 2 * MiB + 512 * 1024;
constexpr size_t WS_BIASPQ = 2 * MiB + 768 * 1024;
constexpr size_t WS_ROPEC = 3 * MiB, WS_ROPES = 4 * MiB;
constexpr size_t WS_SSQ = 5 * MiB;
constexpr size_t WS_KEYS = 7 * MiB;
constexpr size_t WS_WIN = 8 * MiB;
constexpr size_t WS_WSBO = 20 * MiB;
constexpr size_t WS_WDILO = 21 * MiB;
constexpr size_t WS_WOUT = 22 * MiB;
constexpr size_t WS_WPQ = 24 * MiB;
constexpr size_t WS_UB = 32 * MiB, WS_VB = 64 * MiB;
constexpr size_t WS_ACT = 96 * MiB;
constexpr size_t A_QSB = WS_ACT, A_KSB = WS_ACT + 32 * MiB, A_VSB = WS_ACT + 64 * MiB;
constexpr size_t A_QD = WS_ACT + 96 * MiB, A_KD = WS_ACT + 144 * MiB, A_VD = WS_ACT + 192 * MiB;
constexpr size_t A_GSB = WS_ACT + 240 * MiB, A_GD = WS_ACT + 304 * MiB;
constexpr size_t A_MERGED = WS_ACT;
constexpr size_t A_X1M = WS_ACT + 64 * MiB;
constexpr size_t A_QPEER = WS_ACT + 128 * MiB;
constexpr size_t A_IDX = WS_ACT + 256 * MiB;
constexpr size_t A_GATE = WS_ACT + 272 * MiB;
constexpr size_t A_ACTG = WS_ACT + 288 * MiB;
constexpr size_t A_PART = WS_ACT + 128 * MiB;
constexpr size_t A_H2Q = WS_ACT + 304 * MiB;
constexpr size_t WS_HINV = 7 * MiB + 640 * 1024;
constexpr size_t A_H2F8 = WS_ACT + 304 * MiB;
constexpr size_t WS_DUMP = 7 * MiB + 768 * 1024;
constexpr size_t WS_R2 = 7 * MiB + 512 * 1024;
constexpr size_t A_POUT = WS_ACT;
constexpr size_t WS_END = WS_ACT + 368 * MiB;
constexpr size_t O_H = 0, O_OSB = 64 * MiB, O_OD = 96 * MiB, O_PO = 112 * MiB;

constexpr int CW_BAR = 4096;

constexpr int RING_BYTES = 131072;
constexpr int MISC_OFF = RING_BYTES + 320;
constexpr int LDS_BYTES = 147456;

#define RLX_AGENT __ATOMIC_RELAXED, __HIP_MEMORY_SCOPE_AGENT
__device__ __forceinline__ unsigned f2bf(float f) { unsigned u = __builtin_bit_cast(unsigned, f); return (u + 0x7fffu + ((u >> 16) & 1u)) >> 16; }
typedef float f32x2_t __attribute__((ext_vector_type(2))); typedef __bf16 bf16x2_t __attribute__((ext_vector_type(2)));
__device__ __forceinline__ unsigned pk2(float lo, float hi) { f32x2_t v = {lo, hi}; bf16x2_t b = __builtin_convertvector(v, bf16x2_t); return __builtin_bit_cast(unsigned, b); }
__device__ __forceinline__ float bflo(unsigned w) { return __uint_as_float(w << 16); }
__device__ __forceinline__ float bfhi(unsigned w) { return __uint_as_float(w & 0xffff0000u); }
__device__ __forceinline__ float wave_sum(float v) {
#pragma unroll
    for (int o = 1; o < 64; o <<= 1) v += __shfl_xor(v, o);
    return v;
}
__device__ __forceinline__ float fast_exp2(float x) { return __builtin_amdgcn_exp2f(x); }
__device__ __forceinline__ float fast_log2(float x) { return __builtin_amdgcn_logf(x); }
__device__ __forceinline__ float fast_rcp(float x) { return __builtin_amdgcn_rcpf(x); }
__device__ __forceinline__ float sigmoidf_(float x) { return fast_rcp(1.f + fast_exp2(-x * LOG2E)); }
#define XB_TMO      128
#define XB_XCNT(j)  (256  + 64 * (j))
#define XB_XSUB(j)  (1280 + 64 * (j))
#define XB_XGEN(j)  (2304 + 64 * (j))
#define XB_TOP      3328
#define XB_TOPGEN   3392
#define XCD_BAR_WORDS 3456
#define XB_SPIN_CAP (1u << 18)

__device__ __forceinline__ unsigned xb_ld(unsigned* p)              { return __hip_atomic_load(p, __ATOMIC_RELAXED, __HIP_MEMORY_SCOPE_AGENT); }
__device__ __forceinline__ unsigned xb_add(unsigned* p, unsigned v) { return __hip_atomic_fetch_add(p, v, __ATOMIC_RELAXED, __HIP_MEMORY_SCOPE_AGENT); }
__device__ __forceinline__ unsigned xb_xcc_id() { return (unsigned)__builtin_amdgcn_s_getreg((3 << 11) | 20) & 0xFu; }
#define XB_SPIN(cond, bar) do { unsigned _sp = 0; while (cond) { __builtin_amdgcn_s_sleep(1); \
    if ((++_sp & 255u) == 0u) { if (xb_ld(&(bar)[XB_TMO])) break; if (_sp > XB_SPIN_CAP) { atomicAdd(&(bar)[XB_TMO], 1u); break; } } } } while (0)

struct XcdBarrier {
    unsigned* bar; unsigned x;
    volatile LAS unsigned* st;
};

__device__ __forceinline__ XcdBarrier xcd_barrier_post(unsigned* bar, volatile LAS unsigned* st) {
    XcdBarrier b; b.bar = bar; b.x = xb_xcc_id(); b.st = st;
    if (threadIdx.x == 0) (void)xb_add(&bar[XB_XCNT(b.x)], 1u);
    return b;
}
__device__ __forceinline__ void xcd_barrier_complete(unsigned* bar, unsigned x, unsigned& nloc, unsigned& nx) {
    const unsigned G = gridDim.x * gridDim.y * gridDim.z;
    unsigned sum, cnt, mine, sp = 0u;
    for (;;) {
        sum = 0u; cnt = 0u; mine = 0u;
#pragma unroll
        for (unsigned j = 0; j < 16; ++j) { const unsigned c = xb_ld(&bar[XB_XCNT(j)]); sum += c; cnt += (c > 0u) ? 1u : 0u; mine = (j == x) ? c : mine; }
        if (sum == G) break;
        __builtin_amdgcn_s_sleep(1);
        if ((++sp & 255u) == 0u) { if (xb_ld(&bar[XB_TMO])) break; if (sp > XB_SPIN_CAP) { atomicAdd(&bar[XB_TMO], 1u); break; } }
    }
    nloc = mine > 0u ? mine : 1u; nx = cnt > 0u ? cnt : 1u;
}

__device__ __forceinline__ void xcd_barrier(const XcdBarrier& b) {
    asm volatile("s_waitcnt vmcnt(0)" ::: "memory");
    __syncthreads();
    if (threadIdx.x == 0) {
        unsigned* bar = b.bar;
        __builtin_amdgcn_s_waitcnt(0);
        unsigned nloc = b.st[0], nx = b.st[1];
        if (nloc == 0u) { xcd_barrier_complete(bar, b.x, nloc, nx); b.st[0] = nloc; b.st[1] = nx; }
        const unsigned old = xb_add(&bar[XB_XSUB(b.x)], 1u);
        const unsigned gen = old / nloc;
        if (old + 1u == (gen + 1u) * nloc) {
            __builtin_amdgcn_fence(__ATOMIC_RELEASE, "agent");
            asm volatile("s_waitcnt vmcnt(0)" ::: "memory");
            const unsigned og = xb_add(&bar[XB_TOP], 1u);
            const unsigned tg = og / nx;
            if (og + 1u == (tg + 1u) * nx) xb_add(&bar[XB_TOPGEN], 1u);
            else XB_SPIN(xb_ld(&bar[XB_TOPGEN]) == tg, bar);
            __builtin_amdgcn_fence(__ATOMIC_ACQUIRE, "agent");
            xb_add(&bar[XB_XGEN(b.x)], 1u);
            asm volatile("s_waitcnt vmcnt(0)" ::: "memory");
        } else {
            XB_SPIN(xb_ld(&bar[XB_XGEN(b.x)]) == gen, bar);
            __builtin_amdgcn_fence(__ATOMIC_ACQUIRE, "agent");
            asm volatile("s_waitcnt vmcnt(0)" ::: "memory");
        }
    }
    __syncthreads();
}

struct Args {
    const float* x; const float* c; const float* w_ada; const float* b_ada; const float* g_mix; const float* w_in; const float* w_sb_o; const float* w_dil_o;
    const float* w_out; const float* g_ffn; const float* w_pq; const float* peer_keys; const float* peer_u; const float* peer_v; const float* g_final;
    float* out; unsigned char* ws; int ph_lo, ph_hi;
};
struct Frame {
    LAS unsigned char* lds;
    int tid, lane, wave, vcu, G, gw, NGW;
};

__device__ __forceinline__ int win_row(int ncol) {
    const int tile = ncol >> 8;
    if (tile >= 6 && tile < 12) { const int d = ncol & 63; const int j = (d & 31) >> 2, i = (d & 3) + ((d >> 5) << 2); return (ncol & ~63) + 8 * j + i; }
    return ncol;
}
template <bool MAPWIN>
__device__ __forceinline__ void p0_transpose_item(const float* W, int K, int N, bf16* WT, LAS float* scr, int item, int lane) {
    const int nblk = N / 32, kb = item / nblk, nb = item % nblk, k0 = 64 * kb, n0 = 32 * nb;
#pragma unroll 8
    for (int i = 0; i < 32; ++i) { const int kk = 2 * i + (lane >> 5); scr[kk * 33 + (lane & 31)] = W[(size_t)(k0 + kk) * N + n0 + (lane & 31)]; }
    asm volatile("s_waitcnt lgkmcnt(0)" ::: "memory");
    const int c = lane & 7;
#pragma unroll
    for (int j = 0; j < 4; ++j) { const int n = (lane >> 3) + 8 * j; const LAS float* s = scr + (8 * c) * 33 + n;
        v4u o; o.x = pk2(s[0 * 33], s[1 * 33]); o.y = pk2(s[2 * 33], s[3 * 33]); o.z = pk2(s[4 * 33], s[5 * 33]); o.w = pk2(s[6 * 33], s[7 * 33]);
        const int rowo = MAPWIN ? win_row(n0 + n) : (n0 + n);
        *(GAS v4u*)(WT + (size_t)rowo * K + k0 + 8 * c) = o; }
    asm volatile("s_waitcnt lgkmcnt(0)" ::: "memory");
}
__device__ __forceinline__ void cvt_row_1024(const float* src, bf16* dst, int lane) {
    const GAS f32x4* s = (const GAS f32x4*)src + lane; GAS v2u* d = (GAS v2u*)dst + lane;
    f32x4 v[4];
#pragma unroll
    for (int j = 0; j < 4; ++j) v[j] = s[64 * j];
#pragma unroll
    for (int j = 0; j < 4; ++j) { v2u o; o.x = pk2(v[j].x, v[j].y); o.y = pk2(v[j].z, v[j].w); d[64 * j] = o; }
}
template <bool SLICED, bool I8 = false>
__device__ __forceinline__ void cvt_row_fp8(const float* src, unsigned char* dst, float* inv, int e, int lane) {
    const GAS f32x4* s = (const GAS f32x4*)src + lane;
    f32x4 v[4]; float m = 0.f;
#pragma unroll
    for (int j = 0; j < 4; ++j) { v[j] = s[64 * j]; m = fmaxf(m, fmaxf(fmaxf(fabsf(v[j].x), fabsf(v[j].y)), fmaxf(fabsf(v[j].z), fabsf(v[j].w)))); }
#pragma unroll
    for (int o = 1; o < 64; o <<= 1) m = fmaxf(m, __shfl_xor(m, o));
    m = fmaxf(m, 1e-30f);
    const int ex = (int)((__float_as_uint(m) >> 23) & 0xff) - 127;
    const float scale = __uint_as_float((unsigned)(127 + 7 - ex) << 23);
    const float iscale = __uint_as_float((unsigned)(127 - 7 + ex) << 23);
    unsigned w[4];
    if (I8) {
        const float s8 = 127.0f / m;
#pragma unroll
        for (int j = 0; j < 4; ++j) w[j] = ((unsigned)(int)__builtin_rintf(v[j].x * s8) & 0xffu) | (((unsigned)(int)__builtin_rintf(v[j].y * s8) & 0xffu) << 8) |
                                            (((unsigned)(int)__builtin_rintf(v[j].z * s8) & 0xffu) << 16) | (((unsigned)(int)__builtin_rintf(v[j].w * s8) & 0xffu) << 24);
    } else {
#pragma unroll
    for (int j = 0; j < 4; ++j) { int t = __builtin_amdgcn_cvt_pk_fp8_f32(v[j].x * scale, v[j].y * scale, 0, false); t = __builtin_amdgcn_cvt_pk_fp8_f32(v[j].z * scale, v[j].w * scale, t, true); w[j] = (unsigned)t; }
    }
    if (!SLICED) { *(GAS v4u*)(dst + (size_t)e * 1024 + 16 * lane) = (v4u){w[0], w[1], w[2], w[3]}; }
    else {
#pragma unroll
        for (int j = 0; j < 4; ++j) *(GAS unsigned*)(dst + (size_t)(2 * j + (lane >> 5)) * (2 * MiB) + (size_t)e * 128 + 4 * (lane & 31)) = w[j]; }
    if (lane == 0) inv[e] = I8 ? m * (1.0f / 127.0f) : iscale;
}
__device__ __forceinline__ void sincos_d(double a, float& sn, float& cs) {
    const double TWO_PI = 6.283185307179586476925286766559;
    const double k = __builtin_rint(a / TWO_PI); const double r = a - k * TWO_PI; const double r2 = r * r;
    double ts = 1.0, tc = 1.0, ss = 1.0, cc = 1.0;
#pragma unroll
    for (int n = 1; n <= 14; ++n) { tc = -tc * r2 / (double)((2 * n - 1) * (2 * n)); ts = -ts * r2 / (double)((2 * n) * (2 * n + 1)); cc += tc; ss += ts; }
    sn = (float)(r * ss); cs = (float)cc;
}

__device__ __forceinline__ void p0_prologue(const Args& A, Frame& F) {
    unsigned char* ws = A.ws;
    LAS float* scr = (LAS float*)(F.lds + F.wave * 16384);
    const int lane = F.lane;
    constexpr int I_MOD = KSPLIT * 24;
    constexpr int I_WIN = (DM / 64) * (NIN / 32);
    constexpr int I_SBO = (512 / 64) * (DM / 32), I_DILO = (256 / 64) * (DM / 32), I_OUT = (DM / 64) * (DM / 32), I_PQ = (DM / 64) * (2048 / 32);
    constexpr int I_KEYS = 256, I_TAB = 2 * PEER_E, I_ROPE = SEQ * 32 / 64;
    constexpr int NITEMS = I_MOD + I_WIN + I_SBO + I_DILO + I_OUT + I_PQ + I_KEYS + I_TAB + I_ROPE;
    for (int it = F.gw; it < NITEMS; it += F.NGW) {
        int r = it;
        if (r < I_MOD) {
            const int ks = r / 24, cc = r % 24, col = 256 * cc + 4 * lane, k0 = 64 * ks;
            float sv[4];
#pragma unroll
            for (int b = 0; b < 4; ++b) { const float cv = A.c[b * DM + k0 + lane]; sv[b] = cv * sigmoidf_(cv); }
            f32x4 acc[4];
#pragma unroll
            for (int b = 0; b < 4; ++b) acc[b] = (f32x4){0.f, 0.f, 0.f, 0.f};
            const GAS f32x4* wp = (const GAS f32x4*)(A.w_ada + (size_t)k0 * NMOD + col);
#pragma unroll 8
            for (int kk = 0; kk < 64; ++kk) { const f32x4 w4 = wp[(size_t)kk * (NMOD / 4)];
#pragma unroll
                for (int b = 0; b < 4; ++b) { const float s = __uint_as_float(__builtin_amdgcn_readlane(__float_as_uint(sv[b]), kk)); acc[b] += w4 * s; } }
            float* mp = (float*)(ws + WS_MODP);
#pragma unroll
            for (int b = 0; b < 4; ++b) *(GAS f32x4*)(mp + ((size_t)(ks * 4 + b)) * NMOD + col) = acc[b];
            continue;
        }
        r -= I_MOD;
        if (r < I_WIN) { p0_transpose_item<true>(A.w_in, DM, NIN, (bf16*)(ws + WS_WIN), scr, r, lane); continue; } r -= I_WIN;
        if (r < I_SBO) { p0_transpose_item<false>(A.w_sb_o, 512, DM, (bf16*)(ws + WS_WSBO), scr, r, lane); continue; } r -= I_SBO;
        if (r < I_DILO) { p0_transpose_item<false>(A.w_dil_o, 256, DM, (bf16*)(ws + WS_WDILO), scr, r, lane); continue; } r -= I_DILO;
        if (r < I_OUT) { p0_transpose_item<false>(A.w_out, DM, DM, (bf16*)(ws + WS_WOUT), scr, r, lane); continue; } r -= I_OUT;
        if (r < I_PQ) { p0_transpose_item<false>(A.w_pq, DM, 2048, (bf16*)(ws + WS_WPQ), scr, r, lane); continue; } r -= I_PQ;
        if (r < I_KEYS) { cvt_row_1024(A.peer_keys + (size_t)r * 1024, (bf16*)(ws + WS_KEYS) + (size_t)r * 1024, lane); continue; } r -= I_KEYS;
        if (r < I_TAB) { if (r < PEER_E) cvt_row_fp8<true, true>(A.peer_u + (size_t)r * 1024, ws + WS_UB, (float*)(ws + WS_UB + 16 * MiB), r, lane);
                         else cvt_row_fp8<true>(A.peer_v + (size_t)(r - PEER_E) * 1024, ws + WS_VB, (float*)(ws + WS_VB + 16 * MiB), r - PEER_E, lane); continue; } r -= I_TAB;
        {
            const int idx = r * 64 + lane, s = idx >> 5, j = idx & 31;
            const float inv = (float)exp2(-(double)j * (13.287712379549449 / 32.0));
            const float ang = (float)s * inv;
            float sn, cs; sincos_d((double)ang, sn, cs);
            ((float*)(ws + WS_ROPEC))[idx] = cs; ((float*)(ws + WS_ROPES))[idx] = sn;
        }
    }
}

__device__ __forceinline__ void p1_hrows(const Args& A, Frame& F) {
    unsigned char* ws = A.ws;
    LAS float* mult = (LAS float*)F.lds; LAS float* addv = mult + DM;
    const float* mp = (const float*)(ws + WS_MODP);
    float* mod = (float*)(ws + WS_MOD);
    bf16* H = (bf16*)((unsigned char*)A.out + O_H);
    for (int ch = F.vcu; ch < TOK / 128; ch += F.G) {
        const int b = (ch * 128) / SEQ;
        __syncthreads();
        for (int k = F.tid; k < DM; k += NWAVES * 64) {
            float sh = A.b_ada[k], sc = A.b_ada[DM + k];
#pragma unroll
            for (int ks = 0; ks < KSPLIT; ++ks) { sh += mp[(size_t)(ks * 4 + b) * NMOD + k]; sc += mp[(size_t)(ks * 4 + b) * NMOD + DM + k]; }
            mult[k] = A.g_mix[k] * (1.f + sc); addv[k] = sh;
        }
        if ((ch * 128) % SEQ == 0) {
            for (int j = F.tid; j < NMOD; j += NWAVES * 64) { float v = A.b_ada[j];
#pragma unroll
                for (int ks = 0; ks < KSPLIT; ++ks) v += mp[(size_t)(ks * 4 + b) * NMOD + j];
                mod[b * NMOD + j] = v; }
        }
        __syncthreads();
        for (int i = 0; i < 16; ++i) {
            const int row = ch * 128 + F.wave * 16 + i;
            const GAS f32x4* xr = (const GAS f32x4*)(A.x + (size_t)row * DM) + F.lane;
            f32x4 v[4]; float s = 0.f;
#pragma unroll
            for (int j = 0; j < 4; ++j) { v[j] = xr[64 * j]; s += (v[j].x * v[j].x + v[j].y * v[j].y) + (v[j].z * v[j].z + v[j].w * v[j].w); }
            const float rr = 1.0f / sqrtf(wave_sum(s) * (1.f / DM) + EPS);
            GAS v2u* o8 = (GAS v2u*)(H + (size_t)row * DM) + F.lane;
#pragma unroll
            for (int j = 0; j < 4; ++j) { const f32x4 mu = *(const LAS f32x4*)(mult + 256 * j + 4 * F.lane), ad = *(const LAS f32x4*)(addv + 256 * j + 4 * F.lane);
                const f32x4 hh = v[j] * rr * mu + ad; v2u o; o.x = pk2(hh.x, hh.y); o.y = pk2(hh.z, hh.w); o8[64 * j] = o; }
        }
    }
}

typedef pg8::f32x4 pf4;
struct EpiG1 {
    static constexpr bool PERM = true, AFTER_DRAIN = false;
    bf16 *Qsb, *Ksb, *Vsb, *Qd, *Kd, *Vd, *Gsb, *Gd; const float* ropeC; const float* ropeS;
    __device__ __forceinline__ void operator()(const pf4 (&acc)[2][2][4][2], const pg8::Unit& u, int wr, int wc, int fr, int fq) const {
        const int pn = u.pn;
        const int row0 = u.pm * 256 + wr * 64 + fr;
        const int b = (u.pm * 256) >> 13;
        if (pn < 6 || (pn >= 12 && pn < 15)) {
            bf16* base; int H, head0; float sc = 1.f;
            if (pn < 2) { base = Qsb; H = SBH; head0 = 4 * pn; sc = C2; }
            else if (pn < 4) { base = Ksb; H = SBH; head0 = 4 * (pn - 2); }
            else if (pn < 6) { base = Vsb; H = SBH; head0 = 4 * (pn - 4); }
            else { base = Vd; H = DILH; head0 = 4 * (pn - 12); }
            const int d0 = 32 * (wc & 1) + 8 * fq;
#pragma unroll
            for (int ai = 0; ai < 2; ++ai)
#pragma unroll
                for (int m = 0; m < 4; ++m) { const int s = (row0 + ai * 128 + m * 16) & (SEQ - 1);
#pragma unroll
                    for (int bj = 0; bj < 2; ++bj) { const int head = head0 + 2 * bj + (wc >> 1);
                        const pf4 v0 = acc[ai][bj][m][0] * sc, v1 = acc[ai][bj][m][1] * sc;
                        v4u w; w.x = pk2(v0[0], v0[1]); w.y = pk2(v0[2], v0[3]); w.z = pk2(v1[0], v1[1]); w.w = pk2(v1[2], v1[3]);
                        *(GAS v4u*)(base + ((size_t)(b * H + head) * SEQ + s) * 64 + d0) = w; } }
        } else if (pn < 12) {
            bf16* base; int head0; float sc = 1.f;
            if (pn < 9) { base = Qd; head0 = 4 * (pn - 6); sc = C2; } else { base = Kd; head0 = 4 * (pn - 9); }
            const int j4 = 4 * (4 * (wc & 1) + fq);
#pragma unroll
            for (int ai = 0; ai < 2; ++ai)
#pragma unroll
                for (int m = 0; m < 4; ++m) { const int s = (row0 + ai * 128 + m * 16) & (SEQ - 1);
                    const pf4 cs = *(const GAS pf4*)(ropeC + s * 32 + j4) * sc, sn = *(const GAS pf4*)(ropeS + s * 32 + j4) * sc;
#pragma unroll
                    for (int bj = 0; bj < 2; ++bj) { const int head = head0 + 2 * bj + (wc >> 1);
                        const pf4 x1 = acc[ai][bj][m][0], x2 = acc[ai][bj][m][1];
                        const pf4 o1 = x1 * cs - x2 * sn, o2 = x1 * sn + x2 * cs;
                        bf16* p = base + ((size_t)(b * DILH + head) * SEQ + s) * 64 + j4;
                        v2u w1, w2; w1.x = pk2(o1[0], o1[1]); w1.y = pk2(o1[2], o1[3]); w2.x = pk2(o2[0], o2[1]); w2.y = pk2(o2[2], o2[3]);
                        *(GAS v2u*)p = w1; *(GAS v2u*)(p + 32) = w2; } }
        } else {
            bf16* base = pn < 19 ? Gsb : Gd; const int ct = (pn < 19 ? pn - 15 : pn - 19) * 256 + wc * 32 + 8 * fq;
#pragma unroll
            for (int ai = 0; ai < 2; ++ai)
#pragma unroll
                for (int m = 0; m < 4; ++m) { const size_t row = (size_t)(row0 + ai * 128 + m * 16);
#pragma unroll
                    for (int bj = 0; bj < 2; ++bj) { const pf4 v0 = acc[ai][bj][m][0], v1 = acc[ai][bj][m][1];
                        v4u w; w.x = pk2(sigmoidf_(v0[0]), sigmoidf_(v0[1])); w.y = pk2(sigmoidf_(v0[2]), sigmoidf_(v0[3]));
                        w.z = pk2(sigmoidf_(v1[0]), sigmoidf_(v1[1])); w.w = pk2(sigmoidf_(v1[2]), sigmoidf_(v1[3]));
                        *(GAS v4u*)(base + row * DM + ct + bj * 128) = w; } }
        }
    }
};
template <bool SECOND> struct EpiMerge {
    static constexpr bool PERM = true, AFTER_DRAIN = false;
    const bf16* G; bf16* Mg;
    __device__ __forceinline__ void operator()(const pf4 (&acc)[2][2][4][2], const pg8::Unit& u, int wr, int wc, int fr, int fq) const {
        const int row0 = u.pm * 256 + wr * 64 + fr, col0 = u.pn * 256 + wc * 32 + 8 * fq;
#pragma unroll
        for (int ai = 0; ai < 2; ++ai)
#pragma unroll
            for (int m = 0; m < 4; ++m) { const size_t off = (size_t)(row0 + ai * 128 + m * 16) * DM + col0;
#pragma unroll
                for (int bj = 0; bj < 2; ++bj) { const v4u g = *(const GAS v4u*)(G + off + bj * 128);
                    pf4 v0 = acc[ai][bj][m][0], v1 = acc[ai][bj][m][1];
                    v0[0] *= bflo(g.x); v0[1] *= bfhi(g.x); v0[2] *= bflo(g.y); v0[3] *= bfhi(g.y); v1[0] *= bflo(g.z); v1[1] *= bfhi(g.z); v1[2] *= bflo(g.w); v1[3] *= bfhi(g.w);
                    if (SECOND) { const v4u t = *(const GAS v4u*)(Mg + off + bj * 128);
                        v0[0] += bflo(t.x); v0[1] += bfhi(t.x); v0[2] += bflo(t.y); v0[3] += bfhi(t.y); v1[0] += bflo(t.z); v1[1] += bfhi(t.z); v1[2] += bflo(t.w); v1[3] += bfhi(t.w); }
                    v4u w; w.x = pk2(v0[0], v0[1]); w.y = pk2(v0[2], v0[3]); w.z = pk2(v1[0], v1[1]); w.w = pk2(v1[2], v1[3]);
                    *(GAS v4u*)(Mg + off + bj * 128) = w; }
                asm volatile("" ::: "memory"); }
    }
};
struct EpiOut {
    static constexpr bool PERM = true, AFTER_DRAIN = false;
    const float* x; float* x1; bf16* x1m; float* ssq; const float* mod; const float* g_ffn;
    __device__ __forceinline__ void operator()(const pf4 (&acc)[2][2][4][2], const pg8::Unit& u, int wr, int wc, int fr, int fq) const {
        const int row0 = u.pm * 256 + wr * 64 + fr, col0 = u.pn * 256 + wc * 32 + 8 * fq;
        const int b = (u.pm * 256) >> 13; const float* mb = mod + (size_t)b * NMOD;
        pf4 gt[2][2], mm[2][2];
#pragma unroll
        for (int bj = 0; bj < 2; ++bj)
#pragma unroll
            for (int n = 0; n < 2; ++n) { const int c = col0 + bj * 128 + 4 * n; gt[bj][n] = *(const GAS pf4*)(mb + 2 * DM + c);
                mm[bj][n] = *(const GAS pf4*)(g_ffn + c) * (*(const GAS pf4*)(mb + 4 * DM + c) + 1.0f); }
#pragma unroll
        for (int ai = 0; ai < 2; ++ai)
#pragma unroll
            for (int m = 0; m < 4; ++m) { const int row = row0 + ai * 128 + m * 16; const size_t off = (size_t)row * DM + col0; float s = 0.f;
#pragma unroll
                for (int bj = 0; bj < 2; ++bj) {
                    const pf4 a0 = *(const GAS pf4*)(x + off + bj * 128), a1 = *(const GAS pf4*)(x + off + bj * 128 + 4);
                    const pf4 y0 = a0 + gt[bj][0] * acc[ai][bj][m][0], y1 = a1 + gt[bj][1] * acc[ai][bj][m][1];
                    *(GAS pf4*)(x1 + off + bj * 128) = y0; *(GAS pf4*)(x1 + off + bj * 128 + 4) = y1;
                    s += (y0[0] * y0[0] + y0[1] * y0[1]) + (y0[2] * y0[2] + y0[3] * y0[3]) + (y1[0] * y1[0] + y1[1] * y1[1]) + (y1[2] * y1[2] + y1[3] * y1[3]);
                    const pf4 z0 = y0 * mm[bj][0], z1 = y1 * mm[bj][1];
                    v4u w; w.x = pk2(z0[0], z0[1]); w.y = pk2(z0[2], z0[3]); w.z = pk2(z1[0], z1[1]); w.w = pk2(z1[2], z1[3]);
                    *(GAS v4u*)(x1m + off + bj * 128) = w; }
                s += __shfl_xor(s, 16); s += __shfl_xor(s, 32);
                if (fq == 0) ssq[(size_t)row * 16 + 4 * u.pn + wc] = s; }
    }
};
struct EpiPq {
    static constexpr bool PERM = true, AFTER_DRAIN = false;
    const float* ssq; const float* bias; bf16* Q; float* r2out;
    __device__ __forceinline__ void operator()(const pf4 (&acc)[2][2][4][2], const pg8::Unit& u, int wr, int wc, int fr, int fq) const {
        const int row0 = u.pm * 256 + wr * 64 + fr, col0 = u.pn * 256 + wc * 32 + 8 * fq;
        const int b = (u.pm * 256) >> 13; const float* bb = bias + (size_t)b * 2048;
        pf4 bv[2][2];
#pragma unroll
        for (int bj = 0; bj < 2; ++bj)
#pragma unroll
            for (int n = 0; n < 2; ++n) bv[bj][n] = *(const GAS pf4*)(bb + col0 + bj * 128 + 4 * n);
#pragma unroll
        for (int ai = 0; ai < 2; ++ai)
#pragma unroll
            for (int m = 0; m < 4; ++m) { const int row = row0 + ai * 128 + m * 16;
                const GAS pf4* sp = (const GAS pf4*)(ssq + (size_t)row * 16);
                const pf4 s4 = (sp[0] + sp[1]) + (sp[2] + sp[3]);
                const float r2 = 1.0f / sqrtf(((s4[0] + s4[1]) + (s4[2] + s4[3])) * (1.f / DM) + EPS);
                if (u.pn == 0 && wc == 0 && fq == 0) r2out[row] = r2;
#pragma unroll
                for (int bj = 0; bj < 2; ++bj) { const pf4 v0 = acc[ai][bj][m][0] * r2 + bv[bj][0], v1 = acc[ai][bj][m][1] * r2 + bv[bj][1];
                    v4u w; w.x = pk2(v0[0], v0[1]); w.y = pk2(v0[2], v0[3]); w.z = pk2(v1[0], v1[1]); w.w = pk2(v1[2], v1[3]);
                    *(GAS v4u*)(Q + (size_t)row * 2048 + col0 + bj * 128) = w; } }
    }
};

constexpr int VSTR = 144;
constexpr int ATT_WAVE_LDS = 2 * 32 * VSTR;
__device__ __forceinline__ int kappa(int r) { return (((r >> 2) & 1) << 4) + ((r >> 3) << 2) + (r & 3); }
struct KVTile { v4u k[4]; v4u v[4]; };
typedef short v4i16_t __attribute__((ext_vector_type(4)));
__device__ __forceinline__ s16x4 vtr(const LAS unsigned char* p) { return __builtin_bit_cast(s16x4, __builtin_amdgcn_ds_read_tr16_b64_v4i16((LAS v4i16_t*)p)); }

__device__ __forceinline__ void kv_load(KVTile& t, const bf16* Kh, const bf16* Vh, int base_tok, int sshift, int lane) {
#pragma unroll
    for (int i = 0; i < 4; ++i) { const size_t off = (size_t)(base_tok + (((lane >> 3) + 8 * i) << sshift)) * 64 + 8 * (lane & 7);
        t.k[i] = *(const GAS v4u*)(Kh + off); t.v[i] = *(const GAS v4u*)(Vh + off); }
}
__device__ __forceinline__ void v_to_lds(const KVTile& t, LAS unsigned char* vl, int lane) {
#pragma unroll
    for (int i = 0; i < 4; ++i) { const int o = ((lane >> 3) + 8 * i) * VSTR + 16 * (lane & 7); *(LAS v4u*)(vl + o) = t.k[i]; *(LAS v4u*)(vl + 32 * VSTR + o) = t.v[i]; }
}
__device__ __forceinline__ f32x16 qk_tile(const LAS unsigned char* vl, const bf16x8 (&qf)[4], int lane) {
    const LAS unsigned char* kp = vl + kappa(lane & 31) * VSTR + 16 * (lane >> 5);
    f32x16 s = {};
#pragma unroll
    for (int st = 0; st < 4; ++st) s = __builtin_amdgcn_mfma_f32_32x32x16_bf16(*(const LAS bf16x8*)(kp + 32 * st), qf[st], s, 0, 0, 0);
    return s;
}
__device__ __forceinline__ void pv_tile(f32x16& o0, f32x16& o1, const float (&p)[16], const LAS unsigned char* vl, int lane) {
    const int g = lane >> 4, li = lane & 15, q = li >> 2, pp = li & 3, h = g >> 1;
    const LAS unsigned char* tb = vl + 32 * VSTR + (16 * h + q) * VSTR + (16 * (g & 1) + 4 * pp) * 2;
    bf16x8 pf[2];
#pragma unroll
    for (int st = 0; st < 2; ++st) { v4u w; w.x = pk2(p[8 * st + 0], p[8 * st + 1]); w.y = pk2(p[8 * st + 2], p[8 * st + 3]); w.z = pk2(p[8 * st + 4], p[8 * st + 5]); w.w = pk2(p[8 * st + 6], p[8 * st + 7]); pf[st] = __builtin_bit_cast(bf16x8, w); }
#pragma unroll
    for (int db = 0; db < 2; ++db)
#pragma unroll
        for (int st = 0; st < 2; ++st) {
            const s16x4 lo = vtr(tb + (8 * st) * VSTR + 64 * db), hi = vtr(tb + (8 * st + 4) * VSTR + 64 * db);
            const bf16x8 vf = (bf16x8){lo[0], lo[1], lo[2], lo[3], hi[0], hi[1], hi[2], hi[3]};
            if (db == 0) o0 = __builtin_amdgcn_mfma_f32_32x32x16_bf16(vf, pf[st], o0, 0, 0, 0);
            else         o1 = __builtin_amdgcn_mfma_f32_32x32x16_bf16(vf, pf[st], o1, 0, 0, 0);
        }
}
__device__ __forceinline__ void o_store(bf16* orow, const f32x16& o0, const f32x16& o1, float sc, int hC) {
#pragma unroll
    for (int a = 0; a < 4; ++a) {
        v2u w0, w1; w0.x = pk2(o0[4 * a] * sc, o0[4 * a + 1] * sc); w0.y = pk2(o0[4 * a + 2] * sc, o0[4 * a + 3] * sc);
        w1.x = pk2(o1[4 * a] * sc, o1[4 * a + 1] * sc); w1.y = pk2(o1[4 * a + 2] * sc, o1[4 * a + 3] * sc);
        *(GAS v2u*)(orow + 8 * a + 4 * hC) = w0; *(GAS v2u*)(orow + 32 + 8 * a + 4 * hC) = w1; }
}

__device__ __forceinline__ void sb_task(const bf16* Qsb, const bf16* Ksb, const bf16* Vsb, bf16* Osb, int task, LAS unsigned char* vl, int lane) {
    const int qt = task & 255, bh = task >> 8, b = bh >> 3, h = bh & 7, t0 = qt * 32;
    const int q = lane & 31, hC = lane >> 5;
    const bf16* Kh = Ksb + (size_t)bh * SEQ * 64; const bf16* Vh = Vsb + (size_t)bh * SEQ * 64;
    bf16x8 qf[4];
    { const bf16* qp = Qsb + ((size_t)bh * SEQ + t0 + q) * 64 + 8 * hC;
#pragma unroll
      for (int st = 0; st < 4; ++st) qf[st] = *(const GAS bf16x8*)(qp + 16 * st); }
    f32x16 o0 = {}, o1 = {}; float carry = 0.f;
    KVTile nxt; kv_load(nxt, Kh, Vh, t0, 0, lane);
    for (int k0 = t0;; k0 -= 32) {
        KVTile cur = nxt;
        const bool more = k0 >= 32;
        if (more) kv_load(nxt, Kh, Vh, k0 - 32, 0, lane);
        v_to_lds(cur, vl, lane);
        const f32x16 s = qk_tile(vl, qf, lane);
        const bool diag = (k0 == t0);
        float L[16], z[16];
#pragma unroll
        for (int r = 0; r < 16; ++r) { z[r] = __builtin_amdgcn_fmed3f(s[r], -120.f, 120.f); const float e = fast_exp2(z[r]); L[r] = -fast_log2(1.f + e);
            if (diag && !(16 * hC + r < q)) L[r] = 0.f; }
        float c[16]; c[15] = L[15];
#pragma unroll
        for (int r = 14; r >= 0; --r) c[r] = c[r + 1] + L[r];
        const float tot = c[0], oth = __shfl_xor(tot, 32);
        const float base = carry + (hC ? 0.f : oth);
        float p[16];
#pragma unroll
        for (int r = 0; r < 16; ++r) { p[r] = fast_exp2(z[r] + (base + c[r])); if (diag && !(16 * hC + r < q)) p[r] = 0.f; }
        carry += tot + oth;
        pv_tile(o0, o1, p, vl, lane);
        if (!more) break;
        if (__all(carry < -160.f)) break;
    }
    o_store(Osb + ((size_t)(b * SEQ + t0 + q)) * 512 + h * 64, o0, o1, 1.f, hC);
}

__device__ __forceinline__ void dil_group(f32x16& o0, f32x16& o1, float& mrun, float& lsum, const bf16x8 (&qf)[4], const bf16* Kh, const bf16* Vh,
                                          int uq, int u_hi, int u_lo, int rs, int rho_g, LAS unsigned char* vl, int lane) {
    const int hC = lane >> 5;
    const int ub_last = u_lo & ~31;
    int ub = u_hi & ~31;
    KVTile nxt; kv_load(nxt, Kh, Vh, (ub << rs) + rho_g, rs, lane);
    for (;; ub -= 32) {
        KVTile cur = nxt;
        const bool more = ub > ub_last;
        if (more) kv_load(nxt, Kh, Vh, ((ub - 32) << rs) + rho_g, rs, lane);
        v_to_lds(cur, vl, lane);
        const f32x16 s = qk_tile(vl, qf, lane);
        float z[16]; float tmax = -1e30f;
        const int d0 = uq - (ub + 16 * hC);
#pragma unroll
        for (int r = 0; r < 16; ++r) { const bool valid = (unsigned)(d0 - r) <= 128u; z[r] = valid ? s[r] : -1e30f; tmax = fmaxf(tmax, z[r]); }
        tmax = fmaxf(tmax, __shfl_xor(tmax, 32));
        const float mnew = fmaxf(mrun, tmax); const float alpha = fast_exp2(mrun - mnew); mrun = mnew;
        float p[16]; float ps = 0.f;
#pragma unroll
        for (int r = 0; r < 16; ++r) { p[r] = (z[r] > -1e29f) ? fast_exp2(z[r] - mnew) : 0.f; ps += p[r]; }
        lsum = lsum * alpha + ps;
        if (!__all(alpha == 1.0f)) {
#pragma unroll
            for (int r = 0; r < 16; ++r) { o0[r] *= alpha; o1[r] *= alpha; }
        }
        pv_tile(o0, o1, p, vl, lane);
        if (!more) break;
    }
}
__device__ __forceinline__ void dil_g0_task(const bf16* Qd, const bf16* Kd, const bf16* Vd, bf16* PO, float* PM, int task, LAS unsigned char* vl, int lane) {
    const int qt = task & 255, hg = (task >> 8) & 3, b = task >> 10;
    const int q = lane & 31, hC = lane >> 5, t0 = 32 * qt, tq = t0 + q;
    f32x16 o0 = {}, o1 = {}; float mrun = -1e30f, lsum = 0.f;
    bf16x8 qf[4];
    { const bf16* qp = Qd + ((size_t)(b * DILH + hg) * SEQ + tq) * 64 + 8 * hC;
#pragma unroll
      for (int st = 0; st < 4; ++st) qf[st] = *(const GAS bf16x8*)(qp + 16 * st); }
    const bf16* Kh = Kd + (size_t)(b * DILH + hg) * SEQ * 64; const bf16* Vh = Vd + (size_t)(b * DILH + hg) * SEQ * 64;
    dil_group(o0, o1, mrun, lsum, qf, Kh, Vh, tq, t0 + 31, t0 >= 128 ? t0 - 128 : 0, 0, 0, vl, lane);
    const float l = lsum + __shfl_xor(lsum, 32);
    o_store(PO + (size_t)(b * SEQ + tq) * 256 + hg * 64, o0, o1, 1.0f, hC);
    if (hC == 0) *(GAS f32x2_t*)(PM + ((size_t)(b * SEQ + tq) * 4 + hg) * 2) = (f32x2_t){mrun, l};
}
__device__ __forceinline__ void dil_task(const bf16* Qd, const bf16* Kd, const bf16* Vd, const bf16* PO, const float* PM, bf16* Od, int task, LAS unsigned char* vl, int lane) {
    const int it = task & 15, rho = (task >> 4) & 15, hg = (task >> 8) & 3, b = task >> 10;
    const int q = lane & 31, hC = lane >> 5, i0 = 32 * it;
    const int tq = 16 * (i0 + q) + rho;
    f32x16 o0 = {}, o1 = {}; float mrun = -1e30f, lsum = 0.f;
#pragma unroll
    for (int g = 1; g < 3; ++g) {
        bf16x8 qf[4];
        { const bf16* qp = Qd + ((size_t)(b * DILH + g * 4 + hg) * SEQ + tq) * 64 + 8 * hC;
#pragma unroll
          for (int st = 0; st < 4; ++st) qf[st] = *(const GAS bf16x8*)(qp + 16 * st); }
        const int rs = 2 * g, cg = 16 >> rs, rho_g = rho & ((1 << rs) - 1), og = rho >> rs;
        const bf16* Kh = Kd + (size_t)(b * DILH + g * 4 + hg) * SEQ * 64; const bf16* Vh = Vd + (size_t)(b * DILH + g * 4 + hg) * SEQ * 64;
        int u_lo = cg * i0 + og - 128; u_lo = u_lo < 0 ? 0 : u_lo;
        dil_group(o0, o1, mrun, lsum, qf, Kh, Vh, cg * (i0 + q) + og, cg * (i0 + 31) + og, u_lo, rs, rho_g, vl, lane);
    }
    float l = lsum + __shfl_xor(lsum, 32);
    const f32x2_t ml = *(const GAS f32x2_t*)(PM + ((size_t)(b * SEQ + tq) * 4 + hg) * 2);
    const float mn = fmaxf(mrun, ml.x), sa = fast_exp2(mrun - mn), sb = fast_exp2(ml.x - mn);
    l = l * sa + ml.y * sb;
    const bf16* pr = PO + (size_t)(b * SEQ + tq) * 256 + hg * 64;
#pragma unroll
    for (int a = 0; a < 4; ++a) { const v2u w0 = *(const GAS v2u*)(pr + 8 * a + 4 * hC), w1 = *(const GAS v2u*)(pr + 32 + 8 * a + 4 * hC);
        o0[4 * a] = o0[4 * a] * sa + bflo(w0.x) * sb; o0[4 * a + 1] = o0[4 * a + 1] * sa + bfhi(w0.x) * sb; o0[4 * a + 2] = o0[4 * a + 2] * sa + bflo(w0.y) * sb; o0[4 * a + 3] = o0[4 * a + 3] * sa + bfhi(w0.y) * sb;
        o1[4 * a] = o1[4 * a] * sa + bflo(w1.x) * sb; o1[4 * a + 1] = o1[4 * a + 1] * sa + bfhi(w1.x) * sb; o1[4 * a + 2] = o1[4 * a + 2] * sa + bflo(w1.y) * sb; o1[4 * a + 3] = o1[4 * a + 3] * sa + bfhi(w1.y) * sb; }
    o_store(Od + (size_t)(b * SEQ + tq) * 256 + hg * 64, o0, o1, 1.0f / l, hC);
}

__device__ __forceinline__ void p3_attention(const Args& A, Frame& F, int pass) {
    unsigned char* ws = A.ws;
    LAS unsigned char* vl = F.lds + F.wave * ATT_WAVE_LDS;
    const bf16 *Qsb = (const bf16*)(ws + A_QSB), *Ksb = (const bf16*)(ws + A_KSB), *Vsb = (const bf16*)(ws + A_VSB);
    const bf16 *Qd = (const bf16*)(ws + A_QD), *Kd = (const bf16*)(ws + A_KD), *Vd = (const bf16*)(ws + A_VD);
    bf16* Osb = (bf16*)((unsigned char*)A.out + O_OSB); bf16* Od = (bf16*)((unsigned char*)A.out + O_OD);
    bf16* PO = (bf16*)((unsigned char*)A.out + O_PO); float* PM = (float*)(ws + WS_SSQ);
    constexpr int N_DIL = NB * 4 * 16 * 16, N_SB = NB * SBH * (SEQ / 32);
    if (pass == 0) {
        for (int t = F.gw; t < N_DIL + N_SB; t += F.NGW) {
            if (t < N_DIL) dil_g0_task(Qd, Kd, Vd, PO, PM, t, vl, F.lane);
            else sb_task(Qsb, Ksb, Vsb, Osb, t - N_DIL, vl, F.lane);
        }
    } else {
        for (int t = F.gw; t < N_DIL; t += F.NGW) dil_task(Qd, Kd, Vd, PO, PM, Od, t, vl, F.lane);
    }
}

__device__ __forceinline__ unsigned sortable(float f) { const unsigned u = __float_as_uint(f); return u ^ ((unsigned)((int)u >> 31) | 0x80000000u); }
__device__ __forceinline__ float unsortable(unsigned s) { const unsigned u = (s & 0x80000000u) ? (s ^ 0x80000000u) : ~s; return __uint_as_float(u); }
__device__ __forceinline__ unsigned umax_(unsigned a, unsigned b) { return a > b ? a : b; }

#define CE_(a, b) do { const unsigned hi_ = umax_(a, b), lo_ = umin_(a, b); a = hi_; b = lo_; } while (0)
__device__ __forceinline__ unsigned umin_(unsigned a, unsigned b) { return a < b ? a : b; }
template <int N, int OFF, int TOT> __device__ __forceinline__ void bitonic_sort_desc(unsigned (&v)[TOT]) {
#pragma unroll
    for (int k = 2; k <= N; k <<= 1)
#pragma unroll
        for (int j = k >> 1; j > 0; j >>= 1)
#pragma unroll
            for (int i = 0; i < N; ++i) { const int l = i ^ j; if (l > i) { if ((i & k) == 0) CE_(v[OFF + i], v[OFF + l]); else CE_(v[OFF + l], v[OFF + i]); } }
}
__device__ __forceinline__ void bitonic_merge16_desc(unsigned (&t)[16]) {
#pragma unroll
    for (int j = 8; j > 0; j >>= 1)
#pragma unroll
        for (int i = 0; i < 16; ++i) { const int l = i ^ j; if (l > i) CE_(t[i], t[l]); }
}
__device__ __forceinline__ void merge_top16(unsigned (&out)[16], const unsigned* a, const unsigned* b) {
#pragma unroll
    for (int i = 0; i < 16; ++i) out[i] = umax_(a[i], b[15 - i]);
    bitonic_merge16_desc(out);
}
__device__ __forceinline__ void cross_lane_top16(unsigned (&top)[16]) {
    unsigned t[16];
#pragma unroll
    for (int i = 0; i < 16; ++i) t[i] = umax_(top[i], (unsigned)__shfl_xor((int)top[15 - i], 32));
    bitonic_merge16_desc(t);
#pragma unroll
    for (int i = 0; i < 16; ++i) top[i] = t[i];
}
__device__ __forceinline__ void top16_of_128(unsigned (&key)[64], LAS unsigned* top  , int lane) {
    bitonic_sort_desc<16, 0, 64>(key); bitonic_sort_desc<16, 16, 64>(key); bitonic_sort_desc<16, 32, 64>(key); bitonic_sort_desc<16, 48, 64>(key);
    unsigned m0[16], m1[16], m[16];
    merge_top16(m0, &key[0], &key[16]); merge_top16(m1, &key[32], &key[48]); merge_top16(m, m0, m1);
    cross_lane_top16(m);
#pragma unroll
    for (int it = 0; it < 16; ++it) top[it * 32 + (lane & 31)] = m[it];
}
__device__ __forceinline__ unsigned pk_lookup(unsigned p0, unsigned p1, unsigned p2, unsigned p3, unsigned a) {
    const unsigned hi = a >> 2; unsigned d = p0; d = hi == 1 ? p1 : d; d = hi == 2 ? p2 : d; d = hi == 3 ? p3 : d;
    return (d >> (8 * (a & 3))) & 0xffu;
}
__device__ __forceinline__ unsigned pack4idx(unsigned t0, unsigned t1, unsigned t2, unsigned t3) { return (127u - (t0 & 127u)) | ((127u - (t1 & 127u)) << 8) | ((127u - (t2 & 127u)) << 16) | ((127u - (t3 & 127u)) << 24); }

constexpr int P7_KSTR = 272, P7_KEYS_BYTES = 256 * P7_KSTR, P7_TL_WAVE = 4096;
__device__ __forceinline__ void topk_phase(const bf16* Qp, const bf16* Kb, unsigned short* IDX, float* GATE, Frame& F) {
    const int lane = F.lane, q = lane & 31, hC = lane >> 5;
    LAS unsigned char* kl = F.lds;
    LAS unsigned* tl = (LAS unsigned*)(F.lds + P7_KEYS_BYTES + F.wave * P7_TL_WAVE);
    const int t0 = (F.vcu * 4 + (F.wave & 3)) * 32, hsel = F.wave >> 2;
#pragma unroll 1
  for (int rnd = 0; rnd < 4; ++rnd) {
    const int ph = 2 * rnd + hsel;
#pragma unroll 1
    for (int half = 0; half < 2; ++half) {
        __syncthreads();
#pragma unroll
        for (int i = 0; i < 8; ++i) { const int idx = F.tid + 512 * i, row = idx >> 4, ch = idx & 15;
            const v4u w = *(const GAS v4u*)(Kb + ((size_t)((2 * rnd + (row >> 7)) * 2 + half) * 128 + (row & 127)) * 128 + 8 * ch);
            *(LAS v4u*)(kl + row * P7_KSTR + 16 * ch) = w; }
        bf16x8 qf[8];
        { const bf16* qp = Qp + (size_t)(t0 + q) * 2048 + ph * 256 + half * 128 + 8 * hC;
#pragma unroll
          for (int st = 0; st < 8; ++st) qf[st] = *(const GAS bf16x8*)(qp + 16 * st); }
        __syncthreads();
        f32x16 C[4] = {};
        const LAS unsigned char* kb = kl + (hsel * 128 + q) * P7_KSTR + 16 * hC;
#pragma unroll
        for (int st = 0; st < 8; ++st)
#pragma unroll
            for (int mt = 0; mt < 4; ++mt) C[mt] = __builtin_amdgcn_mfma_f32_32x32x16_bf16(*(const LAS bf16x8*)(kb + mt * 32 * P7_KSTR + 32 * st), qf[st], C[mt], 0, 0, 0);
        unsigned key[64];
#pragma unroll
        for (int mt = 0; mt < 4; ++mt)
#pragma unroll
            for (int r = 0; r < 16; ++r) { const int kidx = 32 * mt + (r & 3) + 8 * (r >> 2) + 4 * hC; key[16 * mt + r] = (sortable(C[mt][r]) & ~127u) | (unsigned)(127 - kidx); }
        top16_of_128(key, tl + half * 512, lane);
    }
    unsigned tops[2][16];
#pragma unroll
    for (int a = 0; a < 16; ++a) { tops[0][a] = tl[a * 32 + q]; tops[1][a] = tl[512 + a * 32 + q]; }
    float s0[16], s1[16];
#pragma unroll
    for (int a = 0; a < 16; ++a) { s0[a] = unsortable(tops[0][a] & ~127u); s1[a] = unsortable(tops[1][a] & ~127u); }
    const unsigned pa0 = pack4idx(tops[0][0], tops[0][1], tops[0][2], tops[0][3]), pa1 = pack4idx(tops[0][4], tops[0][5], tops[0][6], tops[0][7]),
                   pa2 = pack4idx(tops[0][8], tops[0][9], tops[0][10], tops[0][11]), pa3 = pack4idx(tops[0][12], tops[0][13], tops[0][14], tops[0][15]);
    const unsigned pb0 = pack4idx(tops[1][0], tops[1][1], tops[1][2], tops[1][3]), pb1 = pack4idx(tops[1][4], tops[1][5], tops[1][6], tops[1][7]),
                   pb2 = pack4idx(tops[1][8], tops[1][9], tops[1][10], tops[1][11]), pb3 = pack4idx(tops[1][12], tops[1][13], tops[1][14], tops[1][15]);
    unsigned cand[32];
    {
        int n = 0;
#pragma unroll
        for (int a = 0; a < 16; ++a)
#pragma unroll
            for (int bq = 0; bq < 16; ++bq) if ((a + 1) * (bq + 1) <= 16) {
                const unsigned ck = (sortable(s0[a] + s1[bq]) & ~255u) | (unsigned)(a * 16 + bq);
                if (n < 25) cand[n] = ck; else cand[n - 25] = hC ? ck : cand[n - 25];
                ++n; }
#pragma unroll
        for (int i = 25; i < 32; ++i) cand[i] = 0u;
    }
    bitonic_sort_desc<32, 0, 32>(cand);
    unsigned win[16];
#pragma unroll
    for (int i = 0; i < 16; ++i) win[i] = cand[i];
    cross_lane_top16(win);
    float gv[16]; int eid[16]; float gs = 0.f;
    const float vmax = unsortable(win[0] & ~255u);
#pragma unroll
    for (int k = 0; k < 16; ++k) { const unsigned a = (win[k] >> 4) & 15u, bq = win[k] & 15u;
        eid[k] = (int)(pk_lookup(pa0, pa1, pa2, pa3, a) * 128u + pk_lookup(pb0, pb1, pb2, pb3, bq));
        gv[k] = fast_exp2((unsortable(win[k] & ~255u) - vmax) * LOG2E); gs += gv[k]; }
    const float ginv = 1.0f / gs;
#ifdef P7_TIME_SORT
    { const unsigned long long t1_ = __builtin_amdgcn_s_memrealtime(); while (__builtin_amdgcn_s_memrealtime() - t1_ < 4ull * tsort) __builtin_amdgcn_s_sleep(1); }
#endif
    const size_t o = (size_t)(t0 + q) * 128 + ph * 16;
    if (hC == 0) {
#pragma unroll
        for (int k = 0; k < 16; k += 8) *(GAS v4u*)(IDX + o + k) = (v4u){(unsigned)eid[k] | ((unsigned)eid[k + 1] << 16), (unsigned)eid[k + 2] | ((unsigned)eid[k + 3] << 16),
                                                                         (unsigned)eid[k + 4] | ((unsigned)eid[k + 5] << 16), (unsigned)eid[k + 6] | ((unsigned)eid[k + 7] << 16)};
    } else {
#pragma unroll
        for (int k = 0; k < 16; k += 4) *(GAS f32x4*)(GATE + o + k) = (f32x4){gv[k] * ginv, gv[k + 1] * ginv, gv[k + 2] * ginv, gv[k + 3] * ginv};
    }
  }
}

__device__ __forceinline__ float gelu_tanh(float x) {
    const float y2 = 2.0f * 0.7978845608028654f * (x + 0.044715f * x * x * x);
    return x * fast_rcp(1.f + fast_exp2(-y2 * LOG2E));
}
__device__ __forceinline__ void unpack8(const v4u w, float (&f)[8]) { f[0] = bflo(w.x); f[1] = bfhi(w.x); f[2] = bflo(w.y); f[3] = bfhi(w.y); f[4] = bflo(w.z); f[5] = bfhi(w.z); f[6] = bflo(w.w); f[7] = bfhi(w.w); }
__device__ __forceinline__ void h2q_row(unsigned char* ws, int t, int lane) {
    const bf16* xr = (const bf16*)(ws + A_X1M) + (size_t)t * DM + 16 * lane; const float* sh = (const float*)(ws + WS_MOD) + (size_t)(t >> 13) * NMOD + 3 * DM + 16 * lane;
    const float r2 = ((const float*)(ws + WS_R2))[t];
    float fa[8], fb[8]; unpack8(*(const GAS v4u*)xr, fa); unpack8(*(const GAS v4u*)(xr + 8), fb);
    float h[16]; float m = 0.f;
#pragma unroll
    for (int k = 0; k < 2; ++k) { const f32x4 s0 = *(const GAS f32x4*)(sh + 4 * k), s1 = *(const GAS f32x4*)(sh + 8 + 4 * k);
#pragma unroll
        for (int i = 0; i < 4; ++i) { h[4 * k + i] = fa[4 * k + i] * r2 + s0[i]; h[8 + 4 * k + i] = fb[4 * k + i] * r2 + s1[i]; m = fmaxf(m, fmaxf(fabsf(h[4 * k + i]), fabsf(h[8 + 4 * k + i]))); } }
#pragma unroll
    for (int o = 1; o < 64; o <<= 1) m = fmaxf(m, __shfl_xor(m, o));
    m = fmaxf(m, 1e-30f);
    const float sc = 127.0f / m;
    unsigned w[4];
#pragma unroll
    for (int j = 0; j < 4; ++j) { unsigned ww = 0;
#pragma unroll
        for (int i = 0; i < 4; ++i) { const int qv = (int)__builtin_rintf(h[4 * j + i] * sc); ww |= ((unsigned)qv & 0xffu) << (8 * i); }
        w[j] = ww; }
    *(GAS v4u*)(ws + A_H2Q + (size_t)t * DM + 16 * lane) = (v4u){w[0], w[1], w[2], w[3]};
    if (lane == 0) ((float*)(ws + WS_HINV))[t] = m * (1.0f / 127.0f);
}
__device__ __forceinline__ void unpack_fp8x16(const v4u w, float (&f)[16]) {
#pragma unroll
    for (int j = 0; j < 4; ++j) { const f32x2_t a = __builtin_amdgcn_cvt_pk_f32_fp8((int)w[j], false), b = __builtin_amdgcn_cvt_pk_f32_fp8((int)w[j], true);
        f[4 * j] = a.x; f[4 * j + 1] = a.y; f[4 * j + 2] = b.x; f[4 * j + 3] = b.y; }
}
__device__ __forceinline__ void peer_u_phase(const Args& A, Frame& F) {
    unsigned char* ws = A.ws;
    const int lane = F.lane, x = blockIdx.x & 7, wrk = (blockIdx.x >> 3) * NWAVES + F.wave, nwr = (F.G >> 3) * NWAVES, g = lane >> 3, c = lane & 7;
    const unsigned char* U8 = ws + WS_UB + (size_t)x * (2 * MiB); const unsigned c16 = 16u * c, g32 = 32u * g;
    const unsigned char* H2Q = ws + A_H2Q + 128 * x; const unsigned char* IDX = ws + A_IDX;
    bf16* PART = (bf16*)(ws + A_PART) + (size_t)x * TOK * 128;
    const int per = TOK / nwr, tb = wrk * per;
    v4u idC[2], idN[2], hC4, hN4;
#define SLOT_ID(ID, sl) (((ID)[(sl) >> 3][((sl) >> 1) & 3] >> (16 * ((sl) & 1))) & 0xffffu)
#define LD_TOK(ID, HV, T) do { const unsigned char* ib_ = IDX + (size_t)(T) * 256; ID[0] = *(const GAS v4u*)(ib_ + g32); ID[1] = *(const GAS v4u*)(ib_ + (g32 + 16u)); \
        HV = *(const GAS v4u*)(H2Q + (size_t)(T) * DM + c16); } while (0)
#define LD_ROWS(R, ID, H) do { _Pragma("unroll") for (int i = 0; i < 8; ++i) R[i] = *(const GAS v4u*)(U8 + (SLOT_ID(ID, 8 * (H) + i) * 128u + c16)); } while (0)
#define DOT16(R, HV) __builtin_amdgcn_sdot4((int)(R)[3], (int)(HV)[3], __builtin_amdgcn_sdot4((int)(R)[2], (int)(HV)[2], __builtin_amdgcn_sdot4((int)(R)[1], (int)(HV)[1], __builtin_amdgcn_sdot4((int)(R)[0], (int)(HV)[0], 0, false), false), false), false)
    LD_TOK(idC, hC4, tb);
    v4u R0[8], R1[8];
    LD_ROWS(R0, idC, 0);
    LD_TOK(idN, hN4, tb + 1 < TOK ? tb + 1 : tb);
    for (int t = tb; t < tb + per; ++t) {
        LD_ROWS(R1, idC, 1);
        int p[16];
#pragma unroll
        for (int i = 0; i < 8; ++i) p[i] = DOT16(R0[i], hC4);
        LD_ROWS(R0, idN, 0);
#pragma unroll
        for (int i = 0; i < 8; ++i) p[8 + i] = DOT16(R1[i], hC4);
        idC[0] = idN[0]; idC[1] = idN[1]; hC4 = hN4;
        { const int tn = t + 2 < tb + per ? t + 2 : tb + per - 1; LD_TOK(idN, hN4, tn); }
        const bool b0 = lane & 1, b1 = lane & 2, b2 = lane & 4;
        int q8[8], q4[4], q2[2];
#pragma unroll
        for (int i = 0; i < 8; ++i) q8[i] = (b0 ? p[8 + i] : p[i]) + __shfl_xor(b0 ? p[i] : p[8 + i], 1);
#pragma unroll
        for (int i = 0; i < 4; ++i) q4[i] = (b1 ? q8[4 + i] : q8[i]) + __shfl_xor(b1 ? q8[i] : q8[4 + i], 2);
#pragma unroll
        for (int i = 0; i < 2; ++i) q2[i] = (b2 ? q4[2 + i] : q4[i]) + __shfl_xor(b2 ? q4[i] : q4[2 + i], 4);
        const int slot = 16 * g + 8 * (lane & 1) + 4 * ((lane >> 1) & 1) + 2 * ((lane >> 2) & 1);
        *(GAS unsigned*)(PART + (size_t)t * 128 + slot) = pk2((float)q2[0], (float)q2[1]);
    }
#undef LD_TOK
#undef LD_ROWS
#undef SLOT_ID
#undef DOT16
}
__device__ __forceinline__ void peer_act_phase(const Args& A, Frame& F) {
    unsigned char* ws = A.ws;
    const bf16* PART = (const bf16*)(ws + A_PART); const unsigned short* IDX = (const unsigned short*)(ws + A_IDX); const float* GATE = (const float*)(ws + A_GATE); bf16* ACTG = (bf16*)(ws + A_ACTG);
    const float* UINV = (const float*)(ws + WS_UB + 16 * MiB); const float* VINV = (const float*)(ws + WS_VB + 16 * MiB); const float* HINV = (const float*)(ws + WS_HINV);
    const size_t n4 = (size_t)TOK * 128 / 4;
    for (size_t i = (size_t)F.vcu * (NWAVES * 64) + F.tid; i < n4; i += (size_t)F.G * NWAVES * 64) {
        f32x4 d = {0.f, 0.f, 0.f, 0.f};
#pragma unroll
        for (int xx = 0; xx < 8; ++xx) { const v2u w = *(const GAS v2u*)(PART + (size_t)xx * TOK * 128 + 4 * i); d[0] += bflo(w.x); d[1] += bfhi(w.x); d[2] += bflo(w.y); d[3] += bfhi(w.y); }
        const v2u ew = *(const GAS v2u*)(IDX + 4 * i); const f32x4 gt = *(const GAS f32x4*)(GATE + 4 * i);
        const unsigned e[4] = {ew.x & 0xffffu, ew.x >> 16, ew.y & 0xffffu, ew.y >> 16};
        float o[4];
        const float hs = HINV[i >> 5];
#pragma unroll
        for (int k = 0; k < 4; ++k) o[k] = gelu_tanh(d[k] * (UINV[e[k]] * hs)) * gt[k] * VINV[e[k]];
        *(GAS v2u*)(ACTG + 4 * i) = (v2u){pk2(o[0], o[1]), pk2(o[2], o[3])};
    }
}
__device__ __forceinline__ void peer_v_phase(const Args& A, Frame& F) {
    unsigned char* ws = A.ws;
    const int lane = F.lane, x = blockIdx.x & 7, wrk = (blockIdx.x >> 3) * NWAVES + F.wave, nwr = (F.G >> 3) * NWAVES, g = lane >> 3, c = lane & 7;
    const unsigned char* V8 = ws + WS_VB + (size_t)x * (2 * MiB); const unsigned c16 = 16u * c, g32 = 32u * g;
    const unsigned char* IDX = ws + A_IDX; const unsigned char* ACTG = ws + A_ACTG; unsigned char* POUT = ws + A_POUT + 256 * x;
    const int per = TOK / nwr, tb = wrk * per;
    v4u idC[2], idN[2], aC[2], aN[2];
#define SLOT_ID(ID, sl) (((ID)[(sl) >> 3][((sl) >> 1) & 3] >> (16 * ((sl) & 1))) & 0xffffu)
#define SLOT_ACT(AV, sl) (((sl) & 1) ? bfhi((AV)[(sl) >> 3][((sl) >> 1) & 3]) : bflo((AV)[(sl) >> 3][((sl) >> 1) & 3]))
#define LD_TOK(ID, AV, T) do { const unsigned char* ib_ = IDX + (size_t)(T) * 256; const unsigned char* ab_ = ACTG + (size_t)(T) * 256; \
        ID[0] = *(const GAS v4u*)(ib_ + g32); ID[1] = *(const GAS v4u*)(ib_ + (g32 + 16u)); AV[0] = *(const GAS v4u*)(ab_ + g32); AV[1] = *(const GAS v4u*)(ab_ + (g32 + 16u)); } while (0)
#define LD_ROWS(R, ID, H) do { _Pragma("unroll") for (int i = 0; i < 8; ++i) R[i] = *(const GAS v4u*)(V8 + (SLOT_ID(ID, 8 * (H) + i) * 128u + c16)); } while (0)
    LD_TOK(idC, aC, tb);
    v4u R0[8], R1[8];
    LD_ROWS(R0, idC, 0);
    LD_TOK(idN, aN, tb + 1 < TOK ? tb + 1 : tb);
    for (int t = tb; t < tb + per; ++t) {
        LD_ROWS(R1, idC, 1);
        float acc[16];
#pragma unroll
        for (int d = 0; d < 16; ++d) acc[d] = 0.f;
#pragma unroll
        for (int i = 0; i < 8; ++i) { float f[16]; unpack_fp8x16(R0[i], f); const float a = SLOT_ACT(aC, i);
#pragma unroll
            for (int d = 0; d < 16; ++d) acc[d] += a * f[d]; }
        LD_ROWS(R0, idN, 0);
#pragma unroll
        for (int i = 0; i < 8; ++i) { float f[16]; unpack_fp8x16(R1[i], f); const float a = SLOT_ACT(aC, 8 + i);
#pragma unroll
            for (int d = 0; d < 16; ++d) acc[d] += a * f[d]; }
        idC[0] = idN[0]; idC[1] = idN[1]; aC[0] = aN[0]; aC[1] = aN[1];
        { const int tn = t + 2 < tb + per ? t + 2 : tb + per - 1; LD_TOK(idN, aN, tn); }
#pragma unroll
        for (int d = 0; d < 16; ++d) { float v = acc[d]; v += __shfl_xor(v, 8); v += __shfl_xor(v, 16); v += __shfl_xor(v, 32); acc[d] = v; }
        if (g == 0) { v4u w0, w1; w0.x = pk2(acc[0], acc[1]); w0.y = pk2(acc[2], acc[3]); w0.z = pk2(acc[4], acc[5]); w0.w = pk2(acc[6], acc[7]);
            w1.x = pk2(acc[8], acc[9]); w1.y = pk2(acc[10], acc[11]); w1.z = pk2(acc[12], acc[13]); w1.w = pk2(acc[14], acc[15]);
            unsigned char* o = POUT + (size_t)t * (DM * 2); *(GAS v4u*)(o + 2u * c16) = w0; *(GAS v4u*)(o + (2u * c16 + 16u)) = w1; }
    }
#undef LD_TOK
#undef LD_ROWS
#undef SLOT_ID
#undef SLOT_ACT
}
__device__ __forceinline__ void peer_final(const Args& A, int t, int lane) {
    unsigned char* ws = A.ws;
    const float* mod = (const float*)(ws + WS_MOD) + (size_t)(t >> 13) * NMOD; const bf16* POUT = (const bf16*)(ws + A_POUT);
    float* orow = A.out + (size_t)t * DM;
    f32x4 x2[4]; float s = 0.f;
#pragma unroll
    for (int j = 0; j < 4; ++j) { const int c = 256 * j + 4 * lane; const f32x4 x1 = *(const GAS f32x4*)(orow + c), gt = *(const GAS f32x4*)(mod + 5 * DM + c); const v2u w = *(const GAS v2u*)(POUT + (size_t)t * DM + c);
        f32x4 y; y[0] = x1[0] + gt[0] * bflo(w.x); y[1] = x1[1] + gt[1] * bfhi(w.x); y[2] = x1[2] + gt[2] * bflo(w.y); y[3] = x1[3] + gt[3] * bfhi(w.y);
        x2[j] = y; s += (y[0] * y[0] + y[1] * y[1]) + (y[2] * y[2] + y[3] * y[3]); }
    const float rr = 1.0f / sqrtf(wave_sum(s) * (1.f / DM) + EPS);
#pragma unroll
    for (int j = 0; j < 4; ++j) { const int c = 256 * j + 4 * lane; const f32x4 gf = *(const GAS f32x4*)(A.g_final + c); *(GAS f32x4*)(orow + c) = x2[j] * rr * gf; }
}

#ifndef MK_ONE_LAUNCH
#define MK_ONE_LAUNCH 1
#endif
constexpr int N_PHASES = 12;

__device__ __forceinline__ void biaspq_task(unsigned char* ws, int n, int lane) {
    const bf16* w = (const bf16*)(ws + WS_WPQ) + (size_t)n * DM + 16 * lane;
    float fa[8], fb[8]; unpack8(*(const GAS v4u*)w, fa); unpack8(*(const GAS v4u*)(w + 8), fb);
    float* bias = (float*)(ws + WS_BIASPQ);
#pragma unroll
    for (int b = 0; b < 4; ++b) { const GAS f32x4* sp = (const GAS f32x4*)((const float*)(ws + WS_MOD) + (size_t)b * NMOD + 3 * DM + 16 * lane);
        const f32x4 s0 = sp[0], s1 = sp[1], s2 = sp[2], s3 = sp[3]; float d = 0.f;
#pragma unroll
        for (int i = 0; i < 4; ++i) { d += fa[i] * s0[i]; d += fa[4 + i] * s1[i]; d += fb[i] * s2[i]; d += fb[4 + i] * s3[i]; }
        d = wave_sum(d); if (lane == 0) bias[b * 2048 + n] = d; }
}

__global__ void __launch_bounds__(NWAVES * 64, 2) mk_fwd(Args A) {
    extern __shared__ __attribute__((aligned(16))) unsigned char lds[];
    Frame F;
    F.lds = (LAS unsigned char*)lds;
    F.G = gridDim.x; { const int bx = blockIdx.x; F.vcu = (F.G % 8 == 0) ? (bx % 8) * (F.G / 8) + bx / 8 : bx; }
    F.NGW = F.G * NWAVES;
#define PHASE_BEGIN() do { int t_ = threadIdx.x; asm volatile("" : "+v"(t_)); F.tid = t_; F.lane = t_ & 63; F.wave = __builtin_amdgcn_readfirstlane(t_ >> 6); F.gw = F.vcu * NWAVES + F.wave; } while (0)
    PHASE_BEGIN();
    unsigned char* ws = A.ws;
    const int lo = A.ph_lo, hi = A.ph_hi;
#if MK_ONE_LAUNCH
    volatile LAS unsigned* MISC = (volatile LAS unsigned*)(F.lds + MISC_OFF);
    for (int u = F.tid; u < (LDS_BYTES - RING_BYTES) / 4; u += NWAVES * 64) ((LAS unsigned*)(F.lds + RING_BYTES))[u] = 0u;
    __syncthreads();
    XcdBarrier bar = xcd_barrier_post((unsigned*)(ws + WS_CTL) + CW_BAR, MISC + 8);
#define GRID_BAR() xcd_barrier(bar)
#else
#define GRID_BAR() do {} while (0)
#endif
#ifdef ONLY_PHASE
#define IN(k) ((k) == ONLY_PHASE && lo <= (k) && (k) < hi)
#else
#define IN(k) (lo <= (k) && (k) < hi)
#endif
#define BOTH(k) (IN(k) && IN((k) + 1))
#ifndef REPEAT_MASK
#define REPEAT_MASK 0
#endif
#define REPS(k) ((((REPEAT_MASK) >> (k)) & 1) + 1)

    if (IN(0)) for (int rep = 0; rep < REPS(0); ++rep) { PHASE_BEGIN(); if (rep) GRID_BAR(); p0_prologue(A, F); if (BOTH(0)) GRID_BAR(); }
    if (IN(1)) for (int rep = 0; rep < REPS(1); ++rep) { PHASE_BEGIN(); if (rep) GRID_BAR(); p1_hrows(A, F); if (BOTH(1)) GRID_BAR(); }
    if (IN(2)) for (int rep = 0; rep < REPS(2); ++rep) { PHASE_BEGIN(); if (rep) GRID_BAR();
        pg8::Gemm g{(const bf16*)((unsigned char*)A.out + O_H), (const bf16*)(ws + WS_WIN), TOK, NIN, DM}; pg8::StaticOrder S; S.init(TOK, NIN, F.G, (int)blockIdx.x);
        EpiG1 E{(bf16*)(ws + A_QSB), (bf16*)(ws + A_KSB), (bf16*)(ws + A_VSB), (bf16*)(ws + A_QD), (bf16*)(ws + A_KD), (bf16*)(ws + A_VD), (bf16*)(ws + A_GSB), (bf16*)(ws + A_GD),
                (const float*)(ws + WS_ROPEC), (const float*)(ws + WS_ROPES)};
        pg8::gemm_phase<EpiG1, pg8::StaticOrder, true, true>(F.lds, g, S, E);
        if (BOTH(2)) GRID_BAR();
    }
    if (IN(3)) for (int rep = 0; rep < REPS(3); ++rep) { PHASE_BEGIN(); if (rep) GRID_BAR(); p3_attention(A, F, 0); GRID_BAR(); PHASE_BEGIN(); p3_attention(A, F, 1); if (BOTH(3)) GRID_BAR(); }
    if (IN(4)) for (int rep = 0; rep < REPS(4); ++rep) { PHASE_BEGIN(); if (rep) GRID_BAR();
        for (int n = F.gw; n < 2048; n += F.NGW) biaspq_task(ws, n, F.lane);
        __syncthreads();
        {   pg8::Gemm g{(const bf16*)((unsigned char*)A.out + O_OD), (const bf16*)(ws + WS_WDILO), TOK, DM, 256}; pg8::StaticOrder S; S.init(TOK, DM, F.G, (int)blockIdx.x);
            EpiMerge<false> E{(const bf16*)(ws + A_GD), (bf16*)(ws + A_MERGED)};
            pg8::gemm_phase<EpiMerge<false>, pg8::StaticOrder, true, true>(F.lds, g, S, E); }
        asm volatile("s_waitcnt vmcnt(0)" ::: "memory"); __syncthreads();
        {   pg8::Gemm g{(const bf16*)((unsigned char*)A.out + O_OSB), (const bf16*)(ws + WS_WSBO), TOK, DM, 512}; pg8::StaticOrder S; S.init(TOK, DM, F.G, (int)blockIdx.x);
            EpiMerge<true> E{(const bf16*)(ws + A_GSB), (bf16*)(ws + A_MERGED)};
            pg8::gemm_phase<EpiMerge<true>, pg8::StaticOrder, true, true>(F.lds, g, S, E); }
        if (BOTH(4)) GRID_BAR();
    }
    if (IN(5)) for (int rep = 0; rep < REPS(5); ++rep) { PHASE_BEGIN(); if (rep) GRID_BAR();
        pg8::Gemm g{(const bf16*)(ws + A_MERGED), (const bf16*)(ws + WS_WOUT), TOK, DM, DM}; pg8::StaticOrder S; S.init(TOK, DM, F.G, (int)blockIdx.x);
        EpiOut E{A.x, A.out, (bf16*)(ws + A_X1M), (float*)(ws + WS_SSQ), (const float*)(ws + WS_MOD), A.g_ffn};
        pg8::gemm_phase<EpiOut, pg8::StaticOrder, true, true>(F.lds, g, S, E);
        if (BOTH(5)) GRID_BAR();
    }
    if (IN(6)) for (int rep = 0; rep < REPS(6); ++rep) { PHASE_BEGIN(); if (rep) GRID_BAR();
        pg8::Gemm g{(const bf16*)(ws + A_X1M), (const bf16*)(ws + WS_WPQ), TOK, 2048, DM}; pg8::StaticOrder S; S.init(TOK, 2048, F.G, (int)blockIdx.x);
        EpiPq E{(const float*)(ws + WS_SSQ), (const float*)(ws + WS_BIASPQ), (bf16*)(ws + A_QPEER), (float*)(ws + WS_R2)};
        pg8::gemm_phase<EpiPq, pg8::StaticOrder, true, true>(F.lds, g, S, E);
        if (BOTH(6)) GRID_BAR();
    }
    if (IN(7)) for (int rep = 0; rep < REPS(7); ++rep) { PHASE_BEGIN(); if (rep) GRID_BAR();
        topk_phase((const bf16*)(ws + A_QPEER), (const bf16*)(ws + WS_KEYS), (unsigned short*)(ws + A_IDX), (float*)(ws + A_GATE), F);
        for (int t = F.gw; t < TOK; t += F.NGW) h2q_row(ws, t, F.lane);
        if (BOTH(7)) GRID_BAR();
    }
    if (IN(8)) for (int rep = 0; rep < REPS(8); ++rep) { PHASE_BEGIN(); if (rep) GRID_BAR();
        peer_u_phase(A, F); if (BOTH(8)) GRID_BAR(); }
    if (IN(9)) { PHASE_BEGIN();
#ifdef VALU_PROBE
        { float a0 = F.lane, a1 = a0 + 1, a2 = a0 + 2, a3 = a0 + 3; unsigned w0 = F.tid * 2654435761u, w1 = w0 ^ 0x3c3c3c3cu, w2 = w0 + 77u, w3 = w0 + 99u;
          f32x2_t p0 = {a0, a1}, p1 = {a2, a3}, p2 = {a1, a2}, p3 = {a3, a0};
          for (int it = 0; it < 4096; ++it) {
#if VALU_PROBE == 1
              f32x2_t c0 = __builtin_amdgcn_cvt_pk_f32_fp8((int)w0, false), c1 = __builtin_amdgcn_cvt_pk_f32_fp8((int)w1, true), c2 = __builtin_amdgcn_cvt_pk_f32_fp8((int)w2, false), c3 = __builtin_amdgcn_cvt_pk_f32_fp8((int)w3, true);
              f32x2_t c4 = __builtin_amdgcn_cvt_pk_f32_fp8((int)w0, true), c5 = __builtin_amdgcn_cvt_pk_f32_fp8((int)w1, false), c6 = __builtin_amdgcn_cvt_pk_f32_fp8((int)w2, true), c7 = __builtin_amdgcn_cvt_pk_f32_fp8((int)w3, false);
              w0 ^= __float_as_uint(c0.x) ^ __float_as_uint(c4.y); w1 ^= __float_as_uint(c1.x) ^ __float_as_uint(c5.y); w2 ^= __float_as_uint(c2.x) ^ __float_as_uint(c6.y); w3 ^= __float_as_uint(c3.x) ^ __float_as_uint(c7.y);
#elif VALU_PROBE == 2
              p0 = p0 * p1 + p2; p1 = p1 * p2 + p3; p2 = p2 * p3 + p0; p3 = p3 * p0 + p1; p0 = p0 * p2 + p1; p1 = p1 * p3 + p2; p2 = p2 * p0 + p3; p3 = p3 * p1 + p0;
#else
              a0 = a0 * a1 + a2; a1 = a1 * a2 + a3; a2 = a2 * a3 + a0; a3 = a3 * a0 + a1; a0 = a0 * a2 + a1; a1 = a1 * a3 + a2; a2 = a2 * a0 + a3; a3 = a3 * a1 + a0;
#endif
          }
          if (a0 + a1 + a2 + a3 + p0.x + p1.y + p2.x + p3.y == 1.2345e33f || (w0 ^ w1 ^ w2 ^ w3) == 0x12345u) ((float*)(ws + WS_DUMP))[F.lane] = a0; }
#endif
#ifdef ICACHE_PROBE
        asm volatile(".rept 8000\n s_nop 0\n .endr" ::: "memory");
#endif
        peer_act_phase(A, F); if (BOTH(9)) GRID_BAR(); }
    if (IN(10)) for (int rep = 0; rep < REPS(10); ++rep) { PHASE_BEGIN(); if (rep) GRID_BAR(); peer_v_phase(A, F); if (BOTH(10)) GRID_BAR(); }
    if (IN(11)) { PHASE_BEGIN();
        for (int t = F.gw; t < TOK; t += F.NGW) peer_final(A, t, F.lane);
    }
#undef IN
#undef BOTH
}

extern "C" void kernel_launch(void* const* d_in, const int* in_sizes, int n_in, void* d_out, int out_size, void* d_ws, size_t ws_size, hipStream_t stream) {
    static int grid = 0;
    if (grid == 0) {
        if (n_in != 15 || in_sizes[0] != TOK * DM || out_size != TOK * DM || ws_size < WS_END) { fprintf(stderr, "kernel_launch: unexpected shapes (n_in %d, in0 %d, out %d, ws %zu < %zu)\n", n_in, n_in > 0 ? in_sizes[0] : -1, out_size, ws_size, (size_t)WS_END); grid = -1; return; }
        int dev = 0, cus = 0, per_cu = 0;
        if (hipGetDevice(&dev) != hipSuccess || hipDeviceGetAttribute(&cus, hipDeviceAttributeMultiprocessorCount, dev) != hipSuccess) { grid = -1; return; }
        if (hipFuncSetAttribute((const void*)mk_fwd, hipFuncAttributeMaxDynamicSharedMemorySize, LDS_BYTES) != hipSuccess) { fprintf(stderr, "kernel_launch: hipFuncSetAttribute failed\n"); grid = -1; return; }
        if (hipOccupancyMaxActiveBlocksPerMultiprocessor(&per_cu, (const void*)mk_fwd, NWAVES * 64, LDS_BYTES) != hipSuccess || per_cu < 1) { fprintf(stderr, "kernel_launch: occupancy query says %d\n", per_cu); per_cu = 1; }
        (void)hipGetLastError();
        grid = cus;
    }
    if (grid < 0) return;
    (void)hipMemsetAsync((char*)d_ws + WS_CTL, 0, CTL_ZERO_BYTES, stream);
    Args a{};
    a.x = (const float*)d_in[0]; a.c = (const float*)d_in[1]; a.w_ada = (const float*)d_in[2]; a.b_ada = (const float*)d_in[3]; a.g_mix = (const float*)d_in[4];
    a.w_in = (const float*)d_in[5]; a.w_sb_o = (const float*)d_in[6]; a.w_dil_o = (const float*)d_in[7]; a.w_out = (const float*)d_in[8]; a.g_ffn = (const float*)d_in[9];
    a.w_pq = (const float*)d_in[10]; a.peer_keys = (const float*)d_in[11]; a.peer_u = (const float*)d_in[12]; a.peer_v = (const float*)d_in[13]; a.g_final = (const float*)d_in[14];
    a.out = (float*)d_out; a.ws = (unsigned char*)d_ws;
#if MK_ONE_LAUNCH
    a.ph_lo = 0; a.ph_hi = N_PHASES;
    void* args[] = {&a};
    hipError_t e = hipLaunchCooperativeKernel((const void*)mk_fwd, dim3(grid), dim3(NWAVES * 64), args, LDS_BYTES, stream);
    if (e != hipSuccess) fprintf(stderr, "kernel_launch: cooperative launch failed: %s (grid %d)\n", hipGetErrorString(e), grid);
#else
    for (int p = 0; p < N_PHASES; ++p) { a.ph_lo = p; a.ph_hi = p + 1; hipLaunchKernelGGL(mk_fwd, dim3(grid), dim3(NWAVES * 64), LDS_BYTES, stream, a); }
#endif
}
```

```cpp
#include <hip/hip_runtime.h>
#include <hip/hip_cooperative_groups.h>
#include <cstdio>
#include <cstdint>
namespace pg8 {
#define PG8_LAS __attribute__((address_space(3)))
typedef unsigned short bf16_t;
typedef short bf16x8 __attribute__((ext_vector_type(8)));
typedef float f32x4 __attribute__((ext_vector_type(4)));
typedef unsigned u32x4 __attribute__((ext_vector_type(4)));
constexpr int BM = 256, BK = 64, HALF = 128, HTB = HALF * BK * 2  , STAGE_BYTES = 8 * HTB, NXCD = 8, WGM = 8;

__host__ __device__ __forceinline__ int lds_byte(int r, int c) { const int st = (r >> 4) * 2 + (c >> 5), rr = r & 15, cc = c & 31, ob = rr * 64 + cc * 2; return st * 1024 + (ob ^ (((ob >> 9) & 1) << 5)); }
__host__ __device__ __forceinline__ void stage_rc(int b, int& R, int& C) { const int st = b / 1024, sb = b % 1024, swz = sb ^ (((sb >> 9) & 1) << 5); R = (st >> 1) * 16 + swz / 64; C = (st & 1) * 32 + (swz % 64) / 2; }
__host__ __device__ __forceinline__ int perm32(int rho) { const int n = rho >> 4, i = rho & 15; return 8 * (i >> 2) + 4 * n + (i & 3); }

struct Unit { int pm, pn; };
struct Gemm { const bf16_t* A; const bf16_t* Bt; int M, N, K; };

struct StaticOrder {
    int nM, nN, nwg, G, c;
    __host__ __device__ void init(int M, int N, int G_, int c_) { nM = M / BM; nN = N / BM; nwg = nM * nN; G = G_; c = c_; }
    __host__ __device__ bool next(int i, Unit& u) const {
        const long L = (long)i * G + c; if (L >= nwg) return false;
        int wgid = (int)L; { const int q = nwg / NXCD, r = nwg % NXCD, xcd = wgid % NXCD, off = wgid / NXCD; wgid = (xcd < r ? xcd * (q + 1) : r * (q + 1) + (xcd - r) * q) + off; }
        const int nig = WGM * nN, gid = wgid / nig, fm = gid * WGM, gsz = (nM - fm) < WGM ? (nM - fm) : WGM;
        u.pm = fm + ((wgid % nig) % gsz); u.pn = (wgid % nig) / gsz; return true;
    }
    __device__ __forceinline__ void a_ready(const Unit&) const {}
    __device__ __forceinline__ void done(const Unit&) const {}
};

__device__ __forceinline__ unsigned cvt_pk_bf16(float lo, float hi) { unsigned r; asm volatile("v_cvt_pk_bf16_f32 %0, %1, %2" : "=v"(r) : "v"(lo), "v"(hi)); return r; }
template <class Epi, class Sched, bool ALIGN_EPI = false, bool SP2 = false>
__device__ __forceinline__ void gemm_phase(PG8_LAS unsigned char* lds, const Gemm g, const Sched& S, const Epi& E) {
    int tid_ = threadIdx.x; asm volatile("" : "+v"(tid_));
    const int tid = tid_, wid = __builtin_amdgcn_readfirstlane(tid >> 6), lane = tid & 63, wr = wid >> 2, wc = wid & 3, fr = lane & 15, fq = lane >> 4;
    const int K = g.K, nt = K / BK;
    unsigned voffA[2], voffB[2];
#pragma unroll
    for (int i = 0; i < 2; ++i) { int R, C; stage_rc(tid * 16 + i * 8192, R, C); const int Rb = Epi::PERM ? ((R & ~31) + perm32(R & 31)) : R;
        voffA[i] = (unsigned)(R * K + C) * 2u; voffB[i] = (unsigned)(Rb * K + C) * 2u; }
    const size_t kstep = (size_t)(BK * 2);
    const size_t hstep = (size_t)HALF * K * 2;
    const size_t tstep = 2 * hstep;
    const unsigned ldsw = (unsigned)wid * 1024u;
    const int aoff = lds_byte(wr * 64 + fr, fq * 8), boff = lds_byte(wc * 32 + fr, fq * 8);
#define PG8_SA(b, h) (((b) * 2 + (h)) * HTB)
#define PG8_SB(b, h) ((4 + (b) * 2 + (h)) * HTB)
#define PG8_STAGE(bufoff, gbase, voff) do { _Pragma("unroll") for (int _i = 0; _i < 2; ++_i) \
        __builtin_amdgcn_global_load_lds((const unsigned*)((const char*)(gbase) + (voff)[_i]), (PG8_LAS unsigned*)(lds + (bufoff) + ldsw + _i * 8192), 16, 0, 0); } while (0)
#define PG8_LDA(dst, b, h) do { _Pragma("unroll") for (int m = 0; m < 4; ++m) _Pragma("unroll") for (int k = 0; k < 2; ++k) dst[m][k] = *(const PG8_LAS bf16x8*)(lds + PG8_SA(b, h) + aoff + m * 2048 + k * 1024); } while (0)
#define PG8_LDB(dst, b, h) do { _Pragma("unroll") for (int n = 0; n < 2; ++n) _Pragma("unroll") for (int k = 0; k < 2; ++k) dst[n][k] = *(const PG8_LAS bf16x8*)(lds + PG8_SB(b, h) + boff + n * 2048 + k * 1024); } while (0)
#define PG8_MMA(ai, bj, At, Bt) do { __builtin_amdgcn_s_setprio(1); _Pragma("unroll") for (int m = 0; m < 4; ++m) _Pragma("unroll") for (int n = 0; n < 2; ++n) _Pragma("unroll") for (int k = 0; k < 2; ++k) \
        acc[ai][bj][m][n] = __builtin_amdgcn_mfma_f32_16x16x32_bf16(Bt[n][k], At[m][k], acc[ai][bj][m][n], 0, 0, 0); __builtin_amdgcn_s_setprio(0); } while (0)
#define PG8_WAIT_V(n) asm volatile("s_waitcnt vmcnt(" #n ")" ::: "memory")
#define PG8_WAIT_L(n) asm volatile("s_waitcnt lgkmcnt(" #n ")" ::: "memory")
#define PG8_BAR __builtin_amdgcn_s_barrier()
#define PG8_SCHED __builtin_amdgcn_sched_barrier(0)
    Unit cur, nxt; int ui = 0;
    if (!S.next(0, cur)) return;
    f32x4 acc[2][2][4][2];
#pragma unroll
    for (int a = 0; a < 2; ++a)
#pragma unroll
        for (int b = 0; b < 2; ++b)
#pragma unroll
            for (int m = 0; m < 4; ++m)
#pragma unroll
                for (int n = 0; n < 2; ++n) acc[a][b][m][n] = (f32x4){0.f, 0.f, 0.f, 0.f};
    bf16x8 At[4][2], B0[2][2], B1[2][2];
    const char* cA = (const char*)g.A + (size_t)cur.pm * tstep; const char* cB = (const char*)g.Bt + (size_t)cur.pn * tstep;
    S.a_ready(cur);
    if constexpr (SP2) {
        PG8_STAGE(PG8_SB(0, 0), cB, voffB); PG8_STAGE(PG8_SB(0, 1), cB + hstep, voffB); PG8_STAGE(PG8_SA(0, 0), cA, voffA); PG8_STAGE(PG8_SA(0, 1), cA + hstep, voffA);
        if (wr == 1) PG8_BAR;
        PG8_WAIT_V(2); PG8_BAR;
        PG8_STAGE(PG8_SB(1, 0), cB + kstep, voffB); PG8_STAGE(PG8_SA(1, 0), cA + kstep, voffA); PG8_STAGE(PG8_SB(1, 1), cB + hstep + kstep, voffB);
        PG8_WAIT_V(6); PG8_BAR;
    } else {
        PG8_STAGE(PG8_SB(0, 0), cB, voffB); PG8_STAGE(PG8_SA(0, 0), cA, voffA); PG8_STAGE(PG8_SB(0, 1), cB + hstep, voffB); PG8_STAGE(PG8_SA(0, 1), cA + hstep, voffA);
        if (wr == 1) PG8_BAR;
        PG8_WAIT_V(4); PG8_BAR;
        PG8_STAGE(PG8_SB(1, 0), cB + kstep, voffB); PG8_STAGE(PG8_SA(1, 0), cA + kstep, voffA); PG8_STAGE(PG8_SB(1, 1), cB + hstep + kstep, voffB);
        PG8_WAIT_V(6); PG8_BAR;
    }
    for (;;) {
        const bool has_next = S.next(ui + 1, nxt);
        const char* nA = has_next ? (const char*)g.A + (size_t)nxt.pm * tstep : cA; const char* nB = has_next ? (const char*)g.Bt + (size_t)nxt.pn * tstep : cB;
        for (int t = 0; t < nt; t += 2) {
            const bool last = (t == nt - 2);
            const char* a1 = cA + (size_t)(t + 1) * kstep;
            const char* a2 = last ? nA : cA + (size_t)(t + 2) * kstep; const char* b2 = last ? nB : cB + (size_t)(t + 2) * kstep;
            const char* a3 = a2 + kstep; const char* b3 = b2 + kstep;
            if (last && has_next) S.a_ready(nxt);
            if constexpr (SP2) {
            PG8_LDB(B0, 0, 0); PG8_LDB(B1, 0, 1); PG8_SCHED; PG8_LDA(At, 0, 0); PG8_STAGE(PG8_SA(1, 1), a1 + hstep, voffA);
            PG8_WAIT_V(8); PG8_WAIT_L(0); PG8_BAR; PG8_MMA(0, 0, At, B0); PG8_MMA(0, 1, At, B1); PG8_BAR; PG8_SCHED;
            PG8_LDA(At, 0, 1); PG8_STAGE(PG8_SB(0, 0), b2, voffB); PG8_STAGE(PG8_SB(0, 1), b2 + hstep, voffB); PG8_STAGE(PG8_SA(0, 0), a2, voffA);
            PG8_WAIT_V(8); PG8_WAIT_L(0); PG8_BAR; PG8_MMA(1, 0, At, B0); PG8_MMA(1, 1, At, B1); PG8_BAR; PG8_SCHED;
            PG8_LDB(B0, 1, 0); PG8_LDB(B1, 1, 1); PG8_SCHED; PG8_LDA(At, 1, 0); PG8_STAGE(PG8_SA(0, 1), a2 + hstep, voffA);
            PG8_WAIT_V(8); PG8_WAIT_L(0); PG8_BAR; PG8_MMA(0, 0, At, B0); PG8_MMA(0, 1, At, B1); PG8_BAR; PG8_SCHED;
            PG8_LDA(At, 1, 1); PG8_STAGE(PG8_SB(1, 0), b3, voffB); PG8_STAGE(PG8_SB(1, 1), b3 + hstep, voffB); PG8_STAGE(PG8_SA(1, 0), a3, voffA);
            PG8_WAIT_V(8); PG8_WAIT_L(0); PG8_BAR; PG8_MMA(1, 0, At, B0); PG8_MMA(1, 1, At, B1); PG8_BAR; PG8_SCHED;
            } else {
            PG8_LDB(B0, 0, 0); PG8_SCHED; PG8_LDA(At, 0, 0); PG8_STAGE(PG8_SA(1, 1), a1 + hstep, voffA);
            PG8_WAIT_L(8); PG8_BAR; PG8_WAIT_L(0); PG8_MMA(0, 0, At, B0); PG8_BAR; PG8_SCHED;
            PG8_LDB(B1, 0, 1); PG8_STAGE(PG8_SB(0, 0), b2, voffB);
            PG8_BAR; PG8_WAIT_L(0); PG8_MMA(0, 1, At, B1); PG8_BAR;
            PG8_LDA(At, 0, 1); PG8_STAGE(PG8_SA(0, 0), a2, voffA);
            PG8_BAR; PG8_WAIT_L(0); PG8_MMA(1, 0, At, B0); PG8_BAR; PG8_SCHED;
            PG8_STAGE(PG8_SB(0, 1), b2 + hstep, voffB);
            PG8_WAIT_V(6); PG8_BAR; PG8_MMA(1, 1, At, B1); PG8_BAR;
            PG8_LDB(B0, 1, 0); PG8_SCHED; PG8_LDA(At, 1, 0); PG8_STAGE(PG8_SA(0, 1), a2 + hstep, voffA);
            PG8_WAIT_L(8); PG8_BAR; PG8_WAIT_L(0); PG8_MMA(0, 0, At, B0); PG8_BAR; PG8_SCHED;
            PG8_LDB(B1, 1, 1); PG8_STAGE(PG8_SB(1, 0), b3, voffB);
            PG8_BAR; PG8_WAIT_L(0); PG8_MMA(0, 1, At, B1); PG8_BAR;
            PG8_LDA(At, 1, 1); PG8_STAGE(PG8_SA(1, 0), a3, voffA);
            PG8_BAR; PG8_WAIT_L(0); PG8_MMA(1, 0, At, B0); PG8_BAR; PG8_SCHED;
            PG8_STAGE(PG8_SB(1, 1), b3 + hstep, voffB);
            PG8_WAIT_V(6); PG8_BAR; PG8_MMA(1, 1, At, B1); PG8_BAR;
            }
        }
        if constexpr (ALIGN_EPI) { if (wr == 0) PG8_BAR; }
        if constexpr (!Epi::AFTER_DRAIN) { E(acc, cur, wr, wc, fr, fq); S.done(cur); }
        if (!has_next) break;
#pragma unroll
        for (int a = 0; a < 2; ++a)
#pragma unroll
            for (int b = 0; b < 2; ++b)
#pragma unroll
                for (int m = 0; m < 4; ++m)
#pragma unroll
                    for (int n = 0; n < 2; ++n) acc[a][b][m][n] = (f32x4){0.f, 0.f, 0.f, 0.f};
        cur = nxt; cA = nA; cB = nB; ++ui;
        if constexpr (ALIGN_EPI) { if (wr == 1) PG8_BAR; }
    }
    PG8_WAIT_V(0);
    if constexpr (!ALIGN_EPI) { if (wr == 0) PG8_BAR; }
    PG8_BAR;
    if constexpr (Epi::AFTER_DRAIN) { E.fused(acc, cur, wr, wc, fr, fq, lds, wid, lane); S.done(cur); }
#undef PG8_SA
#undef PG8_SB
#undef PG8_STAGE
#undef PG8_LDA
#undef PG8_LDB
#undef PG8_MMA
#undef PG8_WAIT_V
#undef PG8_WAIT_L
#undef PG8_BAR
#undef PG8_SCHED
}
}

#define GAS __attribute__((address_space(1)))
#define LAS __attribute__((address_space(3)))
typedef unsigned short bf16;
typedef unsigned v4u __attribute__((ext_vector_type(4)));
typedef unsigned v2u __attribute__((ext_vector_type(2)));
typedef float f32x4 __attribute__((ext_vector_type(4)));
typedef float f32x16 __attribute__((ext_vector_type(16)));
typedef short bf16x8 __attribute__((ext_vector_type(8)));
typedef short s16x4 __attribute__((ext_vector_type(4)));

constexpr int NWAVES = 8;
constexpr int NB = 4, SEQ = 8192, DM = 1024, TOK = NB * SEQ;
constexpr int NIN = 5888;
constexpr int SBH = 8, DILH = 12;
constexpr int NMOD = 6 * DM;
constexpr int KSPLIT = 16;
constexpr float EPS = 1e-6f;
constexpr float LOG2E = 1.4426950408889634f;
constexpr float C2 = 0.125f * LOG2E;
constexpr int PEER_E = 16384;

constexpr size_t MiB = 1u << 20;
constexpr size_t WS_CTL = 0, CTL_ZERO_BYTES = 1 * MiB;
constexpr size_t WS_MODP = 1 * MiB;
constexpr size_t WS_MOD = 2 * MiB + 512 * 1024;
constexpr size_t WS_BIASPQ = 2 * MiB + 768 * 1024;
constexpr size_t WS_ROPEC = 3 * MiB, WS_ROPES = 4 * MiB;
constexpr size_t WS_SSQ = 5 * MiB;
constexpr size_t WS_KEYS = 7 * MiB;
constexpr size_t WS_WIN = 8 * MiB;
constexpr size_t WS_WSBO = 20 * MiB;
constexpr size_t WS_WDILO = 21 * MiB;
constexpr size_t WS_WOUT = 22 * MiB;
constexpr size_t WS_WPQ = 24 * MiB;
constexpr size_t WS_UB = 32 * MiB, WS_VB = 64 * MiB;
constexpr size_t WS_ACT = 96 * MiB;
constexpr size_t A_QSB = WS_ACT, A_KSB = WS_ACT + 32 * MiB, A_VSB = WS_ACT + 64 * MiB;
constexpr size_t A_QD = WS_ACT + 96 * MiB, A_KD = WS_ACT + 144 * MiB, A_VD = WS_ACT + 192 * MiB;
constexpr size_t A_GSB = WS_ACT + 240 * MiB, A_GD = WS_ACT + 304 * MiB;
constexpr size_t A_MERGED = WS_ACT;
constexpr size_t A_X1M = WS_ACT + 64 * MiB;
constexpr size_t A_QPEER = WS_ACT + 128 * MiB;
constexpr size_t A_IDX = WS_ACT + 256 * MiB;
constexpr size_t A_GATE = WS_ACT + 272 * MiB;
constexpr size_t A_ACTG = WS_ACT + 288 * MiB;
constexpr size_t A_PART = WS_ACT + 128 * MiB;
constexpr size_t A_H2Q = WS_ACT + 304 * MiB;
constexpr size_t WS_HINV = 7 * MiB + 640 * 1024;
constexpr size_t A_H2F8 = WS_ACT + 304 * MiB;
constexpr size_t WS_DUMP = 7 * MiB + 768 * 1024;
constexpr size_t WS_R2 = 7 * MiB + 512 * 1024;
constexpr size_t A_POUT = WS_ACT;
constexpr size_t WS_END = WS_ACT + 368 * MiB;
constexpr size_t O_H = 0, O_OSB = 64 * MiB, O_OD = 96 * MiB, O_PO = 112 * MiB;

constexpr int CW_BAR = 4096;

constexpr int RING_BYTES = 131072;
constexpr int MISC_OFF = RING_BYTES + 320;
constexpr int LDS_BYTES = 147456;

#define RLX_AGENT __ATOMIC_RELAXED, __HIP_MEMORY_SCOPE_AGENT
__device__ __forceinline__ unsigned f2bf(float f) { unsigned u = __builtin_bit_cast(unsigned, f); return (u + 0x7fffu + ((u >> 16) & 1u)) >> 16; }
typedef float f32x2_t __attribute__((ext_vector_type(2))); typedef __bf16 bf16x2_t __attribute__((ext_vector_type(2)));
__device__ __forceinline__ unsigned pk2(float lo, float hi) { f32x2_t v = {lo, hi}; bf16x2_t b = __builtin_convertvector(v, bf16x2_t); return __builtin_bit_cast(unsigned, b); }
__device__ __forceinline__ float bflo(unsigned w) { return __uint_as_float(w << 16); }
__device__ __forceinline__ float bfhi(unsigned w) { return __uint_as_float(w & 0xffff0000u); }
__device__ __forceinline__ float wave_sum(float v) {
#pragma unroll
    for (int o = 1; o < 64; o <<= 1) v += __shfl_xor(v, o);
    return v;
}
__device__ __forceinline__ float fast_exp2(float x) { return __builtin_amdgcn_exp2f(x); }
__device__ __forceinline__ float fast_log2(float x) { return __builtin_amdgcn_logf(x); }
__device__ __forceinline__ float fast_rcp(float x) { return __builtin_amdgcn_rcpf(x); }
__device__ __forceinline__ float sigmoidf_(float x) { return fast_rcp(1.f + fast_exp2(-x * LOG2E)); }
#define XB_TMO      128
#define XB_XCNT(j)  (256  + 64 * (j))
#define XB_XSUB(j)  (1280 + 64 * (j))
#define XB_XGEN(j)  (2304 + 64 * (j))
#define XB_TOP      3328
#define XB_TOPGEN   3392
#define XCD_BAR_WORDS 3456
#define XB_SPIN_CAP (1u << 18)

__device__ __forceinline__ unsigned xb_ld(unsigned* p)              { return __hip_atomic_load(p, __ATOMIC_RELAXED, __HIP_MEMORY_SCOPE_AGENT); }
__device__ __forceinline__ unsigned xb_add(unsigned* p, unsigned v) { return __hip_atomic_fetch_add(p, v, __ATOMIC_RELAXED, __HIP_MEMORY_SCOPE_AGENT); }
__device__ __forceinline__ unsigned xb_xcc_id() { return (unsigned)__builtin_amdgcn_s_getreg((3 << 11) | 20) & 0xFu; }
#define XB_SPIN(cond, bar) do { unsigned _sp = 0; while (cond) { __builtin_amdgcn_s_sleep(1); \
    if ((++_sp & 255u) == 0u) { if (xb_ld(&(bar)[XB_TMO])) break; if (_sp > XB_SPIN_CAP) { atomicAdd(&(bar)[XB_TMO], 1u); break; } } } } while (0)

struct XcdBarrier {
    unsigned* bar; unsigned x;
    volatile LAS unsigned* st;
};

__device__ __forceinline__ XcdBarrier xcd_barrier_post(unsigned* bar, volatile LAS unsigned* st) {
    XcdBarrier b; b.bar = bar; b.x = xb_xcc_id(); b.st = st;
    if (threadIdx.x == 0) (void)xb_add(&bar[XB_XCNT(b.x)], 1u);
    return b;
}
__device__ __forceinline__ void xcd_barrier_complete(unsigned* bar, unsigned x, unsigned& nloc, unsigned& nx) {
    const unsigned G = gridDim.x * gridDim.y * gridDim.z;
    unsigned sum, cnt, mine, sp = 0u;
    for (;;) {
        sum = 0u; cnt = 0u; mine = 0u;
#pragma unroll
        for (unsigned j = 0; j < 16; ++j) { const unsigned c = xb_ld(&bar[XB_XCNT(j)]); sum += c; cnt += (c > 0u) ? 1u : 0u; mine = (j == x) ? c : mine; }
        if (sum == G) break;
        __builtin_amdgcn_s_sleep(1);
        if ((++sp & 255u) == 0u) { if (xb_ld(&bar[XB_TMO])) break; if (sp > XB_SPIN_CAP) { atomicAdd(&bar[XB_TMO], 1u); break; } }
    }
    nloc = mine > 0u ? mine : 1u; nx = cnt > 0u ? cnt : 1u;
}

__device__ __forceinline__ void xcd_barrier(const XcdBarrier& b) {
    asm volatile("s_waitcnt vmcnt(0)" ::: "memory");
    __syncthreads();
    if (threadIdx.x == 0) {
        unsigned* bar = b.bar;
        __builtin_amdgcn_s_waitcnt(0);
        unsigned nloc = b.st[0], nx = b.st[1];
        if (nloc == 0u) { xcd_barrier_complete(bar, b.x, nloc, nx); b.st[0] = nloc; b.st[1] = nx; }
        const unsigned old = xb_add(&bar[XB_XSUB(b.x)], 1u);
        const unsigned gen = old / nloc;
        if (old + 1u == (gen + 1u) * nloc) {
            __builtin_amdgcn_fence(__ATOMIC_RELEASE, "agent");
            asm volatile("s_waitcnt vmcnt(0)" ::: "memory");
            const unsigned og = xb_add(&bar[XB_TOP], 1u);
            const unsigned tg = og / nx;
            if (og + 1u == (tg + 1u) * nx) xb_add(&bar[XB_TOPGEN], 1u);
            else XB_SPIN(xb_ld(&bar[XB_TOPGEN]) == tg, bar);
            __builtin_amdgcn_fence(__ATOMIC_ACQUIRE, "agent");
            xb_add(&bar[XB_XGEN(b.x)], 1u);
            asm volatile("s_waitcnt vmcnt(0)" ::: "memory");
        } else {
            XB_SPIN(xb_ld(&bar[XB_XGEN(b.x)]) == gen, bar);
            __builtin_amdgcn_fence(__ATOMIC_ACQUIRE, "agent");
            asm volatile("s_waitcnt vmcnt(0)" ::: "memory");
        }
    }
    __syncthreads();
}

struct Args {
    const float* x; const float* c; const float* w_ada; const float* b_ada; const float* g_mix; const float* w_in; const float* w_sb_o; const float* w_dil_o;
    const float* w_out; const float* g_ffn; const float* w_pq; const float* peer_keys; const float* peer_u; const float* peer_v; const float* g_final;
    float* out; unsigned char* ws; int ph_lo, ph_hi;
};
struct Frame {
    LAS unsigned char* lds;
    int tid, lane, wave, vcu, G, gw, NGW;
};

__device__ __forceinline__ int win_row(int ncol) {
    const int tile = ncol >> 8;
    if (tile >= 6 && tile < 12) { const int d = ncol & 63; const int j = (d & 31) >> 2, i = (d & 3) + ((d >> 5) << 2); return (ncol & ~63) + 8 * j + i; }
    return ncol;
}
template <bool MAPWIN>
__device__ __forceinline__ void p0_transpose_item(const float* W, int K, int N, bf16* WT, LAS float* scr, int item, int lane) {
    const int nblk = N / 32, kb = item / nblk, nb = item % nblk, k0 = 64 * kb, n0 = 32 * nb;
#pragma unroll 8
    for (int i = 0; i < 32; ++i) { const int kk = 2 * i + (lane >> 5); scr[kk * 33 + (lane & 31)] = W[(size_t)(k0 + kk) * N + n0 + (lane & 31)]; }
    asm volatile("s_waitcnt lgkmcnt(0)" ::: "memory");
    const int c = lane & 7;
#pragma unroll
    for (int j = 0; j < 4; ++j) { const int n = (lane >> 3) + 8 * j; const LAS float* s = scr + (8 * c) * 33 + n;
        v4u o; o.x = pk2(s[0 * 33], s[1 * 33]); o.y = pk2(s[2 * 33], s[3 * 33]); o.z = pk2(s[4 * 33], s[5 * 33]); o.w = pk2(s[6 * 33], s[7 * 33]);
        const int rowo = MAPWIN ? win_row(n0 + n) : (n0 + n);
        *(GAS v4u*)(WT + (size_t)rowo * K + k0 + 8 * c) = o; }
    asm volatile("s_waitcnt lgkmcnt(0)" ::: "memory");
}
__device__ __forceinline__ void cvt_row_1024(const float* src, bf16* dst, int lane) {
    const GAS f32x4* s = (const GAS f32x4*)src + lane; GAS v2u* d = (GAS v2u*)dst + lane;
    f32x4 v[4];
#pragma unroll
    for (int j = 0; j < 4; ++j) v[j] = s[64 * j];
#pragma unroll
    for (int j = 0; j < 4; ++j) { v2u o; o.x = pk2(v[j].x, v[j].y); o.y = pk2(v[j].z, v[j].w); d[64 * j] = o; }
}
template <bool SLICED, bool I8 = false>
__device__ __forceinline__ void cvt_row_fp8(const float* src, unsigned char* dst, float* inv, int e, int lane) {
    const GAS f32x4* s = (const GAS f32x4*)src + lane;
    f32x4 v[4]; float m = 0.f;
#pragma unroll
    for (int j = 0; j < 4; ++j) { v[j] = s[64 * j]; m = fmaxf(m, fmaxf(fmaxf(fabsf(v[j].x), fabsf(v[j].y)), fmaxf(fabsf(v[j].z), fabsf(v[j].w)))); }
#pragma unroll
    for (int o = 1; o < 64; o <<= 1) m = fmaxf(m, __shfl_xor(m, o));
    m = fmaxf(m, 1e-30f);
    const int ex = (int)((__float_as_uint(m) >> 23) & 0xff) - 127;
    const float scale = __uint_as_float((unsigned)(127 + 7 - ex) << 23);
    const float iscale = __uint_as_float((unsigned)(127 - 7 + ex) << 23);
    unsigned w[4];
    if (I8) {
        const float s8 = 127.0f / m;
#pragma unroll
        for (int j = 0; j < 4; ++j) w[j] = ((unsigned)(int)__builtin_rintf(v[j].x * s8) & 0xffu) | (((unsigned)(int)__builtin_rintf(v[j].y * s8) & 0xffu) << 8) |
                                            (((unsigned)(int)__builtin_rintf(v[j].z * s8) & 0xffu) << 16) | (((unsigned)(int)__builtin_rintf(v[j].w * s8) & 0xffu) << 24);
    } else {
#pragma unroll
    for (int j = 0; j < 4; ++j) { int t = __builtin_amdgcn_cvt_pk_fp8_f32(v[j].x * scale, v[j].y * scale, 0, false); t = __builtin_amdgcn_cvt_pk_fp8_f32(v[j].z * scale, v[j].w * scale, t, true); w[j] = (unsigned)t; }
    }
    if (!SLICED) { *(GAS v4u*)(dst + (size_t)e * 1024 + 16 * lane) = (v4u){w[0], w[1], w[2], w[3]}; }
    else {
#pragma unroll
        for (int j = 0; j < 4; ++j) *(GAS unsigned*)(dst + (size_t)(2 * j + (lane >> 5)) * (2 * MiB) + (size_t)e * 128 + 4 * (lane & 31)) = w[j]; }
    if (lane == 0) inv[e] = I8 ? m * (1.0f / 127.0f) : iscale;
}
__device__ __forceinline__ void sincos_d(double a, float& sn, float& cs) {
    const double TWO_PI = 6.283185307179586476925286766559;
    const double k = __builtin_rint(a / TWO_PI); const double r = a - k * TWO_PI; const double r2 = r * r;
    double ts = 1.0, tc = 1.0, ss = 1.0, cc = 1.0;
#pragma unroll
    for (int n = 1; n <= 14; ++n) { tc = -tc * r2 / (double)((2 * n - 1) * (2 * n)); ts = -ts * r2 / (double)((2 * n) * (2 * n + 1)); cc += tc; ss += ts; }
    sn = (float)(r * ss); cs = (float)cc;
}

__device__ __forceinline__ void p0_prologue(const Args& A, Frame& F) {
    unsigned char* ws = A.ws;
    LAS float* scr = (LAS float*)(F.lds + F.wave * 16384);
    const int lane = F.lane;
    constexpr int I_MOD = KSPLIT * 24;
    constexpr int I_WIN = (DM / 64) * (NIN / 32);
    constexpr int I_SBO = (512 / 64) * (DM / 32), I_DILO = (256 / 64) * (DM / 32), I_OUT = (DM / 64) * (DM / 32), I_PQ = (DM / 64) * (2048 / 32);
    constexpr int I_KEYS = 256, I_TAB = 2 * PEER_E, I_ROPE = SEQ * 32 / 64;
    constexpr int NITEMS = I_MOD + I_WIN + I_SBO + I_DILO + I_OUT + I_PQ + I_KEYS + I_TAB + I_ROPE;
    for (int it = F.gw; it < NITEMS; it += F.NGW) {
        int r = it;
        if (r < I_MOD) {
            const int ks = r / 24, cc = r % 24, col = 256 * cc + 4 * lane, k0 = 64 * ks;
            float sv[4];
#pragma unroll
            for (int b = 0; b < 4; ++b) { const float cv = A.c[b * DM + k0 + lane]; sv[b] = cv * sigmoidf_(cv); }
            f32x4 acc[4];
#pragma unroll
            for (int b = 0; b < 4; ++b) acc[b] = (f32x4){0.f, 0.f, 0.f, 0.f};
            const GAS f32x4* wp = (const GAS f32x4*)(A.w_ada + (size_t)k0 * NMOD + col);
#pragma unroll 8
            for (int kk = 0; kk < 64; ++kk) { const f32x4 w4 = wp[(size_t)kk * (NMOD / 4)];
#pragma unroll
                for (int b = 0; b < 4; ++b) { const float s = __uint_as_float(__builtin_amdgcn_readlane(__float_as_uint(sv[b]), kk)); acc[b] += w4 * s; } }
            float* mp = (float*)(ws + WS_MODP);
#pragma unroll
            for (int b = 0; b < 4; ++b) *(GAS f32x4*)(mp + ((size_t)(ks * 4 + b)) * NMOD + col) = acc[b];
            continue;
        }
        r -= I_MOD;
        if (r < I_WIN) { p0_transpose_item<true>(A.w_in, DM, NIN, (bf16*)(ws + WS_WIN), scr, r, lane); continue; } r -= I_WIN;
        if (r < I_SBO) { p0_transpose_item<false>(A.w_sb_o, 512, DM, (bf16*)(ws + WS_WSBO), scr, r, lane); continue; } r -= I_SBO;
        if (r < I_DILO) { p0_transpose_item<false>(A.w_dil_o, 256, DM, (bf16*)(ws + WS_WDILO), scr, r, lane); continue; } r -= I_DILO;
        if (r < I_OUT) { p0_transpose_item<false>(A.w_out, DM, DM, (bf16*)(ws + WS_WOUT), scr, r, lane); continue; } r -= I_OUT;
        if (r < I_PQ) { p0_transpose_item<false>(A.w_pq, DM, 2048, (bf16*)(ws + WS_WPQ), scr, r, lane); continue; } r -= I_PQ;
        if (r < I_KEYS) { cvt_row_1024(A.peer_keys + (size_t)r * 1024, (bf16*)(ws + WS_KEYS) + (size_t)r * 1024, lane); continue; } r -= I_KEYS;
        if (r < I_TAB) { if (r < PEER_E) cvt_row_fp8<true, true>(A.peer_u + (size_t)r * 1024, ws + WS_UB, (float*)(ws + WS_UB + 16 * MiB), r, lane);
                         else cvt_row_fp8<true>(A.peer_v + (size_t)(r - PEER_E) * 1024, ws + WS_VB, (float*)(ws + WS_VB + 16 * MiB), r - PEER_E, lane); continue; } r -= I_TAB;
        {
            const int idx = r * 64 + lane, s = idx >> 5, j = idx & 31;
            const float inv = (float)exp2(-(double)j * (13.287712379549449 / 32.0));
            const float ang = (float)s * inv;
            float sn, cs; sincos_d((double)ang, sn, cs);
            ((float*)(ws + WS_ROPEC))[idx] = cs; ((float*)(ws + WS_ROPES))[idx] = sn;
        }
    }
}

__device__ __forceinline__ void p1_hrows(const Args& A, Frame& F) {
    unsigned char* ws = A.ws;
    LAS float* mult = (LAS float*)F.lds; LAS float* addv = mult + DM;
    const float* mp = (const float*)(ws + WS_MODP);
    float* mod = (float*)(ws + WS_MOD);
    bf16* H = (bf16*)((unsigned char*)A.out + O_H);
    for (int ch = F.vcu; ch < TOK / 128; ch += F.G) {
        const int b = (ch * 128) / SEQ;
        __syncthreads();
        for (int k = F.tid; k < DM; k += NWAVES * 64) {
            float sh = A.b_ada[k], sc = A.b_ada[DM + k];
#pragma unroll
            for (int ks = 0; ks < KSPLIT; ++ks) { sh += mp[(size_t)(ks * 4 + b) * NMOD + k]; sc += mp[(size_t)(ks * 4 + b) * NMOD + DM + k]; }
            mult[k] = A.g_mix[k] * (1.f + sc); addv[k] = sh;
        }
        if ((ch * 128) % SEQ == 0) {
            for (int j = F.tid; j < NMOD; j += NWAVES * 64) { float v = A.b_ada[j];
#pragma unroll
                for (int ks = 0; ks < KSPLIT; ++ks) v += mp[(size_t)(ks * 4 + b) * NMOD + j];
                mod[b * NMOD + j] = v; }
        }
        __syncthreads();
        for (int i = 0; i < 16; ++i) {
            const int row = ch * 128 + F.wave * 16 + i;
            const GAS f32x4* xr = (const GAS f32x4*)(A.x + (size_t)row * DM) + F.lane;
            f32x4 v[4]; float s = 0.f;
#pragma unroll
            for (int j = 0; j < 4; ++j) { v[j] = xr[64 * j]; s += (v[j].x * v[j].x + v[j].y * v[j].y) + (v[j].z * v[j].z + v[j].w * v[j].w); }
            const float rr = 1.0f / sqrtf(wave_sum(s) * (1.f / DM) + EPS);
            GAS v2u* o8 = (GAS v2u*)(H + (size_t)row * DM) + F.lane;
#pragma unroll
            for (int j = 0; j < 4; ++j) { const f32x4 mu = *(const LAS f32x4*)(mult + 256 * j + 4 * F.lane), ad = *(const LAS f32x4*)(addv + 256 * j + 4 * F.lane);
                const f32x4 hh = v[j] * rr * mu + ad; v2u o; o.x = pk2(hh.x, hh.y); o.y = pk2(hh.z, hh.w); o8[64 * j] = o; }
        }
    }
}

typedef pg8::f32x4 pf4;
struct EpiG1 {
    static constexpr bool PERM = true, AFTER_DRAIN = false;
    bf16 *Qsb, *Ksb, *Vsb, *Qd, *Kd, *Vd, *Gsb, *Gd; const float* ropeC; const float* ropeS;
    __device__ __forceinline__ void operator()(const pf4 (&acc)[2][2][4][2], const pg8::Unit& u, int wr, int wc, int fr, int fq) const {
        const int pn = u.pn;
        const int row0 = u.pm * 256 + wr * 64 + fr;
        const int b = (u.pm * 256) >> 13;
        if (pn < 6 || (pn >= 12 && pn < 15)) {
            bf16* base; int H, head0; float sc = 1.f;
            if (pn < 2) { base = Qsb; H = SBH; head0 = 4 * pn; sc = C2; }
            else if (pn < 4) { base = Ksb; H = SBH; head0 = 4 * (pn - 2); }
            else if (pn < 6) { base = Vsb; H = SBH; head0 = 4 * (pn - 4); }
            else { base = Vd; H = DILH; head0 = 4 * (pn - 12); }
            const int d0 = 32 * (wc & 1) + 8 * fq;
#pragma unroll
            for (int ai = 0; ai < 2; ++ai)
#pragma unroll
                for (int m = 0; m < 4; ++m) { const int s = (row0 + ai * 128 + m * 16) & (SEQ - 1);
#pragma unroll
                    for (int bj = 0; bj < 2; ++bj) { const int head = head0 + 2 * bj + (wc >> 1);
                        const pf4 v0 = acc[ai][bj][m][0] * sc, v1 = acc[ai][bj][m][1] * sc;
                        v4u w; w.x = pk2(v0[0], v0[1]); w.y = pk2(v0[2], v0[3]); w.z = pk2(v1[0], v1[1]); w.w = pk2(v1[2], v1[3]);
                        *(GAS v4u*)(base + ((size_t)(b * H + head) * SEQ + s) * 64 + d0) = w; } }
        } else if (pn < 12) {
            bf16* base; int head0; float sc = 1.f;
            if (pn < 9) { base = Qd; head0 = 4 * (pn - 6); sc = C2; } else { base = Kd; head0 = 4 * (pn - 9); }
            const int j4 = 4 * (4 * (wc & 1) + fq);
#pragma unroll
            for (int ai = 0; ai < 2; ++ai)
#pragma unroll
                for (int m = 0; m < 4; ++m) { const int s = (row0 + ai * 128 + m * 16) & (SEQ - 1);
                    const pf4 cs = *(const GAS pf4*)(ropeC + s * 32 + j4) * sc, sn = *(const GAS pf4*)(ropeS + s * 32 + j4) * sc;
#pragma unroll
                    for (int bj = 0; bj < 2; ++bj) { const int head = head0 + 2 * bj + (wc >> 1);
                        const pf4 x1 = acc[ai][bj][m][0], x2 = acc[ai][bj][m][1];
                        const pf4 o1 = x1 * cs - x2 * sn, o2 = x1 * sn + x2 * cs;
                        bf16* p = base + ((size_t)(b * DILH + head) * SEQ + s) * 64 + j4;
                        v2u w1, w2; w1.x = pk2(o1[0], o1[1]); w1.y = pk2(o1[2], o1[3]); w2.x = pk2(o2[0], o2[1]); w2.y = pk2(o2[2], o2[3]);
                        *(GAS v2u*)p = w1; *(GAS v2u*)(p + 32) = w2; } }
        } else {
            bf16* base = pn < 19 ? Gsb : Gd; const int ct = (pn < 19 ? pn - 15 : pn - 19) * 256 + wc * 32 + 8 * fq;
#pragma unroll
            for (int ai = 0; ai < 2; ++ai)
#pragma unroll
                for (int m = 0; m < 4; ++m) { const size_t row = (size_t)(row0 + ai * 128 + m * 16);
#pragma unroll
                    for (int bj = 0; bj < 2; ++bj) { const pf4 v0 = acc[ai][bj][m][0], v1 = acc[ai][bj][m][1];
                        v4u w; w.x = pk2(sigmoidf_(v0[0]), sigmoidf_(v0[1])); w.y = pk2(sigmoidf_(v0[2]), sigmoidf_(v0[3]));
                        w.z = pk2(sigmoidf_(v1[0]), sigmoidf_(v1[1])); w.w = pk2(sigmoidf_(v1[2]), sigmoidf_(v1[3]));
                        *(GAS v4u*)(base + row * DM + ct + bj * 128) = w; } }
        }
    }
};
template <bool SECOND> struct EpiMerge {
    static constexpr bool PERM = true, AFTER_DRAIN = false;
    const bf16* G; bf16* Mg;
    __device__ __forceinline__ void operator()(const pf4 (&acc)[2][2][4][2], const pg8::Unit& u, int wr, int wc, int fr, int fq) const {
        const int row0 = u.pm * 256 + wr * 64 + fr, col0 = u.pn * 256 + wc * 32 + 8 * fq;
#pragma unroll
        for (int ai = 0; ai < 2; ++ai)
#pragma unroll
            for (int m = 0; m < 4; ++m) { const size_t off = (size_t)(row0 + ai * 128 + m * 16) * DM + col0;
#pragma unroll
                for (int bj = 0; bj < 2; ++bj) { const v4u g = *(const GAS v4u*)(G + off + bj * 128);
                    pf4 v0 = acc[ai][bj][m][0], v1 = acc[ai][bj][m][1];
                    v0[0] *= bflo(g.x); v0[1] *= bfhi(g.x); v0[2] *= bflo(g.y); v0[3] *= bfhi(g.y); v1[0] *= bflo(g.z); v1[1] *= bfhi(g.z); v1[2] *= bflo(g.w); v1[3] *= bfhi(g.w);
                    if (SECOND) { const v4u t = *(const GAS v4u*)(Mg + off + bj * 128);
                        v0[0] += bflo(t.x); v0[1] += bfhi(t.x); v0[2] += bflo(t.y); v0[3] += bfhi(t.y); v1[0] += bflo(t.z); v1[1] += bfhi(t.z); v1[2] += bflo(t.w); v1[3] += bfhi(t.w); }
                    v4u w; w.x = pk2(v0[0], v0[1]); w.y = pk2(v0[2], v0[3]); w.z = pk2(v1[0], v1[1]); w.w = pk2(v1[2], v1[3]);
                    *(GAS v4u*)(Mg + off + bj * 128) = w; }
                asm volatile("" ::: "memory"); }
    }
};
struct EpiOut {
    static constexpr bool PERM = true, AFTER_DRAIN = false;
    const float* x; float* x1; bf16* x1m; float* ssq; const float* mod; const float* g_ffn;
    __device__ __forceinline__ void operator()(const pf4 (&acc)[2][2][4][2], const pg8::Unit& u, int wr, int wc, int fr, int fq) const {
        const int row0 = u.pm * 256 + wr * 64 + fr, col0 = u.pn * 256 + wc * 32 + 8 * fq;
        const int b = (u.pm * 256) >> 13; const float* mb = mod + (size_t)b * NMOD;
        pf4 gt[2][2], mm[2][2];
#pragma unroll
        for (int bj = 0; bj < 2; ++bj)
#pragma unroll
            for (int n = 0; n < 2; ++n) { const int c = col0 + bj * 128 + 4 * n; gt[bj][n] = *(const GAS pf4*)(mb + 2 * DM + c);
                mm[bj][n] = *(const GAS pf4*)(g_ffn + c) * (*(const GAS pf4*)(mb + 4 * DM + c) + 1.0f); }
#pragma unroll
        for (int ai = 0; ai < 2; ++ai)
#pragma unroll
            for (int m = 0; m < 4; ++m) { const int row = row0 + ai * 128 + m * 16; const size_t off = (size_t)row * DM + col0; float s = 0.f;
#pragma unroll
                for (int bj = 0; bj < 2; ++bj) {
                    const pf4 a0 = *(const GAS pf4*)(x + off + bj * 128), a1 = *(const GAS pf4*)(x + off + bj * 128 + 4);
                    const pf4 y0 = a0 + gt[bj][0] * acc[ai][bj][m][0], y1 = a1 + gt[bj][1] * acc[ai][bj][m][1];
                    *(GAS pf4*)(x1 + off + bj * 128) = y0; *(GAS pf4*)(x1 + off + bj * 128 + 4) = y1;
                    s += (y0[0] * y0[0] + y0[1] * y0[1]) + (y0[2] * y0[2] + y0[3] * y0[3]) + (y1[0] * y1[0] + y1[1] * y1[1]) + (y1[2] * y1[2] + y1[3] * y1[3]);
                    const pf4 z0 = y0 * mm[bj][0], z1 = y1 * mm[bj][1];
                    v4u w; w.x = pk2(z0[0], z0[1]); w.y = pk2(z0[2], z0[3]); w.z = pk2(z1[0], z1[1]); w.w = pk2(z1[2], z1[3]);
                    *(GAS v4u*)(x1m + off + bj * 128) = w; }
                s += __shfl_xor(s, 16); s += __shfl_xor(s, 32);
                if (fq == 0) ssq[(size_t)row * 16 + 4 * u.pn + wc] = s; }
    }
};
struct EpiPq {
    static constexpr bool PERM = true, AFTER_DRAIN = false;
    const float* ssq; const float* bias; bf16* Q; float* r2out;
    __device__ __forceinline__ void operator()(const pf4 (&acc)[2][2][4][2], const pg8::Unit& u, int wr, int wc, int fr, int fq) const {
        const int row0 = u.pm * 256 + wr * 64 + fr, col0 = u.pn * 256 + wc * 32 + 8 * fq;
        const int b = (u.pm * 256) >> 13; const float* bb = bias + (size_t)b * 2048;
        pf4 bv[2][2];
#pragma unroll
        for (int bj = 0; bj < 2; ++bj)
#pragma unroll
            for (int n = 0; n < 2; ++n) bv[bj][n] = *(const GAS pf4*)(bb + col0 + bj * 128 + 4 * n);
#pragma unroll
        for (int ai = 0; ai < 2; ++ai)
#pragma unroll
            for (int m = 0; m < 4; ++m) { const int row = row0 + ai * 128 + m * 16;
                const GAS pf4* sp = (const GAS pf4*)(ssq + (size_t)row * 16);
                const pf4 s4 = (sp[0] + sp[1]) + (sp[2] + sp[3]);
                const float r2 = 1.0f / sqrtf(((s4[0] + s4[1]) + (s4[2] + s4[3])) * (1.f / DM) + EPS);
                if (u.pn == 0 && wc == 0 && fq == 0) r2out[row] = r2;
#pragma unroll
                for (int bj = 0; bj < 2; ++bj) { const pf4 v0 = acc[ai][bj][m][0] * r2 + bv[bj][0], v1 = acc[ai][bj][m][1] * r2 + bv[bj][1];
                    v4u w; w.x = pk2(v0[0], v0[1]); w.y = pk2(v0[2], v0[3]); w.z = pk2(v1[0], v1[1]); w.w = pk2(v1[2], v1[3]);
                    *(GAS v4u*)(Q + (size_t)row * 2048 + col0 + bj * 128) = w; } }
    }
};

constexpr int VSTR = 144;
constexpr int ATT_WAVE_LDS = 2 * 32 * VSTR;
__device__ __forceinline__ int kappa(int r) { return (((r >> 2) & 1) << 4) + ((r >> 3) << 2) + (r & 3); }
struct KVTile { v4u k[4]; v4u v[4]; };
typedef short v4i16_t __attribute__((ext_vector_type(4)));
__device__ __forceinline__ s16x4 vtr(const LAS unsigned char* p) { return __builtin_bit_cast(s16x4, __builtin_amdgcn_ds_read_tr16_b64_v4i16((LAS v4i16_t*)p)); }

__device__ __forceinline__ void kv_load(KVTile& t, const bf16* Kh, const bf16* Vh, int base_tok, int sshift, int lane) {
#pragma unroll
    for (int i = 0; i < 4; ++i) { const size_t off = (size_t)(base_tok + (((lane >> 3) + 8 * i) << sshift)) * 64 + 8 * (lane & 7);
        t.k[i] = *(const GAS v4u*)(Kh + off); t.v[i] = *(const GAS v4u*)(Vh + off); }
}
__device__ __forceinline__ void v_to_lds(const KVTile& t, LAS unsigned char* vl, int lane) {
#pragma unroll
    for (int i = 0; i < 4; ++i) { const int o = ((lane >> 3) + 8 * i) * VSTR + 16 * (lane & 7); *(LAS v4u*)(vl + o) = t.k[i]; *(LAS v4u*)(vl + 32 * VSTR + o) = t.v[i]; }
}
__device__ __forceinline__ f32x16 qk_tile(const LAS unsigned char* vl, const bf16x8 (&qf)[4], int lane) {
    const LAS unsigned char* kp = vl + kappa(lane & 31) * VSTR + 16 * (lane >> 5);
    f32x16 s = {};
#pragma unroll
    for (int st = 0; st < 4; ++st) s = __builtin_amdgcn_mfma_f32_32x32x16_bf16(*(const LAS bf16x8*)(kp + 32 * st), qf[st], s, 0, 0, 0);
    return s;
}
__device__ __forceinline__ void pv_tile(f32x16& o0, f32x16& o1, const float (&p)[16], const LAS unsigned char* vl, int lane) {
    const int g = lane >> 4, li = lane & 15, q = li >> 2, pp = li & 3, h = g >> 1;
    const LAS unsigned char* tb = vl + 32 * VSTR + (16 * h + q) * VSTR + (16 * (g & 1) + 4 * pp) * 2;
    bf16x8 pf[2];
#pragma unroll
    for (int st = 0; st < 2; ++st) { v4u w; w.x = pk2(p[8 * st + 0], p[8 * st + 1]); w.y = pk2(p[8 * st + 2], p[8 * st + 3]); w.z = pk2(p[8 * st + 4], p[8 * st + 5]); w.w = pk2(p[8 * st + 6], p[8 * st + 7]); pf[st] = __builtin_bit_cast(bf16x8, w); }
#pragma unroll
    for (int db = 0; db < 2; ++db)
#pragma unroll
        for (int st = 0; st < 2; ++st) {
            const s16x4 lo = vtr(tb + (8 * st) * VSTR + 64 * db), hi = vtr(tb + (8 * st + 4) * VSTR + 64 * db);
            const bf16x8 vf = (bf16x8){lo[0], lo[1], lo[2], lo[3], hi[0], hi[1], hi[2], hi[3]};
            if (db == 0) o0 = __builtin_amdgcn_mfma_f32_32x32x16_bf16(vf, pf[st], o0, 0, 0, 0);
            else         o1 = __builtin_amdgcn_mfma_f32_32x32x16_bf16(vf, pf[st], o1, 0, 0, 0);
        }
}
__device__ __forceinline__ void o_store(bf16* orow, const f32x16& o0, const f32x16& o1, float sc, int hC) {
#pragma unroll
    for (int a = 0; a < 4; ++a) {
        v2u w0, w1; w0.x = pk2(o0[4 * a] * sc, o0[4 * a + 1] * sc); w0.y = pk2(o0[4 * a + 2] * sc, o0[4 * a + 3] * sc);
        w1.x = pk2(o1[4 * a] * sc, o1[4 * a + 1] * sc); w1.y = pk2(o1[4 * a + 2] * sc, o1[4 * a + 3] * sc);
        *(GAS v2u*)(orow + 8 * a + 4 * hC) = w0; *(GAS v2u*)(orow + 32 + 8 * a + 4 * hC) = w1; }
}

__device__ __forceinline__ void sb_task(const bf16* Qsb, const bf16* Ksb, const bf16* Vsb, bf16* Osb, int task, LAS unsigned char* vl, int lane) {
    const int qt = task & 255, bh = task >> 8, b = bh >> 3, h = bh & 7, t0 = qt * 32;
    const int q = lane & 31, hC = lane >> 5;
    const bf16* Kh = Ksb + (size_t)bh * SEQ * 64; const bf16* Vh = Vsb + (size_t)bh * SEQ * 64;
    bf16x8 qf[4];
    { const bf16* qp = Qsb + ((size_t)bh * SEQ + t0 + q) * 64 + 8 * hC;
#pragma unroll
      for (int st = 0; st < 4; ++st) qf[st] = *(const GAS bf16x8*)(qp + 16 * st); }
    f32x16 o0 = {}, o1 = {}; float carry = 0.f;
    KVTile nxt; kv_load(nxt, Kh, Vh, t0, 0, lane);
    for (int k0 = t0;; k0 -= 32) {
        KVTile cur = nxt;
        const bool more = k0 >= 32;
        if (more) kv_load(nxt, Kh, Vh, k0 - 32, 0, lane);
        v_to_lds(cur, vl, lane);
        const f32x16 s = qk_tile(vl, qf, lane);
        const bool diag = (k0 == t0);
        float L[16], z[16];
#pragma unroll
        for (int r = 0; r < 16; ++r) { z[r] = __builtin_amdgcn_fmed3f(s[r], -120.f, 120.f); const float e = fast_exp2(z[r]); L[r] = -fast_log2(1.f + e);
            if (diag && !(16 * hC + r < q)) L[r] = 0.f; }
        float c[16]; c[15] = L[15];
#pragma unroll
        for (int r = 14; r >= 0; --r) c[r] = c[r + 1] + L[r];
        const float tot = c[0], oth = __shfl_xor(tot, 32);
        const float base = carry + (hC ? 0.f : oth);
        float p[16];
#pragma unroll
        for (int r = 0; r < 16; ++r) { p[r] = fast_exp2(z[r] + (base + c[r])); if (diag && !(16 * hC + r < q)) p[r] = 0.f; }
        carry += tot + oth;
        pv_tile(o0, o1, p, vl, lane);
        if (!more) break;
        if (__all(carry < -160.f)) break;
    }
    o_store(Osb + ((size_t)(b * SEQ + t0 + q)) * 512 + h * 64, o0, o1, 1.f, hC);
}

__device__ __forceinline__ void dil_group(f32x16& o0, f32x16& o1, float& mrun, float& lsum, const bf16x8 (&qf)[4], const bf16* Kh, const bf16* Vh,
                                          int uq, int u_hi, int u_lo, int rs, int rho_g, LAS unsigned char* vl, int lane) {
    const int hC = lane >> 5;
    const int ub_last = u_lo & ~31;
    int ub = u_hi & ~31;
    KVTile nxt; kv_load(nxt, Kh, Vh, (ub << rs) + rho_g, rs, lane);
    for (;; ub -= 32) {
        KVTile cur = nxt;
        const bool more = ub > ub_last;
        if (more) kv_load(nxt, Kh, Vh, ((ub - 32) << rs) + rho_g, rs, lane);
        v_to_lds(cur, vl, lane);
        const f32x16 s = qk_tile(vl, qf, lane);
        float z[16]; float tmax = -1e30f;
        const int d0 = uq - (ub + 16 * hC);
#pragma unroll
        for (int r = 0; r < 16; ++r) { const bool valid = (unsigned)(d0 - r) <= 128u; z[r] = valid ? s[r] : -1e30f; tmax = fmaxf(tmax, z[r]); }
        tmax = fmaxf(tmax, __shfl_xor(tmax, 32));
        const float mnew = fmaxf(mrun, tmax); const float alpha = fast_exp2(mrun - mnew); mrun = mnew;
        float p[16]; float ps = 0.f;
#pragma unroll
        for (int r = 0; r < 16; ++r) { p[r] = (z[r] > -1e29f) ? fast_exp2(z[r] - mnew) : 0.f; ps += p[r]; }
        lsum = lsum * alpha + ps;
        if (!__all(alpha == 1.0f)) {
#pragma unroll
            for (int r = 0; r < 16; ++r) { o0[r] *= alpha; o1[r] *= alpha; }
        }
        pv_tile(o0, o1, p, vl, lane);
        if (!more) break;
    }
}
__device__ __forceinline__ void dil_g0_task(const bf16* Qd, const bf16* Kd, const bf16* Vd, bf16* PO, float* PM, int task, LAS unsigned char* vl, int lane) {
    const int qt = task & 255, hg = (task >> 8) & 3, b = task >> 10;
    const int q = lane & 31, hC = lane >> 5, t0 = 32 * qt, tq = t0 + q;
    f32x16 o0 = {}, o1 = {}; float mrun = -1e30f, lsum = 0.f;
    bf16x8 qf[4];
    { const bf16* qp = Qd + ((size_t)(b * DILH + hg) * SEQ + tq) * 64 + 8 * hC;
#pragma unroll
      for (int st = 0; st < 4; ++st) qf[st] = *(const GAS bf16x8*)(qp + 16 * st); }
    const bf16* Kh = Kd + (size_t)(b * DILH + hg) * SEQ * 64; const bf16* Vh = Vd + (size_t)(b * DILH + hg) * SEQ * 64;
    dil_group(o0, o1, mrun, lsum, qf, Kh, Vh, tq, t0 + 31, t0 >= 128 ? t0 - 128 : 0, 0, 0, vl, lane);
    const float l = lsum + __shfl_xor(lsum, 32);
    o_store(PO + (size_t)(b * SEQ + tq) * 256 + hg * 64, o0, o1, 1.0f, hC);
    if (hC == 0) *(GAS f32x2_t*)(PM + ((size_t)(b * SEQ + tq) * 4 + hg) * 2) = (f32x2_t){mrun, l};
}
__device__ __forceinline__ void dil_task(const bf16* Qd, const bf16* Kd, const bf16* Vd, const bf16* PO, const float* PM, bf16* Od, int task, LAS unsigned char* vl, int lane) {
    const int it = task & 15, rho = (task >> 4) & 15, hg = (task >> 8) & 3, b = task >> 10;
    const int q = lane & 31, hC = lane >> 5, i0 = 32 * it;
    const int tq = 16 * (i0 + q) + rho;
    f32x16 o0 = {}, o1 = {}; float mrun = -1e30f, lsum = 0.f;
#pragma unroll
    for (int g = 1; g < 3; ++g) {
        bf16x8 qf[4];
        { const bf16* qp = Qd + ((size_t)(b * DILH + g * 4 + hg) * SEQ + tq) * 64 + 8 * hC;
#pragma unroll
          for (int st = 0; st < 4; ++st) qf[st] = *(const GAS bf16x8*)(qp + 16 * st); }
        const int rs = 2 * g, cg = 16 >> rs, rho_g = rho & ((1 << rs) - 1), og = rho >> rs;
        const bf16* Kh = Kd + (size_t)(b * DILH + g * 4 + hg) * SEQ * 64; const bf16* Vh = Vd + (size_t)(b * DILH + g * 4 + hg) * SEQ * 64;
        int u_lo = cg * i0 + og - 128; u_lo = u_lo < 0 ? 0 : u_lo;
        dil_group(o0, o1, mrun, lsum, qf, Kh, Vh, cg * (i0 + q) + og, cg * (i0 + 31) + og, u_lo, rs, rho_g, vl, lane);
    }
    float l = lsum + __shfl_xor(lsum, 32);
    const f32x2_t ml = *(const GAS f32x2_t*)(PM + ((size_t)(b * SEQ + tq) * 4 + hg) * 2);
    const float mn = fmaxf(mrun, ml.x), sa = fast_exp2(mrun - mn), sb = fast_exp2(ml.x - mn);
    l = l * sa + ml.y * sb;
    const bf16* pr = PO + (size_t)(b * SEQ + tq) * 256 + hg * 64;
#pragma unroll
    for (int a = 0; a < 4; ++a) { const v2u w0 = *(const GAS v2u*)(pr + 8 * a + 4 * hC), w1 = *(const GAS v2u*)(pr + 32 + 8 * a + 4 * hC);
        o0[4 * a] = o0[4 * a] * sa + bflo(w0.x) * sb; o0[4 * a + 1] = o0[4 * a + 1] * sa + bfhi(w0.x) * sb; o0[4 * a + 2] = o0[4 * a + 2] * sa + bflo(w0.y) * sb; o0[4 * a + 3] = o0[4 * a + 3] * sa + bfhi(w0.y) * sb;
        o1[4 * a] = o1[4 * a] * sa + bflo(w1.x) * sb; o1[4 * a + 1] = o1[4 * a + 1] * sa + bfhi(w1.x) * sb; o1[4 * a + 2] = o1[4 * a + 2] * sa + bflo(w1.y) * sb; o1[4 * a + 3] = o1[4 * a + 3] * sa + bfhi(w1.y) * sb; }
    o_store(Od + (size_t)(b * SEQ + tq) * 256 + hg * 64, o0, o1, 1.0f / l, hC);
}

__device__ __forceinline__ void p3_attention(const Args& A, Frame& F, int pass) {
    unsigned char* ws = A.ws;
    LAS unsigned char* vl = F.lds + F.wave * ATT_WAVE_LDS;
    const bf16 *Qsb = (const bf16*)(ws + A_QSB), *Ksb = (const bf16*)(ws + A_KSB), *Vsb = (const bf16*)(ws + A_VSB);
    const bf16 *Qd = (const bf16*)(ws + A_QD), *Kd = (const bf16*)(ws + A_KD), *Vd = (const bf16*)(ws + A_VD);
    bf16* Osb = (bf16*)((unsigned char*)A.out + O_OSB); bf16* Od = (bf16*)((unsigned char*)A.out + O_OD);
    bf16* PO = (bf16*)((unsigned char*)A.out + O_PO); float* PM = (float*)(ws + WS_SSQ);
    constexpr int N_DIL = NB * 4 * 16 * 16, N_SB = NB * SBH * (SEQ / 32);
    if (pass == 0) {
        for (int t = F.gw; t < N_DIL + N_SB; t += F.NGW) {
            if (t < N_DIL) dil_g0_task(Qd, Kd, Vd, PO, PM, t, vl, F.lane);
            else sb_task(Qsb, Ksb, Vsb, Osb, t - N_DIL, vl, F.lane);
        }
    } else {
        for (int t = F.gw; t < N_DIL; t += F.NGW) dil_task(Qd, Kd, Vd, PO, PM, Od, t, vl, F.lane);
    }
}

__device__ __forceinline__ unsigned sortable(float f) { const unsigned u = __float_as_uint(f); return u ^ ((unsigned)((int)u >> 31) | 0x80000000u); }
__device__ __forceinline__ float unsortable(unsigned s) { const unsigned u = (s & 0x80000000u) ? (s ^ 0x80000000u) : ~s; return __uint_as_float(u); }
__device__ __forceinline__ unsigned umax_(unsigned a, unsigned b) { return a > b ? a : b; }

#define CE_(a, b) do { const unsigned hi_ = umax_(a, b), lo_ = umin_(a, b); a = hi_; b = lo_; } while (0)
__device__ __forceinline__ unsigned umin_(unsigned a, unsigned b) { return a < b ? a : b; }
template <int N, int OFF, int TOT> __device__ __forceinline__ void bitonic_sort_desc(unsigned (&v)[TOT]) {
#pragma unroll
    for (int k = 2; k <= N; k <<= 1)
#pragma unroll
        for (int j = k >> 1; j > 0; j >>= 1)
#pragma unroll
            for (int i = 0; i < N; ++i) { const int l = i ^ j; if (l > i) { if ((i & k) == 0) CE_(v[OFF + i], v[OFF + l]); else CE_(v[OFF + l], v[OFF + i]); } }
}
__device__ __forceinline__ void bitonic_merge16_desc(unsigned (&t)[16]) {
#pragma unroll
    for (int j = 8; j > 0; j >>= 1)
#pragma unroll
        for (int i = 0; i < 16; ++i) { const int l = i ^ j; if (l > i) CE_(t[i], t[l]); }
}
__device__ __forceinline__ void merge_top16(unsigned (&out)[16], const unsigned* a, const unsigned* b) {
#pragma unroll
    for (int i = 0; i < 16; ++i) out[i] = umax_(a[i], b[15 - i]);
    bitonic_merge16_desc(out);
}
__device__ __forceinline__ void cross_lane_top16(unsigned (&top)[16]) {
    unsigned t[16];
#pragma unroll
    for (int i = 0; i < 16; ++i) t[i] = umax_(top[i], (unsigned)__shfl_xor((int)top[15 - i], 32));
    bitonic_merge16_desc(t);
#pragma unroll
    for (int i = 0; i < 16; ++i) top[i] = t[i];
}
__device__ __forceinline__ void top16_of_128(unsigned (&key)[64], LAS unsigned* top  , int lane) {
    bitonic_sort_desc<16, 0, 64>(key); bitonic_sort_desc<16, 16, 64>(key); bitonic_sort_desc<16, 32, 64>(key); bitonic_sort_desc<16, 48, 64>(key);
    unsigned m0[16], m1[16], m[16];
    merge_top16(m0, &key[0], &key[16]); merge_top16(m1, &key[32], &key[48]); merge_top16(m, m0, m1);
    cross_lane_top16(m);
#pragma unroll
    for (int it = 0; it < 16; ++it) top[it * 32 + (lane & 31)] = m[it];
}
__device__ __forceinline__ unsigned pk_lookup(unsigned p0, unsigned p1, unsigned p2, unsigned p3, unsigned a) {
    const unsigned hi = a >> 2; unsigned d = p0; d = hi == 1 ? p1 : d; d = hi == 2 ? p2 : d; d = hi == 3 ? p3 : d;
    return (d >> (8 * (a & 3))) & 0xffu;
}
__device__ __forceinline__ unsigned pack4idx(unsigned t0, unsigned t1, unsigned t2, unsigned t3) { return (127u - (t0 & 127u)) | ((127u - (t1 & 127u)) << 8) | ((127u - (t2 & 127u)) << 16) | ((127u - (t3 & 127u)) << 24); }

constexpr int P7_KSTR = 272, P7_KEYS_BYTES = 256 * P7_KSTR, P7_TL_WAVE = 4096;
__device__ __forceinline__ void topk_phase(const bf16* Qp, const bf16* Kb, unsigned short* IDX, float* GATE, Frame& F) {
    const int lane = F.lane, q = lane & 31, hC = lane >> 5;
    LAS unsigned char* kl = F.lds;
    LAS unsigned* tl = (LAS unsigned*)(F.lds + P7_KEYS_BYTES + F.wave * P7_TL_WAVE);
    const int t0 = (F.vcu * 4 + (F.wave & 3)) * 32, hsel = F.wave >> 2;
#pragma unroll 1
  for (int rnd = 0; rnd < 4; ++rnd) {
    const int ph = 2 * rnd + hsel;
#pragma unroll 1
    for (int half = 0; half < 2; ++half) {
        __syncthreads();
#pragma unroll
        for (int i = 0; i < 8; ++i) { const int idx = F.tid + 512 * i, row = idx >> 4, ch = idx & 15;
            const v4u w = *(const GAS v4u*)(Kb + ((size_t)((2 * rnd + (row >> 7)) * 2 + half) * 128 + (row & 127)) * 128 + 8 * ch);
            *(LAS v4u*)(kl + row * P7_KSTR + 16 * ch) = w; }
        bf16x8 qf[8];
        { const bf16* qp = Qp + (size_t)(t0 + q) * 2048 + ph * 256 + half * 128 + 8 * hC;
#pragma unroll
          for (int st = 0; st < 8; ++st) qf[st] = *(const GAS bf16x8*)(qp + 16 * st); }
        __syncthreads();
        f32x16 C[4] = {};
        const LAS unsigned char* kb = kl + (hsel * 128 + q) * P7_KSTR + 16 * hC;
#pragma unroll
        for (int st = 0; st < 8; ++st)
#pragma unroll
            for (int mt = 0; mt < 4; ++mt) C[mt] = __builtin_amdgcn_mfma_f32_32x32x16_bf16(*(const LAS bf16x8*)(kb + mt * 32 * P7_KSTR + 32 * st), qf[st], C[mt], 0, 0, 0);
        unsigned key[64];
#pragma unroll
        for (int mt = 0; mt < 4; ++mt)
#pragma unroll
            for (int r = 0; r < 16; ++r) { const int kidx = 32 * mt + (r & 3) + 8 * (r >> 2) + 4 * hC; key[16 * mt + r] = (sortable(C[mt][r]) & ~127u) | (unsigned)(127 - kidx); }
        top16_of_128(key, tl + half * 512, lane);
    }
    unsigned tops[2][16];
#pragma unroll
    for (int a = 0; a < 16; ++a) { tops[0][a] = tl[a * 32 + q]; tops[1][a] = tl[512 + a * 32 + q]; }
    float s0[16], s1[16];
#pragma unroll
    for (int a = 0; a < 16; ++a) { s0[a] = unsortable(tops[0][a] & ~127u); s1[a] = unsortable(tops[1][a] & ~127u); }
    const unsigned pa0 = pack4idx(tops[0][0], tops[0][1], tops[0][2], tops[0][3]), pa1 = pack4idx(tops[0][4], tops[0][5], tops[0][6], tops[0][7]),
                   pa2 = pack4idx(tops[0][8], tops[0][9], tops[0][10], tops[0][11]), pa3 = pack4idx(tops[0][12], tops[0][13], tops[0][14], tops[0][15]);
    const unsigned pb0 = pack4idx(tops[1][0], tops[1][1], tops[1][2], tops[1][3]), pb1 = pack4idx(tops[1][4], tops[1][5], tops[1][6], tops[1][7]),
                   pb2 = pack4idx(tops[1][8], tops[1][9], tops[1][10], tops[1][11]), pb3 = pack4idx(tops[1][12], tops[1][13], tops[1][14], tops[1][15]);
    unsigned cand[32];
    {
        int n = 0;
#pragma unroll
        for (int a = 0; a < 16; ++a)
#pragma unroll
            for (int bq = 0; bq < 16; ++bq) if ((a + 1) * (bq + 1) <= 16) {
                const unsigned ck = (sortable(s0[a] + s1[bq]) & ~255u) | (unsigned)(a * 16 + bq);
                if (n < 25) cand[n] = ck; else cand[n - 25] = hC ? ck : cand[n - 25];
                ++n; }
#pragma unroll
        for (int i = 25; i < 32; ++i) cand[i] = 0u;
    }
    bitonic_sort_desc<32, 0, 32>(cand);
    unsigned win[16];
#pragma unroll
    for (int i = 0; i < 16; ++i) win[i] = cand[i];
    cross_lane_top16(win);
    float gv[16]; int eid[16]; float gs = 0.f;
    const float vmax = unsortable(win[0] & ~255u);
#pragma unroll
    for (int k = 0; k < 16; ++k) { const unsigned a = (win[k] >> 4) & 15u, bq = win[k] & 15u;
        eid[k] = (int)(pk_lookup(pa0, pa1, pa2, pa3, a) * 128u + pk_lookup(pb0, pb1, pb2, pb3, bq));
        gv[k] = fast_exp2((unsortable(win[k] & ~255u) - vmax) * LOG2E); gs += gv[k]; }
    const float ginv = 1.0f / gs;
#ifdef P7_TIME_SORT
    { const unsigned long long t1_ = __builtin_amdgcn_s_memrealtime(); while (__builtin_amdgcn_s_memrealtime() - t1_ < 4ull * tsort) __builtin_amdgcn_s_sleep(1); }
#endif
    const size_t o = (size_t)(t0 + q) * 128 + ph * 16;
    if (hC == 0) {
#pragma unroll
        for (int k = 0; k < 16; k += 8) *(GAS v4u*)(IDX + o + k) = (v4u){(unsigned)eid[k] | ((unsigned)eid[k + 1] << 16), (unsigned)eid[k + 2] | ((unsigned)eid[k + 3] << 16),
                                                                         (unsigned)eid[k + 4] | ((unsigned)eid[k + 5] << 16), (unsigned)eid[k + 6] | ((unsigned)eid[k + 7] << 16)};
    } else {
#pragma unroll
        for (int k = 0; k < 16; k += 4) *(GAS f32x4*)(GATE + o + k) = (f32x4){gv[k] * ginv, gv[k + 1] * ginv, gv[k + 2] * ginv, gv[k + 3] * ginv};
    }
  }
}

__device__ __forceinline__ float gelu_tanh(float x) {
    const float y2 = 2.0f * 0.7978845608028654f * (x + 0.044715f * x * x * x);
    return x * fast_rcp(1.f + fast_exp2(-y2 * LOG2E));
}
__device__ __forceinline__ void unpack8(const v4u w, float (&f)[8]) { f[0] = bflo(w.x); f[1] = bfhi(w.x); f[2] = bflo(w.y); f[3] = bfhi(w.y); f[4] = bflo(w.z); f[5] = bfhi(w.z); f[6] = bflo(w.w); f[7] = bfhi(w.w); }
__device__ __forceinline__ void h2q_row(unsigned char* ws, int t, int lane) {
    const bf16* xr = (const bf16*)(ws + A_X1M) + (size_t)t * DM + 16 * lane; const float* sh = (const float*)(ws + WS_MOD) + (size_t)(t >> 13) * NMOD + 3 * DM + 16 * lane;
    const float r2 = ((const float*)(ws + WS_R2))[t];
    float fa[8], fb[8]; unpack8(*(const GAS v4u*)xr, fa); unpack8(*(const GAS v4u*)(xr + 8), fb);
    float h[16]; float m = 0.f;
#pragma unroll
    for (int k = 0; k < 2; ++k) { const f32x4 s0 = *(const GAS f32x4*)(sh + 4 * k), s1 = *(const GAS f32x4*)(sh + 8 + 4 * k);
#pragma unroll
        for (int i = 0; i < 4; ++i) { h[4 * k + i] = fa[4 * k + i] * r2 + s0[i]; h[8 + 4 * k + i] = fb[4 * k + i] * r2 + s1[i]; m = fmaxf(m, fmaxf(fabsf(h[4 * k + i]), fabsf(h[8 + 4 * k + i]))); } }
#pragma unroll
    for (int o = 1; o < 64; o <<= 1) m = fmaxf(m, __shfl_xor(m, o));
    m = fmaxf(m, 1e-30f);
    const float sc = 127.0f / m;
    unsigned w[4];
#pragma unroll
    for (int j = 0; j < 4; ++j) { unsigned ww = 0;
#pragma unroll
        for (int i = 0; i < 4; ++i) { const int qv = (int)__builtin_rintf(h[4 * j + i] * sc); ww |= ((unsigned)qv & 0xffu) << (8 * i); }
        w[j] = ww; }
    *(GAS v4u*)(ws + A_H2Q + (size_t)t * DM + 16 * lane) = (v4u){w[0], w[1], w[2], w[3]};
    if (lane == 0) ((float*)(ws + WS_HINV))[t] = m * (1.0f / 127.0f);
}
__device__ __forceinline__ void unpack_fp8x16(const v4u w, float (&f)[16]) {
#pragma unroll
    for (int j = 0; j < 4; ++j) { const f32x2_t a = __builtin_amdgcn_cvt_pk_f32_fp8((int)w[j], false), b = __builtin_amdgcn_cvt_pk_f32_fp8((int)w[j], true);
        f[4 * j] = a.x; f[4 * j + 1] = a.y; f[4 * j + 2] = b.x; f[4 * j + 3] = b.y; }
}
__device__ __forceinline__ void peer_u_phase(const Args& A, Frame& F) {
    unsigned char* ws = A.ws;
    const int lane = F.lane, x = blockIdx.x & 7, wrk = (blockIdx.x >> 3) * NWAVES + F.wave, nwr = (F.G >> 3) * NWAVES, g = lane >> 3, c = lane & 7;
    const unsigned char* U8 = ws + WS_UB + (size_t)x * (2 * MiB); const unsigned c16 = 16u * c, g32 = 32u * g;
    const unsigned char* H2Q = ws + A_H2Q + 128 * x; const unsigned char* IDX = ws + A_IDX;
    bf16* PART = (bf16*)(ws + A_PART) + (size_t)x * TOK * 128;
    const int per = TOK / nwr, tb = wrk * per;
    v4u idC[2], idN[2], hC4;
#define SLOT_ID(ID, sl) (((ID)[(sl) >> 3][((sl) >> 1) & 3] >> (16 * ((sl) & 1))) & 0xffffu)
#define LD_TOK(ID, HV, T) do { const unsigned char* ib_ = IDX + (size_t)(T) * 256; ID[0] = *(const GAS v4u*)(ib_ + g32); ID[1] = *(const GAS v4u*)(ib_ + (g32 + 16u)); \
        HV = *(const GAS v4u*)(H2Q + (size_t)(T) * DM + c16); } while (0)
#define LD_ROWS(R, ID, H) do { _Pragma("unroll") for (int i = 0; i < 8; ++i) R[i] = *(const GAS v4u*)(U8 + (SLOT_ID(ID, 8 * (H) + i) * 128u + c16)); } while (0)
#define DOT16(R, HV) __builtin_amdgcn_sdot4((int)(R)[3], (int)(HV)[3], __builtin_amdgcn_sdot4((int)(R)[2], (int)(HV)[2], __builtin_amdgcn_sdot4((int)(R)[1], (int)(HV)[1], __builtin_amdgcn_sdot4((int)(R)[0], (int)(HV)[0], 0, false), false), false), false)
    v4u idD[2], hD4, hA4, hB4;
    v4u R0[8], R1[8], R2[8], R3[8];
    const int tl = tb + per - 1;
#define CL(T) ((T) <= tl ? (T) : tl)
#define REDUCE_STORE(PA, PB, T) do { int p_[16]; \
        _Pragma("unroll") for (int i = 0; i < 8; ++i) { p_[i] = PA[i]; p_[8 + i] = PB[i]; } \
        const bool b0 = lane & 1, b1 = lane & 2, b2 = lane & 4; int q8[8], q4[4], q2[2]; \
        _Pragma("unroll") for (int i = 0; i < 8; ++i) q8[i] = (b0 ? p_[8 + i] : p_[i]) + __shfl_xor(b0 ? p_[i] : p_[8 + i], 1); \
        _Pragma("unroll") for (int i = 0; i < 4; ++i) q4[i] = (b1 ? q8[4 + i] : q8[i]) + __shfl_xor(b1 ? q8[i] : q8[4 + i], 2); \
        _Pragma("unroll") for (int i = 0; i < 2; ++i) q2[i] = (b2 ? q4[2 + i] : q4[i]) + __shfl_xor(b2 ? q4[i] : q4[2 + i], 4); \
        *(GAS unsigned*)(PART + (size_t)(T) * 128 + slot) = pk2((float)q2[0], (float)q2[1]); } while (0)
    const int slot = 16 * g + 8 * (lane & 1) + 4 * ((lane >> 1) & 1) + 2 * ((lane >> 2) & 1);
    LD_TOK(idC, hA4, tb); LD_TOK(idN, hB4, CL(tb + 1));
    LD_ROWS(R0, idC, 0); LD_ROWS(R1, idC, 1);
    LD_TOK(idC, hC4, CL(tb + 2));
    LD_ROWS(R2, idN, 0); LD_ROWS(R3, idN, 1);
    LD_TOK(idD, hD4, CL(tb + 3));
    for (int t = tb; t < tb + per; t += 2) {
        int pa[8], pb[8];
#pragma unroll
        for (int i = 0; i < 8; ++i) { pa[i] = DOT16(R0[i], hA4); pb[i] = DOT16(R1[i], hA4); }
        LD_ROWS(R0, idC, 0); LD_ROWS(R1, idC, 1); hA4 = hC4;
        LD_TOK(idC, hC4, CL(t + 4));
        REDUCE_STORE(pa, pb, t);
#pragma unroll
        for (int i = 0; i < 8; ++i) { pa[i] = DOT16(R2[i], hB4); pb[i] = DOT16(R3[i], hB4); }
        LD_ROWS(R2, idD, 0); LD_ROWS(R3, idD, 1); hB4 = hD4;
        LD_TOK(idD, hD4, CL(t + 5));
        REDUCE_STORE(pa, pb, CL(t + 1));
    }
#undef CL
#undef REDUCE_STORE
#undef LD_TOK
#undef LD_ROWS
#undef SLOT_ID
#undef DOT16
}
__device__ __forceinline__ void peer_act_phase(const Args& A, Frame& F) {
    unsigned char* ws = A.ws;
    const bf16* PART = (const bf16*)(ws + A_PART); const unsigned short* IDX = (const unsigned short*)(ws + A_IDX); const float* GATE = (const float*)(ws + A_GATE); bf16* ACTG = (bf16*)(ws + A_ACTG);
    const float* UINV = (const float*)(ws + WS_UB + 16 * MiB); const float* VINV = (const float*)(ws + WS_VB + 16 * MiB); const float* HINV = (const float*)(ws + WS_HINV);
    const size_t n4 = (size_t)TOK * 128 / 4;
    for (size_t i = (size_t)F.vcu * (NWAVES * 64) + F.tid; i < n4; i += (size_t)F.G * NWAVES * 64) {
        f32x4 d = {0.f, 0.f, 0.f, 0.f};
#pragma unroll
        for (int xx = 0; xx < 8; ++xx) { const v2u w = *(const GAS v2u*)(PART + (size_t)xx * TOK * 128 + 4 * i); d[0] += bflo(w.x); d[1] += bfhi(w.x); d[2] += bflo(w.y); d[3] += bfhi(w.y); }
        const v2u ew = *(const GAS v2u*)(IDX + 4 * i); const f32x4 gt = *(const GAS f32x4*)(GATE + 4 * i);
        const unsigned e[4] = {ew.x & 0xffffu, ew.x >> 16, ew.y & 0xffffu, ew.y >> 16};
        float o[4];
        const float hs = HINV[i >> 5];
#pragma unroll
        for (int k = 0; k < 4; ++k) o[k] = gelu_tanh(d[k] * (UINV[e[k]] * hs)) * gt[k] * VINV[e[k]];
        *(GAS v2u*)(ACTG + 4 * i) = (v2u){pk2(o[0], o[1]), pk2(o[2], o[3])};
    }
}
__device__ __forceinline__ void peer_v_phase(const Args& A, Frame& F) {
    unsigned char* ws = A.ws;
    const int lane = F.lane, x = blockIdx.x & 7, wrk = (blockIdx.x >> 3) * NWAVES + F.wave, nwr = (F.G >> 3) * NWAVES, g = lane >> 3, c = lane & 7;
    const unsigned char* V8 = ws + WS_VB + (size_t)x * (2 * MiB); const unsigned c16 = 16u * c, g32 = 32u * g;
    const unsigned char* IDX = ws + A_IDX; const unsigned char* ACTG = ws + A_ACTG; unsigned char* POUT = ws + A_POUT + 256 * x;
    const int per = TOK / nwr, tb = wrk * per;
    v4u idC[2], idN[2], aC[2], aN[2];
#define SLOT_ID(ID, sl) (((ID)[(sl) >> 3][((sl) >> 1) & 3] >> (16 * ((sl) & 1))) & 0xffffu)
#define SLOT_ACT(AV, sl) (((sl) & 1) ? bfhi((AV)[(sl) >> 3][((sl) >> 1) & 3]) : bflo((AV)[(sl) >> 3][((sl) >> 1) & 3]))
#define LD_TOK(ID, AV, T) do { const unsigned char* ib_ = IDX + (size_t)(T) * 256; const unsigned char* ab_ = ACTG + (size_t)(T) * 256; \
        ID[0] = *(const GAS v4u*)(ib_ + g32); ID[1] = *(const GAS v4u*)(ib_ + (g32 + 16u)); AV[0] = *(const GAS v4u*)(ab_ + g32); AV[1] = *(const GAS v4u*)(ab_ + (g32 + 16u)); } while (0)
#define LD_ROWS(R, ID, H) do { _Pragma("unroll") for (int i = 0; i < 8; ++i) R[i] = *(const GAS v4u*)(V8 + (SLOT_ID(ID, 8 * (H) + i) * 128u + c16)); } while (0)
    LD_TOK(idC, aC, tb);
    v4u R0[8], R1[8];
    LD_ROWS(R0, idC, 0);
    LD_TOK(idN, aN, tb + 1 < TOK ? tb + 1 : tb);
    for (int t = tb; t < tb + per; ++t) {
        LD_ROWS(R1, idC, 1);
        float acc[16];
#pragma unroll
        for (int d = 0; d < 16; ++d) acc[d] = 0.f;
#pragma unroll
        for (int i = 0; i < 8; ++i) { float f[16]; unpack_fp8x16(R0[i], f); const float a = SLOT_ACT(aC, i);
#pragma unroll
            for (int d = 0; d < 16; ++d) acc[d] += a * f[d]; }
        LD_ROWS(R0, idN, 0);
#pragma unroll
        for (int i = 0; i < 8; ++i) { float f[16]; unpack_fp8x16(R1[i], f); const float a = SLOT_ACT(aC, 8 + i);
#pragma unroll
            for (int d = 0; d < 16; ++d) acc[d] += a * f[d]; }
        idC[0] = idN[0]; idC[1] = idN[1]; aC[0] = aN[0]; aC[1] = aN[1];
        { const int tn = t + 2 < tb + per ? t + 2 : tb + per - 1; LD_TOK(idN, aN, tn); }
#pragma unroll
        for (int d = 0; d < 16; ++d) { float v = acc[d]; v += __shfl_xor(v, 8); v += __shfl_xor(v, 16); v += __shfl_xor(v, 32); acc[d] = v; }
        if (g == 0) { v4u w0, w1; w0.x = pk2(acc[0], acc[1]); w0.y = pk2(acc[2], acc[3]); w0.z = pk2(acc[4], acc[5]); w0.w = pk2(acc[6], acc[7]);
            w1.x = pk2(acc[8], acc[9]); w1.y = pk2(acc[10], acc[11]); w1.z = pk2(acc[12], acc[13]); w1.w = pk2(acc[14], acc[15]);
            unsigned char* o = POUT + (size_t)t * (DM * 2); *(GAS v4u*)(o + 2u * c16) = w0; *(GAS v4u*)(o + (2u * c16 + 16u)) = w1; }
    }
#undef LD_TOK
#undef LD_ROWS
#undef SLOT_ID
#undef SLOT_ACT
}
__device__ __forceinline__ void peer_final(const Args& A, int t, int lane) {
    unsigned char* ws = A.ws;
    const float* mod = (const float*)(ws + WS_MOD) + (size_t)(t >> 13) * NMOD; const bf16* POUT = (const bf16*)(ws + A_POUT);
    float* orow = A.out + (size_t)t * DM;
    f32x4 x2[4]; float s = 0.f;
#pragma unroll
    for (int j = 0; j < 4; ++j) { const int c = 256 * j + 4 * lane; const f32x4 x1 = *(const GAS f32x4*)(orow + c), gt = *(const GAS f32x4*)(mod + 5 * DM + c); const v2u w = *(const GAS v2u*)(POUT + (size_t)t * DM + c);
        f32x4 y; y[0] = x1[0] + gt[0] * bflo(w.x); y[1] = x1[1] + gt[1] * bfhi(w.x); y[2] = x1[2] + gt[2] * bflo(w.y); y[3] = x1[3] + gt[3] * bfhi(w.y);
        x2[j] = y; s += (y[0] * y[0] + y[1] * y[1]) + (y[2] * y[2] + y[3] * y[3]); }
    const float rr = 1.0f / sqrtf(wave_sum(s) * (1.f / DM) + EPS);
#pragma unroll
    for (int j = 0; j < 4; ++j) { const int c = 256 * j + 4 * lane; const f32x4 gf = *(const GAS f32x4*)(A.g_final + c); *(GAS f32x4*)(orow + c) = x2[j] * rr * gf; }
}

#ifndef MK_ONE_LAUNCH
#define MK_ONE_LAUNCH 1
#endif
constexpr int N_PHASES = 12;

__device__ __forceinline__ void biaspq_task(unsigned char* ws, int n, int lane) {
    const bf16* w = (const bf16*)(ws + WS_WPQ) + (size_t)n * DM + 16 * lane;
    float fa[8], fb[8]; unpack8(*(const GAS v4u*)w, fa); unpack8(*(const GAS v4u*)(w + 8), fb);
    float* bias = (float*)(ws + WS_BIASPQ);
#pragma unroll
    for (int b = 0; b < 4; ++b) { const GAS f32x4* sp = (const GAS f32x4*)((const float*)(ws + WS_MOD) + (size_t)b * NMOD + 3 * DM + 16 * lane);
        const f32x4 s0 = sp[0], s1 = sp[1], s2 = sp[2], s3 = sp[3]; float d = 0.f;
#pragma unroll
        for (int i = 0; i < 4; ++i) { d += fa[i] * s0[i]; d += fa[4 + i] * s1[i]; d += fb[i] * s2[i]; d += fb[4 + i] * s3[i]; }
        d = wave_sum(d); if (lane == 0) bias[b * 2048 + n] = d; }
}

__global__ void __launch_bounds__(NWAVES * 64, 2) mk_fwd(Args A) {
    extern __shared__ __attribute__((aligned(16))) unsigned char lds[];
    Frame F;
    F.lds = (LAS unsigned char*)lds;
    F.G = gridDim.x; { const int bx = blockIdx.x; F.vcu = (F.G % 8 == 0) ? (bx % 8) * (F.G / 8) + bx / 8 : bx; }
    F.NGW = F.G * NWAVES;
#define PHASE_BEGIN() do { int t_ = threadIdx.x; asm volatile("" : "+v"(t_)); F.tid = t_; F.lane = t_ & 63; F.wave = __builtin_amdgcn_readfirstlane(t_ >> 6); F.gw = F.vcu * NWAVES + F.wave; } while (0)
    PHASE_BEGIN();
    unsigned char* ws = A.ws;
    const int lo = A.ph_lo, hi = A.ph_hi;
#if MK_ONE_LAUNCH
    volatile LAS unsigned* MISC = (volatile LAS unsigned*)(F.lds + MISC_OFF);
    for (int u = F.tid; u < (LDS_BYTES - RING_BYTES) / 4; u += NWAVES * 64) ((LAS unsigned*)(F.lds + RING_BYTES))[u] = 0u;
    __syncthreads();
    XcdBarrier bar = xcd_barrier_post((unsigned*)(ws + WS_CTL) + CW_BAR, MISC + 8);
#define GRID_BAR() xcd_barrier(bar)
#else
#define GRID_BAR() do {} while (0)
#endif
#ifdef ONLY_PHASE
#define IN(k) ((k) == ONLY_PHASE && lo <= (k) && (k) < hi)
#else
#define IN(k) (lo <= (k) && (k) < hi)
#endif
#define BOTH(k) (IN(k) && IN((k) + 1))
#ifndef REPEAT_MASK
#define REPEAT_MASK 0
#endif
#define REPS(k) ((((REPEAT_MASK) >> (k)) & 1) + 1)

    if (IN(0)) for (int rep = 0; rep < REPS(0); ++rep) { PHASE_BEGIN(); if (rep) GRID_BAR(); p0_prologue(A, F); if (BOTH(0)) GRID_BAR(); }
    if (IN(1)) for (int rep = 0; rep < REPS(1); ++rep) { PHASE_BEGIN(); if (rep) GRID_BAR(); p1_hrows(A, F); if (BOTH(1)) GRID_BAR(); }
    if (IN(2)) for (int rep = 0; rep < REPS(2); ++rep) { PHASE_BEGIN(); if (rep) GRID_BAR();
        pg8::Gemm g{(const bf16*)((unsigned char*)A.out + O_H), (const bf16*)(ws + WS_WIN), TOK, NIN, DM}; pg8::StaticOrder S; S.init(TOK, NIN, F.G, (int)blockIdx.x);
        EpiG1 E{(bf16*)(ws + A_QSB), (bf16*)(ws + A_KSB), (bf16*)(ws + A_VSB), (bf16*)(ws + A_QD), (bf16*)(ws + A_KD), (bf16*)(ws + A_VD), (bf16*)(ws + A_GSB), (bf16*)(ws + A_GD),
                (const float*)(ws + WS_ROPEC), (const float*)(ws + WS_ROPES)};
        pg8::gemm_phase<EpiG1, pg8::StaticOrder, true, true>(F.lds, g, S, E);
        if (BOTH(2)) GRID_BAR();
    }
    if (IN(3)) for (int rep = 0; rep < REPS(3); ++rep) { PHASE_BEGIN(); if (rep) GRID_BAR(); p3_attention(A, F, 0); GRID_BAR(); PHASE_BEGIN(); p3_attention(A, F, 1); if (BOTH(3)) GRID_BAR(); }
    if (IN(4)) for (int rep = 0; rep < REPS(4); ++rep) { PHASE_BEGIN(); if (rep) GRID_BAR();
        for (int n = F.gw; n < 2048; n += F.NGW) biaspq_task(ws, n, F.lane);
        __syncthreads();
        {   pg8::Gemm g{(const bf16*)((unsigned char*)A.out + O_OD), (const bf16*)(ws + WS_WDILO), TOK, DM, 256}; pg8::StaticOrder S; S.init(TOK, DM, F.G, (int)blockIdx.x);
            EpiMerge<false> E{(const bf16*)(ws + A_GD), (bf16*)(ws + A_MERGED)};
            pg8::gemm_phase<EpiMerge<false>, pg8::StaticOrder, true, true>(F.lds, g, S, E); }
        asm volatile("s_waitcnt vmcnt(0)" ::: "memory"); __syncthreads();
        {   pg8::Gemm g{(const bf16*)((unsigned char*)A.out + O_OSB), (const bf16*)(ws + WS_WSBO), TOK, DM, 512}; pg8::StaticOrder S; S.init(TOK, DM, F.G, (int)blockIdx.x);
            EpiMerge<true> E{(const bf16*)(ws + A_GSB), (bf16*)(ws + A_MERGED)};
            pg8::gemm_phase<EpiMerge<true>, pg8::StaticOrder, true, true>(F.lds, g, S, E); }
        if (BOTH(4)) GRID_BAR();
    }
    if (IN(5)) for (int rep = 0; rep < REPS(5); ++rep) { PHASE_BEGIN(); if (rep) GRID_BAR();
        pg8::Gemm g{(const bf16*)(ws + A_MERGED), (const bf16*)(ws + WS_WOUT), TOK, DM, DM}; pg8::StaticOrder S; S.init(TOK, DM, F.G, (int)blockIdx.x);
        EpiOut E{A.x, A.out, (bf16*)(ws + A_X1M), (float*)(ws + WS_SSQ), (const float*)(ws + WS_MOD), A.g_ffn};
        pg8::gemm_phase<EpiOut, pg8::StaticOrder, true, true>(F.lds, g, S, E);
        if (BOTH(5)) GRID_BAR();
    }
    if (IN(6)) for (int rep = 0; rep < REPS(6); ++rep) { PHASE_BEGIN(); if (rep) GRID_BAR();
        pg8::Gemm g{(const bf16*)(ws + A_X1M), (const bf16*)(ws + WS_WPQ), TOK, 2048, DM}; pg8::StaticOrder S; S.init(TOK, 2048, F.G, (int)blockIdx.x);
        EpiPq E{(const float*)(ws + WS_SSQ), (const float*)(ws + WS_BIASPQ), (bf16*)(ws + A_QPEER), (float*)(ws + WS_R2)};
        pg8::gemm_phase<EpiPq, pg8::StaticOrder, true, true>(F.lds, g, S, E);
        if (BOTH(6)) GRID_BAR();
    }
    if (IN(7)) for (int rep = 0; rep < REPS(7); ++rep) { PHASE_BEGIN(); if (rep) GRID_BAR();
        topk_phase((const bf16*)(ws + A_QPEER), (const bf16*)(ws + WS_KEYS), (unsigned short*)(ws + A_IDX), (float*)(ws + A_GATE), F);
        for (int t = F.gw; t < TOK; t += F.NGW) h2q_row(ws, t, F.lane);
        if (BOTH(7)) GRID_BAR();
    }
    if (IN(8)) for (int rep = 0; rep < REPS(8); ++rep) { PHASE_BEGIN(); if (rep) GRID_BAR();
        peer_u_phase(A, F); if (BOTH(8)) GRID_BAR(); }
    if (IN(9)) { PHASE_BEGIN();
#ifdef VALU_PROBE
        { float a0 = F.lane, a1 = a0 + 1, a2 = a0 + 2, a3 = a0 + 3; unsigned w0 = F.tid * 2654435761u, w1 = w0 ^ 0x3c3c3c3cu, w2 = w0 + 77u, w3 = w0 + 99u;
          f32x2_t p0 = {a0, a1}, p1 = {a2, a3}, p2 = {a1, a2}, p3 = {a3, a0};
          for (int it = 0; it < 4096; ++it) {
#if VALU_PROBE == 1
              f32x2_t c0 = __builtin_amdgcn_cvt_pk_f32_fp8((int)w0, false), c1 = __builtin_amdgcn_cvt_pk_f32_fp8((int)w1, true), c2 = __builtin_amdgcn_cvt_pk_f32_fp8((int)w2, false), c3 = __builtin_amdgcn_cvt_pk_f32_fp8((int)w3, true);
              f32x2_t c4 = __builtin_amdgcn_cvt_pk_f32_fp8((int)w0, true), c5 = __builtin_amdgcn_cvt_pk_f32_fp8((int)w1, false), c6 = __builtin_amdgcn_cvt_pk_f32_fp8((int)w2, true), c7 = __builtin_amdgcn_cvt_pk_f32_fp8((int)w3, false);
              w0 ^= __float_as_uint(c0.x) ^ __float_as_uint(c4.y); w1 ^= __float_as_uint(c1.x) ^ __float_as_uint(c5.y); w2 ^= __float_as_uint(c2.x) ^ __float_as_uint(c6.y); w3 ^= __float_as_uint(c3.x) ^ __float_as_uint(c7.y);
#elif VALU_PROBE == 2
              p0 = p0 * p1 + p2; p1 = p1 * p2 + p3; p2 = p2 * p3 + p0; p3 = p3 * p0 + p1; p0 = p0 * p2 + p1; p1 = p1 * p3 + p2; p2 = p2 * p0 + p3; p3 = p3 * p1 + p0;
#else
              a0 = a0 * a1 + a2; a1 = a1 * a2 + a3; a2 = a2 * a3 + a0; a3 = a3 * a0 + a1; a0 = a0 * a2 + a1; a1 = a1 * a3 + a2; a2 = a2 * a0 + a3; a3 = a3 * a1 + a0;
#endif
          }
          if (a0 + a1 + a2 + a3 + p0.x + p1.y + p2.x + p3.y == 1.2345e33f || (w0 ^ w1 ^ w2 ^ w3) == 0x12345u) ((float*)(ws + WS_DUMP))[F.lane] = a0; }
#endif
#ifdef ICACHE_PROBE
        asm volatile(".rept 8000\n s_nop 0\n .endr" ::: "memory");
#endif
        peer_act_phase(A, F); if (BOTH(9)) GRID_BAR(); }
    if (IN(10)) for (int rep = 0; rep < REPS(10); ++rep) { PHASE_BEGIN(); if (rep) GRID_BAR(); peer_v_phase(A, F); if (BOTH(10)) GRID_BAR(); }
    if (IN(11)) { PHASE_BEGIN();
        for (int t = F.gw; t < TOK; t += F.NGW) peer_final(A, t, F.lane);
    }
#undef IN
#undef BOTH
}

extern "C" void kernel_launch(void* const* d_in, const int* in_sizes, int n_in, void* d_out, int out_size, void* d_ws, size_t ws_size, hipStream_t stream) {
    static int grid = 0;
    if (grid == 0) {
        if (n_in != 15 || in_sizes[0] != TOK * DM || out_size != TOK * DM || ws_size < WS_END) { fprintf(stderr, "kernel_launch: unexpected shapes (n_in %d, in0 %d, out %d, ws %zu < %zu)\n", n_in, n_in > 0 ? in_sizes[0] : -1, out_size, ws_size, (size_t)WS_END); grid = -1; return; }
        int dev = 0, cus = 0, per_cu = 0;
        if (hipGetDevice(&dev) != hipSuccess || hipDeviceGetAttribute(&cus, hipDeviceAttributeMultiprocessorCount, dev) != hipSuccess) { grid = -1; return; }
        if (hipFuncSetAttribute((const void*)mk_fwd, hipFuncAttributeMaxDynamicSharedMemorySize, LDS_BYTES) != hipSuccess) { fprintf(stderr, "kernel_launch: hipFuncSetAttribute failed\n"); grid = -1; return; }
        if (hipOccupancyMaxActiveBlocksPerMultiprocessor(&per_cu, (const void*)mk_fwd, NWAVES * 64, LDS_BYTES) != hipSuccess || per_cu < 1) { fprintf(stderr, "kernel_launch: occupancy query says %d\n", per_cu); per_cu = 1; }
        (void)hipGetLastError();
        grid = cus;
    }
    if (grid < 0) return;
    (void)hipMemsetAsync((char*)d_ws + WS_CTL, 0, CTL_ZERO_BYTES, stream);
    Args a{};
    a.x = (const float*)d_in[0]; a.c = (const float*)d_in[1]; a.w_ada = (const float*)d_in[2]; a.b_ada = (const float*)d_in[3]; a.g_mix = (const float*)d_in[4];
    a.w_in = (const float*)d_in[5]; a.w_sb_o = (const float*)d_in[6]; a.w_dil_o = (const float*)d_in[7]; a.w_out = (const float*)d_in[8]; a.g_ffn = (const float*)d_in[9];
    a.w_pq = (const float*)d_in[10]; a.peer_keys = (const float*)d_in[11]; a.peer_u = (const float*)d_in[12]; a.peer_v = (const float*)d_in[13]; a.g_final = (const float*)d_in[14];
    a.out = (float*)d_out; a.ws = (unsigned char*)d_ws;
#if MK_ONE_LAUNCH
    a.ph_lo = 0; a.ph_hi = N_PHASES;
    void* args[] = {&a};
    hipError_t e = hipLaunchCooperativeKernel((const void*)mk_fwd, dim3(grid), dim3(NWAVES * 64), args, LDS_BYTES, stream);
    if (e != hipSuccess) fprintf(stderr, "kernel_launch: cooperative launch failed: %s (grid %d)\n", hipGetErrorString(e), grid);
#else
    for (int p = 0; p < N_PHASES; ++p) { a.ph_lo = p; a.ph_hi = p + 1; hipLaunchKernelGGL(mk_fwd, dim3(grid), dim3(NWAVES * 64), LDS_BYTES, stream, a); }
#endif
}
```

```cpp
#include <hip/hip_runtime.h>
#include <hip/hip_cooperative_groups.h>
#include <cstdio>
#include <cstdint>
namespace pg8 {
#define PG8_LAS __attribute__((address_space(3)))
typedef unsigned short bf16_t;
typedef short bf16x8 __attribute__((ext_vector_type(8)));
typedef float f32x4 __attribute__((ext_vector_type(4)));
typedef unsigned u32x4 __attribute__((ext_vector_type(4)));
constexpr int BM = 256, BK = 64, HALF = 128, HTB = HALF * BK * 2  , STAGE_BYTES = 8 * HTB, NXCD = 8, WGM = 8;

__host__ __device__ __forceinline__ int lds_byte(int r, int c) { const int st = (r >> 4) * 2 + (c >> 5), rr = r & 15, cc = c & 31, ob = rr * 64 + cc * 2; return st * 1024 + (ob ^ (((ob >> 9) & 1) << 5)); }
__host__ __device__ __forceinline__ void stage_rc(int b, int& R, int& C) { const int st = b / 1024, sb = b % 1024, swz = sb ^ (((sb >> 9) & 1) << 5); R = (st >> 1) * 16 + swz / 64; C = (st & 1) * 32 + (swz % 64) / 2; }
__host__ __device__ __forceinline__ int perm32(int rho) { const int n = rho >> 4, i = rho & 15; return 8 * (i >> 2) + 4 * n + (i & 3); }

struct Unit { int pm, pn; };
struct Gemm { const bf16_t* A; const bf16_t* Bt; int M, N, K; };

struct StaticOrder {
    int nM, nN, nwg, G, c;
    __host__ __device__ void init(int M, int N, int G_, int c_) { nM = M / BM; nN = N / BM; nwg = nM * nN; G = G_; c = c_; }
    __host__ __device__ bool next(int i, Unit& u) const {
        const long L = (long)i * G + c; if (L >= nwg) return false;
        int wgid = (int)L; { const int q = nwg / NXCD, r = nwg % NXCD, xcd = wgid % NXCD, off = wgid / NXCD; wgid = (xcd < r ? xcd * (q + 1) : r * (q + 1) + (xcd - r) * q) + off; }
        const int nig = WGM * nN, gid = wgid / nig, fm = gid * WGM, gsz = (nM - fm) < WGM ? (nM - fm) : WGM;
        u.pm = fm + ((wgid % nig) % gsz); u.pn = (wgid % nig) / gsz; return true;
    }
    __device__ __forceinline__ void a_ready(const Unit&) const {}
    __device__ __forceinline__ void done(const Unit&) const {}
};

__device__ __forceinline__ unsigned cvt_pk_bf16(float lo, float hi) { unsigned r; asm volatile("v_cvt_pk_bf16_f32 %0, %1, %2" : "=v"(r) : "v"(lo), "v"(hi)); return r; }
typedef int i32x4 __attribute__((ext_vector_type(4)));
template <bool I8> __device__ __forceinline__ f32x4 mma16(bf16x8 b, bf16x8 a, f32x4 c) {
    if constexpr (I8) return __builtin_bit_cast(f32x4, __builtin_amdgcn_mfma_i32_16x16x64_i8(__builtin_bit_cast(i32x4, b), __builtin_bit_cast(i32x4, a), __builtin_bit_cast(i32x4, c), 0, 0, 0));
    else return __builtin_amdgcn_mfma_f32_16x16x32_bf16(b, a, c, 0, 0, 0);
}
template <class Epi, class Sched, bool ALIGN_EPI = false, bool SP2 = false, bool I8 = false>
__device__ __forceinline__ void gemm_phase(PG8_LAS unsigned char* lds, const Gemm g, const Sched& S, const Epi& E) {
    int tid_ = threadIdx.x; asm volatile("" : "+v"(tid_));
    const int tid = tid_, wid = __builtin_amdgcn_readfirstlane(tid >> 6), lane = tid & 63, wr = wid >> 2, wc = wid & 3, fr = lane & 15, fq = lane >> 4;
    const int K = g.K, nt = K / BK;
    unsigned voffA[2], voffB[2];
#pragma unroll
    for (int i = 0; i < 2; ++i) { int R, C; stage_rc(tid * 16 + i * 8192, R, C); const int Rb = Epi::PERM ? ((R & ~31) + perm32(R & 31)) : R;
        voffA[i] = (unsigned)(R * K + C) * 2u; voffB[i] = (unsigned)(Rb * K + C) * 2u; }
    const size_t kstep = (size_t)(BK * 2);
    const size_t hstep = (size_t)HALF * K * 2;
    const size_t tstep = 2 * hstep;
    const unsigned ldsw = (unsigned)wid * 1024u;
    const int aoff = lds_byte(wr * 64 + fr, fq * 8), boff = lds_byte(wc * 32 + fr, fq * 8);
#define PG8_SA(b, h) (((b) * 2 + (h)) * HTB)
#define PG8_SB(b, h) ((4 + (b) * 2 + (h)) * HTB)
#define PG8_STAGE(bufoff, gbase, voff) do { _Pragma("unroll") for (int _i = 0; _i < 2; ++_i) \
        __builtin_amdgcn_global_load_lds((const unsigned*)((const char*)(gbase) + (voff)[_i]), (PG8_LAS unsigned*)(lds + (bufoff) + ldsw + _i * 8192), 16, 0, 0); } while (0)
#define PG8_LDA(dst, b, h) do { _Pragma("unroll") for (int m = 0; m < 4; ++m) _Pragma("unroll") for (int k = 0; k < 2; ++k) dst[m][k] = *(const PG8_LAS bf16x8*)(lds + PG8_SA(b, h) + aoff + m * 2048 + k * 1024); } while (0)
#define PG8_LDB(dst, b, h) do { _Pragma("unroll") for (int n = 0; n < 2; ++n) _Pragma("unroll") for (int k = 0; k < 2; ++k) dst[n][k] = *(const PG8_LAS bf16x8*)(lds + PG8_SB(b, h) + boff + n * 2048 + k * 1024); } while (0)
#define PG8_MMA(ai, bj, At, Bt) do { __builtin_amdgcn_s_setprio(1); _Pragma("unroll") for (int m = 0; m < 4; ++m) _Pragma("unroll") for (int n = 0; n < 2; ++n) _Pragma("unroll") for (int k = 0; k < 2; ++k) \
        acc[ai][bj][m][n] = mma16<I8>(Bt[n][k], At[m][k], acc[ai][bj][m][n]); __builtin_amdgcn_s_setprio(0); } while (0)
#define PG8_WAIT_V(n) asm volatile("s_waitcnt vmcnt(" #n ")" ::: "memory")
#define PG8_WAIT_L(n) asm volatile("s_waitcnt lgkmcnt(" #n ")" ::: "memory")
#define PG8_BAR __builtin_amdgcn_s_barrier()
#define PG8_SCHED __builtin_amdgcn_sched_barrier(0)
    Unit cur, nxt; int ui = 0;
    if (!S.next(0, cur)) return;
    f32x4 acc[2][2][4][2];
#pragma unroll
    for (int a = 0; a < 2; ++a)
#pragma unroll
        for (int b = 0; b < 2; ++b)
#pragma unroll
            for (int m = 0; m < 4; ++m)
#pragma unroll
                for (int n = 0; n < 2; ++n) acc[a][b][m][n] = (f32x4){0.f, 0.f, 0.f, 0.f};
    bf16x8 At[4][2], B0[2][2], B1[2][2];
    const char* cA = (const char*)g.A + (size_t)cur.pm * tstep; const char* cB = (const char*)g.Bt + (size_t)cur.pn * tstep;
    S.a_ready(cur);
    if constexpr (SP2) {
        PG8_STAGE(PG8_SB(0, 0), cB, voffB); PG8_STAGE(PG8_SB(0, 1), cB + hstep, voffB); PG8_STAGE(PG8_SA(0, 0), cA, voffA); PG8_STAGE(PG8_SA(0, 1), cA + hstep, voffA);
        if (wr == 1) PG8_BAR;
        PG8_WAIT_V(2); PG8_BAR;
        PG8_STAGE(PG8_SB(1, 0), cB + kstep, voffB); PG8_STAGE(PG8_SA(1, 0), cA + kstep, voffA); PG8_STAGE(PG8_SB(1, 1), cB + hstep + kstep, voffB);
        PG8_WAIT_V(6); PG8_BAR;
    } else {
        PG8_STAGE(PG8_SB(0, 0), cB, voffB); PG8_STAGE(PG8_SA(0, 0), cA, voffA); PG8_STAGE(PG8_SB(0, 1), cB + hstep, voffB); PG8_STAGE(PG8_SA(0, 1), cA + hstep, voffA);
        if (wr == 1) PG8_BAR;
        PG8_WAIT_V(4); PG8_BAR;
        PG8_STAGE(PG8_SB(1, 0), cB + kstep, voffB); PG8_STAGE(PG8_SA(1, 0), cA + kstep, voffA); PG8_STAGE(PG8_SB(1, 1), cB + hstep + kstep, voffB);
        PG8_WAIT_V(6); PG8_BAR;
    }
    for (;;) {
        const bool has_next = S.next(ui + 1, nxt);
        const char* nA = has_next ? (const char*)g.A + (size_t)nxt.pm * tstep : cA; const char* nB = has_next ? (const char*)g.Bt + (size_t)nxt.pn * tstep : cB;
        for (int t = 0; t < nt; t += 2) {
            const bool last = (t == nt - 2);
            const char* a1 = cA + (size_t)(t + 1) * kstep;
            const char* a2 = last ? nA : cA + (size_t)(t + 2) * kstep; const char* b2 = last ? nB : cB + (size_t)(t + 2) * kstep;
            const char* a3 = a2 + kstep; const char* b3 = b2 + kstep;
            if (last && has_next) S.a_ready(nxt);
            if constexpr (SP2) {
            PG8_LDB(B0, 0, 0); PG8_LDB(B1, 0, 1); PG8_SCHED; PG8_LDA(At, 0, 0); PG8_STAGE(PG8_SA(1, 1), a1 + hstep, voffA);
            PG8_WAIT_V(8); PG8_WAIT_L(0); PG8_BAR; PG8_MMA(0, 0, At, B0); PG8_MMA(0, 1, At, B1); PG8_BAR; PG8_SCHED;
            PG8_LDA(At, 0, 1); PG8_STAGE(PG8_SB(0, 0), b2, voffB); PG8_STAGE(PG8_SB(0, 1), b2 + hstep, voffB); PG8_STAGE(PG8_SA(0, 0), a2, voffA);
            PG8_WAIT_V(8); PG8_WAIT_L(0); PG8_BAR; PG8_MMA(1, 0, At, B0); PG8_MMA(1, 1, At, B1); PG8_BAR; PG8_SCHED;
            PG8_LDB(B0, 1, 0); PG8_LDB(B1, 1, 1); PG8_SCHED; PG8_LDA(At, 1, 0); PG8_STAGE(PG8_SA(0, 1), a2 + hstep, voffA);
            PG8_WAIT_V(8); PG8_WAIT_L(0); PG8_BAR; PG8_MMA(0, 0, At, B0); PG8_MMA(0, 1, At, B1); PG8_BAR; PG8_SCHED;
            PG8_LDA(At, 1, 1); PG8_STAGE(PG8_SB(1, 0), b3, voffB); PG8_STAGE(PG8_SB(1, 1), b3 + hstep, voffB); PG8_STAGE(PG8_SA(1, 0), a3, voffA);
            PG8_WAIT_V(8); PG8_WAIT_L(0); PG8_BAR; PG8_MMA(1, 0, At, B0); PG8_MMA(1, 1, At, B1); PG8_BAR; PG8_SCHED;
            } else {
            PG8_LDB(B0, 0, 0); PG8_SCHED; PG8_LDA(At, 0, 0); PG8_STAGE(PG8_SA(1, 1), a1 + hstep, voffA);
            PG8_WAIT_L(8); PG8_BAR; PG8_WAIT_L(0); PG8_MMA(0, 0, At, B0); PG8_BAR; PG8_SCHED;
            PG8_LDB(B1, 0, 1); PG8_STAGE(PG8_SB(0, 0), b2, voffB);
            PG8_BAR; PG8_WAIT_L(0); PG8_MMA(0, 1, At, B1); PG8_BAR;
            PG8_LDA(At, 0, 1); PG8_STAGE(PG8_SA(0, 0), a2, voffA);
            PG8_BAR; PG8_WAIT_L(0); PG8_MMA(1, 0, At, B0); PG8_BAR; PG8_SCHED;
            PG8_STAGE(PG8_SB(0, 1), b2 + hstep, voffB);
            PG8_WAIT_V(6); PG8_BAR; PG8_MMA(1, 1, At, B1); PG8_BAR;
            PG8_LDB(B0, 1, 0); PG8_SCHED; PG8_LDA(At, 1, 0); PG8_STAGE(PG8_SA(0, 1), a2 + hstep, voffA);
            PG8_WAIT_L(8); PG8_BAR; PG8_WAIT_L(0); PG8_MMA(0, 0, At, B0); PG8_BAR; PG8_SCHED;
            PG8_LDB(B1, 1, 1); PG8_STAGE(PG8_SB(1, 0), b3, voffB);
            PG8_BAR; PG8_WAIT_L(0); PG8_MMA(0, 1, At, B1); PG8_BAR;
            PG8_LDA(At, 1, 1); PG8_STAGE(PG8_SA(1, 0), a3, voffA);
            PG8_BAR; PG8_WAIT_L(0); PG8_MMA(1, 0, At, B0); PG8_BAR; PG8_SCHED;
            PG8_STAGE(PG8_SB(1, 1), b3 + hstep, voffB);
            PG8_WAIT_V(6); PG8_BAR; PG8_MMA(1, 1, At, B1); PG8_BAR;
            }
        }
        if constexpr (ALIGN_EPI) { if (wr == 0) PG8_BAR; }
        if constexpr (!Epi::AFTER_DRAIN) { E(acc, cur, wr, wc, fr, fq); S.done(cur); }
        if (!has_next) break;
#pragma unroll
        for (int a = 0; a < 2; ++a)
#pragma unroll
            for (int b = 0; b < 2; ++b)
#pragma unroll
                for (int m = 0; m < 4; ++m)
#pragma unroll
                    for (int n = 0; n < 2; ++n) acc[a][b][m][n] = (f32x4){0.f, 0.f, 0.f, 0.f};
        cur = nxt; cA = nA; cB = nB; ++ui;
        if constexpr (ALIGN_EPI) { if (wr == 1) PG8_BAR; }
    }
    PG8_WAIT_V(0);
    if constexpr (!ALIGN_EPI) { if (wr == 0) PG8_BAR; }
    PG8_BAR;
    if constexpr (Epi::AFTER_DRAIN) { E.fused(acc, cur, wr, wc, fr, fq, lds, wid, lane); S.done(cur); }
#undef PG8_SA
#undef PG8_SB
#undef PG8_STAGE
#undef PG8_LDA
#undef PG8_LDB
#undef PG8_MMA
#undef PG8_WAIT_V
#undef PG8_WAIT_L
#undef PG8_BAR
#undef PG8_SCHED
}
}

#define GAS __attribute__((address_space(1)))
#define LAS __attribute__((address_space(3)))
typedef unsigned short bf16;
typedef unsigned v4u __attribute__((ext_vector_type(4)));
typedef unsigned v2u __attribute__((ext_vector_type(2)));
typedef float f32x4 __attribute__((ext_vector_type(4)));
typedef float f32x16 __attribute__((ext_vector_type(16)));
typedef short bf16x8 __attribute__((ext_vector_type(8)));
typedef short s16x4 __attribute__((ext_vector_type(4)));

constexpr int NWAVES = 8;
constexpr int NB = 4, SEQ = 8192, DM = 1024, TOK = NB * SEQ;
constexpr int NIN = 5888;
constexpr int SBH = 8, DILH = 12;
constexpr int NMOD = 6 * DM;
constexpr int KSPLIT = 16;
constexpr float EPS = 1e-6f;
constexpr float LOG2E = 1.4426950408889634f;
constexpr float C2 = 0.125f * LOG2E;
constexpr int PEER_E = 16384;

constexpr size_t MiB = 1u << 20;
constexpr size_t WS_CTL = 0, CTL_ZERO_BYTES = 1 * MiB;
constexpr size_t WS_MODP = 1 * MiB;
constexpr size_t WS_MOD = 2 * MiB + 512 * 1024;
constexpr size_t WS_BIASPQ = 2 * MiB + 768 * 1024;
constexpr size_t WS_ROPEC = 3 * MiB, WS_ROPES = 4 * MiB;
constexpr size_t WS_SSQ = 5 * MiB;
constexpr size_t WS_KEYS = 7 * MiB;
constexpr size_t WS_WIN = 8 * MiB;
constexpr size_t WS_WSBO = 20 * MiB;
constexpr size_t WS_WDILO = 21 * MiB;
constexpr size_t WS_WOUT = 22 * MiB;
constexpr size_t WS_WPQ = 24 * MiB;
constexpr size_t WS_UB = 32 * MiB, WS_VB = 64 * MiB;
constexpr size_t WS_ACT = 96 * MiB;
constexpr size_t A_QSB = WS_ACT, A_KSB = WS_ACT + 32 * MiB, A_VSB = WS_ACT + 64 * MiB;
constexpr size_t A_QD = WS_ACT + 96 * MiB, A_KD = WS_ACT + 144 * MiB, A_VD = WS_ACT + 192 * MiB;
constexpr size_t A_GSB = WS_ACT + 240 * MiB, A_GD = WS_ACT + 304 * MiB;
constexpr size_t A_MERGED = WS_ACT;
constexpr size_t A_X1M = WS_ACT + 64 * MiB;
constexpr size_t A_QPEER = WS_ACT + 128 * MiB;
constexpr size_t A_IDX = WS_ACT + 256 * MiB;
constexpr size_t A_GATE = WS_ACT + 272 * MiB;
constexpr size_t A_ACTG = WS_ACT + 288 * MiB;
constexpr size_t A_PART = WS_ACT + 128 * MiB;
constexpr size_t A_H2Q = WS_ACT + 304 * MiB;
constexpr size_t WS_HINV = 7 * MiB + 640 * 1024;
constexpr size_t A_H2F8 = WS_ACT + 304 * MiB;
constexpr size_t WS_DUMP = 7 * MiB + 768 * 1024;
constexpr size_t WS_R2 = 7 * MiB + 512 * 1024;
constexpr size_t A_POUT = WS_ACT;
constexpr size_t WS_END = WS_ACT + 368 * MiB;
constexpr size_t O_H = 0, O_OSB = 64 * MiB, O_OD = 96 * MiB, O_PO = 112 * MiB;

constexpr int CW_BAR = 4096;
constexpr int CW_COLMAX = 16384;
constexpr size_t WS_SA = 7 * MiB + 832 * 1024;
constexpr size_t WS_SB = 7 * MiB + 960 * 1024;

constexpr int RING_BYTES = 131072;
constexpr int MISC_OFF = RING_BYTES + 320;
constexpr int LDS_BYTES = 147456;

#define RLX_AGENT __ATOMIC_RELAXED, __HIP_MEMORY_SCOPE_AGENT
__device__ __forceinline__ unsigned f2bf(float f) { unsigned u = __builtin_bit_cast(unsigned, f); return (u + 0x7fffu + ((u >> 16) & 1u)) >> 16; }
typedef float f32x2_t __attribute__((ext_vector_type(2))); typedef __bf16 bf16x2_t __attribute__((ext_vector_type(2)));
__device__ __forceinline__ unsigned pk2(float lo, float hi) { f32x2_t v = {lo, hi}; bf16x2_t b = __builtin_convertvector(v, bf16x2_t); return __builtin_bit_cast(unsigned, b); }
__device__ __forceinline__ float bflo(unsigned w) { return __uint_as_float(w << 16); }
__device__ __forceinline__ float bfhi(unsigned w) { return __uint_as_float(w & 0xffff0000u); }
__device__ __forceinline__ float wave_sum(float v) {
#pragma unroll
    for (int o = 1; o < 64; o <<= 1) v += __shfl_xor(v, o);
    return v;
}
__device__ __forceinline__ float fast_exp2(float x) { return __builtin_amdgcn_exp2f(x); }
__device__ __forceinline__ float fast_log2(float x) { return __builtin_amdgcn_logf(x); }
__device__ __forceinline__ float fast_rcp(float x) { return __builtin_amdgcn_rcpf(x); }
__device__ __forceinline__ float sigmoidf_(float x) { return fast_rcp(1.f + fast_exp2(-x * LOG2E)); }
#define XB_TMO      128
#define XB_XCNT(j)  (256  + 64 * (j))
#define XB_XSUB(j)  (1280 + 64 * (j))
#define XB_XGEN(j)  (2304 + 64 * (j))
#define XB_TOP      3328
#define XB_TOPGEN   3392
#define XCD_BAR_WORDS 3456
#define XB_SPIN_CAP (1u << 18)

__device__ __forceinline__ unsigned xb_ld(unsigned* p)              { return __hip_atomic_load(p, __ATOMIC_RELAXED, __HIP_MEMORY_SCOPE_AGENT); }
__device__ __forceinline__ unsigned xb_add(unsigned* p, unsigned v) { return __hip_atomic_fetch_add(p, v, __ATOMIC_RELAXED, __HIP_MEMORY_SCOPE_AGENT); }
__device__ __forceinline__ unsigned xb_xcc_id() { return (unsigned)__builtin_amdgcn_s_getreg((3 << 11) | 20) & 0xFu; }
#define XB_SPIN(cond, bar) do { unsigned _sp = 0; while (cond) { __builtin_amdgcn_s_sleep(1); \
    if ((++_sp & 255u) == 0u) { if (xb_ld(&(bar)[XB_TMO])) break; if (_sp > XB_SPIN_CAP) { atomicAdd(&(bar)[XB_TMO], 1u); break; } } } } while (0)

struct XcdBarrier {
    unsigned* bar; unsigned x;
    volatile LAS unsigned* st;
};

__device__ __forceinline__ XcdBarrier xcd_barrier_post(unsigned* bar, volatile LAS unsigned* st) {
    XcdBarrier b; b.bar = bar; b.x = xb_xcc_id(); b.st = st;
    if (threadIdx.x == 0) (void)xb_add(&bar[XB_XCNT(b.x)], 1u);
    return b;
}
__device__ __forceinline__ void xcd_barrier_complete(unsigned* bar, unsigned x, unsigned& nloc, unsigned& nx) {
    const unsigned G = gridDim.x * gridDim.y * gridDim.z;
    unsigned sum, cnt, mine, sp = 0u;
    for (;;) {
        sum = 0u; cnt = 0u; mine = 0u;
#pragma unroll
        for (unsigned j = 0; j < 16; ++j) { const unsigned c = xb_ld(&bar[XB_XCNT(j)]); sum += c; cnt += (c > 0u) ? 1u : 0u; mine = (j == x) ? c : mine; }
        if (sum == G) break;
        __builtin_amdgcn_s_sleep(1);
        if ((++sp & 255u) == 0u) { if (xb_ld(&bar[XB_TMO])) break; if (sp > XB_SPIN_CAP) { atomicAdd(&bar[XB_TMO], 1u); break; } }
    }
    nloc = mine > 0u ? mine : 1u; nx = cnt > 0u ? cnt : 1u;
}

__device__ __forceinline__ void xcd_barrier(const XcdBarrier& b) {
    asm volatile("s_waitcnt vmcnt(0)" ::: "memory");
    __syncthreads();
    if (threadIdx.x == 0) {
        unsigned* bar = b.bar;
        __builtin_amdgcn_s_waitcnt(0);
        unsigned nloc = b.st[0], nx = b.st[1];
        if (nloc == 0u) { xcd_barrier_complete(bar, b.x, nloc, nx); b.st[0] = nloc; b.st[1] = nx; }
        const unsigned old = xb_add(&bar[XB_XSUB(b.x)], 1u);
        const unsigned gen = old / nloc;
        if (old + 1u == (gen + 1u) * nloc) {
            __builtin_amdgcn_fence(__ATOMIC_RELEASE, "agent");
            asm volatile("s_waitcnt vmcnt(0)" ::: "memory");
            const unsigned og = xb_add(&bar[XB_TOP], 1u);
            const unsigned tg = og / nx;
            if (og + 1u == (tg + 1u) * nx) xb_add(&bar[XB_TOPGEN], 1u);
            else XB_SPIN(xb_ld(&bar[XB_TOPGEN]) == tg, bar);
            __builtin_amdgcn_fence(__ATOMIC_ACQUIRE, "agent");
            xb_add(&bar[XB_XGEN(b.x)], 1u);
            asm volatile("s_waitcnt vmcnt(0)" ::: "memory");
        } else {
            XB_SPIN(xb_ld(&bar[XB_XGEN(b.x)]) == gen, bar);
            __builtin_amdgcn_fence(__ATOMIC_ACQUIRE, "agent");
            asm volatile("s_waitcnt vmcnt(0)" ::: "memory");
        }
    }
    __syncthreads();
}

struct Args {
    const float* x; const float* c; const float* w_ada; const float* b_ada; const float* g_mix; const float* w_in; const float* w_sb_o; const float* w_dil_o;
    const float* w_out; const float* g_ffn; const float* w_pq; const float* peer_keys; const float* peer_u; const float* peer_v; const float* g_final;
    float* out; unsigned char* ws; int ph_lo, ph_hi;
};
struct Frame {
    LAS unsigned char* lds;
    int tid, lane, wave, vcu, G, gw, NGW;
};

__device__ __forceinline__ int win_row(int ncol) {
    const int tile = ncol >> 8;
    if (tile >= 6 && tile < 12) { const int d = ncol & 63; const int j = (d & 31) >> 2, i = (d & 3) + ((d >> 5) << 2); return (ncol & ~63) + 8 * j + i; }
    return ncol;
}
template <bool MAPWIN>
__device__ __forceinline__ void p0_transpose_item(const float* W, int K, int N, bf16* WT, LAS float* scr, int item, int lane) {
    const int nblk = N / 32, kb = item / nblk, nb = item % nblk, k0 = 64 * kb, n0 = 32 * nb;
#pragma unroll 8
    for (int i = 0; i < 32; ++i) { const int kk = 2 * i + (lane >> 5); scr[kk * 33 + (lane & 31)] = W[(size_t)(k0 + kk) * N + n0 + (lane & 31)]; }
    asm volatile("s_waitcnt lgkmcnt(0)" ::: "memory");
    const int c = lane & 7;
#pragma unroll
    for (int j = 0; j < 4; ++j) { const int n = (lane >> 3) + 8 * j; const LAS float* s = scr + (8 * c) * 33 + n;
        v4u o; o.x = pk2(s[0 * 33], s[1 * 33]); o.y = pk2(s[2 * 33], s[3 * 33]); o.z = pk2(s[4 * 33], s[5 * 33]); o.w = pk2(s[6 * 33], s[7 * 33]);
        const int rowo = MAPWIN ? win_row(n0 + n) : (n0 + n);
        *(GAS v4u*)(WT + (size_t)rowo * K + k0 + 8 * c) = o; }
    asm volatile("s_waitcnt lgkmcnt(0)" ::: "memory");
}
__device__ __forceinline__ void win_quant_item(const float* W, const unsigned* colmax, unsigned char* W8, float* sB, LAS float* scr, int item, int lane) {
    constexpr int K = DM, N = NIN;
    const int nblk = N / 32, kb = item / nblk, nb = item % nblk, k0 = 64 * kb, n0 = 32 * nb;
#pragma unroll 8
    for (int i = 0; i < 32; ++i) { const int kk = 2 * i + (lane >> 5); scr[kk * 33 + (lane & 31)] = W[(size_t)(k0 + kk) * N + n0 + (lane & 31)]; }
    asm volatile("s_waitcnt lgkmcnt(0)" ::: "memory");
    const int c = lane & 7;
#pragma unroll
    for (int j = 0; j < 4; ++j) { const int n = (lane >> 3) + 8 * j; const LAS float* s = scr + (8 * c) * 33 + n;
        const float cm = fmaxf(__uint_as_float(colmax[n0 + n]), 1e-30f), sc = 127.0f / cm;
        unsigned lo = 0, hi = 0;
#pragma unroll
        for (int i = 0; i < 4; ++i) { lo |= ((unsigned)(int)__builtin_rintf(s[i * 33] * sc) & 0xffu) << (8 * i); hi |= ((unsigned)(int)__builtin_rintf(s[(4 + i) * 33] * sc) & 0xffu) << (8 * i); }
        const int rowo = win_row(n0 + n);
        *(GAS v2u*)(W8 + (size_t)rowo * K + k0 + 8 * c) = (v2u){lo, hi};
        if (kb == 0 && c == 0) sB[rowo] = cm * (1.0f / 127.0f); }
    asm volatile("s_waitcnt lgkmcnt(0)" ::: "memory");
}
__device__ __forceinline__ void cvt_row_1024(const float* src, bf16* dst, int lane) {
    const GAS f32x4* s = (const GAS f32x4*)src + lane; GAS v2u* d = (GAS v2u*)dst + lane;
    f32x4 v[4];
#pragma unroll
    for (int j = 0; j < 4; ++j) v[j] = s[64 * j];
#pragma unroll
    for (int j = 0; j < 4; ++j) { v2u o; o.x = pk2(v[j].x, v[j].y); o.y = pk2(v[j].z, v[j].w); d[64 * j] = o; }
}
template <bool SLICED, bool I8 = false>
__device__ __forceinline__ void cvt_row_fp8(const float* src, unsigned char* dst, float* inv, int e, int lane) {
    const GAS f32x4* s = (const GAS f32x4*)src + lane;
    f32x4 v[4]; float m = 0.f;
#pragma unroll
    for (int j = 0; j < 4; ++j) { v[j] = s[64 * j]; m = fmaxf(m, fmaxf(fmaxf(fabsf(v[j].x), fabsf(v[j].y)), fmaxf(fabsf(v[j].z), fabsf(v[j].w)))); }
#pragma unroll
    for (int o = 1; o < 64; o <<= 1) m = fmaxf(m, __shfl_xor(m, o));
    m = fmaxf(m, 1e-30f);
    const int ex = (int)((__float_as_uint(m) >> 23) & 0xff) - 127;
    const float scale = __uint_as_float((unsigned)(127 + 7 - ex) << 23);
    const float iscale = __uint_as_float((unsigned)(127 - 7 + ex) << 23);
    unsigned w[4];
    if (I8) {
        const float s8 = 127.0f / m;
#pragma unroll
        for (int j = 0; j < 4; ++j) w[j] = ((unsigned)(int)__builtin_rintf(v[j].x * s8) & 0xffu) | (((unsigned)(int)__builtin_rintf(v[j].y * s8) & 0xffu) << 8) |
                                            (((unsigned)(int)__builtin_rintf(v[j].z * s8) & 0xffu) << 16) | (((unsigned)(int)__builtin_rintf(v[j].w * s8) & 0xffu) << 24);
    } else {
#pragma unroll
    for (int j = 0; j < 4; ++j) { int t = __builtin_amdgcn_cvt_pk_fp8_f32(v[j].x * scale, v[j].y * scale, 0, false); t = __builtin_amdgcn_cvt_pk_fp8_f32(v[j].z * scale, v[j].w * scale, t, true); w[j] = (unsigned)t; }
    }
    if (!SLICED) { *(GAS v4u*)(dst + (size_t)e * 1024 + 16 * lane) = (v4u){w[0], w[1], w[2], w[3]}; }
    else {
#pragma unroll
        for (int j = 0; j < 4; ++j) *(GAS unsigned*)(dst + (size_t)(2 * j + (lane >> 5)) * (2 * MiB) + (size_t)e * 128 + 4 * (lane & 31)) = w[j]; }
    if (lane == 0) inv[e] = I8 ? m * (1.0f / 127.0f) : iscale;
}
__device__ __forceinline__ void sincos_d(double a, float& sn, float& cs) {
    const double TWO_PI = 6.283185307179586476925286766559;
    const double k = __builtin_rint(a / TWO_PI); const double r = a - k * TWO_PI; const double r2 = r * r;
    double ts = 1.0, tc = 1.0, ss = 1.0, cc = 1.0;
#pragma unroll
    for (int n = 1; n <= 14; ++n) { tc = -tc * r2 / (double)((2 * n - 1) * (2 * n)); ts = -ts * r2 / (double)((2 * n) * (2 * n + 1)); cc += tc; ss += ts; }
    sn = (float)(r * ss); cs = (float)cc;
}

__device__ __forceinline__ void p0_prologue(const Args& A, Frame& F) {
    unsigned char* ws = A.ws;
    LAS float* scr = (LAS float*)(F.lds + F.wave * 16384);
    const int lane = F.lane;
    constexpr int I_MOD = KSPLIT * 24;
    constexpr int I_WIN = (DM / 64) * (NIN / 32);
    constexpr int I_SBO = (512 / 64) * (DM / 32), I_DILO = (256 / 64) * (DM / 32), I_OUT = (DM / 64) * (DM / 32), I_PQ = (DM / 64) * (2048 / 32);
    constexpr int I_KEYS = 256, I_TAB = 2 * PEER_E, I_ROPE = SEQ * 32 / 64;
    constexpr int NITEMS = I_MOD + I_WIN + I_SBO + I_DILO + I_OUT + I_PQ + I_KEYS + I_TAB + I_ROPE;
    for (int it = F.gw; it < NITEMS; it += F.NGW) {
        int r = it;
        if (r < I_MOD) {
            const int ks = r / 24, cc = r % 24, col = 256 * cc + 4 * lane, k0 = 64 * ks;
            float sv[4];
#pragma unroll
            for (int b = 0; b < 4; ++b) { const float cv = A.c[b * DM + k0 + lane]; sv[b] = cv * sigmoidf_(cv); }
            f32x4 acc[4];
#pragma unroll
            for (int b = 0; b < 4; ++b) acc[b] = (f32x4){0.f, 0.f, 0.f, 0.f};
            const GAS f32x4* wp = (const GAS f32x4*)(A.w_ada + (size_t)k0 * NMOD + col);
#pragma unroll 8
            for (int kk = 0; kk < 64; ++kk) { const f32x4 w4 = wp[(size_t)kk * (NMOD / 4)];
#pragma unroll
                for (int b = 0; b < 4; ++b) { const float s = __uint_as_float(__builtin_amdgcn_readlane(__float_as_uint(sv[b]), kk)); acc[b] += w4 * s; } }
            float* mp = (float*)(ws + WS_MODP);
#pragma unroll
            for (int b = 0; b < 4; ++b) *(GAS f32x4*)(mp + ((size_t)(ks * 4 + b)) * NMOD + col) = acc[b];
            continue;
        }
        r -= I_MOD;
        if (r < I_WIN) {
            const int nblk = NIN / 32, kb = r / nblk, nb = r % nblk, col = 32 * nb + (lane & 31); float m = 0.f;
            const float* wp = A.w_in + (size_t)(64 * kb + (lane >> 5)) * NIN + col;
#pragma unroll 8
            for (int i = 0; i < 32; ++i) m = fmaxf(m, fabsf(wp[(size_t)(2 * i) * NIN]));
            m = fmaxf(m, __shfl_xor(m, 32));
            if (lane < 32) atomicMax((unsigned*)(ws + WS_CTL) + CW_COLMAX + col, __float_as_uint(m));
            continue; } r -= I_WIN;
        if (r < I_SBO) { p0_transpose_item<false>(A.w_sb_o, 512, DM, (bf16*)(ws + WS_WSBO), scr, r, lane); continue; } r -= I_SBO;
        if (r < I_DILO) { p0_transpose_item<false>(A.w_dil_o, 256, DM, (bf16*)(ws + WS_WDILO), scr, r, lane); continue; } r -= I_DILO;
        if (r < I_OUT) { p0_transpose_item<false>(A.w_out, DM, DM, (bf16*)(ws + WS_WOUT), scr, r, lane); continue; } r -= I_OUT;
        if (r < I_PQ) { p0_transpose_item<false>(A.w_pq, DM, 2048, (bf16*)(ws + WS_WPQ), scr, r, lane); continue; } r -= I_PQ;
        if (r < I_KEYS) { cvt_row_1024(A.peer_keys + (size_t)r * 1024, (bf16*)(ws + WS_KEYS) + (size_t)r * 1024, lane); continue; } r -= I_KEYS;
        if (r < I_TAB) { if (r < PEER_E) cvt_row_fp8<true, true>(A.peer_u + (size_t)r * 1024, ws + WS_UB, (float*)(ws + WS_UB + 16 * MiB), r, lane);
                         else cvt_row_fp8<true>(A.peer_v + (size_t)(r - PEER_E) * 1024, ws + WS_VB, (float*)(ws + WS_VB + 16 * MiB), r - PEER_E, lane); continue; } r -= I_TAB;
        {
            const int idx = r * 64 + lane, s = idx >> 5, j = idx & 31;
            const float inv = (float)exp2(-(double)j * (13.287712379549449 / 32.0));
            const float ang = (float)s * inv;
            float sn, cs; sincos_d((double)ang, sn, cs);
            ((float*)(ws + WS_ROPEC))[idx] = cs; ((float*)(ws + WS_ROPES))[idx] = sn;
        }
    }
}

__device__ __forceinline__ void p1_hrows(const Args& A, Frame& F) {
    unsigned char* ws = A.ws;
    LAS float* mult = (LAS float*)F.lds; LAS float* addv = mult + DM;
    const float* mp = (const float*)(ws + WS_MODP);
    float* mod = (float*)(ws + WS_MOD);
    unsigned char* H = (unsigned char*)A.out + O_H;
    float* sA = (float*)(ws + WS_SA);
    {
        LAS float* scr = (LAS float*)(F.lds + F.wave * 16384);
        constexpr int I_WIN = (DM / 64) * (NIN / 32);
        for (int it = F.gw; it < I_WIN; it += F.NGW) win_quant_item(A.w_in, (const unsigned*)(ws + WS_CTL) + CW_COLMAX, ws + WS_WIN, (float*)(ws + WS_SB), scr, it, F.lane);
    }
    for (int ch = F.vcu; ch < TOK / 128; ch += F.G) {
        const int b = (ch * 128) / SEQ;
        __syncthreads();
        for (int k = F.tid; k < DM; k += NWAVES * 64) {
            float sh = A.b_ada[k], sc = A.b_ada[DM + k];
#pragma unroll
            for (int ks = 0; ks < KSPLIT; ++ks) { sh += mp[(size_t)(ks * 4 + b) * NMOD + k]; sc += mp[(size_t)(ks * 4 + b) * NMOD + DM + k]; }
            mult[k] = A.g_mix[k] * (1.f + sc); addv[k] = sh;
        }
        if ((ch * 128) % SEQ == 0) {
            for (int j = F.tid; j < NMOD; j += NWAVES * 64) { float v = A.b_ada[j];
#pragma unroll
                for (int ks = 0; ks < KSPLIT; ++ks) v += mp[(size_t)(ks * 4 + b) * NMOD + j];
                mod[b * NMOD + j] = v; }
        }
        __syncthreads();
        for (int i = 0; i < 16; ++i) {
            const int row = ch * 128 + F.wave * 16 + i;
            const GAS f32x4* xr = (const GAS f32x4*)(A.x + (size_t)row * DM) + F.lane;
            f32x4 v[4]; float s = 0.f;
#pragma unroll
            for (int j = 0; j < 4; ++j) { v[j] = xr[64 * j]; s += (v[j].x * v[j].x + v[j].y * v[j].y) + (v[j].z * v[j].z + v[j].w * v[j].w); }
            const float rr = 1.0f / sqrtf(wave_sum(s) * (1.f / DM) + EPS);
            float hm = 0.f;
#pragma unroll
            for (int j = 0; j < 4; ++j) { const f32x4 mu = *(const LAS f32x4*)(mult + 256 * j + 4 * F.lane), ad = *(const LAS f32x4*)(addv + 256 * j + 4 * F.lane);
                v[j] = v[j] * rr * mu + ad; hm = fmaxf(hm, fmaxf(fmaxf(fabsf(v[j].x), fabsf(v[j].y)), fmaxf(fabsf(v[j].z), fabsf(v[j].w)))); }
#pragma unroll
            for (int o = 1; o < 64; o <<= 1) hm = fmaxf(hm, __shfl_xor(hm, o));
            hm = fmaxf(hm, 1e-30f);
            const float qs = 127.0f / hm;
            GAS unsigned* o4 = (GAS unsigned*)(H + (size_t)row * DM) + F.lane;
#pragma unroll
            for (int j = 0; j < 4; ++j) o4[64 * j] = ((unsigned)(int)__builtin_rintf(v[j].x * qs) & 0xffu) | (((unsigned)(int)__builtin_rintf(v[j].y * qs) & 0xffu) << 8) |
                                                     (((unsigned)(int)__builtin_rintf(v[j].z * qs) & 0xffu) << 16) | (((unsigned)(int)__builtin_rintf(v[j].w * qs) & 0xffu) << 24);
            if (F.lane == 0) sA[row] = hm * (1.0f / 127.0f);
        }
    }
}

typedef pg8::f32x4 pf4;
struct EpiG1 {
    static constexpr bool PERM = true, AFTER_DRAIN = false;
    bf16 *Qsb, *Ksb, *Vsb, *Qd, *Kd, *Vd, *Gsb, *Gd; const float* ropeC; const float* ropeS; const float* sA; const float* sB;
    static __device__ __forceinline__ pf4 deq(const pf4& a, const pf4& sc) { const pg8::i32x4 i = __builtin_bit_cast(pg8::i32x4, a); return (pf4){(float)i[0], (float)i[1], (float)i[2], (float)i[3]} * sc; }
    __device__ __forceinline__ void operator()(const pf4 (&accI)[2][2][4][2], const pg8::Unit& u, int wr, int wc, int fr, int fq) const {
        const int pn = u.pn;
        const int row0 = u.pm * 256 + wr * 64 + fr;
        const int b = (u.pm * 256) >> 13;
        pf4 sb[2][2];
#pragma unroll
        for (int bj = 0; bj < 2; ++bj)
#pragma unroll
            for (int n = 0; n < 2; ++n) sb[bj][n] = *(const GAS pf4*)(sB + pn * 256 + bj * 128 + wc * 32 + 8 * fq + 4 * n);
        pf4 acc[2][2][4][2];
#pragma unroll
        for (int ai = 0; ai < 2; ++ai)
#pragma unroll
            for (int m = 0; m < 4; ++m) { const float sa = sA[row0 + ai * 128 + m * 16];
#pragma unroll
                for (int bj = 0; bj < 2; ++bj)
#pragma unroll
                    for (int n = 0; n < 2; ++n) acc[ai][bj][m][n] = deq(accI[ai][bj][m][n], sb[bj][n] * sa); }
        if (pn < 6 || (pn >= 12 && pn < 15)) {
            bf16* base; int H, head0; float sc = 1.f;
            if (pn < 2) { base = Qsb; H = SBH; head0 = 4 * pn; sc = C2; }
            else if (pn < 4) { base = Ksb; H = SBH; head0 = 4 * (pn - 2); }
            else if (pn < 6) { base = Vsb; H = SBH; head0 = 4 * (pn - 4); }
            else { base = Vd; H = DILH; head0 = 4 * (pn - 12); }
            const int d0 = 32 * (wc & 1) + 8 * fq;
#pragma unroll
            for (int ai = 0; ai < 2; ++ai)
#pragma unroll
                for (int m = 0; m < 4; ++m) { const int s = (row0 + ai * 128 + m * 16) & (SEQ - 1);
#pragma unroll
                    for (int bj = 0; bj < 2; ++bj) { const int head = head0 + 2 * bj + (wc >> 1);
                        const pf4 v0 = acc[ai][bj][m][0] * sc, v1 = acc[ai][bj][m][1] * sc;
                        v4u w; w.x = pk2(v0[0], v0[1]); w.y = pk2(v0[2], v0[3]); w.z = pk2(v1[0], v1[1]); w.w = pk2(v1[2], v1[3]);
                        *(GAS v4u*)(base + ((size_t)(b * H + head) * SEQ + s) * 64 + d0) = w; } }
        } else if (pn < 12) {
            bf16* base; int head0; float sc = 1.f;
            if (pn < 9) { base = Qd; head0 = 4 * (pn - 6); sc = C2; } else { base = Kd; head0 = 4 * (pn - 9); }
            const int j4 = 4 * (4 * (wc & 1) + fq);
#pragma unroll
            for (int ai = 0; ai < 2; ++ai)
#pragma unroll
                for (int m = 0; m < 4; ++m) { const int s = (row0 + ai * 128 + m * 16) & (SEQ - 1);
                    const pf4 cs = *(const GAS pf4*)(ropeC + s * 32 + j4) * sc, sn = *(const GAS pf4*)(ropeS + s * 32 + j4) * sc;
#pragma unroll
                    for (int bj = 0; bj < 2; ++bj) { const int head = head0 + 2 * bj + (wc >> 1);
                        const pf4 x1 = acc[ai][bj][m][0], x2 = acc[ai][bj][m][1];
                        const pf4 o1 = x1 * cs - x2 * sn, o2 = x1 * sn + x2 * cs;
                        bf16* p = base + ((size_t)(b * DILH + head) * SEQ + s) * 64 + j4;
                        v2u w1, w2; w1.x = pk2(o1[0], o1[1]); w1.y = pk2(o1[2], o1[3]); w2.x = pk2(o2[0], o2[1]); w2.y = pk2(o2[2], o2[3]);
                        *(GAS v2u*)p = w1; *(GAS v2u*)(p + 32) = w2; } }
        } else {
            bf16* base = pn < 19 ? Gsb : Gd; const int ct = (pn < 19 ? pn - 15 : pn - 19) * 256 + wc * 32 + 8 * fq;
#pragma unroll
            for (int ai = 0; ai < 2; ++ai)
#pragma unroll
                for (int m = 0; m < 4; ++m) { const size_t row = (size_t)(row0 + ai * 128 + m * 16);
#pragma unroll
                    for (int bj = 0; bj < 2; ++bj) { const pf4 v0 = acc[ai][bj][m][0], v1 = acc[ai][bj][m][1];
                        v4u w; w.x = pk2(sigmoidf_(v0[0]), sigmoidf_(v0[1])); w.y = pk2(sigmoidf_(v0[2]), sigmoidf_(v0[3]));
                        w.z = pk2(sigmoidf_(v1[0]), sigmoidf_(v1[1])); w.w = pk2(sigmoidf_(v1[2]), sigmoidf_(v1[3]));
                        *(GAS v4u*)(base + row * DM + ct + bj * 128) = w; } }
        }
    }
};
template <bool SECOND> struct EpiMerge {
    static constexpr bool PERM = true, AFTER_DRAIN = false;
    const bf16* G; bf16* Mg;
    __device__ __forceinline__ void operator()(const pf4 (&acc)[2][2][4][2], const pg8::Unit& u, int wr, int wc, int fr, int fq) const {
        const int row0 = u.pm * 256 + wr * 64 + fr, col0 = u.pn * 256 + wc * 32 + 8 * fq;
#pragma unroll
        for (int ai = 0; ai < 2; ++ai)
#pragma unroll
            for (int m = 0; m < 4; ++m) { const size_t off = (size_t)(row0 + ai * 128 + m * 16) * DM + col0;
#pragma unroll
                for (int bj = 0; bj < 2; ++bj) { const v4u g = *(const GAS v4u*)(G + off + bj * 128);
                    pf4 v0 = acc[ai][bj][m][0], v1 = acc[ai][bj][m][1];
                    v0[0] *= bflo(g.x); v0[1] *= bfhi(g.x); v0[2] *= bflo(g.y); v0[3] *= bfhi(g.y); v1[0] *= bflo(g.z); v1[1] *= bfhi(g.z); v1[2] *= bflo(g.w); v1[3] *= bfhi(g.w);
                    if (SECOND) { const v4u t = *(const GAS v4u*)(Mg + off + bj * 128);
                        v0[0] += bflo(t.x); v0[1] += bfhi(t.x); v0[2] += bflo(t.y); v0[3] += bfhi(t.y); v1[0] += bflo(t.z); v1[1] += bfhi(t.z); v1[2] += bflo(t.w); v1[3] += bfhi(t.w); }
                    v4u w; w.x = pk2(v0[0], v0[1]); w.y = pk2(v0[2], v0[3]); w.z = pk2(v1[0], v1[1]); w.w = pk2(v1[2], v1[3]);
                    *(GAS v4u*)(Mg + off + bj * 128) = w; }
                asm volatile("" ::: "memory"); }
    }
};
struct EpiOut {
    static constexpr bool PERM = true, AFTER_DRAIN = false;
    const float* x; float* x1; bf16* x1m; float* ssq; const float* mod; const float* g_ffn;
    __device__ __forceinline__ void operator()(const pf4 (&acc)[2][2][4][2], const pg8::Unit& u, int wr, int wc, int fr, int fq) const {
        const int row0 = u.pm * 256 + wr * 64 + fr, col0 = u.pn * 256 + wc * 32 + 8 * fq;
        const int b = (u.pm * 256) >> 13; const float* mb = mod + (size_t)b * NMOD;
        pf4 gt[2][2], mm[2][2];
#pragma unroll
        for (int bj = 0; bj < 2; ++bj)
#pragma unroll
            for (int n = 0; n < 2; ++n) { const int c = col0 + bj * 128 + 4 * n; gt[bj][n] = *(const GAS pf4*)(mb + 2 * DM + c);
                mm[bj][n] = *(const GAS pf4*)(g_ffn + c) * (*(const GAS pf4*)(mb + 4 * DM + c) + 1.0f); }
#pragma unroll
        for (int ai = 0; ai < 2; ++ai)
#pragma unroll
            for (int m = 0; m < 4; ++m) { const int row = row0 + ai * 128 + m * 16; const size_t off = (size_t)row * DM + col0; float s = 0.f;
#pragma unroll
                for (int bj = 0; bj < 2; ++bj) {
                    const pf4 a0 = *(const GAS pf4*)(x + off + bj * 128), a1 = *(const GAS pf4*)(x + off + bj * 128 + 4);
                    const pf4 y0 = a0 + gt[bj][0] * acc[ai][bj][m][0], y1 = a1 + gt[bj][1] * acc[ai][bj][m][1];
                    *(GAS pf4*)(x1 + off + bj * 128) = y0; *(GAS pf4*)(x1 + off + bj * 128 + 4) = y1;
                    s += (y0[0] * y0[0] + y0[1] * y0[1]) + (y0[2] * y0[2] + y0[3] * y0[3]) + (y1[0] * y1[0] + y1[1] * y1[1]) + (y1[2] * y1[2] + y1[3] * y1[3]);
                    const pf4 z0 = y0 * mm[bj][0], z1 = y1 * mm[bj][1];
                    v4u w; w.x = pk2(z0[0], z0[1]); w.y = pk2(z0[2], z0[3]); w.z = pk2(z1[0], z1[1]); w.w = pk2(z1[2], z1[3]);
                    *(GAS v4u*)(x1m + off + bj * 128) = w; }
                s += __shfl_xor(s, 16); s += __shfl_xor(s, 32);
                if (fq == 0) ssq[(size_t)row * 16 + 4 * u.pn + wc] = s; }
    }
};
struct EpiPq {
    static constexpr bool PERM = true, AFTER_DRAIN = false;
    const float* ssq; const float* bias; bf16* Q; float* r2out;
    __device__ __forceinline__ void operator()(const pf4 (&acc)[2][2][4][2], const pg8::Unit& u, int wr, int wc, int fr, int fq) const {
        const int row0 = u.pm * 256 + wr * 64 + fr, col0 = u.pn * 256 + wc * 32 + 8 * fq;
        const int b = (u.pm * 256) >> 13; const float* bb = bias + (size_t)b * 2048;
        pf4 bv[2][2];
#pragma unroll
        for (int bj = 0; bj < 2; ++bj)
#pragma unroll
            for (int n = 0; n < 2; ++n) bv[bj][n] = *(const GAS pf4*)(bb + col0 + bj * 128 + 4 * n);
#pragma unroll
        for (int ai = 0; ai < 2; ++ai)
#pragma unroll
            for (int m = 0; m < 4; ++m) { const int row = row0 + ai * 128 + m * 16;
                const GAS pf4* sp = (const GAS pf4*)(ssq + (size_t)row * 16);
                const pf4 s4 = (sp[0] + sp[1]) + (sp[2] + sp[3]);
                const float r2 = 1.0f / sqrtf(((s4[0] + s4[1]) + (s4[2] + s4[3])) * (1.f / DM) + EPS);
                if (u.pn == 0 && wc == 0 && fq == 0) r2out[row] = r2;
#pragma unroll
                for (int bj = 0; bj < 2; ++bj) { const pf4 v0 = acc[ai][bj][m][0] * r2 + bv[bj][0], v1 = acc[ai][bj][m][1] * r2 + bv[bj][1];
                    v4u w; w.x = pk2(v0[0], v0[1]); w.y = pk2(v0[2], v0[3]); w.z = pk2(v1[0], v1[1]); w.w = pk2(v1[2], v1[3]);
                    *(GAS v4u*)(Q + (size_t)row * 2048 + col0 + bj * 128) = w; } }
    }
};

constexpr int VSTR = 144;
constexpr int ATT_WAVE_LDS = 2 * 32 * VSTR;
__device__ __forceinline__ int kappa(int r) { return (((r >> 2) & 1) << 4) + ((r >> 3) << 2) + (r & 3); }
struct KVTile { v4u k[4]; v4u v[4]; };
typedef short v4i16_t __attribute__((ext_vector_type(4)));
__device__ __forceinline__ s16x4 vtr(const LAS unsigned char* p) { return __builtin_bit_cast(s16x4, __builtin_amdgcn_ds_read_tr16_b64_v4i16((LAS v4i16_t*)p)); }

__device__ __forceinline__ void kv_load(KVTile& t, const bf16* Kh, const bf16* Vh, int base_tok, int sshift, int lane) {
#pragma unroll
    for (int i = 0; i < 4; ++i) { const size_t off = (size_t)(base_tok + (((lane >> 3) + 8 * i) << sshift)) * 64 + 8 * (lane & 7);
        t.k[i] = *(const GAS v4u*)(Kh + off); t.v[i] = *(const GAS v4u*)(Vh + off); }
}
__device__ __forceinline__ void v_to_lds(const KVTile& t, LAS unsigned char* vl, int lane) {
#pragma unroll
    for (int i = 0; i < 4; ++i) { const int o = ((lane >> 3) + 8 * i) * VSTR + 16 * (lane & 7); *(LAS v4u*)(vl + o) = t.k[i]; *(LAS v4u*)(vl + 32 * VSTR + o) = t.v[i]; }
}
__device__ __forceinline__ f32x16 qk_tile(const LAS unsigned char* vl, const bf16x8 (&qf)[4], int lane) {
    const LAS unsigned char* kp = vl + kappa(lane & 31) * VSTR + 16 * (lane >> 5);
    f32x16 s = {};
#pragma unroll
    for (int st = 0; st < 4; ++st) s = __builtin_amdgcn_mfma_f32_32x32x16_bf16(*(const LAS bf16x8*)(kp + 32 * st), qf[st], s, 0, 0, 0);
    return s;
}
__device__ __forceinline__ void pv_tile(f32x16& o0, f32x16& o1, const float (&p)[16], const LAS unsigned char* vl, int lane) {
    const int g = lane >> 4, li = lane & 15, q = li >> 2, pp = li & 3, h = g >> 1;
    const LAS unsigned char* tb = vl + 32 * VSTR + (16 * h + q) * VSTR + (16 * (g & 1) + 4 * pp) * 2;
    bf16x8 pf[2];
#pragma unroll
    for (int st = 0; st < 2; ++st) { v4u w; w.x = pk2(p[8 * st + 0], p[8 * st + 1]); w.y = pk2(p[8 * st + 2], p[8 * st + 3]); w.z = pk2(p[8 * st + 4], p[8 * st + 5]); w.w = pk2(p[8 * st + 6], p[8 * st + 7]); pf[st] = __builtin_bit_cast(bf16x8, w); }
#pragma unroll
    for (int db = 0; db < 2; ++db)
#pragma unroll
        for (int st = 0; st < 2; ++st) {
            const s16x4 lo = vtr(tb + (8 * st) * VSTR + 64 * db), hi = vtr(tb + (8 * st + 4) * VSTR + 64 * db);
            const bf16x8 vf = (bf16x8){lo[0], lo[1], lo[2], lo[3], hi[0], hi[1], hi[2], hi[3]};
            if (db == 0) o0 = __builtin_amdgcn_mfma_f32_32x32x16_bf16(vf, pf[st], o0, 0, 0, 0);
            else         o1 = __builtin_amdgcn_mfma_f32_32x32x16_bf16(vf, pf[st], o1, 0, 0, 0);
        }
}
__device__ __forceinline__ void o_store(bf16* orow, const f32x16& o0, const f32x16& o1, float sc, int hC) {
#pragma unroll
    for (int a = 0; a < 4; ++a) {
        v2u w0, w1; w0.x = pk2(o0[4 * a] * sc, o0[4 * a + 1] * sc); w0.y = pk2(o0[4 * a + 2] * sc, o0[4 * a + 3] * sc);
        w1.x = pk2(o1[4 * a] * sc, o1[4 * a + 1] * sc); w1.y = pk2(o1[4 * a + 2] * sc, o1[4 * a + 3] * sc);
        *(GAS v2u*)(orow + 8 * a + 4 * hC) = w0; *(GAS v2u*)(orow + 32 + 8 * a + 4 * hC) = w1; }
}

__device__ __forceinline__ void sb_task(const bf16* Qsb, const bf16* Ksb, const bf16* Vsb, bf16* Osb, int task, LAS unsigned char* vl, int lane) {
    const int qt = task & 255, bh = task >> 8, b = bh >> 3, h = bh & 7, t0 = qt * 32;
    const int q = lane & 31, hC = lane >> 5;
    const bf16* Kh = Ksb + (size_t)bh * SEQ * 64; const bf16* Vh = Vsb + (size_t)bh * SEQ * 64;
    bf16x8 qf[4];
    { const bf16* qp = Qsb + ((size_t)bh * SEQ + t0 + q) * 64 + 8 * hC;
#pragma unroll
      for (int st = 0; st < 4; ++st) qf[st] = *(const GAS bf16x8*)(qp + 16 * st); }
    f32x16 o0 = {}, o1 = {}; float carry = 0.f;
    KVTile nxt; kv_load(nxt, Kh, Vh, t0, 0, lane);
    for (int k0 = t0;; k0 -= 32) {
        KVTile cur = nxt;
        const bool more = k0 >= 32;
        if (more) kv_load(nxt, Kh, Vh, k0 - 32, 0, lane);
        v_to_lds(cur, vl, lane);
        const f32x16 s = qk_tile(vl, qf, lane);
        const bool diag = (k0 == t0);
        float L[16], z[16];
#pragma unroll
        for (int r = 0; r < 16; ++r) { z[r] = __builtin_amdgcn_fmed3f(s[r], -120.f, 120.f); const float e = fast_exp2(z[r]); L[r] = -fast_log2(1.f + e);
            if (diag && !(16 * hC + r < q)) L[r] = 0.f; }
        float c[16]; c[15] = L[15];
#pragma unroll
        for (int r = 14; r >= 0; --r) c[r] = c[r + 1] + L[r];
        const float tot = c[0], oth = __shfl_xor(tot, 32);
        const float base = carry + (hC ? 0.f : oth);
        float p[16];
#pragma unroll
        for (int r = 0; r < 16; ++r) { p[r] = fast_exp2(z[r] + (base + c[r])); if (diag && !(16 * hC + r < q)) p[r] = 0.f; }
        carry += tot + oth;
        pv_tile(o0, o1, p, vl, lane);
        if (!more) break;
        if (__all(carry < -160.f)) break;
    }
    o_store(Osb + ((size_t)(b * SEQ + t0 + q)) * 512 + h * 64, o0, o1, 1.f, hC);
}

__device__ __forceinline__ void dil_group(f32x16& o0, f32x16& o1, float& mrun, float& lsum, const bf16x8 (&qf)[4], const bf16* Kh, const bf16* Vh,
                                          int uq, int u_hi, int u_lo, int rs, int rho_g, LAS unsigned char* vl, int lane) {
    const int hC = lane >> 5;
    const int ub_last = u_lo & ~31;
    int ub = u_hi & ~31;
    KVTile nxt; kv_load(nxt, Kh, Vh, (ub << rs) + rho_g, rs, lane);
    for (;; ub -= 32) {
        KVTile cur = nxt;
        const bool more = ub > ub_last;
        if (more) kv_load(nxt, Kh, Vh, ((ub - 32) << rs) + rho_g, rs, lane);
        v_to_lds(cur, vl, lane);
        const f32x16 s = qk_tile(vl, qf, lane);
        float z[16]; float tmax = -1e30f;
        const int d0 = uq - (ub + 16 * hC);
#pragma unroll
        for (int r = 0; r < 16; ++r) { const bool valid = (unsigned)(d0 - r) <= 128u; z[r] = valid ? s[r] : -1e30f; tmax = fmaxf(tmax, z[r]); }
        tmax = fmaxf(tmax, __shfl_xor(tmax, 32));
        const float mnew = fmaxf(mrun, tmax); const float alpha = fast_exp2(mrun - mnew); mrun = mnew;
        float p[16]; float ps = 0.f;
#pragma unroll
        for (int r = 0; r < 16; ++r) { p[r] = (z[r] > -1e29f) ? fast_exp2(z[r] - mnew) : 0.f; ps += p[r]; }
        lsum = lsum * alpha + ps;
        if (!__all(alpha == 1.0f)) {
#pragma unroll
            for (int r = 0; r < 16; ++r) { o0[r] *= alpha; o1[r] *= alpha; }
        }
        pv_tile(o0, o1, p, vl, lane);
        if (!more) break;
    }
}
__device__ __forceinline__ void dil_g0_task(const bf16* Qd, const bf16* Kd, const bf16* Vd, bf16* PO, float* PM, int task, LAS unsigned char* vl, int lane) {
    const int qt = task & 255, hg = (task >> 8) & 3, b = task >> 10;
    const int q = lane & 31, hC = lane >> 5, t0 = 32 * qt, tq = t0 + q;
    f32x16 o0 = {}, o1 = {}; float mrun = -1e30f, lsum = 0.f;
    bf16x8 qf[4];
    { const bf16* qp = Qd + ((size_t)(b * DILH + hg) * SEQ + tq) * 64 + 8 * hC;
#pragma unroll
      for (int st = 0; st < 4; ++st) qf[st] = *(const GAS bf16x8*)(qp + 16 * st); }
    const bf16* Kh = Kd + (size_t)(b * DILH + hg) * SEQ * 64; const bf16* Vh = Vd + (size_t)(b * DILH + hg) * SEQ * 64;
    dil_group(o0, o1, mrun, lsum, qf, Kh, Vh, tq, t0 + 31, t0 >= 128 ? t0 - 128 : 0, 0, 0, vl, lane);
    const float l = lsum + __shfl_xor(lsum, 32);
    o_store(PO + (size_t)(b * SEQ + tq) * 256 + hg * 64, o0, o1, 1.0f, hC);
    if (hC == 0) *(GAS f32x2_t*)(PM + ((size_t)(b * SEQ + tq) * 4 + hg) * 2) = (f32x2_t){mrun, l};
}
__device__ __forceinline__ void dil_task(const bf16* Qd, const bf16* Kd, const bf16* Vd, const bf16* PO, const float* PM, bf16* Od, int task, LAS unsigned char* vl, int lane) {
    const int it = task & 15, rho = (task >> 4) & 15, hg = (task >> 8) & 3, b = task >> 10;
    const int q = lane & 31, hC = lane >> 5, i0 = 32 * it;
    const int tq = 16 * (i0 + q) + rho;
    f32x16 o0 = {}, o1 = {}; float mrun = -1e30f, lsum = 0.f;
#pragma unroll
    for (int g = 1; g < 3; ++g) {
        bf16x8 qf[4];
        { const bf16* qp = Qd + ((size_t)(b * DILH + g * 4 + hg) * SEQ + tq) * 64 + 8 * hC;
#pragma unroll
          for (int st = 0; st < 4; ++st) qf[st] = *(const GAS bf16x8*)(qp + 16 * st); }
        const int rs = 2 * g, cg = 16 >> rs, rho_g = rho & ((1 << rs) - 1), og = rho >> rs;
        const bf16* Kh = Kd + (size_t)(b * DILH + g * 4 + hg) * SEQ * 64; const bf16* Vh = Vd + (size_t)(b * DILH + g * 4 + hg) * SEQ * 64;
        int u_lo = cg * i0 + og - 128; u_lo = u_lo < 0 ? 0 : u_lo;
        dil_group(o0, o1, mrun, lsum, qf, Kh, Vh, cg * (i0 + q) + og, cg * (i0 + 31) + og, u_lo, rs, rho_g, vl, lane);
    }
    float l = lsum + __shfl_xor(lsum, 32);
    const f32x2_t ml = *(const GAS f32x2_t*)(PM + ((size_t)(b * SEQ + tq) * 4 + hg) * 2);
    const float mn = fmaxf(mrun, ml.x), sa = fast_exp2(mrun - mn), sb = fast_exp2(ml.x - mn);
    l = l * sa + ml.y * sb;
    const bf16* pr = PO + (size_t)(b * SEQ + tq) * 256 + hg * 64;
#pragma unroll
    for (int a = 0; a < 4; ++a) { const v2u w0 = *(const GAS v2u*)(pr + 8 * a + 4 * hC), w1 = *(const GAS v2u*)(pr + 32 + 8 * a + 4 * hC);
        o0[4 * a] = o0[4 * a] * sa + bflo(w0.x) * sb; o0[4 * a + 1] = o0[4 * a + 1] * sa + bfhi(w0.x) * sb; o0[4 * a + 2] = o0[4 * a + 2] * sa + bflo(w0.y) * sb; o0[4 * a + 3] = o0[4 * a + 3] * sa + bfhi(w0.y) * sb;
        o1[4 * a] = o1[4 * a] * sa + bflo(w1.x) * sb; o1[4 * a + 1] = o1[4 * a + 1] * sa + bfhi(w1.x) * sb; o1[4 * a + 2] = o1[4 * a + 2] * sa + bflo(w1.y) * sb; o1[4 * a + 3] = o1[4 * a + 3] * sa + bfhi(w1.y) * sb; }
    o_store(Od + (size_t)(b * SEQ + tq) * 256 + hg * 64, o0, o1, 1.0f / l, hC);
}

__device__ __forceinline__ void p3_attention(const Args& A, Frame& F, int pass) {
    unsigned char* ws = A.ws;
    LAS unsigned char* vl = F.lds + F.wave * ATT_WAVE_LDS;
    const bf16 *Qsb = (const bf16*)(ws + A_QSB), *Ksb = (const bf16*)(ws + A_KSB), *Vsb = (const bf16*)(ws + A_VSB);
    const bf16 *Qd = (const bf16*)(ws + A_QD), *Kd = (const bf16*)(ws + A_KD), *Vd = (const bf16*)(ws + A_VD);
    bf16* Osb = (bf16*)((unsigned char*)A.out + O_OSB); bf16* Od = (bf16*)((unsigned char*)A.out + O_OD);
    bf16* PO = (bf16*)((unsigned char*)A.out + O_PO); float* PM = (float*)(ws + WS_SSQ);
    constexpr int N_DIL = NB * 4 * 16 * 16, N_SB = NB * SBH * (SEQ / 32);
    if (pass == 0) {
        for (int t = F.gw; t < N_DIL + N_SB; t += F.NGW) {
            if (t < N_DIL) dil_g0_task(Qd, Kd, Vd, PO, PM, t, vl, F.lane);
            else sb_task(Qsb, Ksb, Vsb, Osb, t - N_DIL, vl, F.lane);
        }
    } else {
        for (int t = F.gw; t < N_DIL; t += F.NGW) dil_task(Qd, Kd, Vd, PO, PM, Od, t, vl, F.lane);
    }
}

__device__ __forceinline__ unsigned sortable(float f) { const unsigned u = __float_as_uint(f); return u ^ ((unsigned)((int)u >> 31) | 0x80000000u); }
__device__ __forceinline__ float unsortable(unsigned s) { const unsigned u = (s & 0x80000000u) ? (s ^ 0x80000000u) : ~s; return __uint_as_float(u); }
__device__ __forceinline__ unsigned umax_(unsigned a, unsigned b) { return a > b ? a : b; }

#define CE_(a, b) do { const unsigned hi_ = umax_(a, b), lo_ = umin_(a, b); a = hi_; b = lo_; } while (0)
__device__ __forceinline__ unsigned umin_(unsigned a, unsigned b) { return a < b ? a : b; }
template <int N, int OFF, int TOT> __device__ __forceinline__ void bitonic_sort_desc(unsigned (&v)[TOT]) {
#pragma unroll
    for (int k = 2; k <= N; k <<= 1)
#pragma unroll
        for (int j = k >> 1; j > 0; j >>= 1)
#pragma unroll
            for (int i = 0; i < N; ++i) { const int l = i ^ j; if (l > i) { if ((i & k) == 0) CE_(v[OFF + i], v[OFF + l]); else CE_(v[OFF + l], v[OFF + i]); } }
}
__device__ __forceinline__ void bitonic_merge16_desc(unsigned (&t)[16]) {
#pragma unroll
    for (int j = 8; j > 0; j >>= 1)
#pragma unroll
        for (int i = 0; i < 16; ++i) { const int l = i ^ j; if (l > i) CE_(t[i], t[l]); }
}
__device__ __forceinline__ void merge_top16(unsigned (&out)[16], const unsigned* a, const unsigned* b) {
#pragma unroll
    for (int i = 0; i < 16; ++i) out[i] = umax_(a[i], b[15 - i]);
    bitonic_merge16_desc(out);
}
__device__ __forceinline__ void cross_lane_top16(unsigned (&top)[16]) {
    unsigned t[16];
#pragma unroll
    for (int i = 0; i < 16; ++i) t[i] = umax_(top[i], (unsigned)__shfl_xor((int)top[15 - i], 32));
    bitonic_merge16_desc(t);
#pragma unroll
    for (int i = 0; i < 16; ++i) top[i] = t[i];
}
__device__ __forceinline__ void top16_of_128(unsigned (&key)[64], LAS unsigned* top  , int lane) {
    bitonic_sort_desc<16, 0, 64>(key); bitonic_sort_desc<16, 16, 64>(key); bitonic_sort_desc<16, 32, 64>(key); bitonic_sort_desc<16, 48, 64>(key);
    unsigned m0[16], m1[16], m[16];
    merge_top16(m0, &key[0], &key[16]); merge_top16(m1, &key[32], &key[48]); merge_top16(m, m0, m1);
    cross_lane_top16(m);
#pragma unroll
    for (int it = 0; it < 16; ++it) top[it * 32 + (lane & 31)] = m[it];
}
__device__ __forceinline__ unsigned pk_lookup(unsigned p0, unsigned p1, unsigned p2, unsigned p3, unsigned a) {
    const unsigned hi = a >> 2; unsigned d = p0; d = hi == 1 ? p1 : d; d = hi == 2 ? p2 : d; d = hi == 3 ? p3 : d;
    return (d >> (8 * (a & 3))) & 0xffu;
}
__device__ __forceinline__ unsigned pack4idx(unsigned t0, unsigned t1, unsigned t2, unsigned t3) { return (127u - (t0 & 127u)) | ((127u - (t1 & 127u)) << 8) | ((127u - (t2 & 127u)) << 16) | ((127u - (t3 & 127u)) << 24); }

constexpr int P7_KSTR = 272, P7_KEYS_BYTES = 256 * P7_KSTR, P7_TL_WAVE = 4096;
__device__ __forceinline__ void topk_phase(const bf16* Qp, const bf16* Kb, unsigned short* IDX, float* GATE, Frame& F) {
    const int lane = F.lane, q = lane & 31, hC = lane >> 5;
    LAS unsigned char* kl = F.lds;
    LAS unsigned* tl = (LAS unsigned*)(F.lds + P7_KEYS_BYTES + F.wave * P7_TL_WAVE);
    const int t0 = (F.vcu * 4 + (F.wave & 3)) * 32, hsel = F.wave >> 2;
#pragma unroll 1
  for (int rnd = 0; rnd < 4; ++rnd) {
    const int ph = 2 * rnd + hsel;
#pragma unroll 1
    for (int half = 0; half < 2; ++half) {
        __syncthreads();
#pragma unroll
        for (int i = 0; i < 8; ++i) { const int idx = F.tid + 512 * i, row = idx >> 4, ch = idx & 15;
            const v4u w = *(const GAS v4u*)(Kb + ((size_t)((2 * rnd + (row >> 7)) * 2 + half) * 128 + (row & 127)) * 128 + 8 * ch);
            *(LAS v4u*)(kl + row * P7_KSTR + 16 * ch) = w; }
        bf16x8 qf[8];
        { const bf16* qp = Qp + (size_t)(t0 + q) * 2048 + ph * 256 + half * 128 + 8 * hC;
#pragma unroll
          for (int st = 0; st < 8; ++st) qf[st] = *(const GAS bf16x8*)(qp + 16 * st); }
        __syncthreads();
        f32x16 C[4] = {};
        const LAS unsigned char* kb = kl + (hsel * 128 + q) * P7_KSTR + 16 * hC;
#pragma unroll
        for (int st = 0; st < 8; ++st)
#pragma unroll
            for (int mt = 0; mt < 4; ++mt) C[mt] = __builtin_amdgcn_mfma_f32_32x32x16_bf16(*(const LAS bf16x8*)(kb + mt * 32 * P7_KSTR + 32 * st), qf[st], C[mt], 0, 0, 0);
        unsigned key[64];
#pragma unroll
        for (int mt = 0; mt < 4; ++mt)
#pragma unroll
            for (int r = 0; r < 16; ++r) { const int kidx = 32 * mt + (r & 3) + 8 * (r >> 2) + 4 * hC; key[16 * mt + r] = (sortable(C[mt][r]) & ~127u) | (unsigned)(127 - kidx); }
        top16_of_128(key, tl + half * 512, lane);
    }
    unsigned tops[2][16];
#pragma unroll
    for (int a = 0; a < 16; ++a) { tops[0][a] = tl[a * 32 + q]; tops[1][a] = tl[512 + a * 32 + q]; }
    float s0[16], s1[16];
#pragma unroll
    for (int a = 0; a < 16; ++a) { s0[a] = unsortable(tops[0][a] & ~127u); s1[a] = unsortable(tops[1][a] & ~127u); }
    const unsigned pa0 = pack4idx(tops[0][0], tops[0][1], tops[0][2], tops[0][3]), pa1 = pack4idx(tops[0][4], tops[0][5], tops[0][6], tops[0][7]),
                   pa2 = pack4idx(tops[0][8], tops[0][9], tops[0][10], tops[0][11]), pa3 = pack4idx(tops[0][12], tops[0][13], tops[0][14], tops[0][15]);
    const unsigned pb0 = pack4idx(tops[1][0], tops[1][1], tops[1][2], tops[1][3]), pb1 = pack4idx(tops[1][4], tops[1][5], tops[1][6], tops[1][7]),
                   pb2 = pack4idx(tops[1][8], tops[1][9], tops[1][10], tops[1][11]), pb3 = pack4idx(tops[1][12], tops[1][13], tops[1][14], tops[1][15]);
    unsigned cand[32];
    {
        int n = 0;
#pragma unroll
        for (int a = 0; a < 16; ++a)
#pragma unroll
            for (int bq = 0; bq < 16; ++bq) if ((a + 1) * (bq + 1) <= 16) {
                const unsigned ck = (sortable(s0[a] + s1[bq]) & ~255u) | (unsigned)(a * 16 + bq);
                if (n < 25) cand[n] = ck; else cand[n - 25] = hC ? ck : cand[n - 25];
                ++n; }
#pragma unroll
        for (int i = 25; i < 32; ++i) cand[i] = 0u;
    }
    bitonic_sort_desc<32, 0, 32>(cand);
    unsigned win[16];
#pragma unroll
    for (int i = 0; i < 16; ++i) win[i] = cand[i];
    cross_lane_top16(win);
    float gv[16]; int eid[16]; float gs = 0.f;
    const float vmax = unsortable(win[0] & ~255u);
#pragma unroll
    for (int k = 0; k < 16; ++k) { const unsigned a = (win[k] >> 4) & 15u, bq = win[k] & 15u;
        eid[k] = (int)(pk_lookup(pa0, pa1, pa2, pa3, a) * 128u + pk_lookup(pb0, pb1, pb2, pb3, bq));
        gv[k] = fast_exp2((unsortable(win[k] & ~255u) - vmax) * LOG2E); gs += gv[k]; }
    const float ginv = 1.0f / gs;
#ifdef P7_TIME_SORT
    { const unsigned long long t1_ = __builtin_amdgcn_s_memrealtime(); while (__builtin_amdgcn_s_memrealtime() - t1_ < 4ull * tsort) __builtin_amdgcn_s_sleep(1); }
#endif
    const size_t o = (size_t)(t0 + q) * 128 + ph * 16;
    if (hC == 0) {
#pragma unroll
        for (int k = 0; k < 16; k += 8) *(GAS v4u*)(IDX + o + k) = (v4u){(unsigned)eid[k] | ((unsigned)eid[k + 1] << 16), (unsigned)eid[k + 2] | ((unsigned)eid[k + 3] << 16),
                                                                         (unsigned)eid[k + 4] | ((unsigned)eid[k + 5] << 16), (unsigned)eid[k + 6] | ((unsigned)eid[k + 7] << 16)};
    } else {
#pragma unroll
        for (int k = 0; k < 16; k += 4) *(GAS f32x4*)(GATE + o + k) = (f32x4){gv[k] * ginv, gv[k + 1] * ginv, gv[k + 2] * ginv, gv[k + 3] * ginv};
    }
  }
}

__device__ __forceinline__ float gelu_tanh(float x) {
    const float y2 = 2.0f * 0.7978845608028654f * (x + 0.044715f * x * x * x);
    return x * fast_rcp(1.f + fast_exp2(-y2 * LOG2E));
}
__device__ __forceinline__ void unpack8(const v4u w, float (&f)[8]) { f[0] = bflo(w.x); f[1] = bfhi(w.x); f[2] = bflo(w.y); f[3] = bfhi(w.y); f[4] = bflo(w.z); f[5] = bfhi(w.z); f[6] = bflo(w.w); f[7] = bfhi(w.w); }
__device__ __forceinline__ void h2q_row(unsigned char* ws, int t, int lane) {
    const bf16* xr = (const bf16*)(ws + A_X1M) + (size_t)t * DM + 16 * lane; const float* sh = (const float*)(ws + WS_MOD) + (size_t)(t >> 13) * NMOD + 3 * DM + 16 * lane;
    const float r2 = ((const float*)(ws + WS_R2))[t];
    float fa[8], fb[8]; unpack8(*(const GAS v4u*)xr, fa); unpack8(*(const GAS v4u*)(xr + 8), fb);
    float h[16]; float m = 0.f;
#pragma unroll
    for (int k = 0; k < 2; ++k) { const f32x4 s0 = *(const GAS f32x4*)(sh + 4 * k), s1 = *(const GAS f32x4*)(sh + 8 + 4 * k);
#pragma unroll
        for (int i = 0; i < 4; ++i) { h[4 * k + i] = fa[4 * k + i] * r2 + s0[i]; h[8 + 4 * k + i] = fb[4 * k + i] * r2 + s1[i]; m = fmaxf(m, fmaxf(fabsf(h[4 * k + i]), fabsf(h[8 + 4 * k + i]))); } }
#pragma unroll
    for (int o = 1; o < 64; o <<= 1) m = fmaxf(m, __shfl_xor(m, o));
    m = fmaxf(m, 1e-30f);
    const float sc = 127.0f / m;
    unsigned w[4];
#pragma unroll
    for (int j = 0; j < 4; ++j) { unsigned ww = 0;
#pragma unroll
        for (int i = 0; i < 4; ++i) { const int qv = (int)__builtin_rintf(h[4 * j + i] * sc); ww |= ((unsigned)qv & 0xffu) << (8 * i); }
        w[j] = ww; }
    *(GAS v4u*)(ws + A_H2Q + (size_t)t * DM + 16 * lane) = (v4u){w[0], w[1], w[2], w[3]};
    if (lane == 0) ((float*)(ws + WS_HINV))[t] = m * (1.0f / 127.0f);
}
__device__ __forceinline__ void unpack_fp8x16(const v4u w, float (&f)[16]) {
#pragma unroll
    for (int j = 0; j < 4; ++j) { const f32x2_t a = __builtin_amdgcn_cvt_pk_f32_fp8((int)w[j], false), b = __builtin_amdgcn_cvt_pk_f32_fp8((int)w[j], true);
        f[4 * j] = a.x; f[4 * j + 1] = a.y; f[4 * j + 2] = b.x; f[4 * j + 3] = b.y; }
}
__device__ __forceinline__ void peer_u_phase(const Args& A, Frame& F) {
    unsigned char* ws = A.ws;
    const int lane = F.lane, x = blockIdx.x & 7, wrk = (blockIdx.x >> 3) * NWAVES + F.wave, nwr = (F.G >> 3) * NWAVES, g = lane >> 3, c = lane & 7;
    const unsigned char* U8 = ws + WS_UB + (size_t)x * (2 * MiB); const unsigned c16 = 16u * c, g32 = 32u * g;
    const unsigned char* H2Q = ws + A_H2Q + 128 * x; const unsigned char* IDX = ws + A_IDX;
    bf16* PART = (bf16*)(ws + A_PART) + (size_t)x * TOK * 128;
    const int per = TOK / nwr, tb = wrk * per;
    v4u idC[2], idN[2], hC4;
#define SLOT_ID(ID, sl) (((ID)[(sl) >> 3][((sl) >> 1) & 3] >> (16 * ((sl) & 1))) & 0xffffu)
#define LD_TOK(ID, HV, T) do { const unsigned char* ib_ = IDX + (size_t)(T) * 256; ID[0] = *(const GAS v4u*)(ib_ + g32); ID[1] = *(const GAS v4u*)(ib_ + (g32 + 16u)); \
        HV = *(const GAS v4u*)(H2Q + (size_t)(T) * DM + c16); } while (0)
#define LD_ROWS(R, ID, H) do { _Pragma("unroll") for (int i = 0; i < 8; ++i) R[i] = *(const GAS v4u*)(U8 + (SLOT_ID(ID, 8 * (H) + i) * 128u + c16)); } while (0)
#define DOT16(R, HV) __builtin_amdgcn_sdot4((int)(R)[3], (int)(HV)[3], __builtin_amdgcn_sdot4((int)(R)[2], (int)(HV)[2], __builtin_amdgcn_sdot4((int)(R)[1], (int)(HV)[1], __builtin_amdgcn_sdot4((int)(R)[0], (int)(HV)[0], 0, false), false), false), false)
    v4u idD[2], hD4, hA4, hB4;
    v4u R0[8], R1[8], R2[8], R3[8];
    const int tl = tb + per - 1;
#define CL(T) ((T) <= tl ? (T) : tl)
#define REDUCE_STORE(PA, PB, T) do { int p_[16]; \
        _Pragma("unroll") for (int i = 0; i < 8; ++i) { p_[i] = PA[i]; p_[8 + i] = PB[i]; } \
        const bool b0 = lane & 1, b1 = lane & 2, b2 = lane & 4; int q8[8], q4[4], q2[2]; \
        _Pragma("unroll") for (int i = 0; i < 8; ++i) q8[i] = (b0 ? p_[8 + i] : p_[i]) + __shfl_xor(b0 ? p_[i] : p_[8 + i], 1); \
        _Pragma("unroll") for (int i = 0; i < 4; ++i) q4[i] = (b1 ? q8[4 + i] : q8[i]) + __shfl_xor(b1 ? q8[i] : q8[4 + i], 2); \
        _Pragma("unroll") for (int i = 0; i < 2; ++i) q2[i] = (b2 ? q4[2 + i] : q4[i]) + __shfl_xor(b2 ? q4[i] : q4[2 + i], 4); \
        *(GAS unsigned*)(PART + (size_t)(T) * 128 + slot) = pk2((float)q2[0], (float)q2[1]); } while (0)
    const int slot = 16 * g + 8 * (lane & 1) + 4 * ((lane >> 1) & 1) + 2 * ((lane >> 2) & 1);
    LD_TOK(idC, hA4, tb); LD_TOK(idN, hB4, CL(tb + 1));
    LD_ROWS(R0, idC, 0); LD_ROWS(R1, idC, 1);
    LD_TOK(idC, hC4, CL(tb + 2));
    LD_ROWS(R2, idN, 0); LD_ROWS(R3, idN, 1);
    LD_TOK(idD, hD4, CL(tb + 3));
    for (int t = tb; t < tb + per; t += 2) {
        int pa[8], pb[8];
#pragma unroll
        for (int i = 0; i < 8; ++i) { pa[i] = DOT16(R0[i], hA4); pb[i] = DOT16(R1[i], hA4); }
        LD_ROWS(R0, idC, 0); LD_ROWS(R1, idC, 1); hA4 = hC4;
        LD_TOK(idC, hC4, CL(t + 4));
        REDUCE_STORE(pa, pb, t);
#pragma unroll
        for (int i = 0; i < 8; ++i) { pa[i] = DOT16(R2[i], hB4); pb[i] = DOT16(R3[i], hB4); }
        LD_ROWS(R2, idD, 0); LD_ROWS(R3, idD, 1); hB4 = hD4;
        LD_TOK(idD, hD4, CL(t + 5));
        REDUCE_STORE(pa, pb, CL(t + 1));
    }
#undef CL
#undef REDUCE_STORE
#undef LD_TOK
#undef LD_ROWS
#undef SLOT_ID
#undef DOT16
}
__device__ __forceinline__ void peer_act_phase(const Args& A, Frame& F) {
    unsigned char* ws = A.ws;
    const bf16* PART = (const bf16*)(ws + A_PART); const unsigned short* IDX = (const unsigned short*)(ws + A_IDX); const float* GATE = (const float*)(ws + A_GATE); bf16* ACTG = (bf16*)(ws + A_ACTG);
    const float* UINV = (const float*)(ws + WS_UB + 16 * MiB); const float* VINV = (const float*)(ws + WS_VB + 16 * MiB); const float* HINV = (const float*)(ws + WS_HINV);
    const size_t n4 = (size_t)TOK * 128 / 4;
    for (size_t i = (size_t)F.vcu * (NWAVES * 64) + F.tid; i < n4; i += (size_t)F.G * NWAVES * 64) {
        f32x4 d = {0.f, 0.f, 0.f, 0.f};
#pragma unroll
        for (int xx = 0; xx < 8; ++xx) { const v2u w = *(const GAS v2u*)(PART + (size_t)xx * TOK * 128 + 4 * i); d[0] += bflo(w.x); d[1] += bfhi(w.x); d[2] += bflo(w.y); d[3] += bfhi(w.y); }
        const v2u ew = *(const GAS v2u*)(IDX + 4 * i); const f32x4 gt = *(const GAS f32x4*)(GATE + 4 * i);
        const unsigned e[4] = {ew.x & 0xffffu, ew.x >> 16, ew.y & 0xffffu, ew.y >> 16};
        float o[4];
        const float hs = HINV[i >> 5];
#pragma unroll
        for (int k = 0; k < 4; ++k) o[k] = gelu_tanh(d[k] * (UINV[e[k]] * hs)) * gt[k] * VINV[e[k]];
        *(GAS v2u*)(ACTG + 4 * i) = (v2u){pk2(o[0], o[1]), pk2(o[2], o[3])};
    }
}
__device__ __forceinline__ void peer_v_phase(const Args& A, Frame& F) {
    unsigned char* ws = A.ws;
    const int lane = F.lane, x = blockIdx.x & 7, wrk = (blockIdx.x >> 3) * NWAVES + F.wave, nwr = (F.G >> 3) * NWAVES, g = lane >> 3, c = lane & 7;
    const unsigned char* V8 = ws + WS_VB + (size_t)x * (2 * MiB); const unsigned c16 = 16u * c, g32 = 32u * g;
    const unsigned char* IDX = ws + A_IDX; const unsigned char* ACTG = ws + A_ACTG; unsigned char* POUT = ws + A_POUT + 256 * x;
    const int per = TOK / nwr, tb = wrk * per;
    v4u idC[2], idN[2], aC[2], aN[2];
#define SLOT_ID(ID, sl) (((ID)[(sl) >> 3][((sl) >> 1) & 3] >> (16 * ((sl) & 1))) & 0xffffu)
#define SLOT_ACT(AV, sl) (((sl) & 1) ? bfhi((AV)[(sl) >> 3][((sl) >> 1) & 3]) : bflo((AV)[(sl) >> 3][((sl) >> 1) & 3]))
#define LD_TOK(ID, AV, T) do { const unsigned char* ib_ = IDX + (size_t)(T) * 256; const unsigned char* ab_ = ACTG + (size_t)(T) * 256; \
        ID[0] = *(const GAS v4u*)(ib_ + g32); ID[1] = *(const GAS v4u*)(ib_ + (g32 + 16u)); AV[0] = *(const GAS v4u*)(ab_ + g32); AV[1] = *(const GAS v4u*)(ab_ + (g32 + 16u)); } while (0)
#define LD_ROWS(R, ID, H) do { _Pragma("unroll") for (int i = 0; i < 8; ++i) R[i] = *(const GAS v4u*)(V8 + (SLOT_ID(ID, 8 * (H) + i) * 128u + c16)); } while (0)
    LD_TOK(idC, aC, tb);
    v4u R0[8], R1[8];
    LD_ROWS(R0, idC, 0);
    LD_TOK(idN, aN, tb + 1 < TOK ? tb + 1 : tb);
    for (int t = tb; t < tb + per; ++t) {
        LD_ROWS(R1, idC, 1);
        float acc[16];
#pragma unroll
        for (int d = 0; d < 16; ++d) acc[d] = 0.f;
#pragma unroll
        for (int i = 0; i < 8; ++i) { float f[16]; unpack_fp8x16(R0[i], f); const float a = SLOT_ACT(aC, i);
#pragma unroll
            for (int d = 0; d < 16; ++d) acc[d] += a * f[d]; }
        LD_ROWS(R0, idN, 0);
#pragma unroll
        for (int i = 0; i < 8; ++i) { float f[16]; unpack_fp8x16(R1[i], f); const float a = SLOT_ACT(aC, 8 + i);
#pragma unroll
            for (int d = 0; d < 16; ++d) acc[d] += a * f[d]; }
        idC[0] = idN[0]; idC[1] = idN[1]; aC[0] = aN[0]; aC[1] = aN[1];
        { const int tn = t + 2 < tb + per ? t + 2 : tb + per - 1; LD_TOK(idN, aN, tn); }
#pragma unroll
        for (int d = 0; d < 16; ++d) { float v = acc[d]; v += __shfl_xor(v, 8); v += __shfl_xor(v, 16); v += __shfl_xor(v, 32); acc[d] = v; }
        if (g == 0) { v4u w0, w1; w0.x = pk2(acc[0], acc[1]); w0.y = pk2(acc[2], acc[3]); w0.z = pk2(acc[4], acc[5]); w0.w = pk2(acc[6], acc[7]);
            w1.x = pk2(acc[8], acc[9]); w1.y = pk2(acc[10], acc[11]); w1.z = pk2(acc[12], acc[13]); w1.w = pk2(acc[14], acc[15]);
            unsigned char* o = POUT + (size_t)t * (DM * 2); *(GAS v4u*)(o + 2u * c16) = w0; *(GAS v4u*)(o + (2u * c16 + 16u)) = w1; }
    }
#undef LD_TOK
#undef LD_ROWS
#undef SLOT_ID
#undef SLOT_ACT
}
__device__ __forceinline__ void peer_final(const Args& A, int t, int lane) {
    unsigned char* ws = A.ws;
    const float* mod = (const float*)(ws + WS_MOD) + (size_t)(t >> 13) * NMOD; const bf16* POUT = (const bf16*)(ws + A_POUT);
    float* orow = A.out + (size_t)t * DM;
    f32x4 x2[4]; float s = 0.f;
#pragma unroll
    for (int j = 0; j < 4; ++j) { const int c = 256 * j + 4 * lane; const f32x4 x1 = *(const GAS f32x4*)(orow + c), gt = *(const GAS f32x4*)(mod + 5 * DM + c); const v2u w = *(const GAS v2u*)(POUT + (size_t)t * DM + c);
        f32x4 y; y[0] = x1[0] + gt[0] * bflo(w.x); y[1] = x1[1] + gt[1] * bfhi(w.x); y[2] = x1[2] + gt[2] * bflo(w.y); y[3] = x1[3] + gt[3] * bfhi(w.y);
        x2[j] = y; s += (y[0] * y[0] + y[1] * y[1]) + (y[2] * y[2] + y[3] * y[3]); }
    const float rr = 1.0f / sqrtf(wave_sum(s) * (1.f / DM) + EPS);
#pragma unroll
    for (int j = 0; j < 4; ++j) { const int c = 256 * j + 4 * lane; const f32x4 gf = *(const GAS f32x4*)(A.g_final + c); *(GAS f32x4*)(orow + c) = x2[j] * rr * gf; }
}

#ifndef MK_ONE_LAUNCH
#define MK_ONE_LAUNCH 1
#endif
constexpr int N_PHASES = 12;

__device__ __forceinline__ void biaspq_task(unsigned char* ws, int n, int lane) {
    const bf16* w = (const bf16*)(ws + WS_WPQ) + (size_t)n * DM + 16 * lane;
    float fa[8], fb[8]; unpack8(*(const GAS v4u*)w, fa); unpack8(*(const GAS v4u*)(w + 8), fb);
    float* bias = (float*)(ws + WS_BIASPQ);
#pragma unroll
    for (int b = 0; b < 4; ++b) { const GAS f32x4* sp = (const GAS f32x4*)((const float*)(ws + WS_MOD) + (size_t)b * NMOD + 3 * DM + 16 * lane);
        const f32x4 s0 = sp[0], s1 = sp[1], s2 = sp[2], s3 = sp[3]; float d = 0.f;
#pragma unroll
        for (int i = 0; i < 4; ++i) { d += fa[i] * s0[i]; d += fa[4 + i] * s1[i]; d += fb[i] * s2[i]; d += fb[4 + i] * s3[i]; }
        d = wave_sum(d); if (lane == 0) bias[b * 2048 + n] = d; }
}

__global__ void __launch_bounds__(NWAVES * 64, 2) mk_fwd(Args A) {
    extern __shared__ __attribute__((aligned(16))) unsigned char lds[];
    Frame F;
    F.lds = (LAS unsigned char*)lds;
    F.G = gridDim.x; { const int bx = blockIdx.x; F.vcu = (F.G % 8 == 0) ? (bx % 8) * (F.G / 8) + bx / 8 : bx; }
    F.NGW = F.G * NWAVES;
#define PHASE_BEGIN() do { int t_ = threadIdx.x; asm volatile("" : "+v"(t_)); F.tid = t_; F.lane = t_ & 63; F.wave = __builtin_amdgcn_readfirstlane(t_ >> 6); F.gw = F.vcu * NWAVES + F.wave; } while (0)
    PHASE_BEGIN();
    unsigned char* ws = A.ws;
    const int lo = A.ph_lo, hi = A.ph_hi;
#if MK_ONE_LAUNCH
    volatile LAS unsigned* MISC = (volatile LAS unsigned*)(F.lds + MISC_OFF);
    for (int u = F.tid; u < (LDS_BYTES - RING_BYTES) / 4; u += NWAVES * 64) ((LAS unsigned*)(F.lds + RING_BYTES))[u] = 0u;
    __syncthreads();
    XcdBarrier bar = xcd_barrier_post((unsigned*)(ws + WS_CTL) + CW_BAR, MISC + 8);
#define GRID_BAR() xcd_barrier(bar)
#else
#define GRID_BAR() do {} while (0)
#endif
#ifdef ONLY_PHASE
#define IN(k) ((k) == ONLY_PHASE && lo <= (k) && (k) < hi)
#else
#define IN(k) (lo <= (k) && (k) < hi)
#endif
#define BOTH(k) (IN(k) && IN((k) + 1))
#ifndef REPEAT_MASK
#define REPEAT_MASK 0
#endif
#define REPS(k) ((((REPEAT_MASK) >> (k)) & 1) + 1)

    if (IN(0)) for (int rep = 0; rep < REPS(0); ++rep) { PHASE_BEGIN(); if (rep) GRID_BAR(); p0_prologue(A, F); if (BOTH(0)) GRID_BAR(); }
    if (IN(1)) for (int rep = 0; rep < REPS(1); ++rep) { PHASE_BEGIN(); if (rep) GRID_BAR(); p1_hrows(A, F); if (BOTH(1)) GRID_BAR(); }
    if (IN(2)) for (int rep = 0; rep < REPS(2); ++rep) { PHASE_BEGIN(); if (rep) GRID_BAR();
        pg8::Gemm g{(const bf16*)((unsigned char*)A.out + O_H), (const bf16*)(ws + WS_WIN), TOK, NIN, DM / 2}; pg8::StaticOrder S; S.init(TOK, NIN, F.G, (int)blockIdx.x);
        EpiG1 E{(bf16*)(ws + A_QSB), (bf16*)(ws + A_KSB), (bf16*)(ws + A_VSB), (bf16*)(ws + A_QD), (bf16*)(ws + A_KD), (bf16*)(ws + A_VD), (bf16*)(ws + A_GSB), (bf16*)(ws + A_GD),
                (const float*)(ws + WS_ROPEC), (const float*)(ws + WS_ROPES), (const float*)(ws + WS_SA), (const float*)(ws + WS_SB)};
        pg8::gemm_phase<EpiG1, pg8::StaticOrder, true, true, true>(F.lds, g, S, E);
        if (BOTH(2)) GRID_BAR();
    }
    if (IN(3)) for (int rep = 0; rep < REPS(3); ++rep) { PHASE_BEGIN(); if (rep) GRID_BAR(); p3_attention(A, F, 0); GRID_BAR(); PHASE_BEGIN(); p3_attention(A, F, 1); if (BOTH(3)) GRID_BAR(); }
    if (IN(4)) for (int rep = 0; rep < REPS(4); ++rep) { PHASE_BEGIN(); if (rep) GRID_BAR();
        for (int n = F.gw; n < 2048; n += F.NGW) biaspq_task(ws, n, F.lane);
        __syncthreads();
        {   pg8::Gemm g{(const bf16*)((unsigned char*)A.out + O_OD), (const bf16*)(ws + WS_WDILO), TOK, DM, 256}; pg8::StaticOrder S; S.init(TOK, DM, F.G, (int)blockIdx.x);
            EpiMerge<false> E{(const bf16*)(ws + A_GD), (bf16*)(ws + A_MERGED)};
            pg8::gemm_phase<EpiMerge<false>, pg8::StaticOrder, true, true>(F.lds, g, S, E); }
        asm volatile("s_waitcnt vmcnt(0)" ::: "memory"); __syncthreads();
        {   pg8::Gemm g{(const bf16*)((unsigned char*)A.out + O_OSB), (const bf16*)(ws + WS_WSBO), TOK, DM, 512}; pg8::StaticOrder S; S.init(TOK, DM, F.G, (int)blockIdx.x);
            EpiMerge<true> E{(const bf16*)(ws + A_GSB), (bf16*)(ws + A_MERGED)};
            pg8::gemm_phase<EpiMerge<true>, pg8::StaticOrder, true, true>(F.lds, g, S, E); }
        if (BOTH(4)) GRID_BAR();
    }
    if (IN(5)) for (int rep = 0; rep < REPS(5); ++rep) { PHASE_BEGIN(); if (rep) GRID_BAR();
        pg8::Gemm g{(const bf16*)(ws + A_MERGED), (const bf16*)(ws + WS_WOUT), TOK, DM, DM}; pg8::StaticOrder S; S.init(TOK, DM, F.G, (int)blockIdx.x);
        EpiOut E{A.x, A.out, (bf16*)(ws + A_X1M), (float*)(ws + WS_SSQ), (const float*)(ws + WS_MOD), A.g_ffn};
        pg8::gemm_phase<EpiOut, pg8::StaticOrder, true, true>(F.lds, g, S, E);
        if (BOTH(5)) GRID_BAR();
    }
    if (IN(6)) for (int rep = 0; rep < REPS(6); ++rep) { PHASE_BEGIN(); if (rep) GRID_BAR();
        pg8::Gemm g{(const bf16*)(ws + A_X1M), (const bf16*)(ws + WS_WPQ), TOK, 2048, DM}; pg8::StaticOrder S; S.init(TOK, 2048, F.G, (int)blockIdx.x);
        EpiPq E{(const float*)(ws + WS_SSQ), (const float*)(ws + WS_BIASPQ), (bf16*)(ws + A_QPEER), (float*)(ws + WS_R2)};
        pg8::gemm_phase<EpiPq, pg8::StaticOrder, true, true>(F.lds, g, S, E);
        if (BOTH(6)) GRID_BAR();
    }
    if (IN(7)) for (int rep = 0; rep < REPS(7); ++rep) { PHASE_BEGIN(); if (rep) GRID_BAR();
        topk_phase((const bf16*)(ws + A_QPEER), (const bf16*)(ws + WS_KEYS), (unsigned short*)(ws + A_IDX), (float*)(ws + A_GATE), F);
        for (int t = F.gw; t < TOK; t += F.NGW) h2q_row(ws, t, F.lane);
        if (BOTH(7)) GRID_BAR();
    }
    if (IN(8)) for (int rep = 0; rep < REPS(8); ++rep) { PHASE_BEGIN(); if (rep) GRID_BAR();
        peer_u_phase(A, F); if (BOTH(8)) GRID_BAR(); }
    if (IN(9)) { PHASE_BEGIN();
#ifdef VALU_PROBE
        { float a0 = F.lane, a1 = a0 + 1, a2 = a0 + 2, a3 = a0 + 3; unsigned w0 = F.tid * 2654435761u, w1 = w0 ^ 0x3c3c3c3cu, w2 = w0 + 77u, w3 = w0 + 99u;
          f32x2_t p0 = {a0, a1}, p1 = {a2, a3}, p2 = {a1, a2}, p3 = {a3, a0};
          for (int it = 0; it < 4096; ++it) {
#if VALU_PROBE == 1
              f32x2_t c0 = __builtin_amdgcn_cvt_pk_f32_fp8((int)w0, false), c1 = __builtin_amdgcn_cvt_pk_f32_fp8((int)w1, true), c2 = __builtin_amdgcn_cvt_pk_f32_fp8((int)w2, false), c3 = __builtin_amdgcn_cvt_pk_f32_fp8((int)w3, true);
              f32x2_t c4 = __builtin_amdgcn_cvt_pk_f32_fp8((int)w0, true), c5 = __builtin_amdgcn_cvt_pk_f32_fp8((int)w1, false), c6 = __builtin_amdgcn_cvt_pk_f32_fp8((int)w2, true), c7 = __builtin_amdgcn_cvt_pk_f32_fp8((int)w3, false);
              w0 ^= __float_as_uint(c0.x) ^ __float_as_uint(c4.y); w1 ^= __float_as_uint(c1.x) ^ __float_as_uint(c5.y); w2 ^= __float_as_uint(c2.x) ^ __float_as_uint(c6.y); w3 ^= __float_as_uint(c3.x) ^ __float_as_uint(c7.y);
#elif VALU_PROBE == 2
              p0 = p0 * p1 + p2; p1 = p1 * p2 + p3; p2 = p2 * p3 + p0; p3 = p3 * p0 + p1; p0 = p0 * p2 + p1; p1 = p1 * p3 + p2; p2 = p2 * p0 + p3; p3 = p3 * p1 + p0;
#else
              a0 = a0 * a1 + a2; a1 = a1 * a2 + a3; a2 = a2 * a3 + a0; a3 = a3 * a0 + a1; a0 = a0 * a2 + a1; a1 = a1 * a3 + a2; a2 = a2 * a0 + a3; a3 = a3 * a1 + a0;
#endif
          }
          if (a0 + a1 + a2 + a3 + p0.x + p1.y + p2.x + p3.y == 1.2345e33f || (w0 ^ w1 ^ w2 ^ w3) == 0x12345u) ((float*)(ws + WS_DUMP))[F.lane] = a0; }
#endif
#ifdef ICACHE_PROBE
        asm volatile(".rept 8000\n s_nop 0\n .endr" ::: "memory");
#endif
        peer_act_phase(A, F); if (BOTH(9)) GRID_BAR(); }
    if (IN(10)) for (int rep = 0; rep < REPS(10); ++rep) { PHASE_BEGIN(); if (rep) GRID_BAR(); peer_v_phase(A, F); if (BOTH(10)) GRID_BAR(); }
    if (IN(11)) { PHASE_BEGIN();
        for (int t = F.gw; t < TOK; t += F.NGW) peer_final(A, t, F.lane);
    }
#undef IN
#undef BOTH
}

extern "C" void kernel_launch(void* const* d_in, const int* in_sizes, int n_in, void* d_out, int out_size, void* d_ws, size_t ws_size, hipStream_t stream) {
    static int grid = 0;
    if (grid == 0) {
        if (n_in != 15 || in_sizes[0] != TOK * DM || out_size != TOK * DM || ws_size < WS_END) { fprintf(stderr, "kernel_launch: unexpected shapes (n_in %d, in0 %d, out %d, ws %zu < %zu)\n", n_in, n_in > 0 ? in_sizes[0] : -1, out_size, ws_size, (size_t)WS_END); grid = -1; return; }
        int dev = 0, cus = 0, per_cu = 0;
        if (hipGetDevice(&dev) != hipSuccess || hipDeviceGetAttribute(&cus, hipDeviceAttributeMultiprocessorCount, dev) != hipSuccess) { grid = -1; return; }
        if (hipFuncSetAttribute((const void*)mk_fwd, hipFuncAttributeMaxDynamicSharedMemorySize, LDS_BYTES) != hipSuccess) { fprintf(stderr, "kernel_launch: hipFuncSetAttribute failed\n"); grid = -1; return; }
        if (hipOccupancyMaxActiveBlocksPerMultiprocessor(&per_cu, (const void*)mk_fwd, NWAVES * 64, LDS_BYTES) != hipSuccess || per_cu < 1) { fprintf(stderr, "kernel_launch: occupancy query says %d\n", per_cu); per_cu = 1; }
        (void)hipGetLastError();
        grid = cus;
    }
    if (grid < 0) return;
    (void)hipMemsetAsync((char*)d_ws + WS_CTL, 0, CTL_ZERO_BYTES, stream);
    Args a{};
    a.x = (const float*)d_in[0]; a.c = (const float*)d_in[1]; a.w_ada = (const float*)d_in[2]; a.b_ada = (const float*)d_in[3]; a.g_mix = (const float*)d_in[4];
    a.w_in = (const float*)d_in[5]; a.w_sb_o = (const float*)d_in[6]; a.w_dil_o = (const float*)d_in[7]; a.w_out = (const float*)d_in[8]; a.g_ffn = (const float*)d_in[9];
    a.w_pq = (const float*)d_in[10]; a.peer_keys = (const float*)d_in[11]; a.peer_u = (const float*)d_in[12]; a.peer_v = (const float*)d_in[13]; a.g_final = (const float*)d_in[14];
    a.out = (float*)d_out; a.ws = (unsigned char*)d_ws;
#if MK_ONE_LAUNCH
    a.ph_lo = 0; a.ph_hi = N_PHASES;
    void* args[] = {&a};
    hipError_t e = hipLaunchCooperativeKernel((const void*)mk_fwd, dim3(grid), dim3(NWAVES * 64), args, LDS_BYTES, stream);
    if (e != hipSuccess) fprintf(stderr, "kernel_launch: cooperative launch failed: %s (grid %d)\n", hipGetErrorString(e), grid);
#else
    for (int p = 0; p < N_PHASES; ++p) { a.ph_lo = p; a.ph_hi = p + 1; hipLaunchKernelGGL(mk_fwd, dim3(grid), dim3(NWAVES * 64), LDS_BYTES, stream, a); }
#endif
}
```

```cpp
#include <hip/hip_runtime.h>
#include <hip/hip_cooperative_groups.h>
#include <cstdio>
#include <cstdint>
namespace pg8 {
#define PG8_LAS __attribute__((address_space(3)))
typedef unsigned short bf16_t;
typedef short bf16x8 __attribute__((ext_vector_type(8)));
typedef float f32x4 __attribute__((ext_vector_type(4)));
typedef unsigned u32x4 __attribute__((ext_vector_type(4)));
constexpr int BM = 256, BK = 64, HALF = 128, HTB = HALF * BK * 2  , STAGE_BYTES = 8 * HTB, NXCD = 8, WGM = 8;

__host__ __device__ __forceinline__ int lds_byte(int r, int c) { const int st = (r >> 4) * 2 + (c >> 5), rr = r & 15, cc = c & 31, ob = rr * 64 + cc * 2; return st * 1024 + (ob ^ (((ob >> 9) & 1) << 5)); }
__host__ __device__ __forceinline__ void stage_rc(int b, int& R, int& C) { const int st = b / 1024, sb = b % 1024, swz = sb ^ (((sb >> 9) & 1) << 5); R = (st >> 1) * 16 + swz / 64; C = (st & 1) * 32 + (swz % 64) / 2; }
__host__ __device__ __forceinline__ int perm32(int rho) { const int n = rho >> 4, i = rho & 15; return 8 * (i >> 2) + 4 * n + (i & 3); }

struct Unit { int pm, pn; };
struct Gemm { const bf16_t* A; const bf16_t* Bt; int M, N, K; };

struct StaticOrder {
    int nM, nN, nwg, G, c;
    __host__ __device__ void init(int M, int N, int G_, int c_) { nM = M / BM; nN = N / BM; nwg = nM * nN; G = G_; c = c_; }
    __host__ __device__ bool next(int i, Unit& u) const {
        const long L = (long)i * G + c; if (L >= nwg) return false;
        int wgid = (int)L; { const int q = nwg / NXCD, r = nwg % NXCD, xcd = wgid % NXCD, off = wgid / NXCD; wgid = (xcd < r ? xcd * (q + 1) : r * (q + 1) + (xcd - r) * q) + off; }
        const int nig = WGM * nN, gid = wgid / nig, fm = gid * WGM, gsz = (nM - fm) < WGM ? (nM - fm) : WGM;
        u.pm = fm + ((wgid % nig) % gsz); u.pn = (wgid % nig) / gsz; return true;
    }
    __device__ __forceinline__ void a_ready(const Unit&) const {}
    __device__ __forceinline__ void done(const Unit&) const {}
};

__device__ __forceinline__ unsigned cvt_pk_bf16(float lo, float hi) { unsigned r; asm volatile("v_cvt_pk_bf16_f32 %0, %1, %2" : "=v"(r) : "v"(lo), "v"(hi)); return r; }
typedef int i32x4 __attribute__((ext_vector_type(4)));
template <bool I8> __device__ __forceinline__ f32x4 mma16(bf16x8 b, bf16x8 a, f32x4 c) {
    if constexpr (I8) return __builtin_bit_cast(f32x4, __builtin_amdgcn_mfma_i32_16x16x64_i8(__builtin_bit_cast(i32x4, b), __builtin_bit_cast(i32x4, a), __builtin_bit_cast(i32x4, c), 0, 0, 0));
    else return __builtin_amdgcn_mfma_f32_16x16x32_bf16(b, a, c, 0, 0, 0);
}
template <class Epi, class Sched, bool ALIGN_EPI = false, bool SP2 = false, bool I8 = false>
__device__ __forceinline__ void gemm_phase(PG8_LAS unsigned char* lds, const Gemm g, const Sched& S, const Epi& E) {
    int tid_ = threadIdx.x; asm volatile("" : "+v"(tid_));
    const int tid = tid_, wid = __builtin_amdgcn_readfirstlane(tid >> 6), lane = tid & 63, wr = wid >> 2, wc = wid & 3, fr = lane & 15, fq = lane >> 4;
    const int K = g.K, nt = K / BK;
    unsigned voffA[2], voffB[2];
#pragma unroll
    for (int i = 0; i < 2; ++i) { int R, C; stage_rc(tid * 16 + i * 8192, R, C); const int Rb = Epi::PERM ? ((R & ~31) + perm32(R & 31)) : R;
        voffA[i] = (unsigned)(R * K + C) * 2u; voffB[i] = (unsigned)(Rb * K + C) * 2u; }
    const size_t kstep = (size_t)(BK * 2);
    const size_t hstep = (size_t)HALF * K * 2;
    const size_t tstep = 2 * hstep;
    const unsigned ldsw = (unsigned)wid * 1024u;
    const int aoff = lds_byte(wr * 64 + fr, fq * 8), boff = lds_byte(wc * 32 + fr, fq * 8);
#define PG8_SA(b, h) (((b) * 2 + (h)) * HTB)
#define PG8_SB(b, h) ((4 + (b) * 2 + (h)) * HTB)
#define PG8_STAGE(bufoff, gbase, voff) do { _Pragma("unroll") for (int _i = 0; _i < 2; ++_i) \
        __builtin_amdgcn_global_load_lds((const unsigned*)((const char*)(gbase) + (voff)[_i]), (PG8_LAS unsigned*)(lds + (bufoff) + ldsw + _i * 8192), 16, 0, 0); } while (0)
#define PG8_LDA(dst, b, h) do { _Pragma("unroll") for (int m = 0; m < 4; ++m) _Pragma("unroll") for (int k = 0; k < 2; ++k) dst[m][k] = *(const PG8_LAS bf16x8*)(lds + PG8_SA(b, h) + aoff + m * 2048 + k * 1024); } while (0)
#define PG8_LDB(dst, b, h) do { _Pragma("unroll") for (int n = 0; n < 2; ++n) _Pragma("unroll") for (int k = 0; k < 2; ++k) dst[n][k] = *(const PG8_LAS bf16x8*)(lds + PG8_SB(b, h) + boff + n * 2048 + k * 1024); } while (0)
#define PG8_MMA(ai, bj, At, Bt) do { __builtin_amdgcn_s_setprio(1); _Pragma("unroll") for (int m = 0; m < 4; ++m) _Pragma("unroll") for (int n = 0; n < 2; ++n) _Pragma("unroll") for (int k = 0; k < 2; ++k) \
        acc[ai][bj][m][n] = mma16<I8>(Bt[n][k], At[m][k], acc[ai][bj][m][n]); __builtin_amdgcn_s_setprio(0); } while (0)
#define PG8_WAIT_V(n) asm volatile("s_waitcnt vmcnt(" #n ")" ::: "memory")
#define PG8_WAIT_L(n) asm volatile("s_waitcnt lgkmcnt(" #n ")" ::: "memory")
#define PG8_BAR __builtin_amdgcn_s_barrier()
#define PG8_SCHED __builtin_amdgcn_sched_barrier(0)
    Unit cur, nxt; int ui = 0;
    if (!S.next(0, cur)) return;
    f32x4 acc[2][2][4][2];
#pragma unroll
    for (int a = 0; a < 2; ++a)
#pragma unroll
        for (int b = 0; b < 2; ++b)
#pragma unroll
            for (int m = 0; m < 4; ++m)
#pragma unroll
                for (int n = 0; n < 2; ++n) acc[a][b][m][n] = (f32x4){0.f, 0.f, 0.f, 0.f};
    bf16x8 At[4][2], B0[2][2], B1[2][2];
    const char* cA = (const char*)g.A + (size_t)cur.pm * tstep; const char* cB = (const char*)g.Bt + (size_t)cur.pn * tstep;
    S.a_ready(cur);
    if constexpr (SP2) {
        PG8_STAGE(PG8_SB(0, 0), cB, voffB); PG8_STAGE(PG8_SB(0, 1), cB + hstep, voffB); PG8_STAGE(PG8_SA(0, 0), cA, voffA); PG8_STAGE(PG8_SA(0, 1), cA + hstep, voffA);
        if (wr == 1) PG8_BAR;
        PG8_WAIT_V(2); PG8_BAR;
        PG8_STAGE(PG8_SB(1, 0), cB + kstep, voffB); PG8_STAGE(PG8_SA(1, 0), cA + kstep, voffA); PG8_STAGE(PG8_SB(1, 1), cB + hstep + kstep, voffB);
        PG8_WAIT_V(6); PG8_BAR;
    } else {
        PG8_STAGE(PG8_SB(0, 0), cB, voffB); PG8_STAGE(PG8_SA(0, 0), cA, voffA); PG8_STAGE(PG8_SB(0, 1), cB + hstep, voffB); PG8_STAGE(PG8_SA(0, 1), cA + hstep, voffA);
        if (wr == 1) PG8_BAR;
        PG8_WAIT_V(4); PG8_BAR;
        PG8_STAGE(PG8_SB(1, 0), cB + kstep, voffB); PG8_STAGE(PG8_SA(1, 0), cA + kstep, voffA); PG8_STAGE(PG8_SB(1, 1), cB + hstep + kstep, voffB);
        PG8_WAIT_V(6); PG8_BAR;
    }
    for (;;) {
        const bool has_next = S.next(ui + 1, nxt);
        const char* nA = has_next ? (const char*)g.A + (size_t)nxt.pm * tstep : cA; const char* nB = has_next ? (const char*)g.Bt + (size_t)nxt.pn * tstep : cB;
        for (int t = 0; t < nt; t += 2) {
            const bool last = (t == nt - 2);
            const char* a1 = cA + (size_t)(t + 1) * kstep;
            const char* a2 = last ? nA : cA + (size_t)(t + 2) * kstep; const char* b2 = last ? nB : cB + (size_t)(t + 2) * kstep;
            const char* a3 = a2 + kstep; const char* b3 = b2 + kstep;
            if (last && has_next) S.a_ready(nxt);
            if constexpr (SP2) {
            PG8_LDB(B0, 0, 0); PG8_LDB(B1, 0, 1); PG8_SCHED; PG8_LDA(At, 0, 0); PG8_STAGE(PG8_SA(1, 1), a1 + hstep, voffA);
            PG8_WAIT_V(8); PG8_WAIT_L(0); PG8_BAR; PG8_MMA(0, 0, At, B0); PG8_MMA(0, 1, At, B1); PG8_BAR; PG8_SCHED;
            PG8_LDA(At, 0, 1); PG8_STAGE(PG8_SB(0, 0), b2, voffB); PG8_STAGE(PG8_SB(0, 1), b2 + hstep, voffB); PG8_STAGE(PG8_SA(0, 0), a2, voffA);
            PG8_WAIT_V(8); PG8_WAIT_L(0); PG8_BAR; PG8_MMA(1, 0, At, B0); PG8_MMA(1, 1, At, B1); PG8_BAR; PG8_SCHED;
            PG8_LDB(B0, 1, 0); PG8_LDB(B1, 1, 1); PG8_SCHED; PG8_LDA(At, 1, 0); PG8_STAGE(PG8_SA(0, 1), a2 + hstep, voffA);
            PG8_WAIT_V(8); PG8_WAIT_L(0); PG8_BAR; PG8_MMA(0, 0, At, B0); PG8_MMA(0, 1, At, B1); PG8_BAR; PG8_SCHED;
            PG8_LDA(At, 1, 1); PG8_STAGE(PG8_SB(1, 0), b3, voffB); PG8_STAGE(PG8_SB(1, 1), b3 + hstep, voffB); PG8_STAGE(PG8_SA(1, 0), a3, voffA);
            PG8_WAIT_V(8); PG8_WAIT_L(0); PG8_BAR; PG8_MMA(1, 0, At, B0); PG8_MMA(1, 1, At, B1); PG8_BAR; PG8_SCHED;
            } else {
            PG8_LDB(B0, 0, 0); PG8_SCHED; PG8_LDA(At, 0, 0); PG8_STAGE(PG8_SA(1, 1), a1 + hstep, voffA);
            PG8_WAIT_L(8); PG8_BAR; PG8_WAIT_L(0); PG8_MMA(0, 0, At, B0); PG8_BAR; PG8_SCHED;
            PG8_LDB(B1, 0, 1); PG8_STAGE(PG8_SB(0, 0), b2, voffB);
            PG8_BAR; PG8_WAIT_L(0); PG8_MMA(0, 1, At, B1); PG8_BAR;
            PG8_LDA(At, 0, 1); PG8_STAGE(PG8_SA(0, 0), a2, voffA);
            PG8_BAR; PG8_WAIT_L(0); PG8_MMA(1, 0, At, B0); PG8_BAR; PG8_SCHED;
            PG8_STAGE(PG8_SB(0, 1), b2 + hstep, voffB);
            PG8_WAIT_V(6); PG8_BAR; PG8_MMA(1, 1, At, B1); PG8_BAR;
            PG8_LDB(B0, 1, 0); PG8_SCHED; PG8_LDA(At, 1, 0); PG8_STAGE(PG8_SA(0, 1), a2 + hstep, voffA);
            PG8_WAIT_L(8); PG8_BAR; PG8_WAIT_L(0); PG8_MMA(0, 0, At, B0); PG8_BAR; PG8_SCHED;
            PG8_LDB(B1, 1, 1); PG8_STAGE(PG8_SB(1, 0), b3, voffB);
            PG8_BAR; PG8_WAIT_L(0); PG8_MMA(0, 1, At, B1); PG8_BAR;
            PG8_LDA(At, 1, 1); PG8_STAGE(PG8_SA(1, 0), a3, voffA);
            PG8_BAR; PG8_WAIT_L(0); PG8_MMA(1, 0, At, B0); PG8_BAR; PG8_SCHED;
            PG8_STAGE(PG8_SB(1, 1), b3 + hstep, voffB);
            PG8_WAIT_V(6); PG8_BAR; PG8_MMA(1, 1, At, B1); PG8_BAR;
            }
        }
        if constexpr (ALIGN_EPI) { if (wr == 0) PG8_BAR; }
        if constexpr (!Epi::AFTER_DRAIN) { E(acc, cur, wr, wc, fr, fq); S.done(cur); }
        if (!has_next) break;
#pragma unroll
        for (int a = 0; a < 2; ++a)
#pragma unroll
            for (int b = 0; b < 2; ++b)
#pragma unroll
                for (int m = 0; m < 4; ++m)
#pragma unroll
                    for (int n = 0; n < 2; ++n) acc[a][b][m][n] = (f32x4){0.f, 0.f, 0.f, 0.f};
        cur = nxt; cA = nA; cB = nB; ++ui;
        if constexpr (ALIGN_EPI) { if (wr == 1) PG8_BAR; }
    }
    PG8_WAIT_V(0);
    if constexpr (!ALIGN_EPI) { if (wr == 0) PG8_BAR; }
    PG8_BAR;
    if constexpr (Epi::AFTER_DRAIN) { E.fused(acc, cur, wr, wc, fr, fq, lds, wid, lane); S.done(cur); }
#undef PG8_SA
#undef PG8_SB
#undef PG8_STAGE
#undef PG8_LDA
#undef PG8_LDB
#undef PG8_MMA
#undef PG8_WAIT_V
#undef PG8_WAIT_L
#undef PG8_BAR
#undef PG8_SCHED
}
}

#define GAS __attribute__((address_space(1)))
#define LAS __attribute__((address_space(3)))
typedef unsigned short bf16;
typedef unsigned v4u __attribute__((ext_vector_type(4)));
typedef unsigned v2u __attribute__((ext_vector_type(2)));
typedef float f32x4 __attribute__((ext_vector_type(4)));
typedef float f32x16 __attribute__((ext_vector_type(16)));
typedef short bf16x8 __attribute__((ext_vector_type(8)));
typedef short s16x4 __attribute__((ext_vector_type(4)));

constexpr int NWAVES = 8;
constexpr int NB = 4, SEQ = 8192, DM = 1024, TOK = NB * SEQ;
constexpr int NIN = 5888;
constexpr int SBH = 8, DILH = 12;
constexpr int NMOD = 6 * DM;
constexpr int KSPLIT = 16;
constexpr float EPS = 1e-6f;
constexpr float LOG2E = 1.4426950408889634f;
constexpr float C2 = 0.125f * LOG2E;
constexpr int PEER_E = 16384;

constexpr size_t MiB = 1u << 20;
constexpr size_t WS_CTL = 0, CTL_ZERO_BYTES = 1 * MiB;
constexpr size_t WS_MODP = 1 * MiB;
constexpr size_t WS_MOD = 2 * MiB + 512 * 1024;
constexpr size_t WS_BIASPQ = 2 * MiB + 768 * 1024;
constexpr size_t WS_ROPEC = 3 * MiB, WS_ROPES = 4 * MiB;
constexpr size_t WS_SSQ = 5 * MiB;
constexpr size_t WS_KEYS = 7 * MiB;
constexpr size_t WS_WIN = 8 * MiB;
constexpr size_t WS_WSBO = 20 * MiB;
constexpr size_t WS_WDILO = 21 * MiB;
constexpr size_t WS_WOUT = 22 * MiB;
constexpr size_t WS_WPQ = 24 * MiB;
constexpr size_t WS_UB = 32 * MiB, WS_VB = 64 * MiB;
constexpr size_t WS_ACT = 96 * MiB;
constexpr size_t A_QSB = WS_ACT, A_KSB = WS_ACT + 32 * MiB, A_VSB = WS_ACT + 64 * MiB;
constexpr size_t A_QD = WS_ACT + 96 * MiB, A_KD = WS_ACT + 144 * MiB, A_VD = WS_ACT + 192 * MiB;
constexpr size_t A_GSB = WS_ACT + 240 * MiB, A_GD = WS_ACT + 304 * MiB;
constexpr size_t A_MERGED = WS_ACT;
constexpr size_t A_X1M = WS_ACT + 64 * MiB;
constexpr size_t A_QPEER = WS_ACT + 128 * MiB;
constexpr size_t A_IDX = WS_ACT + 256 * MiB;
constexpr size_t A_GATE = WS_ACT + 272 * MiB;
constexpr size_t A_ACTG = WS_ACT + 288 * MiB;
constexpr size_t A_PART = WS_ACT + 128 * MiB;
constexpr size_t A_H2Q = WS_ACT + 304 * MiB;
constexpr size_t WS_HINV = 7 * MiB + 640 * 1024;
constexpr size_t A_H2F8 = WS_ACT + 304 * MiB;
constexpr size_t WS_DUMP = 7 * MiB + 768 * 1024;
constexpr size_t WS_R2 = 7 * MiB + 512 * 1024;
constexpr size_t A_POUT = WS_ACT;
constexpr size_t WS_END = WS_ACT + 368 * MiB;
constexpr size_t O_H = 0, O_OSB = 64 * MiB, O_OD = 96 * MiB, O_PO = 112 * MiB;

constexpr int CW_BAR = 4096;
constexpr int CW_COLMAX = 16384;
constexpr size_t WS_SA = 7 * MiB + 832 * 1024;
constexpr size_t WS_SB = 7 * MiB + 960 * 1024;

constexpr int RING_BYTES = 131072;
constexpr int MISC_OFF = RING_BYTES + 320;
constexpr int LDS_BYTES = 147456;

#define RLX_AGENT __ATOMIC_RELAXED, __HIP_MEMORY_SCOPE_AGENT
__device__ __forceinline__ unsigned f2bf(float f) { unsigned u = __builtin_bit_cast(unsigned, f); return (u + 0x7fffu + ((u >> 16) & 1u)) >> 16; }
typedef float f32x2_t __attribute__((ext_vector_type(2))); typedef __bf16 bf16x2_t __attribute__((ext_vector_type(2)));
__device__ __forceinline__ unsigned pk2(float lo, float hi) { f32x2_t v = {lo, hi}; bf16x2_t b = __builtin_convertvector(v, bf16x2_t); return __builtin_bit_cast(unsigned, b); }
__device__ __forceinline__ float bflo(unsigned w) { return __uint_as_float(w << 16); }
__device__ __forceinline__ float bfhi(unsigned w) { return __uint_as_float(w & 0xffff0000u); }
__device__ __forceinline__ float wave_sum(float v) {
#pragma unroll
    for (int o = 1; o < 64; o <<= 1) v += __shfl_xor(v, o);
    return v;
}
__device__ __forceinline__ float fast_exp2(float x) { return __builtin_amdgcn_exp2f(x); }
__device__ __forceinline__ float fast_log2(float x) { return __builtin_amdgcn_logf(x); }
__device__ __forceinline__ float fast_rcp(float x) { return __builtin_amdgcn_rcpf(x); }
__device__ __forceinline__ float sigmoidf_(float x) { return fast_rcp(1.f + fast_exp2(-x * LOG2E)); }
#define XB_TMO      128
#define XB_XCNT(j)  (256  + 64 * (j))
#define XB_XSUB(j)  (1280 + 64 * (j))
#define XB_XGEN(j)  (2304 + 64 * (j))
#define XB_TOP      3328
#define XB_TOPGEN   3392
#define XCD_BAR_WORDS 3456
#define XB_SPIN_CAP (1u << 18)

__device__ __forceinline__ unsigned xb_ld(unsigned* p)              { return __hip_atomic_load(p, __ATOMIC_RELAXED, __HIP_MEMORY_SCOPE_AGENT); }
__device__ __forceinline__ unsigned xb_add(unsigned* p, unsigned v) { return __hip_atomic_fetch_add(p, v, __ATOMIC_RELAXED, __HIP_MEMORY_SCOPE_AGENT); }
__device__ __forceinline__ unsigned xb_xcc_id() { return (unsigned)__builtin_amdgcn_s_getreg((3 << 11) | 20) & 0xFu; }
#define XB_SPIN(cond, bar) do { unsigned _sp = 0; while (cond) { __builtin_amdgcn_s_sleep(1); \
    if ((++_sp & 255u) == 0u) { if (xb_ld(&(bar)[XB_TMO])) break; if (_sp > XB_SPIN_CAP) { atomicAdd(&(bar)[XB_TMO], 1u); break; } } } } while (0)

struct XcdBarrier {
    unsigned* bar; unsigned x;
    volatile LAS unsigned* st;
};

__device__ __forceinline__ XcdBarrier xcd_barrier_post(unsigned* bar, volatile LAS unsigned* st) {
    XcdBarrier b; b.bar = bar; b.x = xb_xcc_id(); b.st = st;
    if (threadIdx.x == 0) (void)xb_add(&bar[XB_XCNT(b.x)], 1u);
    return b;
}
__device__ __forceinline__ void xcd_barrier_complete(unsigned* bar, unsigned x, unsigned& nloc, unsigned& nx) {
    const unsigned G = gridDim.x * gridDim.y * gridDim.z;
    unsigned sum, cnt, mine, sp = 0u;
    for (;;) {
        sum = 0u; cnt = 0u; mine = 0u;
#pragma unroll
        for (unsigned j = 0; j < 16; ++j) { const unsigned c = xb_ld(&bar[XB_XCNT(j)]); sum += c; cnt += (c > 0u) ? 1u : 0u; mine = (j == x) ? c : mine; }
        if (sum == G) break;
        __builtin_amdgcn_s_sleep(1);
        if ((++sp & 255u) == 0u) { if (xb_ld(&bar[XB_TMO])) break; if (sp > XB_SPIN_CAP) { atomicAdd(&bar[XB_TMO], 1u); break; } }
    }
    nloc = mine > 0u ? mine : 1u; nx = cnt > 0u ? cnt : 1u;
}

__device__ __forceinline__ void xcd_barrier(const XcdBarrier& b) {
    asm volatile("s_waitcnt vmcnt(0)" ::: "memory");
    __syncthreads();
    if (threadIdx.x == 0) {
        unsigned* bar = b.bar;
        __builtin_amdgcn_s_waitcnt(0);
        unsigned nloc = b.st[0], nx = b.st[1];
        if (nloc == 0u) { xcd_barrier_complete(bar, b.x, nloc, nx); b.st[0] = nloc; b.st[1] = nx; }
        const unsigned old = xb_add(&bar[XB_XSUB(b.x)], 1u);
        const unsigned gen = old / nloc;
        if (old + 1u == (gen + 1u) * nloc) {
            __builtin_amdgcn_fence(__ATOMIC_RELEASE, "agent");
            asm volatile("s_waitcnt vmcnt(0)" ::: "memory");
            const unsigned og = xb_add(&bar[XB_TOP], 1u);
            const unsigned tg = og / nx;
            if (og + 1u == (tg + 1u) * nx) xb_add(&bar[XB_TOPGEN], 1u);
            else XB_SPIN(xb_ld(&bar[XB_TOPGEN]) == tg, bar);
            __builtin_amdgcn_fence(__ATOMIC_ACQUIRE, "agent");
            xb_add(&bar[XB_XGEN(b.x)], 1u);
            asm volatile("s_waitcnt vmcnt(0)" ::: "memory");
        } else {
            XB_SPIN(xb_ld(&bar[XB_XGEN(b.x)]) == gen, bar);
            __builtin_amdgcn_fence(__ATOMIC_ACQUIRE, "agent");
            asm volatile("s_waitcnt vmcnt(0)" ::: "memory");
        }
    }
    __syncthreads();
}

struct Args {
    const float* x; const float* c; const float* w_ada; const float* b_ada; const float* g_mix; const float* w_in; const float* w_sb_o; const float* w_dil_o;
    const float* w_out; const float* g_ffn; const float* w_pq; const float* peer_keys; const float* peer_u; const float* peer_v; const float* g_final;
    float* out; unsigned char* ws; int ph_lo, ph_hi;
};
struct Frame {
    LAS unsigned char* lds;
    int tid, lane, wave, vcu, G, gw, NGW;
};

__device__ __forceinline__ int win_row(int ncol) {
    const int tile = ncol >> 8;
    if (tile >= 6 && tile < 12) { const int d = ncol & 63; const int j = (d & 31) >> 2, i = (d & 3) + ((d >> 5) << 2); return (ncol & ~63) + 8 * j + i; }
    return ncol;
}
template <bool MAPWIN>
__device__ __forceinline__ void p0_transpose_item(const float* W, int K, int N, bf16* WT, LAS float* scr, int item, int lane) {
    const int nblk = N / 32, kb = item / nblk, nb = item % nblk, k0 = 64 * kb, n0 = 32 * nb;
#pragma unroll 8
    for (int i = 0; i < 32; ++i) { const int kk = 2 * i + (lane >> 5); scr[kk * 33 + (lane & 31)] = W[(size_t)(k0 + kk) * N + n0 + (lane & 31)]; }
    asm volatile("s_waitcnt lgkmcnt(0)" ::: "memory");
    const int c = lane & 7;
#pragma unroll
    for (int j = 0; j < 4; ++j) { const int n = (lane >> 3) + 8 * j; const LAS float* s = scr + (8 * c) * 33 + n;
        v4u o; o.x = pk2(s[0 * 33], s[1 * 33]); o.y = pk2(s[2 * 33], s[3 * 33]); o.z = pk2(s[4 * 33], s[5 * 33]); o.w = pk2(s[6 * 33], s[7 * 33]);
        const int rowo = MAPWIN ? win_row(n0 + n) : (n0 + n);
        *(GAS v4u*)(WT + (size_t)rowo * K + k0 + 8 * c) = o; }
    asm volatile("s_waitcnt lgkmcnt(0)" ::: "memory");
}
__device__ __forceinline__ void win_quant_item(const float* W, const unsigned* colmax, unsigned char* W8, float* sB, LAS float* scr, int item, int lane) {
    constexpr int K = DM, N = NIN;
    const int nblk = N / 32, kb = item / nblk, nb = item % nblk, k0 = 64 * kb, n0 = 32 * nb;
#pragma unroll 8
    for (int i = 0; i < 32; ++i) { const int kk = 2 * i + (lane >> 5); scr[kk * 33 + (lane & 31)] = W[(size_t)(k0 + kk) * N + n0 + (lane & 31)]; }
    asm volatile("s_waitcnt lgkmcnt(0)" ::: "memory");
    const int c = lane & 7;
#pragma unroll
    for (int j = 0; j < 4; ++j) { const int n = (lane >> 3) + 8 * j; const LAS float* s = scr + (8 * c) * 33 + n;
        const float cm = fmaxf(__uint_as_float(colmax[n0 + n]), 1e-30f), sc = 127.0f / cm;
        unsigned lo = 0, hi = 0;
#pragma unroll
        for (int i = 0; i < 4; ++i) { lo |= ((unsigned)(int)__builtin_rintf(s[i * 33] * sc) & 0xffu) << (8 * i); hi |= ((unsigned)(int)__builtin_rintf(s[(4 + i) * 33] * sc) & 0xffu) << (8 * i); }
        const int rowo = win_row(n0 + n);
        *(GAS v2u*)(W8 + (size_t)rowo * K + k0 + 8 * c) = (v2u){lo, hi};
        if (kb == 0 && c == 0) sB[rowo] = cm * (1.0f / 127.0f); }
    asm volatile("s_waitcnt lgkmcnt(0)" ::: "memory");
}
__device__ __forceinline__ void cvt_row_1024(const float* src, bf16* dst, int lane) {
    const GAS f32x4* s = (const GAS f32x4*)src + lane; GAS v2u* d = (GAS v2u*)dst + lane;
    f32x4 v[4];
#pragma unroll
    for (int j = 0; j < 4; ++j) v[j] = s[64 * j];
#pragma unroll
    for (int j = 0; j < 4; ++j) { v2u o; o.x = pk2(v[j].x, v[j].y); o.y = pk2(v[j].z, v[j].w); d[64 * j] = o; }
}
template <bool SLICED, bool I8 = false>
__device__ __forceinline__ void cvt_row_fp8(const float* src, unsigned char* dst, float* inv, int e, int lane) {
    const GAS f32x4* s = (const GAS f32x4*)src + lane;
    f32x4 v[4]; float m = 0.f;
#pragma unroll
    for (int j = 0; j < 4; ++j) { v[j] = s[64 * j]; m = fmaxf(m, fmaxf(fmaxf(fabsf(v[j].x), fabsf(v[j].y)), fmaxf(fabsf(v[j].z), fabsf(v[j].w)))); }
#pragma unroll
    for (int o = 1; o < 64; o <<= 1) m = fmaxf(m, __shfl_xor(m, o));
    m = fmaxf(m, 1e-30f);
    const int ex = (int)((__float_as_uint(m) >> 23) & 0xff) - 127;
    const float scale = __uint_as_float((unsigned)(127 + 7 - ex) << 23);
    const float iscale = __uint_as_float((unsigned)(127 - 7 + ex) << 23);
    unsigned w[4];
    if (I8) {
        const float s8 = 127.0f / m;
#pragma unroll
        for (int j = 0; j < 4; ++j) w[j] = ((unsigned)(int)__builtin_rintf(v[j].x * s8) & 0xffu) | (((unsigned)(int)__builtin_rintf(v[j].y * s8) & 0xffu) << 8) |
                                            (((unsigned)(int)__builtin_rintf(v[j].z * s8) & 0xffu) << 16) | (((unsigned)(int)__builtin_rintf(v[j].w * s8) & 0xffu) << 24);
    } else {
#pragma unroll
    for (int j = 0; j < 4; ++j) { int t = __builtin_amdgcn_cvt_pk_fp8_f32(v[j].x * scale, v[j].y * scale, 0, false); t = __builtin_amdgcn_cvt_pk_fp8_f32(v[j].z * scale, v[j].w * scale, t, true); w[j] = (unsigned)t; }
    }
    if (!SLICED) { *(GAS v4u*)(dst + (size_t)e * 1024 + 16 * lane) = (v4u){w[0], w[1], w[2], w[3]}; }
    else {
#pragma unroll
        for (int j = 0; j < 4; ++j) *(GAS unsigned*)(dst + (size_t)(2 * j + (lane >> 5)) * (2 * MiB) + (size_t)e * 128 + 4 * (lane & 31)) = w[j]; }
    if (lane == 0) inv[e] = I8 ? m * (1.0f / 127.0f) : iscale;
}
__device__ __forceinline__ void sincos_d(double a, float& sn, float& cs) {
    const double TWO_PI = 6.283185307179586476925286766559;
    const double k = __builtin_rint(a / TWO_PI); const double r = a - k * TWO_PI; const double r2 = r * r;
    double ts = 1.0, tc = 1.0, ss = 1.0, cc = 1.0;
#pragma unroll
    for (int n = 1; n <= 14; ++n) { tc = -tc * r2 / (double)((2 * n - 1) * (2 * n)); ts = -ts * r2 / (double)((2 * n) * (2 * n + 1)); cc += tc; ss += ts; }
    sn = (float)(r * ss); cs = (float)cc;
}

__device__ __forceinline__ void p0_prologue(const Args& A, Frame& F) {
    unsigned char* ws = A.ws;
    LAS float* scr = (LAS float*)(F.lds + F.wave * 16384);
    const int lane = F.lane;
    constexpr int I_MOD = KSPLIT * 24;
    constexpr int I_WIN = (DM / 64) * (NIN / 32);
    constexpr int I_SBO = (512 / 64) * (DM / 32), I_DILO = (256 / 64) * (DM / 32), I_OUT = (DM / 64) * (DM / 32), I_PQ = (DM / 64) * (2048 / 32);
    constexpr int I_KEYS = 256, I_TAB = 2 * PEER_E, I_ROPE = SEQ * 32 / 64;
    constexpr int NITEMS = I_MOD + I_WIN + I_SBO + I_DILO + I_OUT + I_PQ + I_KEYS + I_TAB + I_ROPE;
    for (int it = F.gw; it < NITEMS; it += F.NGW) {
        int r = it;
        if (r < I_MOD) {
            const int ks = r / 24, cc = r % 24, col = 256 * cc + 4 * lane, k0 = 64 * ks;
            float sv[4];
#pragma unroll
            for (int b = 0; b < 4; ++b) { const float cv = A.c[b * DM + k0 + lane]; sv[b] = cv * sigmoidf_(cv); }
            f32x4 acc[4];
#pragma unroll
            for (int b = 0; b < 4; ++b) acc[b] = (f32x4){0.f, 0.f, 0.f, 0.f};
            const GAS f32x4* wp = (const GAS f32x4*)(A.w_ada + (size_t)k0 * NMOD + col);
#pragma unroll 8
            for (int kk = 0; kk < 64; ++kk) { const f32x4 w4 = wp[(size_t)kk * (NMOD / 4)];
#pragma unroll
                for (int b = 0; b < 4; ++b) { const float s = __uint_as_float(__builtin_amdgcn_readlane(__float_as_uint(sv[b]), kk)); acc[b] += w4 * s; } }
            float* mp = (float*)(ws + WS_MODP);
#pragma unroll
            for (int b = 0; b < 4; ++b) *(GAS f32x4*)(mp + ((size_t)(ks * 4 + b)) * NMOD + col) = acc[b];
            continue;
        }
        r -= I_MOD;
        if (r < I_WIN) {
            const int nblk = NIN / 32, kb = r / nblk, nb = r % nblk, col = 32 * nb + (lane & 31); float m = 0.f;
            const float* wp = A.w_in + (size_t)(64 * kb + (lane >> 5)) * NIN + col;
#pragma unroll 8
            for (int i = 0; i < 32; ++i) m = fmaxf(m, fabsf(wp[(size_t)(2 * i) * NIN]));
            m = fmaxf(m, __shfl_xor(m, 32));
            if (lane < 32) atomicMax((unsigned*)(ws + WS_CTL) + CW_COLMAX + col, __float_as_uint(m));
            continue; } r -= I_WIN;
        if (r < I_SBO) { p0_transpose_item<false>(A.w_sb_o, 512, DM, (bf16*)(ws + WS_WSBO), scr, r, lane); continue; } r -= I_SBO;
        if (r < I_DILO) { p0_transpose_item<false>(A.w_dil_o, 256, DM, (bf16*)(ws + WS_WDILO), scr, r, lane); continue; } r -= I_DILO;
        if (r < I_OUT) { p0_transpose_item<false>(A.w_out, DM, DM, (bf16*)(ws + WS_WOUT), scr, r, lane); continue; } r -= I_OUT;
        if (r < I_PQ) { p0_transpose_item<false>(A.w_pq, DM, 2048, (bf16*)(ws + WS_WPQ), scr, r, lane); continue; } r -= I_PQ;
        if (r < I_KEYS) { cvt_row_1024(A.peer_keys + (size_t)r * 1024, (bf16*)(ws + WS_KEYS) + (size_t)r * 1024, lane); continue; } r -= I_KEYS;
        if (r < I_TAB) { if (r < PEER_E) cvt_row_fp8<true, true>(A.peer_u + (size_t)r * 1024, ws + WS_UB, (float*)(ws + WS_UB + 16 * MiB), r, lane);
                         else cvt_row_fp8<true>(A.peer_v + (size_t)(r - PEER_E) * 1024, ws + WS_VB, (float*)(ws + WS_VB + 16 * MiB), r - PEER_E, lane); continue; } r -= I_TAB;
        {
            const int idx = r * 64 + lane, s = idx >> 5, j = idx & 31;
            const float inv = (float)exp2(-(double)j * (13.287712379549449 / 32.0));
            const float ang = (float)s * inv;
            float sn, cs; sincos_d((double)ang, sn, cs);
            ((float*)(ws + WS_ROPEC))[idx] = cs; ((float*)(ws + WS_ROPES))[idx] = sn;
        }
    }
}

__device__ __forceinline__ void p1_hrows(const Args& A, Frame& F) {
    unsigned char* ws = A.ws;
    LAS float* mult = (LAS float*)F.lds; LAS float* addv = mult + DM;
    const float* mp = (const float*)(ws + WS_MODP);
    float* mod = (float*)(ws + WS_MOD);
    unsigned char* H = (unsigned char*)A.out + O_H;
    float* sA = (float*)(ws + WS_SA);
    {
        LAS float* scr = (LAS float*)(F.lds + F.wave * 16384);
        constexpr int I_WIN = (DM / 64) * (NIN / 32);
        for (int it = F.gw; it < I_WIN; it += F.NGW) win_quant_item(A.w_in, (const unsigned*)(ws + WS_CTL) + CW_COLMAX, ws + WS_WIN, (float*)(ws + WS_SB), scr, it, F.lane);
    }
    for (int ch = F.vcu; ch < TOK / 128; ch += F.G) {
        const int b = (ch * 128) / SEQ;
        __syncthreads();
        for (int k = F.tid; k < DM; k += NWAVES * 64) {
            float sh = A.b_ada[k], sc = A.b_ada[DM + k];
#pragma unroll
            for (int ks = 0; ks < KSPLIT; ++ks) { sh += mp[(size_t)(ks * 4 + b) * NMOD + k]; sc += mp[(size_t)(ks * 4 + b) * NMOD + DM + k]; }
            mult[k] = A.g_mix[k] * (1.f + sc); addv[k] = sh;
        }
        if ((ch * 128) % SEQ == 0) {
            for (int j = F.tid; j < NMOD; j += NWAVES * 64) { float v = A.b_ada[j];
#pragma unroll
                for (int ks = 0; ks < KSPLIT; ++ks) v += mp[(size_t)(ks * 4 + b) * NMOD + j];
                mod[b * NMOD + j] = v; }
        }
        __syncthreads();
        for (int i = 0; i < 16; ++i) {
            const int row = ch * 128 + F.wave * 16 + i;
            const GAS f32x4* xr = (const GAS f32x4*)(A.x + (size_t)row * DM) + F.lane;
            f32x4 v[4]; float s = 0.f;
#pragma unroll
            for (int j = 0; j < 4; ++j) { v[j] = xr[64 * j]; s += (v[j].x * v[j].x + v[j].y * v[j].y) + (v[j].z * v[j].z + v[j].w * v[j].w); }
            const float rr = 1.0f / sqrtf(wave_sum(s) * (1.f / DM) + EPS);
            float hm = 0.f;
#pragma unroll
            for (int j = 0; j < 4; ++j) { const f32x4 mu = *(const LAS f32x4*)(mult + 256 * j + 4 * F.lane), ad = *(const LAS f32x4*)(addv + 256 * j + 4 * F.lane);
                v[j] = v[j] * rr * mu + ad; hm = fmaxf(hm, fmaxf(fmaxf(fabsf(v[j].x), fabsf(v[j].y)), fmaxf(fabsf(v[j].z), fabsf(v[j].w)))); }
#pragma unroll
            for (int o = 1; o < 64; o <<= 1) hm = fmaxf(hm, __shfl_xor(hm, o));
            hm = fmaxf(hm, 1e-30f);
            const float qs = 127.0f / hm;
            GAS unsigned* o4 = (GAS unsigned*)(H + (size_t)row * DM) + F.lane;
#pragma unroll
            for (int j = 0; j < 4; ++j) o4[64 * j] = ((unsigned)(int)__builtin_rintf(v[j].x * qs) & 0xffu) | (((unsigned)(int)__builtin_rintf(v[j].y * qs) & 0xffu) << 8) |
                                                     (((unsigned)(int)__builtin_rintf(v[j].z * qs) & 0xffu) << 16) | (((unsigned)(int)__builtin_rintf(v[j].w * qs) & 0xffu) << 24);
            if (F.lane == 0) sA[row] = hm * (1.0f / 127.0f);
        }
    }
}

typedef pg8::f32x4 pf4;
struct EpiG1 {
    static constexpr bool PERM = true, AFTER_DRAIN = false;
    bf16 *Qsb, *Ksb, *Vsb, *Qd, *Kd, *Vd, *Gsb, *Gd; const float* ropeC; const float* ropeS; const float* sA; const float* sB;
    static __device__ __forceinline__ pf4 deq(const pf4& a, const pf4& sc) { const pg8::i32x4 i = __builtin_bit_cast(pg8::i32x4, a); return (pf4){(float)i[0], (float)i[1], (float)i[2], (float)i[3]} * sc; }
    __device__ __forceinline__ void operator()(const pf4 (&accI)[2][2][4][2], const pg8::Unit& u, int wr, int wc, int fr, int fq) const {
        const int pn = u.pn;
        const int row0 = u.pm * 256 + wr * 64 + fr;
        const int b = (u.pm * 256) >> 13;
        pf4 sb[2][2];
#pragma unroll
        for (int bj = 0; bj < 2; ++bj)
#pragma unroll
            for (int n = 0; n < 2; ++n) sb[bj][n] = *(const GAS pf4*)(sB + pn * 256 + bj * 128 + wc * 32 + 8 * fq + 4 * n);
        pf4 acc[2][2][4][2];
#pragma unroll
        for (int ai = 0; ai < 2; ++ai)
#pragma unroll
            for (int m = 0; m < 4; ++m) { const float sa = sA[row0 + ai * 128 + m * 16];
#pragma unroll
                for (int bj = 0; bj < 2; ++bj)
#pragma unroll
                    for (int n = 0; n < 2; ++n) acc[ai][bj][m][n] = deq(accI[ai][bj][m][n], sb[bj][n] * sa); }
        if (pn < 6 || (pn >= 12 && pn < 15)) {
            bf16* base; int H, head0; float sc = 1.f;
            if (pn < 2) { base = Qsb; H = SBH; head0 = 4 * pn; sc = C2; }
            else if (pn < 4) { base = Ksb; H = SBH; head0 = 4 * (pn - 2); }
            else if (pn < 6) { base = Vsb; H = SBH; head0 = 4 * (pn - 4); }
            else { base = Vd; H = DILH; head0 = 4 * (pn - 12); }
            const int d0 = 32 * (wc & 1) + 8 * fq;
#pragma unroll
            for (int ai = 0; ai < 2; ++ai)
#pragma unroll
                for (int m = 0; m < 4; ++m) { const int s = (row0 + ai * 128 + m * 16) & (SEQ - 1);
#pragma unroll
                    for (int bj = 0; bj < 2; ++bj) { const int head = head0 + 2 * bj + (wc >> 1);
                        const pf4 v0 = acc[ai][bj][m][0] * sc, v1 = acc[ai][bj][m][1] * sc;
                        v4u w; w.x = pk2(v0[0], v0[1]); w.y = pk2(v0[2], v0[3]); w.z = pk2(v1[0], v1[1]); w.w = pk2(v1[2], v1[3]);
                        *(GAS v4u*)(base + ((size_t)(b * H + head) * SEQ + s) * 64 + d0) = w; } }
        } else if (pn < 12) {
            bf16* base; int head0; float sc = 1.f;
            if (pn < 9) { base = Qd; head0 = 4 * (pn - 6); sc = C2; } else { base = Kd; head0 = 4 * (pn - 9); }
            const int j4 = 4 * (4 * (wc & 1) + fq);
#pragma unroll
            for (int ai = 0; ai < 2; ++ai) {
                pf4 csv[4], snv[4];
#pragma unroll
                for (int m = 0; m < 4; ++m) { const int s = (row0 + ai * 128 + m * 16) & (SEQ - 1); csv[m] = *(const GAS pf4*)(ropeC + s * 32 + j4); snv[m] = *(const GAS pf4*)(ropeS + s * 32 + j4); }
                __builtin_amdgcn_sched_barrier(0);
#pragma unroll
                for (int m = 0; m < 4; ++m) { const int s = (row0 + ai * 128 + m * 16) & (SEQ - 1);
                    const pf4 cs = csv[m] * sc, sn = snv[m] * sc;
#pragma unroll
                    for (int bj = 0; bj < 2; ++bj) { const int head = head0 + 2 * bj + (wc >> 1);
                        const pf4 x1 = acc[ai][bj][m][0], x2 = acc[ai][bj][m][1];
                        const pf4 o1 = x1 * cs - x2 * sn, o2 = x1 * sn + x2 * cs;
                        bf16* p = base + ((size_t)(b * DILH + head) * SEQ + s) * 64 + j4;
                        v2u w1, w2; w1.x = pk2(o1[0], o1[1]); w1.y = pk2(o1[2], o1[3]); w2.x = pk2(o2[0], o2[1]); w2.y = pk2(o2[2], o2[3]);
                        *(GAS v2u*)p = w1; *(GAS v2u*)(p + 32) = w2; } }
            }
        } else {
            bf16* base = pn < 19 ? Gsb : Gd; const int ct = (pn < 19 ? pn - 15 : pn - 19) * 256 + wc * 32 + 8 * fq;
#pragma unroll
            for (int ai = 0; ai < 2; ++ai)
#pragma unroll
                for (int m = 0; m < 4; ++m) { const size_t row = (size_t)(row0 + ai * 128 + m * 16);
#pragma unroll
                    for (int bj = 0; bj < 2; ++bj) { const pf4 v0 = acc[ai][bj][m][0], v1 = acc[ai][bj][m][1];
                        v4u w; w.x = pk2(sigmoidf_(v0[0]), sigmoidf_(v0[1])); w.y = pk2(sigmoidf_(v0[2]), sigmoidf_(v0[3]));
                        w.z = pk2(sigmoidf_(v1[0]), sigmoidf_(v1[1])); w.w = pk2(sigmoidf_(v1[2]), sigmoidf_(v1[3]));
                        *(GAS v4u*)(base + row * DM + ct + bj * 128) = w; } }
        }
    }
};
template <bool SECOND> struct EpiMerge {
    static constexpr bool PERM = true, AFTER_DRAIN = false;
    const bf16* G; bf16* Mg;
    __device__ __forceinline__ void operator()(const pf4 (&acc)[2][2][4][2], const pg8::Unit& u, int wr, int wc, int fr, int fq) const {
        const int row0 = u.pm * 256 + wr * 64 + fr, col0 = u.pn * 256 + wc * 32 + 8 * fq;
#pragma unroll
        for (int g2 = 0; g2 < 4; ++g2) {
            const int ai = g2 >> 1, mb = 2 * (g2 & 1);
            v4u gv[2][2], tv[2][2];
#pragma unroll
            for (int mm_ = 0; mm_ < 2; ++mm_) { const size_t off = (size_t)(row0 + ai * 128 + (mb + mm_) * 16) * DM + col0;
#pragma unroll
                for (int bj = 0; bj < 2; ++bj) { gv[mm_][bj] = *(const GAS v4u*)(G + off + bj * 128); if (SECOND) tv[mm_][bj] = *(const GAS v4u*)(Mg + off + bj * 128); } }
            __builtin_amdgcn_sched_barrier(0);
#pragma unroll
            for (int mm_ = 0; mm_ < 2; ++mm_) { const int m = mb + mm_; const size_t off = (size_t)(row0 + ai * 128 + m * 16) * DM + col0;
#pragma unroll
                for (int bj = 0; bj < 2; ++bj) { const v4u g = gv[mm_][bj];
                    pf4 v0 = acc[ai][bj][m][0], v1 = acc[ai][bj][m][1];
                    v0[0] *= bflo(g.x); v0[1] *= bfhi(g.x); v0[2] *= bflo(g.y); v0[3] *= bfhi(g.y); v1[0] *= bflo(g.z); v1[1] *= bfhi(g.z); v1[2] *= bflo(g.w); v1[3] *= bfhi(g.w);
                    if (SECOND) { const v4u t = tv[mm_][bj];
                        v0[0] += bflo(t.x); v0[1] += bfhi(t.x); v0[2] += bflo(t.y); v0[3] += bfhi(t.y); v1[0] += bflo(t.z); v1[1] += bfhi(t.z); v1[2] += bflo(t.w); v1[3] += bfhi(t.w); }
                    v4u w; w.x = pk2(v0[0], v0[1]); w.y = pk2(v0[2], v0[3]); w.z = pk2(v1[0], v1[1]); w.w = pk2(v1[2], v1[3]);
                    *(GAS v4u*)(Mg + off + bj * 128) = w; } }
            __builtin_amdgcn_sched_barrier(0);
        }
    }
};
struct EpiOut {
    static constexpr bool PERM = true, AFTER_DRAIN = false;
    const float* x; float* x1; bf16* x1m; float* ssq; const float* mod; const float* g_ffn;
    __device__ __forceinline__ void operator()(const pf4 (&acc)[2][2][4][2], const pg8::Unit& u, int wr, int wc, int fr, int fq) const {
        const int row0 = u.pm * 256 + wr * 64 + fr, col0 = u.pn * 256 + wc * 32 + 8 * fq;
        const int b = (u.pm * 256) >> 13; const float* mb = mod + (size_t)b * NMOD;
        pf4 gt[2][2], mm[2][2];
#pragma unroll
        for (int bj = 0; bj < 2; ++bj)
#pragma unroll
            for (int n = 0; n < 2; ++n) { const int c = col0 + bj * 128 + 4 * n; gt[bj][n] = *(const GAS pf4*)(mb + 2 * DM + c);
                mm[bj][n] = *(const GAS pf4*)(g_ffn + c) * (*(const GAS pf4*)(mb + 4 * DM + c) + 1.0f); }
#pragma unroll
        for (int g2 = 0; g2 < 4; ++g2) {
            const int ai = g2 >> 1, mb = 2 * (g2 & 1);
            pf4 xa[2][2][2];
#pragma unroll
            for (int mm_ = 0; mm_ < 2; ++mm_) { const size_t off = (size_t)(row0 + ai * 128 + (mb + mm_) * 16) * DM + col0;
#pragma unroll
                for (int bj = 0; bj < 2; ++bj) { xa[mm_][bj][0] = *(const GAS pf4*)(x + off + bj * 128); xa[mm_][bj][1] = *(const GAS pf4*)(x + off + bj * 128 + 4); } }
            __builtin_amdgcn_sched_barrier(0);
#pragma unroll
            for (int mm_ = 0; mm_ < 2; ++mm_) { const int m = mb + mm_; const int row = row0 + ai * 128 + m * 16; const size_t off = (size_t)row * DM + col0; float s = 0.f;
#pragma unroll
                for (int bj = 0; bj < 2; ++bj) {
                    const pf4 y0 = xa[mm_][bj][0] + gt[bj][0] * acc[ai][bj][m][0], y1 = xa[mm_][bj][1] + gt[bj][1] * acc[ai][bj][m][1];
                    *(GAS pf4*)(x1 + off + bj * 128) = y0; *(GAS pf4*)(x1 + off + bj * 128 + 4) = y1;
                    s += (y0[0] * y0[0] + y0[1] * y0[1]) + (y0[2] * y0[2] + y0[3] * y0[3]) + (y1[0] * y1[0] + y1[1] * y1[1]) + (y1[2] * y1[2] + y1[3] * y1[3]);
                    const pf4 z0 = y0 * mm[bj][0], z1 = y1 * mm[bj][1];
                    v4u w; w.x = pk2(z0[0], z0[1]); w.y = pk2(z0[2], z0[3]); w.z = pk2(z1[0], z1[1]); w.w = pk2(z1[2], z1[3]);
                    *(GAS v4u*)(x1m + off + bj * 128) = w; }
                s += __shfl_xor(s, 16); s += __shfl_xor(s, 32);
                if (fq == 0) ssq[(size_t)row * 16 + 4 * u.pn + wc] = s; }
        }
    }
};
struct EpiPq {
    static constexpr bool PERM = true, AFTER_DRAIN = false;
    const float* ssq; const float* bias; bf16* Q; float* r2out;
    __device__ __forceinline__ void operator()(const pf4 (&acc)[2][2][4][2], const pg8::Unit& u, int wr, int wc, int fr, int fq) const {
        const int row0 = u.pm * 256 + wr * 64 + fr, col0 = u.pn * 256 + wc * 32 + 8 * fq;
        const int b = (u.pm * 256) >> 13; const float* bb = bias + (size_t)b * 2048;
        pf4 bv[2][2];
#pragma unroll
        for (int bj = 0; bj < 2; ++bj)
#pragma unroll
            for (int n = 0; n < 2; ++n) bv[bj][n] = *(const GAS pf4*)(bb + col0 + bj * 128 + 4 * n);
#pragma unroll
        for (int g2 = 0; g2 < 4; ++g2) {
            const int ai = g2 >> 1, mb = 2 * (g2 & 1);
            pf4 st[2][4];
#pragma unroll
            for (int mm_ = 0; mm_ < 2; ++mm_) { const GAS pf4* sp = (const GAS pf4*)(ssq + (size_t)(row0 + ai * 128 + (mb + mm_) * 16) * 16);
#pragma unroll
                for (int k = 0; k < 4; ++k) st[mm_][k] = sp[k]; }
            __builtin_amdgcn_sched_barrier(0);
#pragma unroll
            for (int mm_ = 0; mm_ < 2; ++mm_) { const int m = mb + mm_; const int row = row0 + ai * 128 + m * 16;
                const pf4 s4 = (st[mm_][0] + st[mm_][1]) + (st[mm_][2] + st[mm_][3]);
                const float r2 = 1.0f / sqrtf(((s4[0] + s4[1]) + (s4[2] + s4[3])) * (1.f / DM) + EPS);
                if (u.pn == 0 && wc == 0 && fq == 0) r2out[row] = r2;
#pragma unroll
                for (int bj = 0; bj < 2; ++bj) { const pf4 v0 = acc[ai][bj][m][0] * r2 + bv[bj][0], v1 = acc[ai][bj][m][1] * r2 + bv[bj][1];
                    v4u w; w.x = pk2(v0[0], v0[1]); w.y = pk2(v0[2], v0[3]); w.z = pk2(v1[0], v1[1]); w.w = pk2(v1[2], v1[3]);
                    *(GAS v4u*)(Q + (size_t)row * 2048 + col0 + bj * 128) = w; } }
        }
    }
};

constexpr int VSTR = 144;
constexpr int ATT_WAVE_LDS = 2 * 32 * VSTR;
__device__ __forceinline__ int kappa(int r) { return (((r >> 2) & 1) << 4) + ((r >> 3) << 2) + (r & 3); }
struct KVTile { v4u k[4]; v4u v[4]; };
typedef short v4i16_t __attribute__((ext_vector_type(4)));
__device__ __forceinline__ s16x4 vtr(const LAS unsigned char* p) { return __builtin_bit_cast(s16x4, __builtin_amdgcn_ds_read_tr16_b64_v4i16((LAS v4i16_t*)p)); }

__device__ __forceinline__ void kv_load(KVTile& t, const bf16* Kh, const bf16* Vh, int base_tok, int sshift, int lane) {
#pragma unroll
    for (int i = 0; i < 4; ++i) { const size_t off = (size_t)(base_tok + (((lane >> 3) + 8 * i) << sshift)) * 64 + 8 * (lane & 7);
        t.k[i] = *(const GAS v4u*)(Kh + off); t.v[i] = *(const GAS v4u*)(Vh + off); }
}
__device__ __forceinline__ void v_to_lds(const KVTile& t, LAS unsigned char* vl, int lane) {
#pragma unroll
    for (int i = 0; i < 4; ++i) { const int o = ((lane >> 3) + 8 * i) * VSTR + 16 * (lane & 7); *(LAS v4u*)(vl + o) = t.k[i]; *(LAS v4u*)(vl + 32 * VSTR + o) = t.v[i]; }
}
__device__ __forceinline__ f32x16 qk_tile(const LAS unsigned char* vl, const bf16x8 (&qf)[4], int lane) {
    const LAS unsigned char* kp = vl + kappa(lane & 31) * VSTR + 16 * (lane >> 5);
    f32x16 s = {};
#pragma unroll
    for (int st = 0; st < 4; ++st) s = __builtin_amdgcn_mfma_f32_32x32x16_bf16(*(const LAS bf16x8*)(kp + 32 * st), qf[st], s, 0, 0, 0);
    return s;
}
__device__ __forceinline__ void pv_tile(f32x16& o0, f32x16& o1, const float (&p)[16], const LAS unsigned char* vl, int lane) {
    const int g = lane >> 4, li = lane & 15, q = li >> 2, pp = li & 3, h = g >> 1;
    const LAS unsigned char* tb = vl + 32 * VSTR + (16 * h + q) * VSTR + (16 * (g & 1) + 4 * pp) * 2;
    bf16x8 pf[2];
#pragma unroll
    for (int st = 0; st < 2; ++st) { v4u w; w.x = pk2(p[8 * st + 0], p[8 * st + 1]); w.y = pk2(p[8 * st + 2], p[8 * st + 3]); w.z = pk2(p[8 * st + 4], p[8 * st + 5]); w.w = pk2(p[8 * st + 6], p[8 * st + 7]); pf[st] = __builtin_bit_cast(bf16x8, w); }
#pragma unroll
    for (int db = 0; db < 2; ++db)
#pragma unroll
        for (int st = 0; st < 2; ++st) {
            const s16x4 lo = vtr(tb + (8 * st) * VSTR + 64 * db), hi = vtr(tb + (8 * st + 4) * VSTR + 64 * db);
            const bf16x8 vf = (bf16x8){lo[0], lo[1], lo[2], lo[3], hi[0], hi[1], hi[2], hi[3]};
            if (db == 0) o0 = __builtin_amdgcn_mfma_f32_32x32x16_bf16(vf, pf[st], o0, 0, 0, 0);
            else         o1 = __builtin_amdgcn_mfma_f32_32x32x16_bf16(vf, pf[st], o1, 0, 0, 0);
        }
}
__device__ __forceinline__ void o_store(bf16* orow, const f32x16& o0, const f32x16& o1, float sc, int hC) {
#pragma unroll
    for (int a = 0; a < 4; ++a) {
        v2u w0, w1; w0.x = pk2(o0[4 * a] * sc, o0[4 * a + 1] * sc); w0.y = pk2(o0[4 * a + 2] * sc, o0[4 * a + 3] * sc);
        w1.x = pk2(o1[4 * a] * sc, o1[4 * a + 1] * sc); w1.y = pk2(o1[4 * a + 2] * sc, o1[4 * a + 3] * sc);
        *(GAS v2u*)(orow + 8 * a + 4 * hC) = w0; *(GAS v2u*)(orow + 32 + 8 * a + 4 * hC) = w1; }
}

__device__ __forceinline__ void sb_task(const bf16* Qsb, const bf16* Ksb, const bf16* Vsb, bf16* Osb, int task, LAS unsigned char* vl, int lane) {
    const int qt = task & 255, bh = task >> 8, b = bh >> 3, h = bh & 7, t0 = qt * 32;
    const int q = lane & 31, hC = lane >> 5;
    const bf16* Kh = Ksb + (size_t)bh * SEQ * 64; const bf16* Vh = Vsb + (size_t)bh * SEQ * 64;
    bf16x8 qf[4];
    { const bf16* qp = Qsb + ((size_t)bh * SEQ + t0 + q) * 64 + 8 * hC;
#pragma unroll
      for (int st = 0; st < 4; ++st) qf[st] = *(const GAS bf16x8*)(qp + 16 * st); }
    f32x16 o0 = {}, o1 = {}; float carry = 0.f;
    KVTile nxt; kv_load(nxt, Kh, Vh, t0, 0, lane);
    for (int k0 = t0;; k0 -= 32) {
        KVTile cur = nxt;
        const bool more = k0 >= 32;
        if (more) kv_load(nxt, Kh, Vh, k0 - 32, 0, lane);
        v_to_lds(cur, vl, lane);
        const f32x16 s = qk_tile(vl, qf, lane);
        const bool diag = (k0 == t0);
        float L[16], z[16];
#pragma unroll
        for (int r = 0; r < 16; ++r) { z[r] = __builtin_amdgcn_fmed3f(s[r], -120.f, 120.f); const float e = fast_exp2(z[r]); L[r] = -fast_log2(1.f + e);
            if (diag && !(16 * hC + r < q)) L[r] = 0.f; }
        float c[16]; c[15] = L[15];
#pragma unroll
        for (int r = 14; r >= 0; --r) c[r] = c[r + 1] + L[r];
        const float tot = c[0], oth = __shfl_xor(tot, 32);
        const float base = carry + (hC ? 0.f : oth);
        float p[16];
#pragma unroll
        for (int r = 0; r < 16; ++r) { p[r] = fast_exp2(z[r] + (base + c[r])); if (diag && !(16 * hC + r < q)) p[r] = 0.f; }
        carry += tot + oth;
        pv_tile(o0, o1, p, vl, lane);
        if (!more) break;
        if (__all(carry < -160.f)) break;
    }
    o_store(Osb + ((size_t)(b * SEQ + t0 + q)) * 512 + h * 64, o0, o1, 1.f, hC);
}

__device__ __forceinline__ void dil_group(f32x16& o0, f32x16& o1, float& mrun, float& lsum, const bf16x8 (&qf)[4], const bf16* Kh, const bf16* Vh,
                                          int uq, int u_hi, int u_lo, int rs, int rho_g, LAS unsigned char* vl, int lane) {
    const int hC = lane >> 5;
    const int ub_last = u_lo & ~31;
    int ub = u_hi & ~31;
    KVTile nxt; kv_load(nxt, Kh, Vh, (ub << rs) + rho_g, rs, lane);
    for (;; ub -= 32) {
        KVTile cur = nxt;
        const bool more = ub > ub_last;
        if (more) kv_load(nxt, Kh, Vh, ((ub - 32) << rs) + rho_g, rs, lane);
        v_to_lds(cur, vl, lane);
        const f32x16 s = qk_tile(vl, qf, lane);
        float z[16]; float tmax = -1e30f;
        const int d0 = uq - (ub + 16 * hC);
#pragma unroll
        for (int r = 0; r < 16; ++r) { const bool valid = (unsigned)(d0 - r) <= 128u; z[r] = valid ? s[r] : -1e30f; tmax = fmaxf(tmax, z[r]); }
        tmax = fmaxf(tmax, __shfl_xor(tmax, 32));
        const float mnew = fmaxf(mrun, tmax); const float alpha = fast_exp2(mrun - mnew); mrun = mnew;
        float p[16]; float ps = 0.f;
#pragma unroll
        for (int r = 0; r < 16; ++r) { p[r] = (z[r] > -1e29f) ? fast_exp2(z[r] - mnew) : 0.f; ps += p[r]; }
        lsum = lsum * alpha + ps;
        if (!__all(alpha == 1.0f)) {
#pragma unroll
            for (int r = 0; r < 16; ++r) { o0[r] *= alpha; o1[r] *= alpha; }
        }
        pv_tile(o0, o1, p, vl, lane);
        if (!more) break;
    }
}
__device__ __forceinline__ void dil_g0_task(const bf16* Qd, const bf16* Kd, const bf16* Vd, bf16* PO, float* PM, int task, LAS unsigned char* vl, int lane) {
    const int qt = task & 255, hg = (task >> 8) & 3, b = task >> 10;
    const int q = lane & 31, hC = lane >> 5, t0 = 32 * qt, tq = t0 + q;
    f32x16 o0 = {}, o1 = {}; float mrun = -1e30f, lsum = 0.f;
    bf16x8 qf[4];
    { const bf16* qp = Qd + ((size_t)(b * DILH + hg) * SEQ + tq) * 64 + 8 * hC;
#pragma unroll
      for (int st = 0; st < 4; ++st) qf[st] = *(const GAS bf16x8*)(qp + 16 * st); }
    const bf16* Kh = Kd + (size_t)(b * DILH + hg) * SEQ * 64; const bf16* Vh = Vd + (size_t)(b * DILH + hg) * SEQ * 64;
    dil_group(o0, o1, mrun, lsum, qf, Kh, Vh, tq, t0 + 31, t0 >= 128 ? t0 - 128 : 0, 0, 0, vl, lane);
    const float l = lsum + __shfl_xor(lsum, 32);
    o_store(PO + (size_t)(b * SEQ + tq) * 256 + hg * 64, o0, o1, 1.0f, hC);
    if (hC == 0) *(GAS f32x2_t*)(PM + ((size_t)(b * SEQ + tq) * 4 + hg) * 2) = (f32x2_t){mrun, l};
}
__device__ __forceinline__ void dil_task(const bf16* Qd, const bf16* Kd, const bf16* Vd, const bf16* PO, const float* PM, bf16* Od, int task, LAS unsigned char* vl, int lane) {
    const int it = task & 15, rho = (task >> 4) & 15, hg = (task >> 8) & 3, b = task >> 10;
    const int q = lane & 31, hC = lane >> 5, i0 = 32 * it;
    const int tq = 16 * (i0 + q) + rho;
    f32x16 o0 = {}, o1 = {}; float mrun = -1e30f, lsum = 0.f;
#pragma unroll
    for (int g = 1; g < 3; ++g) {
        bf16x8 qf[4];
        { const bf16* qp = Qd + ((size_t)(b * DILH + g * 4 + hg) * SEQ + tq) * 64 + 8 * hC;
#pragma unroll
          for (int st = 0; st < 4; ++st) qf[st] = *(const GAS bf16x8*)(qp + 16 * st); }
        const int rs = 2 * g, cg = 16 >> rs, rho_g = rho & ((1 << rs) - 1), og = rho >> rs;
        const bf16* Kh = Kd + (size_t)(b * DILH + g * 4 + hg) * SEQ * 64; const bf16* Vh = Vd + (size_t)(b * DILH + g * 4 + hg) * SEQ * 64;
        int u_lo = cg * i0 + og - 128; u_lo = u_lo < 0 ? 0 : u_lo;
        dil_group(o0, o1, mrun, lsum, qf, Kh, Vh, cg * (i0 + q) + og, cg * (i0 + 31) + og, u_lo, rs, rho_g, vl, lane);
    }
    float l = lsum + __shfl_xor(lsum, 32);
    const f32x2_t ml = *(const GAS f32x2_t*)(PM + ((size_t)(b * SEQ + tq) * 4 + hg) * 2);
    const float mn = fmaxf(mrun, ml.x), sa = fast_exp2(mrun - mn), sb = fast_exp2(ml.x - mn);
    l = l * sa + ml.y * sb;
    const bf16* pr = PO + (size_t)(b * SEQ + tq) * 256 + hg * 64;
#pragma unroll
    for (int a = 0; a < 4; ++a) { const v2u w0 = *(const GAS v2u*)(pr + 8 * a + 4 * hC), w1 = *(const GAS v2u*)(pr + 32 + 8 * a + 4 * hC);
        o0[4 * a] = o0[4 * a] * sa + bflo(w0.x) * sb; o0[4 * a + 1] = o0[4 * a + 1] * sa + bfhi(w0.x) * sb; o0[4 * a + 2] = o0[4 * a + 2] * sa + bflo(w0.y) * sb; o0[4 * a + 3] = o0[4 * a + 3] * sa + bfhi(w0.y) * sb;
        o1[4 * a] = o1[4 * a] * sa + bflo(w1.x) * sb; o1[4 * a + 1] = o1[4 * a + 1] * sa + bfhi(w1.x) * sb; o1[4 * a + 2] = o1[4 * a + 2] * sa + bflo(w1.y) * sb; o1[4 * a + 3] = o1[4 * a + 3] * sa + bfhi(w1.y) * sb; }
    o_store(Od + (size_t)(b * SEQ + tq) * 256 + hg * 64, o0, o1, 1.0f / l, hC);
}

__device__ __forceinline__ void p3_attention(const Args& A, Frame& F, int pass) {
    unsigned char* ws = A.ws;
    LAS unsigned char* vl = F.lds + F.wave * ATT_WAVE_LDS;
    const bf16 *Qsb = (const bf16*)(ws + A_QSB), *Ksb = (const bf16*)(ws + A_KSB), *Vsb = (const bf16*)(ws + A_VSB);
    const bf16 *Qd = (const bf16*)(ws + A_QD), *Kd = (const bf16*)(ws + A_KD), *Vd = (const bf16*)(ws + A_VD);
    bf16* Osb = (bf16*)((unsigned char*)A.out + O_OSB); bf16* Od = (bf16*)((unsigned char*)A.out + O_OD);
    bf16* PO = (bf16*)((unsigned char*)A.out + O_PO); float* PM = (float*)(ws + WS_SSQ);
    constexpr int N_DIL = NB * 4 * 16 * 16, N_SB = NB * SBH * (SEQ / 32);
    if (pass == 0) {
        for (int t = F.gw; t < N_DIL + N_SB; t += F.NGW) {
            if (t < N_DIL) dil_g0_task(Qd, Kd, Vd, PO, PM, t, vl, F.lane);
            else sb_task(Qsb, Ksb, Vsb, Osb, t - N_DIL, vl, F.lane);
        }
    } else {
        for (int t = F.gw; t < N_DIL; t += F.NGW) dil_task(Qd, Kd, Vd, PO, PM, Od, t, vl, F.lane);
    }
}

__device__ __forceinline__ unsigned sortable(float f) { const unsigned u = __float_as_uint(f); return u ^ ((unsigned)((int)u >> 31) | 0x80000000u); }
__device__ __forceinline__ float unsortable(unsigned s) { const unsigned u = (s & 0x80000000u) ? (s ^ 0x80000000u) : ~s; return __uint_as_float(u); }
__device__ __forceinline__ unsigned umax_(unsigned a, unsigned b) { return a > b ? a : b; }

#define CE_(a, b) do { const unsigned hi_ = umax_(a, b), lo_ = umin_(a, b); a = hi_; b = lo_; } while (0)
__device__ __forceinline__ unsigned umin_(unsigned a, unsigned b) { return a < b ? a : b; }
template <int N, int OFF, int TOT> __device__ __forceinline__ void bitonic_sort_desc(unsigned (&v)[TOT]) {
#pragma unroll
    for (int k = 2; k <= N; k <<= 1)
#pragma unroll
        for (int j = k >> 1; j > 0; j >>= 1)
#pragma unroll
            for (int i = 0; i < N; ++i) { const int l = i ^ j; if (l > i) { if ((i & k) == 0) CE_(v[OFF + i], v[OFF + l]); else CE_(v[OFF + l], v[OFF + i]); } }
}
__device__ __forceinline__ void bitonic_merge16_desc(unsigned (&t)[16]) {
#pragma unroll
    for (int j = 8; j > 0; j >>= 1)
#pragma unroll
        for (int i = 0; i < 16; ++i) { const int l = i ^ j; if (l > i) CE_(t[i], t[l]); }
}
__device__ __forceinline__ void merge_top16(unsigned (&out)[16], const unsigned* a, const unsigned* b) {
#pragma unroll
    for (int i = 0; i < 16; ++i) out[i] = umax_(a[i], b[15 - i]);
    bitonic_merge16_desc(out);
}
__device__ __forceinline__ void cross_lane_top16(unsigned (&top)[16]) {
    unsigned t[16];
#pragma unroll
    for (int i = 0; i < 16; ++i) t[i] = umax_(top[i], (unsigned)__shfl_xor((int)top[15 - i], 32));
    bitonic_merge16_desc(t);
#pragma unroll
    for (int i = 0; i < 16; ++i) top[i] = t[i];
}
__device__ __forceinline__ void top16_of_128(unsigned (&key)[64], LAS unsigned* top  , int lane) {
    bitonic_sort_desc<16, 0, 64>(key); bitonic_sort_desc<16, 16, 64>(key); bitonic_sort_desc<16, 32, 64>(key); bitonic_sort_desc<16, 48, 64>(key);
    unsigned m0[16], m1[16], m[16];
    merge_top16(m0, &key[0], &key[16]); merge_top16(m1, &key[32], &key[48]); merge_top16(m, m0, m1);
    cross_lane_top16(m);
#pragma unroll
    for (int it = 0; it < 16; ++it) top[it * 32 + (lane & 31)] = m[it];
}
__device__ __forceinline__ unsigned pk_lookup(unsigned p0, unsigned p1, unsigned p2, unsigned p3, unsigned a) {
    const unsigned hi = a >> 2; unsigned d = p0; d = hi == 1 ? p1 : d; d = hi == 2 ? p2 : d; d = hi == 3 ? p3 : d;
    return (d >> (8 * (a & 3))) & 0xffu;
}
__device__ __forceinline__ unsigned pack4idx(unsigned t0, unsigned t1, unsigned t2, unsigned t3) { return (127u - (t0 & 127u)) | ((127u - (t1 & 127u)) << 8) | ((127u - (t2 & 127u)) << 16) | ((127u - (t3 & 127u)) << 24); }

constexpr int P7_KSTR = 272, P7_KEYS_BYTES = 256 * P7_KSTR, P7_TL_WAVE = 4096;
__device__ __forceinline__ void topk_phase(const bf16* Qp, const bf16* Kb, unsigned short* IDX, float* GATE, Frame& F) {
    const int lane = F.lane, q = lane & 31, hC = lane >> 5;
    LAS unsigned char* kl = F.lds;
    LAS unsigned* tl = (LAS unsigned*)(F.lds + P7_KEYS_BYTES + F.wave * P7_TL_WAVE);
    const int t0 = (F.vcu * 4 + (F.wave & 3)) * 32, hsel = F.wave >> 2;
#pragma unroll 1
  for (int rnd = 0; rnd < 4; ++rnd) {
    const int ph = 2 * rnd + hsel;
#pragma unroll 1
    for (int half = 0; half < 2; ++half) {
        __syncthreads();
#pragma unroll
        for (int i = 0; i < 8; ++i) { const int idx = F.tid + 512 * i, row = idx >> 4, ch = idx & 15;
            const v4u w = *(const GAS v4u*)(Kb + ((size_t)((2 * rnd + (row >> 7)) * 2 + half) * 128 + (row & 127)) * 128 + 8 * ch);
            *(LAS v4u*)(kl + row * P7_KSTR + 16 * ch) = w; }
        bf16x8 qf[8];
        { const bf16* qp = Qp + (size_t)(t0 + q) * 2048 + ph * 256 + half * 128 + 8 * hC;
#pragma unroll
          for (int st = 0; st < 8; ++st) qf[st] = *(const GAS bf16x8*)(qp + 16 * st); }
        __syncthreads();
        f32x16 C[4] = {};
        const LAS unsigned char* kb = kl + (hsel * 128 + q) * P7_KSTR + 16 * hC;
#pragma unroll
        for (int st = 0; st < 8; ++st)
#pragma unroll
            for (int mt = 0; mt < 4; ++mt) C[mt] = __builtin_amdgcn_mfma_f32_32x32x16_bf16(*(const LAS bf16x8*)(kb + mt * 32 * P7_KSTR + 32 * st), qf[st], C[mt], 0, 0, 0);
        unsigned key[64];
#pragma unroll
        for (int mt = 0; mt < 4; ++mt)
#pragma unroll
            for (int r = 0; r < 16; ++r) { const int kidx = 32 * mt + (r & 3) + 8 * (r >> 2) + 4 * hC; key[16 * mt + r] = (sortable(C[mt][r]) & ~127u) | (unsigned)(127 - kidx); }
        top16_of_128(key, tl + half * 512, lane);
    }
    unsigned tops[2][16];
#pragma unroll
    for (int a = 0; a < 16; ++a) { tops[0][a] = tl[a * 32 + q]; tops[1][a] = tl[512 + a * 32 + q]; }
    float s0[16], s1[16];
#pragma unroll
    for (int a = 0; a < 16; ++a) { s0[a] = unsortable(tops[0][a] & ~127u); s1[a] = unsortable(tops[1][a] & ~127u); }
    const unsigned pa0 = pack4idx(tops[0][0], tops[0][1], tops[0][2], tops[0][3]), pa1 = pack4idx(tops[0][4], tops[0][5], tops[0][6], tops[0][7]),
                   pa2 = pack4idx(tops[0][8], tops[0][9], tops[0][10], tops[0][11]), pa3 = pack4idx(tops[0][12], tops[0][13], tops[0][14], tops[0][15]);
    const unsigned pb0 = pack4idx(tops[1][0], tops[1][1], tops[1][2], tops[1][3]), pb1 = pack4idx(tops[1][4], tops[1][5], tops[1][6], tops[1][7]),
                   pb2 = pack4idx(tops[1][8], tops[1][9], tops[1][10], tops[1][11]), pb3 = pack4idx(tops[1][12], tops[1][13], tops[1][14], tops[1][15]);
    unsigned cand[32];
    {
        int n = 0;
#pragma unroll
        for (int a = 0; a < 16; ++a)
#pragma unroll
            for (int bq = 0; bq < 16; ++bq) if ((a + 1) * (bq + 1) <= 16) {
                const unsigned ck = (sortable(s0[a] + s1[bq]) & ~255u) | (unsigned)(a * 16 + bq);
                if (n < 25) cand[n] = ck; else cand[n - 25] = hC ? ck : cand[n - 25];
                ++n; }
#pragma unroll
        for (int i = 25; i < 32; ++i) cand[i] = 0u;
    }
    bitonic_sort_desc<32, 0, 32>(cand);
    unsigned win[16];
#pragma unroll
    for (int i = 0; i < 16; ++i) win[i] = cand[i];
    cross_lane_top16(win);
    float gv[16]; int eid[16]; float gs = 0.f;
    const float vmax = unsortable(win[0] & ~255u);
#pragma unroll
    for (int k = 0; k < 16; ++k) { const unsigned a = (win[k] >> 4) & 15u, bq = win[k] & 15u;
        eid[k] = (int)(pk_lookup(pa0, pa1, pa2, pa3, a) * 128u + pk_lookup(pb0, pb1, pb2, pb3, bq));
        gv[k] = fast_exp2((unsortable(win[k] & ~255u) - vmax) * LOG2E); gs += gv[k]; }
    const float ginv = 1.0f / gs;
#ifdef P7_TIME_SORT
    { const unsigned long long t1_ = __builtin_amdgcn_s_memrealtime(); while (__builtin_amdgcn_s_memrealtime() - t1_ < 4ull * tsort) __builtin_amdgcn_s_sleep(1); }
#endif
    const size_t o = (size_t)(t0 + q) * 128 + ph * 16;
    if (hC == 0) {
#pragma unroll
        for (int k = 0; k < 16; k += 8) *(GAS v4u*)(IDX + o + k) = (v4u){(unsigned)eid[k] | ((unsigned)eid[k + 1] << 16), (unsigned)eid[k + 2] | ((unsigned)eid[k + 3] << 16),
                                                                         (unsigned)eid[k + 4] | ((unsigned)eid[k + 5] << 16), (unsigned)eid[k + 6] | ((unsigned)eid[k + 7] << 16)};
    } else {
#pragma unroll
        for (int k = 0; k < 16; k += 4) *(GAS f32x4*)(GATE + o + k) = (f32x4){gv[k] * ginv, gv[k + 1] * ginv, gv[k + 2] * ginv, gv[k + 3] * ginv};
    }
  }
}

__device__ __forceinline__ float gelu_tanh(float x) {
    const float y2 = 2.0f * 0.7978845608028654f * (x + 0.044715f * x * x * x);
    return x * fast_rcp(1.f + fast_exp2(-y2 * LOG2E));
}
__device__ __forceinline__ void unpack8(const v4u w, float (&f)[8]) { f[0] = bflo(w.x); f[1] = bfhi(w.x); f[2] = bflo(w.y); f[3] = bfhi(w.y); f[4] = bflo(w.z); f[5] = bfhi(w.z); f[6] = bflo(w.w); f[7] = bfhi(w.w); }
__device__ __forceinline__ void h2q_row(unsigned char* ws, int t, int lane) {
    const bf16* xr = (const bf16*)(ws + A_X1M) + (size_t)t * DM + 16 * lane; const float* sh = (const float*)(ws + WS_MOD) + (size_t)(t >> 13) * NMOD + 3 * DM + 16 * lane;
    const float r2 = ((const float*)(ws + WS_R2))[t];
    float fa[8], fb[8]; unpack8(*(const GAS v4u*)xr, fa); unpack8(*(const GAS v4u*)(xr + 8), fb);
    float h[16]; float m = 0.f;
#pragma unroll
    for (int k = 0; k < 2; ++k) { const f32x4 s0 = *(const GAS f32x4*)(sh + 4 * k), s1 = *(const GAS f32x4*)(sh + 8 + 4 * k);
#pragma unroll
        for (int i = 0; i < 4; ++i) { h[4 * k + i] = fa[4 * k + i] * r2 + s0[i]; h[8 + 4 * k + i] = fb[4 * k + i] * r2 + s1[i]; m = fmaxf(m, fmaxf(fabsf(h[4 * k + i]), fabsf(h[8 + 4 * k + i]))); } }
#pragma unroll
    for (int o = 1; o < 64; o <<= 1) m = fmaxf(m, __shfl_xor(m, o));
    m = fmaxf(m, 1e-30f);
    const float sc = 127.0f / m;
    unsigned w[4];
#pragma unroll
    for (int j = 0; j < 4; ++j) { unsigned ww = 0;
#pragma unroll
        for (int i = 0; i < 4; ++i) { const int qv = (int)__builtin_rintf(h[4 * j + i] * sc); ww |= ((unsigned)qv & 0xffu) << (8 * i); }
        w[j] = ww; }
    *(GAS v4u*)(ws + A_H2Q + (size_t)t * DM + 16 * lane) = (v4u){w[0], w[1], w[2], w[3]};
    if (lane == 0) ((float*)(ws + WS_HINV))[t] = m * (1.0f / 127.0f);
}
__device__ __forceinline__ void unpack_fp8x16(const v4u w, float (&f)[16]) {
#pragma unroll
    for (int j = 0; j < 4; ++j) { const f32x2_t a = __builtin_amdgcn_cvt_pk_f32_fp8((int)w[j], false), b = __builtin_amdgcn_cvt_pk_f32_fp8((int)w[j], true);
        f[4 * j] = a.x; f[4 * j + 1] = a.y; f[4 * j + 2] = b.x; f[4 * j + 3] = b.y; }
}
__device__ __forceinline__ void peer_u_phase(const Args& A, Frame& F) {
    unsigned char* ws = A.ws;
    const int lane = F.lane, x = blockIdx.x & 7, wrk = (blockIdx.x >> 3) * NWAVES + F.wave, nwr = (F.G >> 3) * NWAVES, g = lane >> 3, c = lane & 7;
    const unsigned char* U8 = ws + WS_UB + (size_t)x * (2 * MiB); const unsigned c16 = 16u * c, g32 = 32u * g;
    const unsigned char* H2Q = ws + A_H2Q + 128 * x; const unsigned char* IDX = ws + A_IDX;
    bf16* PART = (bf16*)(ws + A_PART) + (size_t)x * TOK * 128;
    const int per = TOK / nwr, tb = wrk * per;
    v4u idC[2], idN[2], hC4;
#define SLOT_ID(ID, sl) (((ID)[(sl) >> 3][((sl) >> 1) & 3] >> (16 * ((sl) & 1))) & 0xffffu)
#define LD_TOK(ID, HV, T) do { const unsigned char* ib_ = IDX + (size_t)(T) * 256; ID[0] = *(const GAS v4u*)(ib_ + g32); ID[1] = *(const GAS v4u*)(ib_ + (g32 + 16u)); \
        HV = *(const GAS v4u*)(H2Q + (size_t)(T) * DM + c16); } while (0)
#define LD_ROWS(R, ID, H) do { _Pragma("unroll") for (int i = 0; i < 8; ++i) R[i] = *(const GAS v4u*)(U8 + (SLOT_ID(ID, 8 * (H) + i) * 128u + c16)); } while (0)
#define DOT16(R, HV) __builtin_amdgcn_sdot4((int)(R)[3], (int)(HV)[3], __builtin_amdgcn_sdot4((int)(R)[2], (int)(HV)[2], __builtin_amdgcn_sdot4((int)(R)[1], (int)(HV)[1], __builtin_amdgcn_sdot4((int)(R)[0], (int)(HV)[0], 0, false), false), false), false)
    v4u idD[2], hD4, hA4, hB4;
    v4u R0[8], R1[8], R2[8], R3[8];
    const int tl = tb + per - 1;
#define CL(T) ((T) <= tl ? (T) : tl)
#define REDUCE_STORE(PA, PB, T) do { int p_[16]; \
        _Pragma("unroll") for (int i = 0; i < 8; ++i) { p_[i] = PA[i]; p_[8 + i] = PB[i]; } \
        const bool b0 = lane & 1, b1 = lane & 2, b2 = lane & 4; int q8[8], q4[4], q2[2]; \
        _Pragma("unroll") for (int i = 0; i < 8; ++i) q8[i] = (b0 ? p_[8 + i] : p_[i]) + __shfl_xor(b0 ? p_[i] : p_[8 + i], 1); \
        _Pragma("unroll") for (int i = 0; i < 4; ++i) q4[i] = (b1 ? q8[4 + i] : q8[i]) + __shfl_xor(b1 ? q8[i] : q8[4 + i], 2); \
        _Pragma("unroll") for (int i = 0; i < 2; ++i) q2[i] = (b2 ? q4[2 + i] : q4[i]) + __shfl_xor(b2 ? q4[i] : q4[2 + i], 4); \
        *(GAS unsigned*)(PART + (size_t)(T) * 128 + slot) = pk2((float)q2[0], (float)q2[1]); } while (0)
    const int slot = 16 * g + 8 * (lane & 1) + 4 * ((lane >> 1) & 1) + 2 * ((lane >> 2) & 1);
    LD_TOK(idC, hA4, tb); LD_TOK(idN, hB4, CL(tb + 1));
    LD_ROWS(R0, idC, 0); LD_ROWS(R1, idC, 1);
    LD_TOK(idC, hC4, CL(tb + 2));
    LD_ROWS(R2, idN, 0); LD_ROWS(R3, idN, 1);
    LD_TOK(idD, hD4, CL(tb + 3));
    for (int t = tb; t < tb + per; t += 2) {
        int pa[8], pb[8];
#pragma unroll
        for (int i = 0; i < 8; ++i) { pa[i] = DOT16(R0[i], hA4); pb[i] = DOT16(R1[i], hA4); }
        LD_ROWS(R0, idC, 0); LD_ROWS(R1, idC, 1); hA4 = hC4;
        LD_TOK(idC, hC4, CL(t + 4));
        REDUCE_STORE(pa, pb, t);
#pragma unroll
        for (int i = 0; i < 8; ++i) { pa[i] = DOT16(R2[i], hB4); pb[i] = DOT16(R3[i], hB4); }
        LD_ROWS(R2, idD, 0); LD_ROWS(R3, idD, 1); hB4 = hD4;
        LD_TOK(idD, hD4, CL(t + 5));
        REDUCE_STORE(pa, pb, CL(t + 1));
    }
#undef CL
#undef REDUCE_STORE
#undef LD_TOK
#undef LD_ROWS
#undef SLOT_ID
#undef DOT16
}
__device__ __forceinline__ void peer_act_phase(const Args& A, Frame& F) {
    unsigned char* ws = A.ws;
    const bf16* PART = (const bf16*)(ws + A_PART); const unsigned short* IDX = (const unsigned short*)(ws + A_IDX); const float* GATE = (const float*)(ws + A_GATE); bf16* ACTG = (bf16*)(ws + A_ACTG);
    const float* UINV = (const float*)(ws + WS_UB + 16 * MiB); const float* VINV = (const float*)(ws + WS_VB + 16 * MiB); const float* HINV = (const float*)(ws + WS_HINV);
    const size_t n4 = (size_t)TOK * 128 / 4;
    for (size_t i = (size_t)F.vcu * (NWAVES * 64) + F.tid; i < n4; i += (size_t)F.G * NWAVES * 64) {
        f32x4 d = {0.f, 0.f, 0.f, 0.f};
#pragma unroll
        for (int xx = 0; xx < 8; ++xx) { const v2u w = *(const GAS v2u*)(PART + (size_t)xx * TOK * 128 + 4 * i); d[0] += bflo(w.x); d[1] += bfhi(w.x); d[2] += bflo(w.y); d[3] += bfhi(w.y); }
        const v2u ew = *(const GAS v2u*)(IDX + 4 * i); const f32x4 gt = *(const GAS f32x4*)(GATE + 4 * i);
        const unsigned e[4] = {ew.x & 0xffffu, ew.x >> 16, ew.y & 0xffffu, ew.y >> 16};
        float o[4];
        const float hs = HINV[i >> 5];
#pragma unroll
        for (int k = 0; k < 4; ++k) o[k] = gelu_tanh(d[k] * (UINV[e[k]] * hs)) * gt[k] * VINV[e[k]];
        *(GAS v2u*)(ACTG + 4 * i) = (v2u){pk2(o[0], o[1]), pk2(o[2], o[3])};
    }
}
__device__ __forceinline__ void peer_v_phase(const Args& A, Frame& F) {
    unsigned char* ws = A.ws;
    const int lane = F.lane, x = blockIdx.x & 7, wrk = (blockIdx.x >> 3) * NWAVES + F.wave, nwr = (F.G >> 3) * NWAVES, g = lane >> 3, c = lane & 7;
    const unsigned char* V8 = ws + WS_VB + (size_t)x * (2 * MiB); const unsigned c16 = 16u * c, g32 = 32u * g;
    const unsigned char* IDX = ws + A_IDX; const unsigned char* ACTG = ws + A_ACTG;
    LAS unsigned char* redw = F.lds + F.wave * 4096 + g * 512 + c * 64; const LAS unsigned char* redr = F.lds + F.wave * 4096 + 8 * lane;
    const int per = TOK / nwr, tb = wrk * per;
#define SLOT_ID(ID, sl) (((ID)[(sl) >> 3][((sl) >> 1) & 3] >> (16 * ((sl) & 1))) & 0xffffu)
#define SLOT_ACT(AV, sl) (((sl) & 1) ? bfhi((AV)[(sl) >> 3][((sl) >> 1) & 3]) : bflo((AV)[(sl) >> 3][((sl) >> 1) & 3]))
#define LD_TOK(ID, AV, T) do { const unsigned char* ib_ = IDX + (size_t)(T) * 256; const unsigned char* ab_ = ACTG + (size_t)(T) * 256; \
        ID[0] = *(const GAS v4u*)(ib_ + g32); ID[1] = *(const GAS v4u*)(ib_ + (g32 + 16u)); AV[0] = *(const GAS v4u*)(ab_ + g32); AV[1] = *(const GAS v4u*)(ab_ + (g32 + 16u)); } while (0)
#define LD_ROWS(R, ID, H) do { _Pragma("unroll") for (int i = 0; i < 8; ++i) R[i] = *(const GAS v4u*)(V8 + (SLOT_ID(ID, 8 * (H) + i) * 128u + c16)); } while (0)
    v4u id0[2], id1[2], id2[2], a0[2], a1[2], a2[2];
    v4u B0[8], B1[8], B2[8];
    const int tl = tb + per - 1;
#define CL(T) ((T) <= tl ? (T) : tl)
#define LD_IDS(ID, T) do { const unsigned o_ = (unsigned)A_IDX + (unsigned)(T) * 256u + g32; ID[0] = *(const GAS v4u*)(ws + o_); ID[1] = *(const GAS v4u*)(ws + (o_ + 16u)); } while (0)
#define LD_ACT(AV, T) do { const unsigned o_ = (unsigned)A_ACTG + (unsigned)(T) * 256u + g32; AV[0] = *(const GAS v4u*)(ws + o_); AV[1] = *(const GAS v4u*)(ws + (o_ + 16u)); } while (0)
#define ROW_FMA(RV, AVAL) do { v4u w_ = (RV); asm volatile("" : "+v"(w_.x), "+v"(w_.y), "+v"(w_.z), "+v"(w_.w)); float f[16]; unpack_fp8x16(w_, f); const float a = (AVAL); \
        _Pragma("unroll") for (int d = 0; d < 16; ++d) acc[d] += a * f[d]; } while (0)
#define ACC_HALF(BV, AV, H) do { _Pragma("unroll") for (int i = 0; i < 8; ++i) ROW_FMA(BV[i], SLOT_ACT(AV, 8 * (H) + i)); } while (0)
#define FINISH(T) do { _Pragma("unroll") for (int k = 0; k < 4; ++k) *(LAS f32x4*)(redw + 16 * k) = (f32x4){acc[4 * k], acc[4 * k + 1], acc[4 * k + 2], acc[4 * k + 3]}; \
        f32x2_t sm = *(const LAS f32x2_t*)(redr); \
        _Pragma("unroll") for (int gg = 1; gg < 8; ++gg) sm += *(const LAS f32x2_t*)(redr + gg * 512); \
        *(GAS unsigned*)(ws + ((unsigned)(A_POUT + 256 * x) + (unsigned)(T) * (DM * 2) + 4u * lane)) = pk2(sm.x, sm.y); \
        _Pragma("unroll") for (int d = 0; d < 16; ++d) acc[d] = 0.f; } while (0)
    float acc[16];
#pragma unroll
    for (int d = 0; d < 16; ++d) acc[d] = 0.f;
    LD_IDS(id0, tb); LD_IDS(id1, CL(tb + 1)); LD_IDS(id2, CL(tb + 2));
    LD_ROWS(B0, id0, 0); LD_ROWS(B1, id0, 1); LD_ACT(a0, tb);
    LD_ROWS(B2, id1, 0); LD_ACT(a1, CL(tb + 1));
    for (int t = tb; t < tb + per; t += 3) {
        ACC_HALF(B0, a0, 0); LD_ROWS(B0, id1, 1); LD_IDS(id0, CL(t + 3));
        ACC_HALF(B1, a0, 1); FINISH(t); LD_ROWS(B1, id2, 0); LD_ACT(a2, CL(t + 2));
        ACC_HALF(B2, a1, 0); LD_ROWS(B2, id2, 1); LD_IDS(id1, CL(t + 4));
        ACC_HALF(B0, a1, 1); FINISH(CL(t + 1)); LD_ROWS(B0, id0, 0); LD_ACT(a0, CL(t + 3));
        ACC_HALF(B1, a2, 0); LD_ROWS(B1, id0, 1); LD_IDS(id2, CL(t + 5));
        ACC_HALF(B2, a2, 1); FINISH(CL(t + 2)); LD_ROWS(B2, id1, 0); LD_ACT(a1, CL(t + 4));

    }
#undef CL
#undef ACC_HALF
#undef FINISH
#undef ROW_FMA
#undef LD_IDS
#undef LD_ACT
#undef LD_TOK
#undef LD_ROWS
#undef SLOT_ID
#undef SLOT_ACT
}
__device__ __forceinline__ void peer_final(const Args& A, int t, int lane) {
    unsigned char* ws = A.ws;
    const float* mod = (const float*)(ws + WS_MOD) + (size_t)(t >> 13) * NMOD; const bf16* POUT = (const bf16*)(ws + A_POUT);
    float* orow = A.out + (size_t)t * DM;
    f32x4 x2[4]; float s = 0.f;
#pragma unroll
    for (int j = 0; j < 4; ++j) { const int c = 256 * j + 4 * lane; const f32x4 x1 = *(const GAS f32x4*)(orow + c), gt = *(const GAS f32x4*)(mod + 5 * DM + c); const v2u w = *(const GAS v2u*)(POUT + (size_t)t * DM + c);
        f32x4 y; y[0] = x1[0] + gt[0] * bflo(w.x); y[1] = x1[1] + gt[1] * bfhi(w.x); y[2] = x1[2] + gt[2] * bflo(w.y); y[3] = x1[3] + gt[3] * bfhi(w.y);
        x2[j] = y; s += (y[0] * y[0] + y[1] * y[1]) + (y[2] * y[2] + y[3] * y[3]); }
    const float rr = 1.0f / sqrtf(wave_sum(s) * (1.f / DM) + EPS);
#pragma unroll
    for (int j = 0; j < 4; ++j) { const int c = 256 * j + 4 * lane; const f32x4 gf = *(const GAS f32x4*)(A.g_final + c); *(GAS f32x4*)(orow + c) = x2[j] * rr * gf; }
}

#ifndef MK_ONE_LAUNCH
#define MK_ONE_LAUNCH 1
#endif
constexpr int N_PHASES = 12;

__device__ __forceinline__ void biaspq_task(unsigned char* ws, int n, int lane) {
    const bf16* w = (const bf16*)(ws + WS_WPQ) + (size_t)n * DM + 16 * lane;
    float fa[8], fb[8]; unpack8(*(const GAS v4u*)w, fa); unpack8(*(const GAS v4u*)(w + 8), fb);
    float* bias = (float*)(ws + WS_BIASPQ);
#pragma unroll
    for (int b = 0; b < 4; ++b) { const GAS f32x4* sp = (const GAS f32x4*)((const float*)(ws + WS_MOD) + (size_t)b * NMOD + 3 * DM + 16 * lane);
        const f32x4 s0 = sp[0], s1 = sp[1], s2 = sp[2], s3 = sp[3]; float d = 0.f;
#pragma unroll
        for (int i = 0; i < 4; ++i) { d += fa[i] * s0[i]; d += fa[4 + i] * s1[i]; d += fb[i] * s2[i]; d += fb[4 + i] * s3[i]; }
        d = wave_sum(d); if (lane == 0) bias[b * 2048 + n] = d; }
}

__global__ void __launch_bounds__(NWAVES * 64, 2) mk_fwd(Args A) {
    extern __shared__ __attribute__((aligned(16))) unsigned char lds[];
    Frame F;
    F.lds = (LAS unsigned char*)lds;
    F.G = gridDim.x; { const int bx = blockIdx.x; F.vcu = (F.G % 8 == 0) ? (bx % 8) * (F.G / 8) + bx / 8 : bx; }
    F.NGW = F.G * NWAVES;
#define PHASE_BEGIN() do { int t_ = threadIdx.x; asm volatile("" : "+v"(t_)); F.tid = t_; F.lane = t_ & 63; F.wave = __builtin_amdgcn_readfirstlane(t_ >> 6); F.gw = F.vcu * NWAVES + F.wave; } while (0)
    PHASE_BEGIN();
    unsigned char* ws = A.ws;
    const int lo = A.ph_lo, hi = A.ph_hi;
#if MK_ONE_LAUNCH
    volatile LAS unsigned* MISC = (volatile LAS unsigned*)(F.lds + MISC_OFF);
    for (int u = F.tid; u < (LDS_BYTES - RING_BYTES) / 4; u += NWAVES * 64) ((LAS unsigned*)(F.lds + RING_BYTES))[u] = 0u;
    __syncthreads();
    XcdBarrier bar = xcd_barrier_post((unsigned*)(ws + WS_CTL) + CW_BAR, MISC + 8);
#define GRID_BAR() xcd_barrier(bar)
#else
#define GRID_BAR() do {} while (0)
#endif
#ifdef ONLY_PHASE
#define IN(k) ((k) == ONLY_PHASE && lo <= (k) && (k) < hi)
#else
#define IN(k) (lo <= (k) && (k) < hi)
#endif
#define BOTH(k) (IN(k) && IN((k) + 1))
#ifndef REPEAT_MASK
#define REPEAT_MASK 0
#endif
#define REPS(k) ((((REPEAT_MASK) >> (k)) & 1) + 1)

    if (IN(0)) for (int rep = 0; rep < REPS(0); ++rep) { PHASE_BEGIN(); if (rep) GRID_BAR(); p0_prologue(A, F); if (BOTH(0)) GRID_BAR(); }
    if (IN(1)) for (int rep = 0; rep < REPS(1); ++rep) { PHASE_BEGIN(); if (rep) GRID_BAR(); p1_hrows(A, F); if (BOTH(1)) GRID_BAR(); }
    if (IN(2)) for (int rep = 0; rep < REPS(2); ++rep) { PHASE_BEGIN(); if (rep) GRID_BAR();
        pg8::Gemm g{(const bf16*)((unsigned char*)A.out + O_H), (const bf16*)(ws + WS_WIN), TOK, NIN, DM / 2}; pg8::StaticOrder S; S.init(TOK, NIN, F.G, (int)blockIdx.x);
        EpiG1 E{(bf16*)(ws + A_QSB), (bf16*)(ws + A_KSB), (bf16*)(ws + A_VSB), (bf16*)(ws + A_QD), (bf16*)(ws + A_KD), (bf16*)(ws + A_VD), (bf16*)(ws + A_GSB), (bf16*)(ws + A_GD),
                (const float*)(ws + WS_ROPEC), (const float*)(ws + WS_ROPES), (const float*)(ws + WS_SA), (const float*)(ws + WS_SB)};
        pg8::gemm_phase<EpiG1, pg8::StaticOrder, true, true, true>(F.lds, g, S, E);
        if (BOTH(2)) GRID_BAR();
    }
    if (IN(3)) for (int rep = 0; rep < REPS(3); ++rep) { PHASE_BEGIN(); if (rep) GRID_BAR(); p3_attention(A, F, 0); GRID_BAR(); PHASE_BEGIN(); p3_attention(A, F, 1); if (BOTH(3)) GRID_BAR(); }
    if (IN(4)) for (int rep = 0; rep < REPS(4); ++rep) { PHASE_BEGIN(); if (rep) GRID_BAR();
        for (int n = F.gw; n < 2048; n += F.NGW) biaspq_task(ws, n, F.lane);
        __syncthreads();
        {   pg8::Gemm g{(const bf16*)((unsigned char*)A.out + O_OD), (const bf16*)(ws + WS_WDILO), TOK, DM, 256}; pg8::StaticOrder S; S.init(TOK, DM, F.G, (int)blockIdx.x);
            EpiMerge<false> E{(const bf16*)(ws + A_GD), (bf16*)(ws + A_MERGED)};
            pg8::gemm_phase<EpiMerge<false>, pg8::StaticOrder, true, true>(F.lds, g, S, E); }
        asm volatile("s_waitcnt vmcnt(0)" ::: "memory"); __syncthreads();
        {   pg8::Gemm g{(const bf16*)((unsigned char*)A.out + O_OSB), (const bf16*)(ws + WS_WSBO), TOK, DM, 512}; pg8::StaticOrder S; S.init(TOK, DM, F.G, (int)blockIdx.x);
            EpiMerge<true> E{(const bf16*)(ws + A_GSB), (bf16*)(ws + A_MERGED)};
            pg8::gemm_phase<EpiMerge<true>, pg8::StaticOrder, true, true>(F.lds, g, S, E); }
        if (BOTH(4)) GRID_BAR();
    }
    if (IN(5)) for (int rep = 0; rep < REPS(5); ++rep) { PHASE_BEGIN(); if (rep) GRID_BAR();
        pg8::Gemm g{(const bf16*)(ws + A_MERGED), (const bf16*)(ws + WS_WOUT), TOK, DM, DM}; pg8::StaticOrder S; S.init(TOK, DM, F.G, (int)blockIdx.x);
        EpiOut E{A.x, A.out, (bf16*)(ws + A_X1M), (float*)(ws + WS_SSQ), (const float*)(ws + WS_MOD), A.g_ffn};
        pg8::gemm_phase<EpiOut, pg8::StaticOrder, true, true>(F.lds, g, S, E);
        if (BOTH(5)) GRID_BAR();
    }
    if (IN(6)) for (int rep = 0; rep < REPS(6); ++rep) { PHASE_BEGIN(); if (rep) GRID_BAR();
        pg8::Gemm g{(const bf16*)(ws + A_X1M), (const bf16*)(ws + WS_WPQ), TOK, 2048, DM}; pg8::StaticOrder S; S.init(TOK, 2048, F.G, (int)blockIdx.x);
        EpiPq E{(const float*)(ws + WS_SSQ), (const float*)(ws + WS_BIASPQ), (bf16*)(ws + A_QPEER), (float*)(ws + WS_R2)};
        pg8::gemm_phase<EpiPq, pg8::StaticOrder, true, true>(F.lds, g, S, E);
        if (BOTH(6)) GRID_BAR();
    }
    if (IN(7)) for (int rep = 0; rep < REPS(7); ++rep) { PHASE_BEGIN(); if (rep) GRID_BAR();
        topk_phase((const bf16*)(ws + A_QPEER), (const bf16*)(ws + WS_KEYS), (unsigned short*)(ws + A_IDX), (float*)(ws + A_GATE), F);
        for (int t = F.gw; t < TOK; t += F.NGW) h2q_row(ws, t, F.lane);
        if (BOTH(7)) GRID_BAR();
    }
    if (IN(8)) for (int rep = 0; rep < REPS(8); ++rep) { PHASE_BEGIN(); if (rep) GRID_BAR();
        peer_u_phase(A, F); if (BOTH(8)) GRID_BAR(); }
    if (IN(9)) { PHASE_BEGIN();
#ifdef VALU_PROBE
        { float a0 = F.lane, a1 = a0 + 1, a2 = a0 + 2, a3 = a0 + 3; unsigned w0 = F.tid * 2654435761u, w1 = w0 ^ 0x3c3c3c3cu, w2 = w0 + 77u, w3 = w0 + 99u;
          f32x2_t p0 = {a0, a1}, p1 = {a2, a3}, p2 = {a1, a2}, p3 = {a3, a0};
          for (int it = 0; it < 4096; ++it) {
#if VALU_PROBE == 1
              f32x2_t c0 = __builtin_amdgcn_cvt_pk_f32_fp8((int)w0, false), c1 = __builtin_amdgcn_cvt_pk_f32_fp8((int)w1, true), c2 = __builtin_amdgcn_cvt_pk_f32_fp8((int)w2, false), c3 = __builtin_amdgcn_cvt_pk_f32_fp8((int)w3, true);
              f32x2_t c4 = __builtin_amdgcn_cvt_pk_f32_fp8((int)w0, true), c5 = __builtin_amdgcn_cvt_pk_f32_fp8((int)w1, false), c6 = __builtin_amdgcn_cvt_pk_f32_fp8((int)w2, true), c7 = __builtin_amdgcn_cvt_pk_f32_fp8((int)w3, false);
              w0 ^= __float_as_uint(c0.x) ^ __float_as_uint(c4.y); w1 ^= __float_as_uint(c1.x) ^ __float_as_uint(c5.y); w2 ^= __float_as_uint(c2.x) ^ __float_as_uint(c6.y); w3 ^= __float_as_uint(c3.x) ^ __float_as_uint(c7.y);
#elif VALU_PROBE == 2
              p0 = p0 * p1 + p2; p1 = p1 * p2 + p3; p2 = p2 * p3 + p0; p3 = p3 * p0 + p1; p0 = p0 * p2 + p1; p1 = p1 * p3 + p2; p2 = p2 * p0 + p3; p3 = p3 * p1 + p0;
#else
              a0 = a0 * a1 + a2; a1 = a1 * a2 + a3; a2 = a2 * a3 + a0; a3 = a3 * a0 + a1; a0 = a0 * a2 + a1; a1 = a1 * a3 + a2; a2 = a2 * a0 + a3; a3 = a3 * a1 + a0;
#endif
          }
          if (a0 + a1 + a2 + a3 + p0.x + p1.y + p2.x + p3.y == 1.2345e33f || (w0 ^ w1 ^ w2 ^ w3) == 0x12345u) ((float*)(ws + WS_DUMP))[F.lane] = a0; }
#endif
#ifdef ICACHE_PROBE
        asm volatile(".rept 8000\n s_nop 0\n .endr" ::: "memory");
#endif
        peer_act_phase(A, F); if (BOTH(9)) GRID_BAR(); }
    if (IN(10)) for (int rep = 0; rep < REPS(10); ++rep) { PHASE_BEGIN(); if (rep) GRID_BAR(); peer_v_phase(A, F); if (BOTH(10)) GRID_BAR(); }
    if (IN(11)) { PHASE_BEGIN();
        for (int t = F.gw; t < TOK; t += F.NGW) peer_final(A, t, F.lane);
    }
#undef IN
#undef BOTH
}

extern "C" void kernel_launch(void* const* d_in, const int* in_sizes, int n_in, void* d_out, int out_size, void* d_ws, size_t ws_size, hipStream_t stream) {
    static int grid = 0;
    if (grid == 0) {
        if (n_in != 15 || in_sizes[0] != TOK * DM || out_size != TOK * DM || ws_size < WS_END) { fprintf(stderr, "kernel_launch: unexpected shapes (n_in %d, in0 %d, out %d, ws %zu < %zu)\n", n_in, n_in > 0 ? in_sizes[0] : -1, out_size, ws_size, (size_t)WS_END); grid = -1; return; }
        int dev = 0, cus = 0, per_cu = 0;
        if (hipGetDevice(&dev) != hipSuccess || hipDeviceGetAttribute(&cus, hipDeviceAttributeMultiprocessorCount, dev) != hipSuccess) { grid = -1; return; }
        if (hipFuncSetAttribute((const void*)mk_fwd, hipFuncAttributeMaxDynamicSharedMemorySize, LDS_BYTES) != hipSuccess) { fprintf(stderr, "kernel_launch: hipFuncSetAttribute failed\n"); grid = -1; return; }
        if (hipOccupancyMaxActiveBlocksPerMultiprocessor(&per_cu, (const void*)mk_fwd, NWAVES * 64, LDS_BYTES) != hipSuccess || per_cu < 1) { fprintf(stderr, "kernel_launch: occupancy query says %d\n", per_cu); per_cu = 1; }
        (void)hipGetLastError();
        grid = cus;
    }
    if (grid < 0) return;
    (void)hipMemsetAsync((char*)d_ws + WS_CTL, 0, CTL_ZERO_BYTES, stream);
    Args a{};
    a.x = (const float*)d_in[0]; a.c = (const float*)d_in[1]; a.w_ada = (const float*)d_in[2]; a.b_ada = (const float*)d_in[3]; a.g_mix = (const float*)d_in[4];
    a.w_in = (const float*)d_in[5]; a.w_sb_o = (const float*)d_in[6]; a.w_dil_o = (const float*)d_in[7]; a.w_out = (const float*)d_in[8]; a.g_ffn = (const float*)d_in[9];
    a.w_pq = (const float*)d_in[10]; a.peer_keys = (const float*)d_in[11]; a.peer_u = (const float*)d_in[12]; a.peer_v = (const float*)d_in[13]; a.g_final = (const float*)d_in[14];
    a.out = (float*)d_out; a.ws = (unsigned char*)d_ws;
#if MK_ONE_LAUNCH
    a.ph_lo = 0; a.ph_hi = N_PHASES;
    void* args[] = {&a};
    hipError_t e = hipLaunchCooperativeKernel((const void*)mk_fwd, dim3(grid), dim3(NWAVES * 64), args, LDS_BYTES, stream);
    if (e != hipSuccess) fprintf(stderr, "kernel_launch: cooperative launch failed: %s (grid %d)\n", hipGetErrorString(e), grid);
#else
    for (int p = 0; p < N_PHASES; ++p) { a.ph_lo = p; a.ph_hi = p + 1; hipLaunchKernelGGL(mk_fwd, dim3(grid), dim3(NWAVES * 64), LDS_BYTES, stream, a); }
#endif
}
```
